# Optimizing an MI355X kernel written in HIP

```python
import jax, jax.numpy as jnp
from jax import lax
import numpy as np

D_MODEL = 1024
BATCH = 16
SEQ = 256
DEPTH = 4
DEC_BATCH = 4
DEC_SEQ = 2048
PAST_LEN = 512

GRID_W = 64
N_EVEN = (DEPTH + 1) // 2
N_ODD = DEPTH // 2
MIX_A = D_MODEL // 2
MIX_B = D_MODEL - MIX_A
GLA_HEADS = 4
GLA_DV = MIX_A // GLA_HEADS
GLA_DK = GLA_DV // 2
GLA_QK = GLA_HEADS * GLA_DK
GATE_RANK = 16
GATE_TAU = 16.0
CHUNK = 32
POOL_WINDOWS = (2, 4, 8, 16)
POOL_GROUPS = len(POOL_WINDOWS)
POOL_GW = MIX_B // POOL_GROUPS
MIX_C = D_MODEL // 2
MIX_D = D_MODEL - MIX_C
FOURIER_GROUPS = 4
FOURIER_GW = MIX_C // FOURIER_GROUPS
CONV_W = 3
D_FF = 4 * D_MODEL
EPS = 1e-6
EVEN_IN = 2 * GLA_QK + 2 * MIX_A + 2 * GATE_RANK + MIX_B
ODD_IN = MIX_C + 3 * MIX_D

kernel_name = 'hybrid_diffusion_gla_pool_fourier_conv_step'


def rmsnorm(x, g):
    xf = x.astype(jnp.float32)
    y = xf * lax.rsqrt(jnp.mean(xf * xf, axis=-1, keepdims=True) + EPS)
    return (y * g.astype(jnp.float32)).astype(x.dtype)


def grid_pos_embed(n_tok):
    rows = n_tok // GRID_W
    r = jnp.broadcast_to(jnp.arange(rows, dtype=jnp.float32)[:, None], (rows, GRID_W)).reshape(-1)
    col = jnp.broadcast_to(jnp.arange(GRID_W, dtype=jnp.float32)[None, :], (rows, GRID_W)).reshape(-1)
    quarter = D_MODEL // 4
    freqs = 1.0 / (10000.0 ** (jnp.arange(quarter, dtype=jnp.float32) / quarter))
    ar = r[:, None] * freqs
    ac = col[:, None] * freqs
    return jnp.concatenate([jnp.sin(ar), jnp.cos(ar), jnp.sin(ac), jnp.cos(ac)], axis=-1)


def gla_scan(q, k, v, logf, s0):
    B, L, H, DK = q.shape
    n = L // CHUNK

    def to_chunks(a):
        return jnp.moveaxis(a.reshape(B, n, CHUNK, *a.shape[2:]), 1, 0)

    mask = jnp.tril(jnp.ones((CHUNK, CHUNK), dtype=bool))

    def step(S, inp):
        qc, kc, vc, gc = inp
        b = jnp.cumsum(gc, axis=1)
        b_last = b[:, -1]
        o_inter = jnp.einsum('bihd,bhde->bihe', qc * jnp.exp(b), S)
        diff = b[:, :, None] - b[:, None, :]
        decay = jnp.exp(jnp.where(mask[None, :, :, None, None], diff, -jnp.inf))
        att = jnp.einsum('bihd,bjhd,bijhd->bhij', qc, kc, decay)
        o = o_inter + jnp.einsum('bhij,bjhe->bihe', att, vc)
        S_new = S * jnp.exp(b_last)[..., None] + jnp.einsum(
            'bjhd,bjhe->bhde', kc * jnp.exp(b_last[:, None] - b), vc)
        return S_new, o

    S_fin, o = lax.scan(step, s0, (to_chunks(q), to_chunks(k), to_chunks(v), to_chunks(logf)))
    o = jnp.moveaxis(o, 0, 1).reshape(B, L, H, v.shape[-1])
    return o, S_fin


def multiscale_pool(u, pool_w, pool_s):
    B, L, _ = u.shape
    uf = u.astype(jnp.float32)
    cs = jnp.concatenate([jnp.zeros((B, 1, MIX_B), jnp.float32), jnp.cumsum(uf, axis=1)], axis=1)
    t = jnp.arange(L)
    outs = []
    for gi, w in enumerate(POOL_WINDOWS):
        csg = cs[:, :, gi * POOL_GW:(gi + 1) * POOL_GW]
        lo = jnp.clip(t - w // 2, 0, L)
        hi = jnp.clip(t + w - w // 2, 0, L)
        cnt = (hi - lo).astype(jnp.float32)[None, :, None]
        outs.append((jnp.take(csg, hi, axis=1) - jnp.take(csg, lo, axis=1)) / cnt)
    pooled = (jnp.concatenate(outs, axis=-1) - uf).reshape(B, L, POOL_GROUPS, POOL_GW)
    y = jnp.einsum('blgc,gcd->blgd', pooled, pool_w.astype(jnp.float32)).reshape(B, L, MIX_B)
    return (y * pool_s.astype(jnp.float32)).astype(u.dtype)


def even_mixer(h, s0, w_in, w_a2, b_a2, gla_g, pool_w, pool_s, w_out):
    B, L, _ = h.shape
    f32 = jnp.float32
    p = h @ w_in
    o1 = GLA_QK
    o2 = o1 + GLA_QK
    o3 = o2 + MIX_A
    o4 = o3 + MIX_A
    o5 = o4 + 2 * GATE_RANK
    q = p[..., :o1].astype(f32).reshape(B, L, GLA_HEADS, GLA_DK) * (GLA_DK ** -0.5)
    k = p[..., o1:o2].astype(f32).reshape(B, L, GLA_HEADS, GLA_DK)
    v = p[..., o2:o3].astype(f32).reshape(B, L, GLA_HEADS, GLA_DV)
    g = p[..., o3:o4]
    glr = p[..., o4:o5].astype(f32).reshape(B, L, 2, GATE_RANK)
    u = p[..., o5:]
    pre = jnp.einsum('blzr,zrk->blzk', glr, w_a2.astype(f32)) + b_a2.astype(f32)
    logf = (jax.nn.log_sigmoid(pre) / GATE_TAU).reshape(B, L, 2, GLA_HEADS, GLA_DK)
    s0 = s0.astype(f32)
    o_f, s_f = gla_scan(q, k, v, logf[:, :, 0], s0[:, 0])
    o_b, s_b = gla_scan(jnp.flip(q, 1), jnp.flip(k, 1), jnp.flip(v, 1), jnp.flip(logf[:, :, 1], 1), s0[:, 1])
    o = o_f + jnp.flip(o_b, 1)
    o = o * lax.rsqrt(jnp.mean(o * o, axis=-1, keepdims=True) + EPS) * gla_g.astype(f32)
    o = o.reshape(B, L, MIX_A).astype(h.dtype) * jax.nn.silu(g)
    y_pool = multiscale_pool(u, pool_w, pool_s)
    y = jnp.concatenate([o, y_pool], axis=-1) @ w_out
    return y, jnp.stack([s_f, s_b], axis=1)


def odd_mixer(h, w_in, conv_w, conv_b, w_out):
    B, L, _ = h.shape
    p = h @ w_in
    f = p[..., :MIX_C]
    xin = p[..., MIX_C:MIX_C + MIX_D]
    bg = p[..., MIX_C + MIX_D:MIX_C + 2 * MIX_D]
    cg = p[..., MIX_C + 2 * MIX_D:]
    ff = f.astype(jnp.float32).reshape(B, L, FOURIER_GROUPS, FOURIER_GW)
    four = jnp.real(jnp.fft.fft2(ff, axes=(1, 3), norm='ortho')).reshape(B, L, MIX_C).astype(h.dtype)
    z = cg * xin
    pad = CONV_W // 2
    zp = jnp.pad(z, ((0, 0), (pad, CONV_W - 1 - pad), (0, 0)))
    conv = conv_b
    for j in range(CONV_W):
        conv = conv + zp[:, j:j + L] * conv_w[j]
    y_conv = bg * conv
    return jnp.concatenate([four, y_conv], axis=-1) @ w_out


def sq_relu_mlp(h, w1, w2):
    a = jax.nn.relu(h @ w1)
    return (a * a) @ w2


def trunk(x, cond, gla_init, norm_g, final_g, w_ada, b_ada, w_mlp1, w_mlp2,
          w_in_even, w_a2, b_a2, gla_norm_g, pool_w, pool_s, w_out_even,
          w_in_odd, conv_w, conv_b, w_out_odd):
    states = []
    for l in range(DEPTH):
        m = jax.nn.silu(cond) @ w_ada[l] + b_ada[l]
        sh1, sc1, g1, sh2, sc2, g2 = jnp.split(m, 6, axis=-1)
        h = rmsnorm(x, norm_g[l, 0]) * (1 + sc1) + sh1
        j = l // 2
        if l % 2 == 0:
            y, s = even_mixer(h, gla_init[:, j], w_in_even[j], w_a2[j], b_a2[j], gla_norm_g[j],
                              pool_w[j], pool_s[j], w_out_even[j])
            states.append(s)
        else:
            y = odd_mixer(h, w_in_odd[j], conv_w[j], conv_b[j], w_out_odd[j])
        x = x + g1 * y
        h = rmsnorm(x, norm_g[l, 1]) * (1 + sc2) + sh2
        x = x + g2 * sq_relu_mlp(h, w_mlp1[l], w_mlp2[l])
    return rmsnorm(x, final_g), jnp.stack(states, axis=1)


def setup_inputs(seed: int = 0) -> dict:
    key = jax.random.key(seed)
    ks = jax.random.split(key, 24)
    f32 = jnp.float32

    def nrm(k, shape, std):
        return jax.random.normal(k, shape, f32) * std

    return {
        'x_prompt': nrm(ks[0], (BATCH, SEQ, D_MODEL), 1.0),
        'x_sample': nrm(ks[1], (DEC_BATCH, DEC_SEQ, D_MODEL), 1.0),
        'state_gla': nrm(ks[2], (DEC_BATCH, N_EVEN, 2, GLA_HEADS, GLA_DK, GLA_DV), 2.0),
        'c': nrm(ks[3], (DEC_BATCH, D_MODEL), 1.0),
        'c_ctx': nrm(ks[4], (D_MODEL,), 1.0),
        'norm_g': 1.0 + nrm(ks[5], (DEPTH, 2, D_MODEL), 0.05),
        'final_g': 1.0 + nrm(ks[6], (D_MODEL,), 0.05),
        'w_ada': nrm(ks[7], (DEPTH, D_MODEL, 6 * D_MODEL), 0.5 * D_MODEL ** -0.5),
        'b_ada': nrm(ks[8], (DEPTH, 6 * D_MODEL), 0.02),
        'w_mlp1': nrm(ks[9], (DEPTH, D_MODEL, D_FF), D_MODEL ** -0.5),
        'w_mlp2': nrm(ks[10], (DEPTH, D_FF, D_MODEL), D_FF ** -0.5),
        'w_in_even': nrm(ks[11], (N_EVEN, D_MODEL, EVEN_IN), D_MODEL ** -0.5),
        'w_a2': nrm(ks[12], (N_EVEN, 2, GATE_RANK, GLA_QK), GATE_RANK ** -0.5),
        'b_a2': nrm(ks[13], (N_EVEN, 2, GLA_QK), 0.1),
        'gla_norm_g': 1.0 + nrm(ks[14], (N_EVEN, GLA_DV), 0.05),
        'pool_w': nrm(ks[15], (N_EVEN, POOL_GROUPS, POOL_GW, POOL_GW), POOL_GW ** -0.5),
        'pool_s': 1.0 + nrm(ks[16], (N_EVEN, MIX_B), 0.05),
        'w_out_even': nrm(ks[17], (N_EVEN, D_MODEL, D_MODEL), D_MODEL ** -0.5),
        'w_in_odd': nrm(ks[18], (N_ODD, D_MODEL, ODD_IN), D_MODEL ** -0.5),
        'conv_w': nrm(ks[19], (N_ODD, CONV_W, MIX_D), CONV_W ** -0.5),
        'conv_b': nrm(ks[20], (N_ODD, MIX_D), 0.02),
        'w_out_odd': nrm(ks[21], (N_ODD, D_MODEL, D_MODEL), D_MODEL ** -0.5),
    }


def reference(x_prompt, x_sample, state_gla, c, c_ctx, norm_g, final_g, w_ada, b_ada, w_mlp1, w_mlp2,
              w_in_even, w_a2, b_a2, gla_norm_g, pool_w, pool_s, w_out_even,
              w_in_odd, conv_w, conv_b, w_out_odd):
    zero_state = jnp.zeros((x_prompt.shape[0], N_EVEN, 2, GLA_HEADS, GLA_DK, GLA_DV), jnp.float32)
    y_prompt, new_state_gla = trunk(
        x_prompt, c_ctx[None, None, :], zero_state, norm_g, final_g, w_ada, b_ada, w_mlp1, w_mlp2,
        w_in_even, w_a2, b_a2, gla_norm_g, pool_w, pool_s, w_out_even, w_in_odd, conv_w, conv_b, w_out_odd)
    n_lat = x_sample.shape[1]
    x_lat = x_sample + grid_pos_embed(n_lat).astype(x_sample.dtype)[None]
    y_sample, _ = trunk(
        x_lat, c[:, None, :], state_gla, norm_g, final_g, w_ada, b_ada, w_mlp1, w_mlp2,
        w_in_even, w_a2, b_a2, gla_norm_g, pool_w, pool_s, w_out_even, w_in_odd, conv_w, conv_b, w_out_odd)
    return (y_prompt, y_sample, new_state_gla.astype(x_prompt.dtype))
```

```cpp
#include <hip/hip_runtime.h>
#include <hip/hip_cooperative_groups.h>
#include <cstdio>
#include <cstdint>
namespace cg = cooperative_groups;

#ifndef DBG_SEL
#define DBG_SEL 63
#endif
#ifndef DBG_NP
#define DBG_NP(x) (x)
#endif
#ifndef DBG_SINIT
#define DBG_SINIT 1
#endif
#ifndef EN
#define EN 31
#endif
#ifndef MULTI_LAUNCH
#define MULTI_LAUNCH 0
#endif

#define LAS __attribute__((address_space(3)))
typedef unsigned short bf16_t;
typedef short bf16x8 __attribute__((ext_vector_type(8)));
typedef float f32x4 __attribute__((ext_vector_type(4)));
typedef unsigned u32x2 __attribute__((ext_vector_type(2)));
typedef unsigned u32x4 __attribute__((ext_vector_type(4)));

constexpr int DM = 1024, NTOK = 12288, NPROMPT = 4096, DFF = 4096;
constexpr int LDS_BYTES = 147456;
constexpr int NPH = 36;
constexpr size_t MBy = 1048576;
constexpr size_t OFF_W1T = 0, OFF_W2T = 32 * MBy, OFF_WIE = 64 * MBy, OFF_WOE = 74 * MBy, OFF_WIO = 78 * MBy, OFF_WOO = 88 * MBy;
constexpr size_t OFF_T2K = 92 * MBy, OFF_T256 = 108 * MBy, OFF_MOD = 108 * MBy + 262144, OFF_U = 109 * MBy, OFF_DTOT = 117 * MBy;
constexpr size_t OFF_X = 118 * MBy, OFF_H = 166 * MBy, OFF_AMIX = 190 * MBy, OFF_BIG = 214 * MBy, WS_NEED = 348 * MBy;
constexpr size_t OFF_HID = OFF_BIG;
constexpr size_t OFF_QB = OFF_BIG, OFF_KB = OFF_BIG + 6 * MBy, OFF_VT = OFF_BIG + 12 * MBy, OFF_GATE = OFF_BIG + 24 * MBy, OFF_LOGF = OFF_BIG + 36 * MBy;
constexpr size_t OFF_UB = OFF_BIG + 60 * MBy, OFF_ODIR = OFF_BIG + 72 * MBy;
constexpr size_t OFF_XTS = OFF_BIG, OFF_XTP = OFF_BIG + 16 * MBy, OFF_XIN = OFF_BIG + 24 * MBy, OFF_BG = OFF_BIG + 36 * MBy, OFF_CG = OFF_BIG + 48 * MBy;
constexpr size_t OFF_FACCP = OFF_BIG + 60 * MBy, OFF_FACCS = OFF_BIG + 68 * MBy;
constexpr size_t OUT_STATE = (size_t)NTOK * DM;

struct Params { const float* in[22]; float* out; unsigned char* ws; int ph_lo, ph_hi; };
typedef const __attribute__((address_space(4))) Params* PP;
enum { I_XP = 0, I_XS, I_STATE, I_C, I_CCTX, I_NORMG, I_FINALG, I_WADA, I_BADA, I_W1, I_W2, I_WINE, I_WA2, I_BA2, I_GLAG, I_POOLW, I_POOLS, I_WOUTE, I_WINO, I_CONVW, I_CONVB, I_WOUTO };

__device__ __forceinline__ int otid() { int t = __builtin_amdgcn_workitem_id_x(); asm volatile("" : "+v"(t)); return t; }
__device__ __forceinline__ int obid() { int b = __builtin_amdgcn_workgroup_id_x(); asm volatile("" : "+s"(b)); return b; }
typedef float f32x2 __attribute__((ext_vector_type(2)));
typedef __bf16 bf16x2v __attribute__((ext_vector_type(2)));
__device__ __forceinline__ unsigned pk2(float lo, float hi) { f32x2 v = {lo, hi}; bf16x2v b = __builtin_convertvector(v, bf16x2v); return __builtin_bit_cast(unsigned, b); }
__device__ __forceinline__ bf16_t f2bf(float x) { return (bf16_t)(pk2(x, 0.f) & 0xffffu); }
__device__ __forceinline__ float bf2f(bf16_t u) { return __uint_as_float(((unsigned)u) << 16); }
__device__ __forceinline__ float bflo(unsigned u) { return __uint_as_float(u << 16); }
__device__ __forceinline__ float bfhi(unsigned u) { return __uint_as_float(u & 0xffff0000u); }
__device__ __forceinline__ float wave_sum(float v) {
#pragma unroll
    for (int o = 1; o < 64; o <<= 1) v += __shfl_xor(v, o);
    return v;
}
__device__ __forceinline__ float siluf(float x) { return x / (1.f + __expf(-x)); }
__device__ __forceinline__ float logsigmoidf(float x) { return fminf(x, 0.f) - log1pf(__expf(-fabsf(x))); }
__device__ __forceinline__ int cond_of_seg(int pm) { return pm < 16 ? 0 : 1 + ((pm - 16) >> 3); }

namespace pg8 {
constexpr int BM = 256, BK = 64, HALF = 128, HTB = HALF * BK * 2, STAGE_BYTES = 8 * HTB, NXCD = 8, WGM = 8;
__host__ __device__ __forceinline__ int lds_byte(int r, int c) { const int st = (r >> 4) * 2 + (c >> 5), rr = r & 15, cc = c & 31, ob = rr * 64 + cc * 2; return st * 1024 + (ob ^ (((ob >> 9) & 1) << 5)); }
__host__ __device__ __forceinline__ void stage_rc(int b, int& R, int& C) { const int st = b / 1024, sb = b % 1024, swz = sb ^ (((sb >> 9) & 1) << 5); R = (st >> 1) * 16 + swz / 64; C = (st & 1) * 32 + (swz % 64) / 2; }
}

enum { KD_BF16 = 0, KD_SILU, KD_RELU2, KD_LOGF, KD_RES, KD_ATOM };
enum { T_IN_EVEN = 0, T_IN_ODD, T_OUT_EVEN, T_OUT_ODD, T_MLP1, T_MLP2, T_DFT_S, T_DFT_P };
struct Unit { int pm, pn; };
struct UnitIO { const char* A; const char* B; char* out; const float* aux; int kind; int ld; };
struct GemmCfg { int type, j, l, nM, nN, ld, nt, G, c; };

__device__ __forceinline__ void make_unit(const GemmCfg& g, int pm, int pn, UnitIO& u) {
    PP Pq = (PP)__builtin_amdgcn_kernarg_segment_ptr();
    unsigned char* ws = Pq->ws;
    const size_t rowA = (size_t)pm * 256 * 1024 * 2;
    u.aux = nullptr; u.kind = KD_BF16; u.ld = 512;
    const float* modp = (const float*)(ws + OFF_MOD) + (size_t)(g.l * 5 + cond_of_seg(pm)) * 6144;
    switch (g.type) {
    case T_IN_EVEN: {
        const char* W = (const char*)(ws + OFF_WIE) + (size_t)g.j * 2560 * 1024 * 2 + (size_t)pn * 256 * 1024 * 2;
        const char* Hh = (const char*)(ws + OFF_H) + rowA;
        u.A = Hh; u.B = W;
        if (pn == 0) { u.out = (char*)(ws + OFF_QB) + (size_t)pm * 256 * 256 * 2; u.ld = 256; }
        else if (pn == 1) { u.out = (char*)(ws + OFF_KB) + (size_t)pm * 256 * 256 * 2; u.ld = 256; }
        else if (pn < 4) { u.A = W; u.B = Hh; u.out = (char*)(ws + OFF_VT) + ((size_t)(pn - 2) * 256 * NTOK + (size_t)pm * 256) * 2; u.ld = NTOK; }
        else if (pn < 6) { u.out = (char*)(ws + OFF_GATE) + ((size_t)pm * 256 * 512 + (pn - 4) * 256) * 2; u.kind = KD_SILU; }
        else if (pn < 8) { u.out = (char*)(ws + OFF_LOGF) + ((size_t)pm * 256 * 512 + (pn - 6) * 256) * 4; u.kind = KD_LOGF; u.aux = Pq->in[I_BA2] + g.j * 512 + (pn - 6) * 256; }
        else { u.out = (char*)(ws + OFF_UB) + ((size_t)pm * 256 * 512 + (pn - 8) * 256) * 2; }
    } break;
    case T_IN_ODD: {
        const char* W = (const char*)(ws + OFF_WIO) + (size_t)g.j * 2560 * 1024 * 2 + (size_t)pn * 256 * 1024 * 2;
        const char* Hh = (const char*)(ws + OFF_H) + rowA;
        u.A = Hh; u.B = W;
        if (pn < 4) {
            u.A = W; u.B = Hh;
            const int z = pn >> 1, ch0 = (pn & 1) * 256;
            if (pm < 16) { u.out = (char*)(ws + OFF_XTP) + ((size_t)(pm * 512 + ch0) * 512 + z * 256) * 2; u.ld = 512; }
            else { const int b = (pm - 16) >> 3, part = (pm - 16) & 7; u.out = (char*)(ws + OFF_XTS) + ((size_t)(b * 512 + ch0) * 4096 + z * 2048 + part * 256) * 2; u.ld = 4096; }
        } else {
            const size_t base = (pn < 6) ? OFF_XIN : (pn < 8 ? OFF_BG : OFF_CG);
            u.out = (char*)(ws + base) + ((size_t)pm * 256 * 512 + (pn & 1) * 256) * 2;
        }
    } break;
    case T_OUT_EVEN: case T_OUT_ODD: {
        u.A = (const char*)(ws + OFF_AMIX) + rowA;
        u.B = (const char*)(ws + (g.type == T_OUT_EVEN ? OFF_WOE : OFF_WOO)) + (size_t)g.j * 1024 * 1024 * 2 + (size_t)pn * 256 * 1024 * 2;
        u.out = (char*)(ws + OFF_X) + ((size_t)pm * 256 * 1024 + pn * 256) * 4; u.ld = 1024; u.kind = KD_RES; u.aux = modp + 2048 + pn * 256;
    } break;
    case T_MLP1: {
        u.A = (const char*)(ws + OFF_H) + rowA;
        u.B = (const char*)(ws + OFF_W1T) + (size_t)g.l * 4096 * 1024 * 2 + (size_t)pn * 256 * 1024 * 2;
        u.out = (char*)(ws + OFF_HID) + ((size_t)pm * 256 * 4096 + pn * 256) * 2; u.ld = 4096; u.kind = KD_RELU2;
    } break;
    case T_MLP2: {
        u.A = (const char*)(ws + OFF_HID) + (size_t)pm * 256 * 4096 * 2;
        u.B = (const char*)(ws + OFF_W2T) + (size_t)g.l * 4096 * 1024 * 2 + (size_t)pn * 256 * 4096 * 2;
        u.out = (char*)(ws + OFF_X) + ((size_t)pm * 256 * 1024 + pn * 256) * 4; u.ld = 1024; u.kind = KD_RES; u.aux = modp + 5120 + pn * 256;
    } break;
    case T_DFT_S: {
        const int pnb = pn >> 2, ks = pn & 3;
        u.A = (const char*)(ws + OFF_T2K) + ((size_t)pm * 256 * 4096 + ks * 1024) * 2;
        u.B = (const char*)(ws + OFF_XTS) + ((size_t)pnb * 256 * 4096 + ks * 1024) * 2;
        u.out = (char*)(ws + OFF_FACCS) + ((size_t)ks * 8192 * 512 + (size_t)((pnb >> 1) * 2048 + pm * 256) * 512 + (pnb & 1) * 256) * 4; u.kind = KD_ATOM;
    } break;
    default: {
        u.A = (const char*)(ws + OFF_T256);
        u.B = (const char*)(ws + OFF_XTP) + (size_t)pn * 256 * 512 * 2;
        u.out = (char*)(ws + OFF_FACCP) + ((size_t)((pn >> 1) * 256) * 512 + (pn & 1) * 256) * 4; u.kind = KD_ATOM;
    } break;
    }
}

__device__ __forceinline__ bool next_unit(const GemmCfg& g, int i, Unit& u) {
    const int nwg = g.nM * g.nN;
    const long L = (long)i * g.G + g.c; if (L >= nwg) return false;
    int wgid = (int)L; { const int q = nwg / pg8::NXCD, r = nwg % pg8::NXCD, xcd = wgid % pg8::NXCD, off = wgid / pg8::NXCD; wgid = (xcd < r ? xcd * (q + 1) : r * (q + 1) + (xcd - r) * q) + off; }
    const int nig = pg8::WGM * g.nN, gid = wgid / nig, fm = gid * pg8::WGM, gsz = (g.nM - fm) < pg8::WGM ? (g.nM - fm) : pg8::WGM;
    const int pm = fm + ((wgid % nig) % gsz), pn = (wgid % nig) / gsz;
    u.pm = pm; u.pn = pn; return true;
}

__device__ __forceinline__ void epilogue(const f32x4 (&acc)[2][2][4][2], const GemmCfg& g, const Unit& uu, int wr, int wc, int fr, int fq) {
    UnitIO u; make_unit(g, uu.pm, uu.pn, u);
    const int row0 = wr * 64 + fr, col0 = wc * 32 + 4 * fq;
    const int kind = u.kind, ld = u.ld;
    if (kind <= KD_RELU2) {
        bf16_t* O = (bf16_t*)u.out;
#pragma unroll
        for (int ai = 0; ai < 2; ++ai)
#pragma unroll
            for (int m = 0; m < 4; ++m) {
                bf16_t* rowp = O + (size_t)(row0 + ai * 128 + m * 16) * ld + col0;
#pragma unroll
                for (int bj = 0; bj < 2; ++bj)
#pragma unroll
                    for (int n = 0; n < 2; ++n) {
                        f32x4 v = acc[ai][bj][m][n];
                        if (kind == KD_SILU) { v[0] = siluf(v[0]); v[1] = siluf(v[1]); v[2] = siluf(v[2]); v[3] = siluf(v[3]); }
                        else if (kind == KD_RELU2) { v[0] = fmaxf(v[0], 0.f); v[1] = fmaxf(v[1], 0.f); v[2] = fmaxf(v[2], 0.f); v[3] = fmaxf(v[3], 0.f); v = v * v; }
                        u32x2 o; o.x = pk2(v[0], v[1]); o.y = pk2(v[2], v[3]);
                        *(u32x2*)(rowp + bj * 128 + n * 16) = o;
                    }
            }
    } else if (kind == KD_RES) {
        float* O = (float*)u.out;
        f32x4 gv[2][2];
#pragma unroll
        for (int bj = 0; bj < 2; ++bj)
#pragma unroll
            for (int n = 0; n < 2; ++n) gv[bj][n] = *(const f32x4*)(u.aux + col0 + bj * 128 + n * 16);
#pragma unroll
        for (int ai = 0; ai < 2; ++ai)
#pragma unroll
            for (int m = 0; m < 4; ++m) {
                float* rowp = O + (size_t)(row0 + ai * 128 + m * 16) * ld + col0;
#pragma unroll
                for (int bj = 0; bj < 2; ++bj)
#pragma unroll
                    for (int n = 0; n < 2; ++n) { f32x4* p = (f32x4*)(rowp + bj * 128 + n * 16); *p = *p + gv[bj][n] * acc[ai][bj][m][n]; }
            }
    } else if (kind == KD_LOGF) {
        float* O = (float*)u.out;
#pragma unroll
        for (int bj = 0; bj < 2; ++bj)
#pragma unroll
            for (int n = 0; n < 2; ++n) {
                const f32x4 bv = *(const f32x4*)(u.aux + col0 + bj * 128 + n * 16);
#pragma unroll
                for (int ai = 0; ai < 2; ++ai)
#pragma unroll
                    for (int m = 0; m < 4; ++m) {
                        f32x4 v = acc[ai][bj][m][n] + bv;
                        v[0] = logsigmoidf(v[0]) * 0.0625f; v[1] = logsigmoidf(v[1]) * 0.0625f; v[2] = logsigmoidf(v[2]) * 0.0625f; v[3] = logsigmoidf(v[3]) * 0.0625f;
                        *(f32x4*)(O + (size_t)(row0 + ai * 128 + m * 16) * ld + col0 + bj * 128 + n * 16) = v;
                    }
            }
    } else {
        float* O = (float*)u.out;
#pragma unroll
        for (int ai = 0; ai < 2; ++ai)
#pragma unroll
            for (int m = 0; m < 4; ++m) {
                float* rowp = O + (size_t)(row0 + ai * 128 + m * 16) * ld + col0;
#pragma unroll
                for (int bj = 0; bj < 2; ++bj)
#pragma unroll
                    for (int n = 0; n < 2; ++n) {
                        *(f32x4*)(rowp + bj * 128 + n * 16) = acc[ai][bj][m][n];
                    }
            }
    }
}

__device__ __forceinline__ void gemm_phase(LAS unsigned char* lds, const GemmCfg& g) {
    using namespace pg8;
    const int tid = otid(), wid = __builtin_amdgcn_readfirstlane(tid >> 6), lane = tid & 63, wr = wid >> 2, wc = wid & 3, fr = lane & 15, fq = lane >> 4;
    const int nt = g.nt;
    unsigned voffA[2];
#pragma unroll
    for (int i = 0; i < 2; ++i) { int R, C; stage_rc(tid * 16 + i * 8192, R, C); voffA[i] = (unsigned)(R * g.ld + C) * 2u; }
#define voffB voffA
    const size_t kstep = (size_t)(BK * 2);
    const size_t hstepA = (size_t)HALF * g.ld * 2;
#define hstepB hstepA
    const unsigned ldsw = (unsigned)wid * 1024u;
    const int aoff = lds_byte(wr * 64 + fr, fq * 8), boff = lds_byte(wc * 32 + fr, fq * 8);
#define PG8_SA(b, h) (((b) * 2 + (h)) * HTB)
#define PG8_SB(b, h) ((4 + (b) * 2 + (h)) * HTB)
#define PG8_STAGE(bufoff, gbase, voff) do { _Pragma("unroll") for (int _i = 0; _i < 2; ++_i) \
        __builtin_amdgcn_global_load_lds((const unsigned*)((const char*)(gbase) + (voff)[_i]), (LAS unsigned*)(lds + (bufoff) + ldsw + _i * 8192), 16, 0, 0); } while (0)
#define PG8_LDA(dst, b, h) do { _Pragma("unroll") for (int m = 0; m < 4; ++m) _Pragma("unroll") for (int k = 0; k < 2; ++k) dst[m][k] = *(const LAS bf16x8*)(lds + PG8_SA(b, h) + aoff + m * 2048 + k * 1024); } while (0)
#define PG8_LDB(dst, b, h) do { _Pragma("unroll") for (int n = 0; n < 2; ++n) _Pragma("unroll") for (int k = 0; k < 2; ++k) dst[n][k] = *(const LAS bf16x8*)(lds + PG8_SB(b, h) + boff + n * 2048 + k * 1024); } while (0)
#define PG8_MMA(ai, bj, At, Bt) do { __builtin_amdgcn_s_setprio(1); _Pragma("unroll") for (int m = 0; m < 4; ++m) _Pragma("unroll") for (int n = 0; n < 2; ++n) _Pragma("unroll") for (int k = 0; k < 2; ++k) \
        acc[ai][bj][m][n] = __builtin_amdgcn_mfma_f32_16x16x32_bf16(Bt[n][k], At[m][k], acc[ai][bj][m][n], 0, 0, 0); __builtin_amdgcn_s_setprio(0); } while (0)
#define PG8_WAIT_V(n) asm volatile("s_waitcnt vmcnt(" #n ")" ::: "memory")
#define PG8_WAIT_L(n) asm volatile("s_waitcnt lgkmcnt(" #n ")" ::: "memory")
#define PG8_BAR __builtin_amdgcn_s_barrier()
#define PG8_SCHED __builtin_amdgcn_sched_barrier(0)
    Unit cur, nxt; int ui = 0;
    if (!next_unit(g, 0, cur)) return;
    f32x4 acc[2][2][4][2];
#pragma unroll
    for (int a = 0; a < 2; ++a)
#pragma unroll
        for (int b = 0; b < 2; ++b)
#pragma unroll
            for (int m = 0; m < 4; ++m)
#pragma unroll
                for (int n = 0; n < 2; ++n) acc[a][b][m][n] = (f32x4){0.f, 0.f, 0.f, 0.f};
    bf16x8 At[4][2], B0[2][2], B1[2][2];
    const char* cA; const char* cB; { UnitIO io; make_unit(g, cur.pm, cur.pn, io); cA = io.A; cB = io.B; }
    PG8_STAGE(PG8_SB(0, 0), cB, voffB); PG8_STAGE(PG8_SA(0, 0), cA, voffA); PG8_STAGE(PG8_SB(0, 1), cB + hstepB, voffB); PG8_STAGE(PG8_SA(0, 1), cA + hstepA, voffA);
    if (wr == 1) PG8_BAR;
    PG8_WAIT_V(4); PG8_BAR;
    PG8_STAGE(PG8_SB(1, 0), cB + kstep, voffB); PG8_STAGE(PG8_SA(1, 0), cA + kstep, voffA); PG8_STAGE(PG8_SB(1, 1), cB + hstepB + kstep, voffB);
    PG8_WAIT_V(6); PG8_BAR;
    for (;;) {
        const bool has_next = next_unit(g, ui + 1, nxt);
        const char* nA = cA; const char* nB = cB; if (has_next) { UnitIO io; make_unit(g, nxt.pm, nxt.pn, io); nA = io.A; nB = io.B; }
        for (int t = 0; t < nt; t += 2) {
            const bool last = (t == nt - 2);
            const char* a1 = cA + (size_t)(t + 1) * kstep;
            const char* a2 = last ? nA : cA + (size_t)(t + 2) * kstep; const char* b2 = last ? nB : cB + (size_t)(t + 2) * kstep;
            const char* a3 = a2 + kstep; const char* b3 = b2 + kstep;
            PG8_LDB(B0, 0, 0); PG8_SCHED; PG8_LDA(At, 0, 0); PG8_STAGE(PG8_SA(1, 1), a1 + hstepA, voffA);
            PG8_WAIT_L(8); PG8_BAR; PG8_WAIT_L(0); PG8_MMA(0, 0, At, B0); PG8_BAR; PG8_SCHED;
            PG8_LDB(B1, 0, 1); PG8_STAGE(PG8_SB(0, 0), b2, voffB);
            PG8_BAR; PG8_WAIT_L(0); PG8_MMA(0, 1, At, B1); PG8_BAR;
            PG8_LDA(At, 0, 1); PG8_STAGE(PG8_SA(0, 0), a2, voffA);
            PG8_BAR; PG8_WAIT_L(0); PG8_MMA(1, 0, At, B0); PG8_BAR; PG8_SCHED;
            PG8_STAGE(PG8_SB(0, 1), b2 + hstepB, voffB);
            PG8_WAIT_V(6); PG8_BAR; PG8_MMA(1, 1, At, B1); PG8_BAR;
            PG8_LDB(B0, 1, 0); PG8_SCHED; PG8_LDA(At, 1, 0); PG8_STAGE(PG8_SA(0, 1), a2 + hstepA, voffA);
            PG8_WAIT_L(8); PG8_BAR; PG8_WAIT_L(0); PG8_MMA(0, 0, At, B0); PG8_BAR; PG8_SCHED;
            PG8_LDB(B1, 1, 1); PG8_STAGE(PG8_SB(1, 0), b3, voffB);
            PG8_BAR; PG8_WAIT_L(0); PG8_MMA(0, 1, At, B1); PG8_BAR;
            PG8_LDA(At, 1, 1); PG8_STAGE(PG8_SA(1, 0), a3, voffA);
            PG8_BAR; PG8_WAIT_L(0); PG8_MMA(1, 0, At, B0); PG8_BAR; PG8_SCHED;
            PG8_STAGE(PG8_SB(1, 1), b3 + hstepB, voffB);
            PG8_WAIT_V(6); PG8_BAR; PG8_MMA(1, 1, At, B1); PG8_BAR;
        }
        epilogue(acc, g, cur, wr, wc, fr, fq);
        if (!has_next) break;
#pragma unroll
        for (int a = 0; a < 2; ++a)
#pragma unroll
            for (int b = 0; b < 2; ++b)
#pragma unroll
                for (int m = 0; m < 4; ++m)
#pragma unroll
                    for (int n = 0; n < 2; ++n) acc[a][b][m][n] = (f32x4){0.f, 0.f, 0.f, 0.f};
        cur = nxt; cA = nA; cB = nB; ++ui;
    }
    PG8_WAIT_V(0);
    if (wr == 0) PG8_BAR;
    PG8_BAR;
#undef voffB
#undef hstepB
#undef PG8_SA
#undef PG8_SB
#undef PG8_STAGE
#undef PG8_LDA
#undef PG8_LDB
#undef PG8_MMA
#undef PG8_WAIT_V
#undef PG8_WAIT_L
#undef PG8_BAR
#undef PG8_SCHED
}

__device__ __forceinline__ void transpose_item(const float* W, int ldn, int n0, int k0, bf16_t* WT, int drow0, int ldk, float scale, LAS float* scr, int lane) {
#pragma unroll 8
    for (int i = 0; i < 32; ++i) { const int kk = 2 * i + (lane >> 5); scr[kk * 33 + (lane & 31)] = W[(size_t)(k0 + kk) * ldn + n0 + (lane & 31)]; }
    asm volatile("s_waitcnt lgkmcnt(0)" ::: "memory");
    const int c = lane & 7;
#pragma unroll
    for (int jx = 0; jx < 4; ++jx) {
        const int n = (lane >> 3) + 8 * jx; const LAS float* s = scr + (8 * c) * 33 + n;
        u32x4 o; o.x = pk2(s[0] * scale, s[33] * scale); o.y = pk2(s[66] * scale, s[99] * scale); o.z = pk2(s[132] * scale, s[165] * scale); o.w = pk2(s[198] * scale, s[231] * scale);
        *(u32x4*)(WT + (size_t)(drow0 + n) * ldk + k0 + 8 * c) = o;
    }
    asm volatile("s_waitcnt lgkmcnt(0)" ::: "memory");
}

__device__ __forceinline__ void prep_phase(PP P, LAS unsigned char* lds) {
    const int tid = otid(), lane = tid & 63, wave = tid >> 6, G = gridDim.x, bx = obid();
    unsigned char* ws = P->ws;
    {
        LAS float* scr = (LAS float*)(lds + wave * 8704);
        constexpr int N1 = 4 * 16 * 128, N2 = 4 * 64 * 32, N3 = 2 * 16 * 64, N4 = 2 * 8 * 32, N5 = 2 * 16 * 48, N6 = 2 * 16 * 32;
        constexpr int NIT = N1 + N2 + N3 + N4 + N5 + N6;
        for (int it = bx * 8 + wave; it < NIT; it += G * 8) {
            int r = it;
            if (r < N1) { const int l = r / 2048, q = r % 2048, kb = q / 128, nb = q % 128;
                transpose_item(P->in[I_W1] + (size_t)l * 1024 * 4096, 4096, nb * 32, kb * 64, (bf16_t*)(ws + OFF_W1T) + (size_t)l * 4096 * 1024, nb * 32, 1024, 1.f, scr, lane); continue; }
            r -= N1;
            if (r < N2) { const int l = r / 2048, q = r % 2048, kb = q / 32, nb = q % 32;
                transpose_item(P->in[I_W2] + (size_t)l * 4096 * 1024, 1024, nb * 32, kb * 64, (bf16_t*)(ws + OFF_W2T) + (size_t)l * 1024 * 4096, nb * 32, 4096, 1.f, scr, lane); continue; }
            r -= N2;
            if (r < N3) { const int j = r / 1024, q = r % 1024, kb = q / 64, nb = q % 64; const int sb = nb < 48 ? nb : nb + 1; const int n0 = sb * 32;
                const int drow = n0 < 1536 ? n0 : n0 + 480;
                transpose_item(P->in[I_WINE] + (size_t)j * 1024 * 2080, 2080, n0, kb * 64, (bf16_t*)(ws + OFF_WIE) + (size_t)j * 2560 * 1024, drow, 1024, n0 < 256 ? 0.125f : 1.f, scr, lane); continue; }
            r -= N3;
            if (r < N4) { const int j = r / 256, q = r % 256, kb = q / 32, nb = q % 32;
                transpose_item(P->in[I_WOUTE] + (size_t)j * 1024 * 1024, 1024, nb * 32, kb * 64, (bf16_t*)(ws + OFF_WOE) + (size_t)j * 1024 * 1024, nb * 32, 1024, 1.f, scr, lane); continue; }
            r -= N4;
            if (r < N5) { const int j = r / 768, q = r % 768, kb = q / 48, nb = q % 48; const int n0 = 512 + nb * 32;
                transpose_item(P->in[I_WINO] + (size_t)j * 1024 * 2048, 2048, n0, kb * 64, (bf16_t*)(ws + OFF_WIO) + (size_t)j * 2560 * 1024, n0 + 512, 1024, 1.f, scr, lane); continue; }
            r -= N5;
            { const int j = r / 512, q = r % 512, kb = q / 32, nb = q % 32;
                transpose_item(P->in[I_WOUTO] + (size_t)j * 1024 * 1024, 1024, nb * 32, kb * 64, (bf16_t*)(ws + OFF_WOO) + (size_t)j * 1024 * 1024, nb * 32, 1024, 1.f, scr, lane); }
        }
    }
    {
        const int gt = bx * 512 + tid, GT = G * 512;
        for (int it = gt; it < 2048 * 512 + 256 * 64; it += GT) {
            int L, k, c0; bf16_t* T; float s;
            if (it < 2048 * 512) { L = 2048; k = it >> 9; c0 = (it & 511) * 8; T = (bf16_t*)(ws + OFF_T2K); s = 1.f / 512.f; }
            else { const int r = it - 2048 * 512; L = 256; k = r >> 6; c0 = (r & 63) * 8; T = (bf16_t*)(ws + OFF_T256); s = 0.00552427172801990f; }
            const int z = c0 >= L; const int l0 = c0 - z * L; const float invL = 1.f / (float)L;
            float v[8];
#pragma unroll
            for (int e = 0; e < 8; ++e) { const int ph = (k * (l0 + e)) & (L - 1); const float fr = (float)ph * invL; v[e] = z ? -__builtin_amdgcn_sinf(fr) * s : __builtin_amdgcn_cosf(fr) * s; }
            u32x4 o; o.x = pk2(v[0], v[1]); o.y = pk2(v[2], v[3]); o.z = pk2(v[4], v[5]); o.w = pk2(v[6], v[7]);
            *(u32x4*)(T + (size_t)k * (2 * L) + c0) = o;
        }
    }
    {
        float* X = (float*)(ws + OFF_X);
        for (int r = bx * 8 + wave; r < NTOK; r += G * 8) {
            if (r < NPROMPT) {
#pragma unroll
                for (int jj = 0; jj < 4; ++jj) *(f32x4*)(X + (size_t)r * 1024 + jj * 256 + lane * 4) = *(const f32x4*)(P->in[I_XP] + (size_t)r * 1024 + jj * 256 + lane * 4);
            } else {
                const int s = r - NPROMPT, t = s & 2047; const float gr = (float)(t >> 6), gc = (float)(t & 63);
#pragma unroll
                for (int jj = 0; jj < 4; ++jj) {
                    f32x4 v = *(const f32x4*)(P->in[I_XS] + (size_t)s * 1024 + jj * 256 + lane * 4);
#pragma unroll
                    for (int e = 0; e < 4; ++e) {
                        const float fq = exp2f(-(float)(lane * 4 + e) * (13.287712379549449f / 256.f));
                        const float ang = (jj < 2 ? gr : gc) * fq;
                        v[e] += (jj & 1) ? cosf(ang) : sinf(ang);
                    }
                    *(f32x4*)(X + (size_t)r * 1024 + jj * 256 + lane * 4) = v;
                }
            }
        }
    }
    __syncthreads();
    {
        LAS float* sc = (LAS float*)lds;
        LAS float* red = (LAS float*)(lds + 20480);
        bool staged = false;
        for (int it = bx; it < 192; it += G) {
            if (!staged) {
                for (int idx = tid; idx < 5120; idx += 512) { const int cnd = idx >> 10, k = idx & 1023; const float c = cnd == 0 ? P->in[I_CCTX][k] : P->in[I_C][(cnd - 1) * 1024 + k]; sc[idx] = siluf(c); }
                staged = true; __syncthreads();
            }
            const int l = it / 48, cb = it % 48, quad = tid & 31, kc = tid >> 5;
            const float* wp = P->in[I_WADA] + ((size_t)l * 1024 + kc * 64) * 6144 + cb * 128 + quad * 4;
            f32x4 a[5];
#pragma unroll
            for (int cnd = 0; cnd < 5; ++cnd) a[cnd] = (f32x4){0.f, 0.f, 0.f, 0.f};
#pragma unroll 8
            for (int kk = 0; kk < 64; ++kk) {
                const f32x4 w = *(const f32x4*)(wp + (size_t)kk * 6144);
#pragma unroll
                for (int cnd = 0; cnd < 5; ++cnd) a[cnd] += w * sc[cnd * 1024 + kc * 64 + kk];
            }
#pragma unroll
            for (int cnd = 0; cnd < 5; ++cnd) *(LAS f32x4*)(red + (kc * 5 + cnd) * 128 + quad * 4) = a[cnd];
            __syncthreads();
            for (int idx = tid; idx < 640; idx += 512) {
                const int cnd = idx >> 7, cc = idx & 127; float s = 0.f;
#pragma unroll
                for (int k2 = 0; k2 < 16; ++k2) s += red[(k2 * 5 + cnd) * 128 + cc];
                ((float*)(ws + OFF_MOD))[(size_t)(l * 5 + cnd) * 6144 + cb * 128 + cc] = s + P->in[I_BADA][l * 6144 + cb * 128 + cc];
            }
            __syncthreads();
        }
    }
    __syncthreads();
    {
        LAS float* wt = (LAS float*)lds;
        LAS float* tab = (LAS float*)(lds + 64 * 129 * 4);
        for (int it = (bx + G - (192 % G)) % G; it < 128; it += G) {
            const int j = it >> 6, g = (it >> 4) & 3, kb = it & 15;
            for (int idx = tid; idx < 64 * 128; idx += 512) { const int kk = idx >> 7, c = idx & 127; wt[kk * 129 + c] = P->in[I_WINO][((size_t)j * 1024 + kb * 64 + kk) * 2048 + g * 128 + c]; }
            if (tid < 128) { tab[tid] = __builtin_amdgcn_cosf((float)tid * (1.f / 128.f)); tab[128 + tid] = __builtin_amdgcn_sinf((float)tid * (1.f / 128.f)); }
            __syncthreads();
            const int k = tid & 63, zg = tid >> 6, z = zg >> 2, m0 = (zg & 3) * 32;
            float acc[32];
#pragma unroll
            for (int mm = 0; mm < 32; ++mm) acc[mm] = 0.f;
            for (int c = 0; c < 128; ++c) {
                const float a = wt[k * 129 + c];
#pragma unroll
                for (int mm = 0; mm < 32; ++mm) acc[mm] += a * tab[z * 128 + (((m0 + mm) * c) & 127)];
            }
            bf16_t* O = (bf16_t*)(ws + OFF_WIO) + (size_t)j * 2560 * 1024 + (size_t)(z * 512 + g * 128 + m0) * 1024 + kb * 64 + k;
#pragma unroll
            for (int mm = 0; mm < 32; ++mm) O[(size_t)mm * 1024] = f2bf(acc[mm]);
            __syncthreads();
        }
    }
    {
        LAS float* Pt = (LAS float*)lds;
        LAS float* Wd = (LAS float*)(lds + 65536);
        for (int it = (bx + G - (64 % G)) % G; it < 128; it += G) {
            const int j = it >> 6, g = (it >> 4) & 3, nb = it & 15;
            for (int idx = tid; idx < 128 * 128; idx += 512) { const int c = idx >> 7, d = idx & 127; Pt[d * 128 + c] = P->in[I_POOLW][((size_t)(j * 4 + g) * 128 + c) * 128 + d] * P->in[I_POOLS][j * 512 + g * 128 + d]; }
            for (int idx = tid; idx < 128 * 64; idx += 512) { const int d = idx >> 6, n = idx & 63; Wd[d * 64 + n] = P->in[I_WOUTE][((size_t)j * 1024 + 512 + g * 128 + d) * 1024 + nb * 64 + n]; }
            __syncthreads();
            const int c = tid & 127, ng = tid >> 7;
            float acc[16];
#pragma unroll
            for (int nn = 0; nn < 16; ++nn) acc[nn] = 0.f;
            for (int d = 0; d < 128; ++d) {
                const float p = Pt[d * 128 + c];
#pragma unroll
                for (int nn = 0; nn < 16; ++nn) acc[nn] += p * Wd[d * 64 + ng * 16 + nn];
            }
            bf16_t* O = (bf16_t*)(ws + OFF_WOE) + (size_t)j * 1024 * 1024 + (size_t)(nb * 64 + ng * 16) * 1024 + 512 + g * 128 + c;
#pragma unroll
            for (int nn = 0; nn < 16; ++nn) O[(size_t)nn * 1024] = f2bf(acc[nn]);
            __syncthreads();
        }
    }
    {
        LAS float* av = (LAS float*)lds;
        LAS float* w2 = (LAS float*)(lds + 16384);
        for (int it = (bx + G - (32 % G)) % G; it < 32; it += G) {
            const int j = it >> 4, kb = it & 15;
            for (int idx = tid; idx < 64 * 32; idx += 512) { const int kk = idx >> 5, r = idx & 31; av[kk * 33 + r] = P->in[I_WINE][((size_t)j * 1024 + kb * 64 + kk) * 2080 + 1536 + r]; }
            for (int idx = tid; idx < 8192; idx += 512) w2[idx] = P->in[I_WA2][(size_t)j * 8192 + idx];
            __syncthreads();
            const int k = tid & 63, grp = tid >> 6, z = grp >> 2, n0 = (grp & 3) * 64;
            float a[16];
#pragma unroll
            for (int r = 0; r < 16; ++r) a[r] = av[k * 33 + z * 16 + r];
            bf16_t* O = (bf16_t*)(ws + OFF_WIE) + (size_t)j * 2560 * 1024 + (size_t)(1536 + z * 256 + n0) * 1024 + kb * 64 + k;
            for (int nn = 0; nn < 64; ++nn) {
                float s = 0.f;
#pragma unroll
                for (int r = 0; r < 16; ++r) s += a[r] * w2[(z * 16 + r) * 256 + n0 + nn];
                O[(size_t)nn * 1024] = f2bf(s);
            }
            __syncthreads();
        }
    }
}

__device__ __forceinline__ void norm_phase(PP P, int l, int which) {
    const int tid = otid(), lane = tid & 63, wave = tid >> 6, G = gridDim.x, bx = obid();
    unsigned char* ws = P->ws;
    const float* X = (const float*)(ws + OFF_X);
    const float* gp = which == 2 ? P->in[I_FINALG] : P->in[I_NORMG] + (size_t)(l * 2 + which) * 1024;
    f32x4 gv[4];
#pragma unroll
    for (int jj = 0; jj < 4; ++jj) gv[jj] = *(const f32x4*)(gp + jj * 256 + lane * 4);
    for (int r = bx * 8 + wave; r < NTOK; r += G * 8) {
        f32x4 v[4]; float ss = 0.f;
#pragma unroll
        for (int jj = 0; jj < 4; ++jj) { v[jj] = *(const f32x4*)(X + (size_t)r * 1024 + jj * 256 + lane * 4); ss += v[jj][0] * v[jj][0] + v[jj][1] * v[jj][1] + v[jj][2] * v[jj][2] + v[jj][3] * v[jj][3]; }
        const float rstd = rsqrtf(wave_sum(ss) * (1.f / 1024.f) + 1e-6f);
        if (which == 2) {
#pragma unroll
            for (int jj = 0; jj < 4; ++jj) *(f32x4*)(P->out + (size_t)r * 1024 + jj * 256 + lane * 4) = v[jj] * rstd * gv[jj];
        } else {
            const int cnd = r < NPROMPT ? 0 : 1 + ((r - NPROMPT) >> 11);
            const float* mp = (const float*)(ws + OFF_MOD) + (size_t)(l * 5 + cnd) * 6144 + which * 3072;
            bf16_t* Hh = (bf16_t*)(ws + OFF_H) + (size_t)r * 1024;
#pragma unroll
            for (int jj = 0; jj < 4; ++jj) {
                const f32x4 sh = *(const f32x4*)(mp + jj * 256 + lane * 4), sc = *(const f32x4*)(mp + 1024 + jj * 256 + lane * 4);
                const f32x4 y = v[jj] * rstd * gv[jj] * (sc + 1.f) + sh;
                u32x2 o; o.x = pk2(y[0], y[1]); o.y = pk2(y[2], y[3]);
                *(u32x2*)(Hh + jj * 256 + lane * 4) = o;
            }
        }
    }
}


__device__ __forceinline__ void pool_phase(PP P) {
    unsigned char* ws = P->ws;
    const bf16_t* UB = (const bf16_t*)(ws + OFF_UB);
    bf16_t* AM = (bf16_t*)(ws + OFF_AMIX);
    for (int idx = obid() * 512 + otid(); idx < NTOK * 64; idx += gridDim.x * 512) {
        const int t = idx >> 6, oc = idx & 63, ch = oc * 8, g = oc >> 4, w = 2 << g;
        int s0, L; if (t < NPROMPT) { s0 = t & ~255; L = 256; } else { s0 = NPROMPT + ((t - NPROMPT) & ~2047); L = 2048; }
        const int tl = t - s0; const int lo = max(tl - (w >> 1), 0), hi = min(tl + w - (w >> 1), L);
        float s[8];
#pragma unroll
        for (int e = 0; e < 8; ++e) s[e] = 0.f;
        for (int tt = lo; tt < hi; ++tt) {
            const u32x4 v = *(const u32x4*)(UB + (size_t)(s0 + tt) * 512 + ch);
            s[0] += bflo(v.x); s[1] += bfhi(v.x); s[2] += bflo(v.y); s[3] += bfhi(v.y); s[4] += bflo(v.z); s[5] += bfhi(v.z); s[6] += bflo(v.w); s[7] += bfhi(v.w);
        }
        const float ic = 1.f / (float)(hi - lo);
        const u32x4 v = *(const u32x4*)(UB + (size_t)t * 512 + ch);
        u32x4 o;
        o.x = pk2(s[0] * ic - bflo(v.x), s[1] * ic - bfhi(v.x)); o.y = pk2(s[2] * ic - bflo(v.y), s[3] * ic - bfhi(v.y));
        o.z = pk2(s[4] * ic - bflo(v.z), s[5] * ic - bfhi(v.z)); o.w = pk2(s[6] * ic - bflo(v.w), s[7] * ic - bfhi(v.w));
        *(u32x4*)(AM + (size_t)t * 1024 + 512 + ch) = o;
    }
}

__device__ __forceinline__ void mixprep_phase(PP P, int j) {
    const int tid = otid(), lane = tid & 63, wave = tid >> 6;
    unsigned char* ws = P->ws;
    const float* O0 = (const float*)(ws + OFF_ODIR); const float* O1 = O0 + (size_t)NTOK * 512;
    const bf16_t* GT = (const bf16_t*)(ws + OFF_GATE);
    bf16_t* AM = (bf16_t*)(ws + OFF_AMIX);
    const int ch = lane * 8;
    const f32x4 g0 = *(const f32x4*)(P->in[I_GLAG] + j * 128 + (ch & 127)), g1 = *(const f32x4*)(P->in[I_GLAG] + j * 128 + (ch & 127) + 4);
    for (int r = obid() * 8 + wave; r < NTOK; r += gridDim.x * 8) {
        f32x4 a = *(const f32x4*)(O0 + (size_t)r * 512 + ch) + *(const f32x4*)(O1 + (size_t)r * 512 + ch);
        f32x4 b = *(const f32x4*)(O0 + (size_t)r * 512 + ch + 4) + *(const f32x4*)(O1 + (size_t)r * 512 + ch + 4);
        float ss = a[0] * a[0] + a[1] * a[1] + a[2] * a[2] + a[3] * a[3] + b[0] * b[0] + b[1] * b[1] + b[2] * b[2] + b[3] * b[3];
        ss += __shfl_xor(ss, 1); ss += __shfl_xor(ss, 2); ss += __shfl_xor(ss, 4); ss += __shfl_xor(ss, 8);
        const float rstd = rsqrtf(ss * (1.f / 128.f) + 1e-6f);
        const u32x4 gt = *(const u32x4*)(GT + (size_t)r * 512 + ch);
        a = a * rstd * g0; b = b * rstd * g1;
        u32x4 o;
        o.x = pk2(a[0] * bflo(gt.x), a[1] * bfhi(gt.x)); o.y = pk2(a[2] * bflo(gt.y), a[3] * bfhi(gt.y));
        o.z = pk2(b[0] * bflo(gt.z), b[1] * bfhi(gt.z)); o.w = pk2(b[2] * bflo(gt.w), b[3] * bfhi(gt.w));
        *(u32x4*)(AM + (size_t)r * 1024 + ch) = o;
    }
}

__device__ __forceinline__ void conv_phase(PP P, int j) {
    unsigned char* ws = P->ws;
    const bf16_t* XI = (const bf16_t*)(ws + OFF_XIN); const bf16_t* BGp = (const bf16_t*)(ws + OFF_BG); const bf16_t* CGp = (const bf16_t*)(ws + OFF_CG);
    bf16_t* AM = (bf16_t*)(ws + OFF_AMIX);
    for (int idx = obid() * 512 + otid(); idx < NTOK * 64; idx += gridDim.x * 512) {
        const int t = idx >> 6, ch = (idx & 63) * 8;
        int s0, L; if (t < NPROMPT) { s0 = t & ~255; L = 256; } else { s0 = NPROMPT + ((t - NPROMPT) & ~2047); L = 2048; }
        const int tl = t - s0;
        float cv[8];
        { const f32x4 b0 = *(const f32x4*)(P->in[I_CONVB] + j * 512 + ch), b1 = *(const f32x4*)(P->in[I_CONVB] + j * 512 + ch + 4);
          cv[0] = b0[0]; cv[1] = b0[1]; cv[2] = b0[2]; cv[3] = b0[3]; cv[4] = b1[0]; cv[5] = b1[1]; cv[6] = b1[2]; cv[7] = b1[3]; }
#pragma unroll
        for (int jj = 0; jj < 3; ++jj) {
            const int tt = tl + jj - 1;
            if (tt < 0 || tt >= L) continue;
            const u32x4 xv = *(const u32x4*)(XI + (size_t)(s0 + tt) * 512 + ch), cg = *(const u32x4*)(CGp + (size_t)(s0 + tt) * 512 + ch);
            const f32x4 w0 = *(const f32x4*)(P->in[I_CONVW] + (size_t)(j * 3 + jj) * 512 + ch), w1 = *(const f32x4*)(P->in[I_CONVW] + (size_t)(j * 3 + jj) * 512 + ch + 4);
            cv[0] += bflo(xv.x) * bflo(cg.x) * w0[0]; cv[1] += bfhi(xv.x) * bfhi(cg.x) * w0[1]; cv[2] += bflo(xv.y) * bflo(cg.y) * w0[2]; cv[3] += bfhi(xv.y) * bfhi(cg.y) * w0[3];
            cv[4] += bflo(xv.z) * bflo(cg.z) * w1[0]; cv[5] += bfhi(xv.z) * bfhi(cg.z) * w1[1]; cv[6] += bflo(xv.w) * bflo(cg.w) * w1[2]; cv[7] += bfhi(xv.w) * bfhi(cg.w) * w1[3];
        }
        const u32x4 bg = *(const u32x4*)(BGp + (size_t)t * 512 + ch);
        u32x4 o;
        o.x = pk2(cv[0] * bflo(bg.x), cv[1] * bfhi(bg.x)); o.y = pk2(cv[2] * bflo(bg.y), cv[3] * bfhi(bg.y));
        o.z = pk2(cv[4] * bflo(bg.z), cv[5] * bfhi(bg.z)); o.w = pk2(cv[6] * bflo(bg.w), cv[7] * bfhi(bg.w));
        *(u32x4*)(AM + (size_t)t * 1024 + 512 + ch) = o;
    }
}

__device__ __forceinline__ void convert_phase(PP P) {
    unsigned char* ws = P->ws;
    bf16_t* AM = (bf16_t*)(ws + OFF_AMIX);
    for (int idx = obid() * 512 + otid(); idx < NTOK * 64; idx += gridDim.x * 512) {
        const int t = idx >> 6, ch = (idx & 63) * 8;
        f32x4 a, b;
        if (t < NPROMPT) { const float* F = (const float*)(ws + OFF_FACCP) + (size_t)t * 512 + ch; a = *(const f32x4*)F; b = *(const f32x4*)(F + 4); }
        else {
            const float* F = (const float*)(ws + OFF_FACCS) + (size_t)(t - NPROMPT) * 512 + ch;
            a = *(const f32x4*)F; b = *(const f32x4*)(F + 4);
#pragma unroll
            for (int ks = 1; ks < 4; ++ks) { a += *(const f32x4*)(F + (size_t)ks * 8192 * 512); b += *(const f32x4*)(F + (size_t)ks * 8192 * 512 + 4); }
        }
        u32x4 o; o.x = pk2(a[0], a[1]); o.y = pk2(a[2], a[3]); o.z = pk2(b[0], b[1]); o.w = pk2(b[2], b[3]);
        *(u32x4*)(AM + (size_t)t * 1024 + ch) = o;
    }
}

__device__ __forceinline__ int permd(int d) { return (d & 32) | ((d & 12) << 1) | ((d & 16) >> 2) | (d & 3); }
__device__ __forceinline__ bf16x8 pack8(const f32x4& a, const f32x4& b) {
    u32x4 o; o.x = pk2(a[0], a[1]); o.y = pk2(a[2], a[3]); o.z = pk2(b[0], b[1]); o.w = pk2(b[2], b[3]);
    return __builtin_bit_cast(bf16x8, o);
}
__device__ __forceinline__ void gla_item(PP P, LAS unsigned char* lds, int j, int seg, int head, int dir, bool full) {
    const int tid = otid(), lane = tid & 63, w = tid >> 6, r = lane & 15, q = lane >> 4;
    unsigned char* ws = P->ws;
    const bf16_t* QB = (const bf16_t*)(ws + OFF_QB); const bf16_t* KB = (const bf16_t*)(ws + OFF_KB); const bf16_t* VT = (const bf16_t*)(ws + OFF_VT);
    const float* LOGF = (const float*)(ws + OFF_LOGF);
    float* ODIR = (float*)(ws + OFF_ODIR);
    float* Ubuf = (float*)(ws + OFF_U); float* Dtot = (float*)(ws + OFF_DTOT);
    LAS bf16_t* QT = (LAS bf16_t*)(lds);
    LAS bf16_t* KT = (LAS bf16_t*)(lds + 36864);
    LAS bf16_t* KH = (LAS bf16_t*)(lds + 73728);
    LAS float* DL = (LAS float*)(lds + 114688);
    LAS bf16x8* ATT = (LAS bf16x8*)(lds + 116736);
    const int tok0 = seg * 256;
    __syncthreads();
    {
        const int d = tid & 63, c = w, pd = permd(d);
        float b = 0.f;
        const float* lf = LOGF + (size_t)(tok0 + 32 * c) * 512 + dir * 256 + head * 64 + d;
        const bf16_t* qp = QB + (size_t)(tok0 + 32 * c) * 256 + head * 64 + d;
        const bf16_t* kp = KB + (size_t)(tok0 + 32 * c) * 256 + head * 64 + d;
#pragma unroll 8
        for (int ii = 0; ii < 32; ++ii) {
            const int il = dir ? 31 - ii : ii;
            b += lf[(size_t)il * 512];
            const float qv = bf2f(qp[(size_t)il * 256]), kv = bf2f(kp[(size_t)il * 256]);
            QT[(32 * c + il) * 72 + pd] = f2bf(qv * __expf(b));
            KT[(32 * c + il) * 72 + pd] = f2bf(kv * __expf(-b));
        }
        const float eT = __expf(b);
        DL[c * 64 + d] = eT;
#pragma unroll 8
        for (int il = 0; il < 32; ++il) KH[(c * 64 + d) * 40 + permd(il)] = f2bf(bf2f(KT[(32 * c + il) * 72 + pd]) * eT);
    }
    __syncthreads();
    if (full) {
        const int c = w;
        f32x4 at[2][2];
#pragma unroll
        for (int a = 0; a < 2; ++a)
#pragma unroll
            for (int b = 0; b < 2; ++b) at[a][b] = (f32x4){0.f, 0.f, 0.f, 0.f};
#pragma unroll
        for (int kk = 0; kk < 2; ++kk) {
            bf16x8 ka[2], qb[2];
#pragma unroll
            for (int t = 0; t < 2; ++t) { ka[t] = *(const LAS bf16x8*)(KT + (32 * c + 16 * t + r) * 72 + 32 * kk + 8 * q); qb[t] = *(const LAS bf16x8*)(QT + (32 * c + 16 * t + r) * 72 + 32 * kk + 8 * q); }
#pragma unroll
            for (int tj = 0; tj < 2; ++tj)
#pragma unroll
                for (int ti = 0; ti < 2; ++ti) at[tj][ti] = __builtin_amdgcn_mfma_f32_16x16x32_bf16(ka[tj], qb[ti], at[tj][ti], 0, 0, 0);
        }
#pragma unroll
        for (int ti = 0; ti < 2; ++ti) {
            const int i = 16 * ti + r;
#pragma unroll
            for (int tj = 0; tj < 2; ++tj)
#pragma unroll
                for (int jj = 0; jj < 4; ++jj) { const int jx = 16 * tj + 4 * q + jj; const bool keep = dir ? (jx >= i) : (jx <= i); if (!keep) at[tj][ti][jj] = 0.f; }
            ATT[(c * 2 + ti) * 64 + lane] = pack8(at[0][ti], at[1][ti]);
        }
    }
    __syncthreads();
    f32x4 S[4];
#pragma unroll
    for (int t = 0; t < 4; ++t) S[t] = (f32x4){0.f, 0.f, 0.f, 0.f};
    const int e = 16 * w + r;
    if (DBG_SINIT && full && seg >= 16) {
        const int sb = (seg - 16) >> 3, part = (seg - 16) & 7;
        const float* s0 = P->in[I_STATE] + ((size_t)(((sb * 2 + j) * 2 + dir) * 4 + head) * 64) * 128;
#pragma unroll
        for (int t = 0; t < 4; ++t)
#pragma unroll
            for (int jj = 0; jj < 4; ++jj) S[t][jj] = s0[(size_t)(16 * t + 4 * q + jj) * 128 + e];
        const int np = DBG_NP(dir ? 7 - part : part);
        for (int x = 0; x < np; ++x) {
            const int pp = dir ? 7 - x : x;
            const size_t ib = (size_t)(((sb * 8 + pp) * 4 + head) * 2 + dir) * 64;
#pragma unroll
            for (int t = 0; t < 4; ++t)
#pragma unroll
                for (int jj = 0; jj < 4; ++jj) { const int d = 16 * t + 4 * q + jj; S[t][jj] = S[t][jj] * Dtot[ib + d] + Ubuf[(ib + d) * 128 + e]; }
        }
    }
    const bf16_t* vt = VT + (size_t)(head * 128 + e) * NTOK + tok0;
    for (int cc = 0; cc < 8; ++cc) {
        const int c = dir ? 7 - cc : cc;
        const u32x2 v0 = *(const u32x2*)(vt + 32 * c + 4 * q), v1 = *(const u32x2*)(vt + 32 * c + 16 + 4 * q);
        u32x4 vv; vv.x = v0.x; vv.y = v0.y; vv.z = v1.x; vv.w = v1.y;
        const bf16x8 vb = __builtin_bit_cast(bf16x8, vv);
        if (full) {
            bf16x8 sb2[2];
            sb2[0] = pack8(S[0], S[1]); sb2[1] = pack8(S[2], S[3]);
#pragma unroll
            for (int mi = 0; mi < 2; ++mi) {
                f32x4 o = (f32x4){0.f, 0.f, 0.f, 0.f};
#pragma unroll
                for (int kk = 0; kk < 2; ++kk) {
                    const bf16x8 qa = *(const LAS bf16x8*)(QT + (32 * c + 16 * mi + r) * 72 + 32 * kk + 8 * q);
                    o = __builtin_amdgcn_mfma_f32_16x16x32_bf16(qa, sb2[kk], o, 0, 0, 0);
                }
                const bf16x8 aa = ATT[(c * 2 + mi) * 64 + lane];
                o = __builtin_amdgcn_mfma_f32_16x16x32_bf16(aa, vb, o, 0, 0, 0);
                float* op = ODIR + ((size_t)dir * NTOK + tok0 + 32 * c + 16 * mi + 4 * q) * 512 + head * 128 + e;
#pragma unroll
                for (int jj = 0; jj < 4; ++jj) op[(size_t)jj * 512] = o[jj];
            }
        }
#pragma unroll
        for (int t = 0; t < 4; ++t) {
            const f32x4 dv = *(const LAS f32x4*)(DL + c * 64 + 16 * t + 4 * q);
            S[t] = S[t] * dv;
            const bf16x8 ka = *(const LAS bf16x8*)(KH + (c * 64 + 16 * t + r) * 40 + 8 * q);
            S[t] = __builtin_amdgcn_mfma_f32_16x16x32_bf16(ka, vb, S[t], 0, 0, 0);
        }
    }
    if (full) {
        if (seg < 16) {
            float* so = P->out + OUT_STATE + ((size_t)(((seg * 2 + j) * 2 + dir) * 4 + head) * 64) * 128;
#pragma unroll
            for (int t = 0; t < 4; ++t)
#pragma unroll
                for (int jj = 0; jj < 4; ++jj) so[(size_t)(16 * t + 4 * q + jj) * 128 + e] = S[t][jj];
        }
    } else {
        const size_t ib = (size_t)(((seg - 16) * 4 + head) * 2 + dir) * 64;
#pragma unroll
        for (int t = 0; t < 4; ++t)
#pragma unroll
            for (int jj = 0; jj < 4; ++jj) Ubuf[(ib + 16 * t + 4 * q + jj) * 128 + e] = S[t][jj];
        if (tid < 64) { float p = 1.f;
#pragma unroll
            for (int c = 0; c < 8; ++c) p *= DL[c * 64 + tid];
            Dtot[ib + tid] = p; }
    }
}

__device__ __forceinline__ void gla_phase(PP P, LAS unsigned char* lds, int j, int sub) {
    const int G = gridDim.x;
    if (sub == 0) {
        for (int it = obid(); it < 384; it += G) {
            if (it >= 128 && it < 256) { const int pi = it - 128; gla_item(P, lds, j, pi >> 3, (pi >> 1) & 3, pi & 1, true); }
            else { const int li = it < 128 ? it : it - 128; gla_item(P, lds, j, 16 + (li >> 3), (li >> 1) & 3, li & 1, false); }
        }
    } else {
        for (int it = obid(); it < 256; it += G) gla_item(P, lds, j, 16 + (it >> 3), (it >> 1) & 3, it & 1, true);
    }
}

enum { PT_PREP = 0, PT_NORM1, PT_GEMM_IN, PT_MIX_A, PT_MIX_B, PT_MIXPREP, PT_GEMM_OUT, PT_NORM2, PT_MLP1, PT_MLP2, PT_FINAL };

__global__ void __launch_bounds__(512, 2) mega_fwd(Params Pk) {
    extern __shared__ __attribute__((aligned(16))) unsigned char smem[];
    LAS unsigned char* lds = (LAS unsigned char*)smem;
#ifdef DBG_ZLDS
    for (int i = otid(); i < LDS_BYTES / 16; i += 512) ((LAS u32x4*)lds)[i] = (u32x4){0u, 0u, 0u, 0u};
    __syncthreads();
#endif
    for (int ph = Pk.ph_lo; ph < Pk.ph_hi; ++ph) {
        PP P = (PP)__builtin_amdgcn_kernarg_segment_ptr();
        asm volatile("" : "+s"(P));
        int pt, l = 0;
        if (ph == 0) pt = PT_PREP;
        else if (ph == NPH - 1) pt = PT_FINAL;
        else {
            const int qq = ph - 1; int s;
            if (qq < 9) { l = 0; s = qq; } else if (qq < 17) { l = 1; s = qq - 9; } else if (qq < 26) { l = 2; s = qq - 17; } else { l = 3; s = qq - 26; }
            pt = (l & 1) ? (s < 4 ? s + 1 : s + 2) : s + 1;
        }
        const int j = l >> 1, odd = l & 1;
        int ngemm = 0; GemmCfg g; g.G = gridDim.x; g.c = obid(); g.j = j; g.l = l; g.nM = 48; g.ld = 1024; g.nt = 16; g.type = 0; g.nN = 0;
        switch (pt) {
        case PT_PREP: if (EN & 1) prep_phase(P, lds); break;
        case PT_NORM1: if (EN & 2) norm_phase(P, l, 0); break;
        case PT_GEMM_IN: ngemm = 1; g.type = odd ? T_IN_ODD : T_IN_EVEN; g.nN = 10; break;
        case PT_MIX_A: if (odd) { ngemm = 2; g.type = T_DFT_S; g.nM = 8; g.nN = 32; g.ld = 4096; g.nt = 16; } else { if (EN & 4) gla_phase(P, lds, j, 0); if (EN & 8) pool_phase(P); } break;
        case PT_MIX_B: if (odd) { if (EN & 8) convert_phase(P); } else { if (EN & 4) gla_phase(P, lds, j, 1); } break;
        case PT_MIXPREP: if (EN & 8) mixprep_phase(P, j); break;
        case PT_GEMM_OUT: ngemm = 1; g.type = odd ? T_OUT_ODD : T_OUT_EVEN; g.nN = 4; break;
        case PT_NORM2: if (EN & 2) norm_phase(P, l, 1); break;
        case PT_MLP1: ngemm = 1; g.type = T_MLP1; g.nN = 16; break;
        case PT_MLP2: ngemm = 1; g.type = T_MLP2; g.nN = 4; g.ld = 4096; g.nt = 64; break;
        default: if (EN & 2) norm_phase(P, 0, 2); break;
        }
        for (int gi = 0; gi < ngemm; ++gi) {
            if (gi == 1) { g.type = T_DFT_P; g.nM = 1; g.nN = 32; g.ld = 512; g.nt = 8; g.c = (obid() + gridDim.x - 32) % gridDim.x; }
            if (EN & 16) gemm_phase(lds, g);
        }
        if (pt == PT_MIX_A && odd && (EN & 8)) conv_phase(P, j);
        if (ph + 1 < Pk.ph_hi) cg::this_grid().sync();
    }
}


#ifdef DBG_K
__device__ __forceinline__ float dgst(unsigned u) { return (float)(u & 0xffffu) + (float)(u >> 16); }
__global__ void dbg_dump(float* out, const unsigned char* ws) {
    const unsigned* Xu = (const unsigned*)(ws + OFF_X); const unsigned* Hu = (const unsigned*)(ws + OFF_H); const unsigned* Au = (const unsigned*)(ws + OFF_AMIX);
    const unsigned* Bu = (const unsigned*)(ws + OFF_BIG); const unsigned* Uu = (const unsigned*)(ws + OFF_U); const unsigned* Wu = (const unsigned*)(ws);
    for (size_t i = (size_t)blockIdx.x * blockDim.x + threadIdx.x; i < (size_t)NTOK * 1024; i += (size_t)gridDim.x * blockDim.x) {
        float v = 0.f;
        if (DBG_SEL & 1) v += dgst(Xu[i]);
        if (DBG_SEL & 2) v += dgst(Hu[i % 6291456]);
        if (DBG_SEL & 4) v += dgst(Au[i % 6291456]);
        if (DBG_SEL & 8) v += dgst(Bu[i]) + dgst(Bu[i + 12582912]) + dgst(Bu[(i + 25165824) % 34603008]);
        if (DBG_SEL & 16) v += dgst(Uu[i % 2113536]);
        if (DBG_SEL & 32) v += dgst(Wu[i]) + dgst(Wu[i + 12582912]) + dgst(Wu[(i + 25165824) % 28573696]);
        out[i] = v;
    }
}
#endif
extern "C" void kernel_launch(void* const* d_in, const int* in_sizes, int n_in, void* d_out, int out_size, void* d_ws, size_t ws_size, hipStream_t stream) {
    static int grid = 0;
    if (grid == 0) {
        if (n_in != 22 || ws_size < WS_NEED) { fprintf(stderr, "kernel_launch: unexpected n_in %d / ws_size %zu (need %zu)\n", n_in, ws_size, (size_t)WS_NEED); grid = -1; return; }
        int dev = 0, cus = 0, per_cu = 0;
        hipGetDevice(&dev);
        hipDeviceGetAttribute(&cus, hipDeviceAttributeMultiprocessorCount, dev);
        if (hipFuncSetAttribute((const void*)mega_fwd, hipFuncAttributeMaxDynamicSharedMemorySize, LDS_BYTES) != hipSuccess) { fprintf(stderr, "kernel_launch: hipFuncSetAttribute failed\n"); grid = -1; return; }
        hipOccupancyMaxActiveBlocksPerMultiprocessor(&per_cu, (const void*)mega_fwd, 512, LDS_BYTES);
        if (per_cu < 1) { fprintf(stderr, "kernel_launch: occupancy query says %d blocks/CU\n", per_cu); per_cu = 1; }
        (void)hipGetLastError();
        grid = cus;
    }
    if (grid < 0) return;
    Params p{};
    for (int i = 0; i < 22; ++i) p.in[i] = (const float*)d_in[i];
    p.out = (float*)d_out; p.ws = (unsigned char*)d_ws;
#if MULTI_LAUNCH
#ifdef DBG_K
    for (int ph = 0; ph < DBG_K; ++ph) {
        p.ph_lo = ph; p.ph_hi = ph + 1;
        hipLaunchKernelGGL(mega_fwd, dim3(grid), dim3(512), LDS_BYTES, stream, p);
    }
    hipLaunchKernelGGL(dbg_dump, dim3(2048), dim3(256), 0, stream, (float*)d_out, (const unsigned char*)d_ws);
#else
    for (int ph = 0; ph < NPH; ++ph) {
        p.ph_lo = ph; p.ph_hi = ph + 1;
        hipLaunchKernelGGL(mega_fwd, dim3(grid), dim3(512), LDS_BYTES, stream, p);
    }
#endif
#else
    p.ph_lo = 0; p.ph_hi = NPH;
    void* args[] = {&p};
    hipError_t e = hipLaunchCooperativeKernel((const void*)mega_fwd, dim3(grid), dim3(512), args, LDS_BYTES, stream);
    if (e != hipSuccess) fprintf(stderr, "cooperative launch failed: %s (grid %d)\n", hipGetErrorString(e), grid);
#endif
}
```

```cpp
#include <hip/hip_runtime.h>
#include <hip/hip_cooperative_groups.h>
#include <cstdio>
#include <cstdint>
namespace cg = cooperative_groups;

#ifndef DBG_SEL
#define DBG_SEL 63
#endif
#ifndef DBG_NP
#define DBG_NP(x) (x)
#endif
#ifndef REP_PT
#define REP_PT -1
#endif
#ifndef REP_N
#define REP_N 1
#endif
#ifndef XSYNC
#define XSYNC 0
#endif
#ifndef DBG_SINIT
#define DBG_SINIT 1
#endif
#ifndef EN
#define EN 31
#endif
#ifndef MULTI_LAUNCH
#define MULTI_LAUNCH 0
#endif

#define LAS __attribute__((address_space(3)))
typedef unsigned short bf16_t;
typedef short bf16x8 __attribute__((ext_vector_type(8)));
typedef float f32x4 __attribute__((ext_vector_type(4)));
typedef unsigned u32x2 __attribute__((ext_vector_type(2)));
typedef unsigned u32x4 __attribute__((ext_vector_type(4)));

constexpr int DM = 1024, NTOK = 12288, NPROMPT = 4096, DFF = 4096;
constexpr int LDS_BYTES = 147456;
constexpr int NPH = 36;
constexpr size_t MBy = 1048576;
constexpr size_t OFF_W1T = 0, OFF_W2T = 32 * MBy, OFF_WIE = 64 * MBy, OFF_WOE = 74 * MBy, OFF_WIO = 78 * MBy, OFF_WOO = 88 * MBy;
constexpr size_t OFF_T2K = 92 * MBy, OFF_T256 = 108 * MBy, OFF_MOD = 108 * MBy + 262144, OFF_U = 109 * MBy, OFF_DTOT = 117 * MBy;
constexpr size_t OFF_X = 118 * MBy, OFF_H = 166 * MBy, OFF_AMIX = 190 * MBy, OFF_BIG = 214 * MBy, WS_NEED = 348 * MBy;
constexpr size_t OFF_HID = OFF_BIG;
constexpr size_t OFF_QB = OFF_BIG, OFF_KB = OFF_BIG + 6 * MBy, OFF_VT = OFF_BIG + 12 * MBy, OFF_GATE = OFF_BIG + 24 * MBy, OFF_LOGF = OFF_BIG + 36 * MBy;
constexpr size_t OFF_UB = OFF_BIG + 60 * MBy, OFF_ODIR = OFF_BIG + 72 * MBy;
constexpr size_t OFF_XTS = OFF_BIG, OFF_XTP = OFF_BIG + 16 * MBy, OFF_XIN = OFF_BIG + 24 * MBy, OFF_BG = OFF_BIG + 36 * MBy, OFF_CG = OFF_BIG + 48 * MBy;
constexpr size_t OFF_FACCP = OFF_BIG + 60 * MBy, OFF_FACCS = OFF_BIG + 68 * MBy;
constexpr size_t OFF_BAR = 117 * MBy + 524288;
constexpr size_t OUT_STATE = (size_t)NTOK * DM;

struct Params { const float* in[22]; float* out; unsigned char* ws; int ph_lo, ph_hi; };
typedef const __attribute__((address_space(4))) Params* PP;
enum { I_XP = 0, I_XS, I_STATE, I_C, I_CCTX, I_NORMG, I_FINALG, I_WADA, I_BADA, I_W1, I_W2, I_WINE, I_WA2, I_BA2, I_GLAG, I_POOLW, I_POOLS, I_WOUTE, I_WINO, I_CONVW, I_CONVB, I_WOUTO };

__device__ __forceinline__ int otid() { int t = __builtin_amdgcn_workitem_id_x(); asm volatile("" : "+v"(t)); return t; }
__device__ __forceinline__ int obid() { int b = __builtin_amdgcn_workgroup_id_x(); asm volatile("" : "+s"(b)); return b; }
typedef float f32x2 __attribute__((ext_vector_type(2)));
typedef __bf16 bf16x2v __attribute__((ext_vector_type(2)));
__device__ __forceinline__ unsigned pk2(float lo, float hi) { f32x2 v = {lo, hi}; bf16x2v b = __builtin_convertvector(v, bf16x2v); return __builtin_bit_cast(unsigned, b); }
__device__ __forceinline__ bf16_t f2bf(float x) { return (bf16_t)(pk2(x, 0.f) & 0xffffu); }
__device__ __forceinline__ float bf2f(bf16_t u) { return __uint_as_float(((unsigned)u) << 16); }
__device__ __forceinline__ float bflo(unsigned u) { return __uint_as_float(u << 16); }
__device__ __forceinline__ float bfhi(unsigned u) { return __uint_as_float(u & 0xffff0000u); }
__device__ __forceinline__ float wave_sum(float v) {
#pragma unroll
    for (int o = 1; o < 64; o <<= 1) v += __shfl_xor(v, o);
    return v;
}
__device__ __forceinline__ float siluf(float x) { return x * __builtin_amdgcn_rcpf(1.f + __expf(-x)); }
__device__ __forceinline__ float logsigmoidf(float x) { return fminf(x, 0.f) - __logf(1.f + __expf(-fabsf(x))); }
__device__ __forceinline__ int cond_of_seg(int pm) { return pm < 16 ? 0 : 1 + ((pm - 16) >> 3); }

namespace pg8 {
constexpr int BM = 256, BK = 64, HALF = 128, HTB = HALF * BK * 2, STAGE_BYTES = 8 * HTB, NXCD = 8, WGM = 8;
__host__ __device__ __forceinline__ int lds_byte(int r, int c) { const int st = (r >> 4) * 2 + (c >> 5), rr = r & 15, cc = c & 31, ob = rr * 64 + cc * 2; return st * 1024 + (ob ^ (((ob >> 9) & 1) << 5)); }
__host__ __device__ __forceinline__ void stage_rc(int b, int& R, int& C) { const int st = b / 1024, sb = b % 1024, swz = sb ^ (((sb >> 9) & 1) << 5); R = (st >> 1) * 16 + swz / 64; C = (st & 1) * 32 + (swz % 64) / 2; }
}

enum { KD_BF16 = 0, KD_SILU, KD_RELU2, KD_LOGF, KD_RES, KD_ATOM };
enum { T_IN_EVEN = 0, T_IN_ODD, T_OUT_EVEN, T_OUT_ODD, T_MLP1, T_MLP2, T_DFT_S, T_DFT_P };
struct Unit { int pm, pn; };
struct UnitIO { const char* A; const char* B; char* out; const float* aux; int kind; int ld; };
struct GemmCfg { int type, j, l, nM, nN, ld, nt, G, c; };

__device__ __forceinline__ void make_unit(const GemmCfg& g, int pm, int pn, UnitIO& u) {
    PP Pq = (PP)__builtin_amdgcn_kernarg_segment_ptr();
    unsigned char* ws = Pq->ws;
    const size_t rowA = (size_t)pm * 256 * 1024 * 2;
    u.aux = nullptr; u.kind = KD_BF16; u.ld = 512;
    const float* modp = (const float*)(ws + OFF_MOD) + (size_t)(g.l * 5 + cond_of_seg(pm)) * 6144;
    switch (g.type) {
    case T_IN_EVEN: {
        const char* W = (const char*)(ws + OFF_WIE) + (size_t)g.j * 2560 * 1024 * 2 + (size_t)pn * 256 * 1024 * 2;
        const char* Hh = (const char*)(ws + OFF_H) + rowA;
        u.A = Hh; u.B = W;
        if (pn == 0) { u.out = (char*)(ws + OFF_QB) + (size_t)pm * 256 * 256 * 2; u.ld = 256; }
        else if (pn == 1) { u.out = (char*)(ws + OFF_KB) + (size_t)pm * 256 * 256 * 2; u.ld = 256; }
        else if (pn < 4) { u.A = W; u.B = Hh; u.out = (char*)(ws + OFF_VT) + ((size_t)(pn - 2) * 256 * NTOK + (size_t)pm * 256) * 2; u.ld = NTOK; }
        else if (pn < 6) { u.out = (char*)(ws + OFF_GATE) + ((size_t)pm * 256 * 512 + (pn - 4) * 256) * 2; u.kind = KD_SILU; }
        else if (pn < 8) { u.out = (char*)(ws + OFF_LOGF) + ((size_t)pm * 256 * 512 + (pn - 6) * 256) * 4; u.kind = KD_LOGF; u.aux = Pq->in[I_BA2] + g.j * 512 + (pn - 6) * 256; }
        else { u.out = (char*)(ws + OFF_UB) + ((size_t)pm * 256 * 512 + (pn - 8) * 256) * 2; }
    } break;
    case T_IN_ODD: {
        const char* W = (const char*)(ws + OFF_WIO) + (size_t)g.j * 2560 * 1024 * 2 + (size_t)pn * 256 * 1024 * 2;
        const char* Hh = (const char*)(ws + OFF_H) + rowA;
        u.A = Hh; u.B = W;
        if (pn < 4) {
            u.A = W; u.B = Hh;
            const int z = pn >> 1, ch0 = (pn & 1) * 256;
            if (pm < 16) { u.out = (char*)(ws + OFF_XTP) + ((size_t)(pm * 512 + ch0) * 512 + z * 256) * 2; u.ld = 512; }
            else { const int b = (pm - 16) >> 3, part = (pm - 16) & 7; u.out = (char*)(ws + OFF_XTS) + ((size_t)(b * 512 + ch0) * 4096 + z * 2048 + part * 256) * 2; u.ld = 4096; }
        } else {
            const size_t base = (pn < 6) ? OFF_XIN : (pn < 8 ? OFF_BG : OFF_CG);
            u.out = (char*)(ws + base) + ((size_t)pm * 256 * 512 + (pn & 1) * 256) * 2;
        }
    } break;
    case T_OUT_EVEN: case T_OUT_ODD: {
        u.A = (const char*)(ws + OFF_AMIX) + rowA;
        u.B = (const char*)(ws + (g.type == T_OUT_EVEN ? OFF_WOE : OFF_WOO)) + (size_t)g.j * 1024 * 1024 * 2 + (size_t)pn * 256 * 1024 * 2;
        u.out = (char*)(ws + OFF_X) + ((size_t)pm * 256 * 1024 + pn * 256) * 4; u.ld = 1024; u.kind = KD_RES; u.aux = modp + 2048 + pn * 256;
    } break;
    case T_MLP1: {
        u.A = (const char*)(ws + OFF_H) + rowA;
        u.B = (const char*)(ws + OFF_W1T) + (size_t)g.l * 4096 * 1024 * 2 + (size_t)pn * 256 * 1024 * 2;
        u.out = (char*)(ws + OFF_HID) + ((size_t)pm * 256 * 4096 + pn * 256) * 2; u.ld = 4096; u.kind = KD_RELU2;
    } break;
    case T_MLP2: {
        u.A = (const char*)(ws + OFF_HID) + (size_t)pm * 256 * 4096 * 2;
        u.B = (const char*)(ws + OFF_W2T) + (size_t)g.l * 4096 * 1024 * 2 + (size_t)pn * 256 * 4096 * 2;
        u.out = (char*)(ws + OFF_X) + ((size_t)pm * 256 * 1024 + pn * 256) * 4; u.ld = 1024; u.kind = KD_RES; u.aux = modp + 5120 + pn * 256;
    } break;
    case T_DFT_S: {
        const int pnb = pn >> 2, ks = pn & 3;
        u.A = (const char*)(ws + OFF_T2K) + ((size_t)pm * 256 * 4096 + ks * 1024) * 2;
        u.B = (const char*)(ws + OFF_XTS) + ((size_t)pnb * 256 * 4096 + ks * 1024) * 2;
        u.out = (char*)(ws + OFF_FACCS) + ((size_t)ks * 8192 * 512 + (size_t)((pnb >> 1) * 2048 + pm * 256) * 512 + (pnb & 1) * 256) * 4; u.kind = KD_ATOM;
    } break;
    default: {
        u.A = (const char*)(ws + OFF_T256);
        u.B = (const char*)(ws + OFF_XTP) + (size_t)pn * 256 * 512 * 2;
        u.out = (char*)(ws + OFF_FACCP) + ((size_t)((pn >> 1) * 256) * 512 + (pn & 1) * 256) * 4; u.kind = KD_ATOM;
    } break;
    }
}

__device__ __forceinline__ bool next_unit(const GemmCfg& g, int i, Unit& u) {
    const int nwg = g.nM * g.nN;
    const long L = (long)i * g.G + g.c; if (L >= nwg) return false;
    int wgid = (int)L; { const int q = nwg / pg8::NXCD, r = nwg % pg8::NXCD, xcd = wgid % pg8::NXCD, off = wgid / pg8::NXCD; wgid = (xcd < r ? xcd * (q + 1) : r * (q + 1) + (xcd - r) * q) + off; }
    const int nig = pg8::WGM * g.nN, gid = wgid / nig, fm = gid * pg8::WGM, gsz = (g.nM - fm) < pg8::WGM ? (g.nM - fm) : pg8::WGM;
    const int pm = fm + ((wgid % nig) % gsz), pn = (wgid % nig) / gsz;
    u.pm = pm; u.pn = pn; return true;
}

__device__ __forceinline__ void epilogue(const f32x4 (&acc)[2][2][4][2], const GemmCfg& g, const Unit& uu, int wr, int wc, int fr, int fq) {
    UnitIO u; make_unit(g, uu.pm, uu.pn, u);
    const int row0 = wr * 64 + fr, col0 = wc * 32 + 4 * fq;
    const int kind = u.kind, ld = u.ld;
    if (kind <= KD_RELU2) {
        bf16_t* O = (bf16_t*)u.out;
#pragma unroll
        for (int ai = 0; ai < 2; ++ai)
#pragma unroll
            for (int m = 0; m < 4; ++m) {
                bf16_t* rowp = O + (size_t)(row0 + ai * 128 + m * 16) * ld + col0;
#pragma unroll
                for (int bj = 0; bj < 2; ++bj)
#pragma unroll
                    for (int n = 0; n < 2; ++n) {
                        f32x4 v = acc[ai][bj][m][n];
                        if (kind == KD_SILU) { v[0] = siluf(v[0]); v[1] = siluf(v[1]); v[2] = siluf(v[2]); v[3] = siluf(v[3]); }
                        else if (kind == KD_RELU2) { v[0] = fmaxf(v[0], 0.f); v[1] = fmaxf(v[1], 0.f); v[2] = fmaxf(v[2], 0.f); v[3] = fmaxf(v[3], 0.f); v = v * v; }
                        u32x2 o; o.x = pk2(v[0], v[1]); o.y = pk2(v[2], v[3]);
                        *(u32x2*)(rowp + bj * 128 + n * 16) = o;
                    }
            }
    } else if (kind == KD_RES) {
        float* O = (float*)u.out;
        f32x4 gv[2][2];
#pragma unroll
        for (int bj = 0; bj < 2; ++bj)
#pragma unroll
            for (int n = 0; n < 2; ++n) gv[bj][n] = *(const f32x4*)(u.aux + col0 + bj * 128 + n * 16);
#pragma unroll
        for (int ai = 0; ai < 2; ++ai)
#pragma unroll
            for (int m = 0; m < 4; ++m) {
                float* rowp = O + (size_t)(row0 + ai * 128 + m * 16) * ld + col0;
#pragma unroll
                for (int bj = 0; bj < 2; ++bj)
#pragma unroll
                    for (int n = 0; n < 2; ++n) { f32x4* p = (f32x4*)(rowp + bj * 128 + n * 16); *p = *p + gv[bj][n] * acc[ai][bj][m][n]; }
            }
    } else if (kind == KD_LOGF) {
        float* O = (float*)u.out;
#pragma unroll
        for (int bj = 0; bj < 2; ++bj)
#pragma unroll
            for (int n = 0; n < 2; ++n) {
                const f32x4 bv = *(const f32x4*)(u.aux + col0 + bj * 128 + n * 16);
#pragma unroll
                for (int ai = 0; ai < 2; ++ai)
#pragma unroll
                    for (int m = 0; m < 4; ++m) {
                        f32x4 v = acc[ai][bj][m][n] + bv;
                        v[0] = logsigmoidf(v[0]) * 0.0625f; v[1] = logsigmoidf(v[1]) * 0.0625f; v[2] = logsigmoidf(v[2]) * 0.0625f; v[3] = logsigmoidf(v[3]) * 0.0625f;
                        *(f32x4*)(O + (size_t)(row0 + ai * 128 + m * 16) * ld + col0 + bj * 128 + n * 16) = v;
                    }
            }
    } else {
        float* O = (float*)u.out;
#pragma unroll
        for (int ai = 0; ai < 2; ++ai)
#pragma unroll
            for (int m = 0; m < 4; ++m) {
                float* rowp = O + (size_t)(row0 + ai * 128 + m * 16) * ld + col0;
#pragma unroll
                for (int bj = 0; bj < 2; ++bj)
#pragma unroll
                    for (int n = 0; n < 2; ++n) {
                        *(f32x4*)(rowp + bj * 128 + n * 16) = acc[ai][bj][m][n];
                    }
            }
    }
}

__device__ __forceinline__ void gemm_phase(LAS unsigned char* lds, const GemmCfg& g) {
    using namespace pg8;
    const int tid = otid(), wid = __builtin_amdgcn_readfirstlane(tid >> 6), lane = tid & 63, wr = wid >> 2, wc = wid & 3, fr = lane & 15, fq = lane >> 4;
    const int nt = g.nt;
    unsigned voffA[2];
#pragma unroll
    for (int i = 0; i < 2; ++i) { int R, C; stage_rc(tid * 16 + i * 8192, R, C); voffA[i] = (unsigned)(R * g.ld + C) * 2u; }
#define voffB voffA
    const size_t kstep = (size_t)(BK * 2);
    const size_t hstepA = (size_t)HALF * g.ld * 2;
#define hstepB hstepA
    const unsigned ldsw = (unsigned)wid * 1024u;
    const int aoff = lds_byte(wr * 64 + fr, fq * 8), boff = lds_byte(wc * 32 + fr, fq * 8);
#define PG8_SA(b, h) (((b) * 2 + (h)) * HTB)
#define PG8_SB(b, h) ((4 + (b) * 2 + (h)) * HTB)
#define PG8_STAGE(bufoff, gbase, voff) do { _Pragma("unroll") for (int _i = 0; _i < 2; ++_i) \
        __builtin_amdgcn_global_load_lds((const unsigned*)((const char*)(gbase) + (voff)[_i]), (LAS unsigned*)(lds + (bufoff) + ldsw + _i * 8192), 16, 0, 0); } while (0)
#define PG8_LDA(dst, b, h) do { _Pragma("unroll") for (int m = 0; m < 4; ++m) _Pragma("unroll") for (int k = 0; k < 2; ++k) dst[m][k] = *(const LAS bf16x8*)(lds + PG8_SA(b, h) + aoff + m * 2048 + k * 1024); } while (0)
#define PG8_LDB(dst, b, h) do { _Pragma("unroll") for (int n = 0; n < 2; ++n) _Pragma("unroll") for (int k = 0; k < 2; ++k) dst[n][k] = *(const LAS bf16x8*)(lds + PG8_SB(b, h) + boff + n * 2048 + k * 1024); } while (0)
#define PG8_MMA(ai, bj, At, Bt) do { __builtin_amdgcn_s_setprio(1); _Pragma("unroll") for (int m = 0; m < 4; ++m) _Pragma("unroll") for (int n = 0; n < 2; ++n) _Pragma("unroll") for (int k = 0; k < 2; ++k) \
        acc[ai][bj][m][n] = __builtin_amdgcn_mfma_f32_16x16x32_bf16(Bt[n][k], At[m][k], acc[ai][bj][m][n], 0, 0, 0); __builtin_amdgcn_s_setprio(0); } while (0)
#define PG8_WAIT_V(n) asm volatile("s_waitcnt vmcnt(" #n ")" ::: "memory")
#define PG8_WAIT_L(n) asm volatile("s_waitcnt lgkmcnt(" #n ")" ::: "memory")
#define PG8_BAR __builtin_amdgcn_s_barrier()
#define PG8_SCHED __builtin_amdgcn_sched_barrier(0)
    Unit cur, nxt; int ui = 0;
    if (!next_unit(g, 0, cur)) return;
    f32x4 acc[2][2][4][2];
#pragma unroll
    for (int a = 0; a < 2; ++a)
#pragma unroll
        for (int b = 0; b < 2; ++b)
#pragma unroll
            for (int m = 0; m < 4; ++m)
#pragma unroll
                for (int n = 0; n < 2; ++n) acc[a][b][m][n] = (f32x4){0.f, 0.f, 0.f, 0.f};
    bf16x8 At[4][2], B0[2][2], B1[2][2];
    const char* cA; const char* cB; { UnitIO io; make_unit(g, cur.pm, cur.pn, io); cA = io.A; cB = io.B; }
    PG8_STAGE(PG8_SB(0, 0), cB, voffB); PG8_STAGE(PG8_SA(0, 0), cA, voffA); PG8_STAGE(PG8_SB(0, 1), cB + hstepB, voffB); PG8_STAGE(PG8_SA(0, 1), cA + hstepA, voffA);
    if (wr == 1) PG8_BAR;
    PG8_WAIT_V(4); PG8_BAR;
    PG8_STAGE(PG8_SB(1, 0), cB + kstep, voffB); PG8_STAGE(PG8_SA(1, 0), cA + kstep, voffA); PG8_STAGE(PG8_SB(1, 1), cB + hstepB + kstep, voffB);
    PG8_WAIT_V(6); PG8_BAR;
    for (;;) {
        const bool has_next = next_unit(g, ui + 1, nxt);
        const char* nA = cA; const char* nB = cB; if (has_next) { UnitIO io; make_unit(g, nxt.pm, nxt.pn, io); nA = io.A; nB = io.B; }
        for (int t = 0; t < nt; t += 2) {
            const bool last = (t == nt - 2);
            const char* a1 = cA + (size_t)(t + 1) * kstep;
            const char* a2 = last ? nA : cA + (size_t)(t + 2) * kstep; const char* b2 = last ? nB : cB + (size_t)(t + 2) * kstep;
            const char* a3 = a2 + kstep; const char* b3 = b2 + kstep;
            PG8_LDB(B0, 0, 0); PG8_SCHED; PG8_LDA(At, 0, 0); PG8_STAGE(PG8_SA(1, 1), a1 + hstepA, voffA);
            PG8_WAIT_L(8); PG8_BAR; PG8_WAIT_L(0); PG8_MMA(0, 0, At, B0); PG8_BAR; PG8_SCHED;
            PG8_LDB(B1, 0, 1); PG8_STAGE(PG8_SB(0, 0), b2, voffB);
            PG8_BAR; PG8_WAIT_L(0); PG8_MMA(0, 1, At, B1); PG8_BAR;
            PG8_LDA(At, 0, 1); PG8_STAGE(PG8_SA(0, 0), a2, voffA);
            PG8_BAR; PG8_WAIT_L(0); PG8_MMA(1, 0, At, B0); PG8_BAR; PG8_SCHED;
            PG8_STAGE(PG8_SB(0, 1), b2 + hstepB, voffB);
            PG8_WAIT_V(6); PG8_BAR; PG8_MMA(1, 1, At, B1); PG8_BAR;
            PG8_LDB(B0, 1, 0); PG8_SCHED; PG8_LDA(At, 1, 0); PG8_STAGE(PG8_SA(0, 1), a2 + hstepA, voffA);
            PG8_WAIT_L(8); PG8_BAR; PG8_WAIT_L(0); PG8_MMA(0, 0, At, B0); PG8_BAR; PG8_SCHED;
            PG8_LDB(B1, 1, 1); PG8_STAGE(PG8_SB(1, 0), b3, voffB);
            PG8_BAR; PG8_WAIT_L(0); PG8_MMA(0, 1, At, B1); PG8_BAR;
            PG8_LDA(At, 1, 1); PG8_STAGE(PG8_SA(1, 0), a3, voffA);
            PG8_BAR; PG8_WAIT_L(0); PG8_MMA(1, 0, At, B0); PG8_BAR; PG8_SCHED;
            PG8_STAGE(PG8_SB(1, 1), b3 + hstepB, voffB);
            PG8_WAIT_V(6); PG8_BAR; PG8_MMA(1, 1, At, B1); PG8_BAR;
        }
        epilogue(acc, g, cur, wr, wc, fr, fq);
        if (!has_next) break;
#pragma unroll
        for (int a = 0; a < 2; ++a)
#pragma unroll
            for (int b = 0; b < 2; ++b)
#pragma unroll
                for (int m = 0; m < 4; ++m)
#pragma unroll
                    for (int n = 0; n < 2; ++n) acc[a][b][m][n] = (f32x4){0.f, 0.f, 0.f, 0.f};
        cur = nxt; cA = nA; cB = nB; ++ui;
    }
    PG8_WAIT_V(0);
    if (wr == 0) PG8_BAR;
    PG8_BAR;
#undef voffB
#undef hstepB
#undef PG8_SA
#undef PG8_SB
#undef PG8_STAGE
#undef PG8_LDA
#undef PG8_LDB
#undef PG8_MMA
#undef PG8_WAIT_V
#undef PG8_WAIT_L
#undef PG8_BAR
#undef PG8_SCHED
}

__device__ __forceinline__ void transpose_item(const float* W, int ldn, int n0, int k0, bf16_t* WT, int drow0, int ldk, float scale, LAS float* scr, int lane) {
#pragma unroll 8
    for (int i = 0; i < 32; ++i) { const int kk = 2 * i + (lane >> 5); scr[kk * 33 + (lane & 31)] = W[(size_t)(k0 + kk) * ldn + n0 + (lane & 31)]; }
    asm volatile("s_waitcnt lgkmcnt(0)" ::: "memory");
    const int c = lane & 7;
#pragma unroll
    for (int jx = 0; jx < 4; ++jx) {
        const int n = (lane >> 3) + 8 * jx; const LAS float* s = scr + (8 * c) * 33 + n;
        u32x4 o; o.x = pk2(s[0] * scale, s[33] * scale); o.y = pk2(s[66] * scale, s[99] * scale); o.z = pk2(s[132] * scale, s[165] * scale); o.w = pk2(s[198] * scale, s[231] * scale);
        *(u32x4*)(WT + (size_t)(drow0 + n) * ldk + k0 + 8 * c) = o;
    }
    asm volatile("s_waitcnt lgkmcnt(0)" ::: "memory");
}

__device__ __forceinline__ void prep_phase(PP P, LAS unsigned char* lds) {
    const int tid = otid(), lane = tid & 63, wave = tid >> 6, G = gridDim.x, bx = obid();
    unsigned char* ws = P->ws;
    {
        LAS float* scr = (LAS float*)(lds + wave * 8704);
        constexpr int N1 = 4 * 16 * 128, N2 = 4 * 64 * 32, N3 = 2 * 16 * 64, N4 = 2 * 8 * 32, N5 = 2 * 16 * 48, N6 = 2 * 16 * 32;
        constexpr int NIT = N1 + N2 + N3 + N4 + N5 + N6;
        for (int it = bx * 8 + wave; it < NIT; it += G * 8) {
            int r = it;
            if (r < N1) { const int l = r / 2048, q = r % 2048, kb = q / 128, nb = q % 128;
                transpose_item(P->in[I_W1] + (size_t)l * 1024 * 4096, 4096, nb * 32, kb * 64, (bf16_t*)(ws + OFF_W1T) + (size_t)l * 4096 * 1024, nb * 32, 1024, 1.f, scr, lane); continue; }
            r -= N1;
            if (r < N2) { const int l = r / 2048, q = r % 2048, kb = q / 32, nb = q % 32;
                transpose_item(P->in[I_W2] + (size_t)l * 4096 * 1024, 1024, nb * 32, kb * 64, (bf16_t*)(ws + OFF_W2T) + (size_t)l * 1024 * 4096, nb * 32, 4096, 1.f, scr, lane); continue; }
            r -= N2;
            if (r < N3) { const int j = r / 1024, q = r % 1024, kb = q / 64, nb = q % 64; const int sb = nb < 48 ? nb : nb + 1; const int n0 = sb * 32;
                const int drow = n0 < 1536 ? n0 : n0 + 480;
                transpose_item(P->in[I_WINE] + (size_t)j * 1024 * 2080, 2080, n0, kb * 64, (bf16_t*)(ws + OFF_WIE) + (size_t)j * 2560 * 1024, drow, 1024, n0 < 256 ? 0.125f : 1.f, scr, lane); continue; }
            r -= N3;
            if (r < N4) { const int j = r / 256, q = r % 256, kb = q / 32, nb = q % 32;
                transpose_item(P->in[I_WOUTE] + (size_t)j * 1024 * 1024, 1024, nb * 32, kb * 64, (bf16_t*)(ws + OFF_WOE) + (size_t)j * 1024 * 1024, nb * 32, 1024, 1.f, scr, lane); continue; }
            r -= N4;
            if (r < N5) { const int j = r / 768, q = r % 768, kb = q / 48, nb = q % 48; const int n0 = 512 + nb * 32;
                transpose_item(P->in[I_WINO] + (size_t)j * 1024 * 2048, 2048, n0, kb * 64, (bf16_t*)(ws + OFF_WIO) + (size_t)j * 2560 * 1024, n0 + 512, 1024, 1.f, scr, lane); continue; }
            r -= N5;
            { const int j = r / 512, q = r % 512, kb = q / 32, nb = q % 32;
                transpose_item(P->in[I_WOUTO] + (size_t)j * 1024 * 1024, 1024, nb * 32, kb * 64, (bf16_t*)(ws + OFF_WOO) + (size_t)j * 1024 * 1024, nb * 32, 1024, 1.f, scr, lane); }
        }
    }
    {
        const int gt = bx * 512 + tid, GT = G * 512;
        for (int it = gt; it < 2048 * 512 + 256 * 64; it += GT) {
            int L, k, c0; bf16_t* T; float s;
            if (it < 2048 * 512) { L = 2048; k = it >> 9; c0 = (it & 511) * 8; T = (bf16_t*)(ws + OFF_T2K); s = 1.f / 512.f; }
            else { const int r = it - 2048 * 512; L = 256; k = r >> 6; c0 = (r & 63) * 8; T = (bf16_t*)(ws + OFF_T256); s = 0.00552427172801990f; }
            const int z = c0 >= L; const int l0 = c0 - z * L; const float invL = 1.f / (float)L;
            float v[8];
#pragma unroll
            for (int e = 0; e < 8; ++e) { const int ph = (k * (l0 + e)) & (L - 1); const float fr = (float)ph * invL; v[e] = z ? -__builtin_amdgcn_sinf(fr) * s : __builtin_amdgcn_cosf(fr) * s; }
            u32x4 o; o.x = pk2(v[0], v[1]); o.y = pk2(v[2], v[3]); o.z = pk2(v[4], v[5]); o.w = pk2(v[6], v[7]);
            *(u32x4*)(T + (size_t)k * (2 * L) + c0) = o;
        }
    }
    {
        float* X = (float*)(ws + OFF_X);
        for (int r = bx * 8 + wave; r < NTOK; r += G * 8) {
            if (r < NPROMPT) {
#pragma unroll
                for (int jj = 0; jj < 4; ++jj) *(f32x4*)(X + (size_t)r * 1024 + jj * 256 + lane * 4) = *(const f32x4*)(P->in[I_XP] + (size_t)r * 1024 + jj * 256 + lane * 4);
            } else {
                const int s = r - NPROMPT, t = s & 2047; const float gr = (float)(t >> 6), gc = (float)(t & 63);
#pragma unroll
                for (int jj = 0; jj < 4; ++jj) {
                    f32x4 v = *(const f32x4*)(P->in[I_XS] + (size_t)s * 1024 + jj * 256 + lane * 4);
#pragma unroll
                    for (int e = 0; e < 4; ++e) {
                        const float fq = exp2f(-(float)(lane * 4 + e) * (13.287712379549449f / 256.f));
                        const float ang = (jj < 2 ? gr : gc) * fq;
                        v[e] += (jj & 1) ? cosf(ang) : sinf(ang);
                    }
                    *(f32x4*)(X + (size_t)r * 1024 + jj * 256 + lane * 4) = v;
                }
            }
        }
    }
    __syncthreads();
    {
        LAS float* sc = (LAS float*)lds;
        LAS float* red = (LAS float*)(lds + 20480);
        bool staged = false;
        for (int it = bx; it < 192; it += G) {
            if (!staged) {
                for (int idx = tid; idx < 5120; idx += 512) { const int cnd = idx >> 10, k = idx & 1023; const float c = cnd == 0 ? P->in[I_CCTX][k] : P->in[I_C][(cnd - 1) * 1024 + k]; sc[idx] = siluf(c); }
                staged = true; __syncthreads();
            }
            const int l = it / 48, cb = it % 48, quad = tid & 31, kc = tid >> 5;
            const float* wp = P->in[I_WADA] + ((size_t)l * 1024 + kc * 64) * 6144 + cb * 128 + quad * 4;
            f32x4 a[5];
#pragma unroll
            for (int cnd = 0; cnd < 5; ++cnd) a[cnd] = (f32x4){0.f, 0.f, 0.f, 0.f};
#pragma unroll 8
            for (int kk = 0; kk < 64; ++kk) {
                const f32x4 w = *(const f32x4*)(wp + (size_t)kk * 6144);
#pragma unroll
                for (int cnd = 0; cnd < 5; ++cnd) a[cnd] += w * sc[cnd * 1024 + kc * 64 + kk];
            }
#pragma unroll
            for (int cnd = 0; cnd < 5; ++cnd) *(LAS f32x4*)(red + (kc * 5 + cnd) * 128 + quad * 4) = a[cnd];
            __syncthreads();
            for (int idx = tid; idx < 640; idx += 512) {
                const int cnd = idx >> 7, cc = idx & 127; float s = 0.f;
#pragma unroll
                for (int k2 = 0; k2 < 16; ++k2) s += red[(k2 * 5 + cnd) * 128 + cc];
                ((float*)(ws + OFF_MOD))[(size_t)(l * 5 + cnd) * 6144 + cb * 128 + cc] = s + P->in[I_BADA][l * 6144 + cb * 128 + cc];
            }
            __syncthreads();
        }
    }
    __syncthreads();
    {
        LAS float* wt = (LAS float*)lds;
        LAS float* tab = (LAS float*)(lds + 64 * 129 * 4);
        for (int it2 = bx; it2 < 256; it2 += G) {
            const int it = it2 >> 1, zsel = it2 & 1;
            const int j = it >> 6, g = (it >> 4) & 3, kb = it & 15;
            for (int idx = tid; idx < 64 * 128; idx += 512) { const int kk = idx >> 7, c = idx & 127; wt[kk * 129 + c] = P->in[I_WINO][((size_t)j * 1024 + kb * 64 + kk) * 2048 + g * 128 + c]; }
            if (tid < 128) { tab[tid] = __builtin_amdgcn_cosf((float)tid * (1.f / 128.f)); tab[128 + tid] = __builtin_amdgcn_sinf((float)tid * (1.f / 128.f)); }
            __syncthreads();
            const int k = tid & 63, zg = tid >> 6, z = zsel, m0 = zg * 16;
            float acc[16];
#pragma unroll
            for (int mm = 0; mm < 16; ++mm) acc[mm] = 0.f;
            for (int c = 0; c < 128; ++c) {
                const float a = wt[k * 129 + c];
#pragma unroll
                for (int mm = 0; mm < 16; ++mm) acc[mm] += a * tab[z * 128 + (((m0 + mm) * c) & 127)];
            }
            bf16_t* O = (bf16_t*)(ws + OFF_WIO) + (size_t)j * 2560 * 1024 + (size_t)(z * 512 + g * 128 + m0) * 1024 + kb * 64 + k;
#pragma unroll
            for (int mm = 0; mm < 16; ++mm) O[(size_t)mm * 1024] = f2bf(acc[mm]);
            __syncthreads();
        }
    }
    {
        LAS float* Pt = (LAS float*)lds;
        LAS float* Wd = (LAS float*)(lds + 65536);
        for (int it = (bx + G - (192 % G)) % G; it < 128; it += G) {
            const int j = it >> 6, g = (it >> 4) & 3, nb = it & 15;
            for (int idx = tid; idx < 128 * 128; idx += 512) { const int c = idx >> 7, d = idx & 127; Pt[d * 128 + c] = P->in[I_POOLW][((size_t)(j * 4 + g) * 128 + c) * 128 + d] * P->in[I_POOLS][j * 512 + g * 128 + d]; }
            for (int idx = tid; idx < 128 * 64; idx += 512) { const int d = idx >> 6, n = idx & 63; Wd[d * 64 + n] = P->in[I_WOUTE][((size_t)j * 1024 + 512 + g * 128 + d) * 1024 + nb * 64 + n]; }
            __syncthreads();
            const int c = tid & 127, ng = tid >> 7;
            float acc[16];
#pragma unroll
            for (int nn = 0; nn < 16; ++nn) acc[nn] = 0.f;
            for (int d = 0; d < 128; ++d) {
                const float p = Pt[d * 128 + c];
#pragma unroll
                for (int nn = 0; nn < 16; ++nn) acc[nn] += p * Wd[d * 64 + ng * 16 + nn];
            }
            bf16_t* O = (bf16_t*)(ws + OFF_WOE) + (size_t)j * 1024 * 1024 + (size_t)(nb * 64 + ng * 16) * 1024 + 512 + g * 128 + c;
#pragma unroll
            for (int nn = 0; nn < 16; ++nn) O[(size_t)nn * 1024] = f2bf(acc[nn]);
            __syncthreads();
        }
    }
    {
        LAS float* av = (LAS float*)lds;
        LAS float* w2 = (LAS float*)(lds + 16384);
        for (int it = (bx + G - (64 % G)) % G; it < 32; it += G) {
            const int j = it >> 4, kb = it & 15;
            for (int idx = tid; idx < 64 * 32; idx += 512) { const int kk = idx >> 5, r = idx & 31; av[kk * 33 + r] = P->in[I_WINE][((size_t)j * 1024 + kb * 64 + kk) * 2080 + 1536 + r]; }
            for (int idx = tid; idx < 8192; idx += 512) w2[idx] = P->in[I_WA2][(size_t)j * 8192 + idx];
            __syncthreads();
            const int k = tid & 63, grp = tid >> 6, z = grp >> 2, n0 = (grp & 3) * 64;
            float a[16];
#pragma unroll
            for (int r = 0; r < 16; ++r) a[r] = av[k * 33 + z * 16 + r];
            bf16_t* O = (bf16_t*)(ws + OFF_WIE) + (size_t)j * 2560 * 1024 + (size_t)(1536 + z * 256 + n0) * 1024 + kb * 64 + k;
            for (int nn = 0; nn < 64; ++nn) {
                float s = 0.f;
#pragma unroll
                for (int r = 0; r < 16; ++r) s += a[r] * w2[(z * 16 + r) * 256 + n0 + nn];
                O[(size_t)nn * 1024] = f2bf(s);
            }
            __syncthreads();
        }
    }
}

__device__ __forceinline__ void norm_phase(PP P, int l, int which) {
    const int tid = otid(), lane = tid & 63, wave = tid >> 6, G = gridDim.x, bx = obid();
    unsigned char* ws = P->ws;
    const float* X = (const float*)(ws + OFF_X);
    const float* gp = which == 2 ? P->in[I_FINALG] : P->in[I_NORMG] + (size_t)(l * 2 + which) * 1024;
    f32x4 gv[4];
#pragma unroll
    for (int jj = 0; jj < 4; ++jj) gv[jj] = *(const f32x4*)(gp + jj * 256 + lane * 4);
    for (int r = bx * 8 + wave; r < NTOK; r += G * 8) {
        f32x4 v[4]; float ss = 0.f;
#pragma unroll
        for (int jj = 0; jj < 4; ++jj) { v[jj] = *(const f32x4*)(X + (size_t)r * 1024 + jj * 256 + lane * 4); ss += v[jj][0] * v[jj][0] + v[jj][1] * v[jj][1] + v[jj][2] * v[jj][2] + v[jj][3] * v[jj][3]; }
        const float rstd = rsqrtf(wave_sum(ss) * (1.f / 1024.f) + 1e-6f);
        if (which == 2) {
#pragma unroll
            for (int jj = 0; jj < 4; ++jj) *(f32x4*)(P->out + (size_t)r * 1024 + jj * 256 + lane * 4) = v[jj] * rstd * gv[jj];
        } else {
            const int cnd = r < NPROMPT ? 0 : 1 + ((r - NPROMPT) >> 11);
            const float* mp = (const float*)(ws + OFF_MOD) + (size_t)(l * 5 + cnd) * 6144 + which * 3072;
            bf16_t* Hh = (bf16_t*)(ws + OFF_H) + (size_t)r * 1024;
#pragma unroll
            for (int jj = 0; jj < 4; ++jj) {
                const f32x4 sh = *(const f32x4*)(mp + jj * 256 + lane * 4), sc = *(const f32x4*)(mp + 1024 + jj * 256 + lane * 4);
                const f32x4 y = v[jj] * rstd * gv[jj] * (sc + 1.f) + sh;
                u32x2 o; o.x = pk2(y[0], y[1]); o.y = pk2(y[2], y[3]);
                *(u32x2*)(Hh + jj * 256 + lane * 4) = o;
            }
        }
    }
}


__device__ __forceinline__ void pool_phase(PP P) {
    unsigned char* ws = P->ws;
    const bf16_t* UB = (const bf16_t*)(ws + OFF_UB);
    bf16_t* AM = (bf16_t*)(ws + OFF_AMIX);
    for (int idx = obid() * 512 + otid(); idx < NTOK * 64; idx += gridDim.x * 512) {
        const int t = idx >> 6, oc = idx & 63, ch = oc * 8, g = oc >> 4, w = 2 << g;
        int s0, L; if (t < NPROMPT) { s0 = t & ~255; L = 256; } else { s0 = NPROMPT + ((t - NPROMPT) & ~2047); L = 2048; }
        const int tl = t - s0; const int lo = max(tl - (w >> 1), 0), hi = min(tl + w - (w >> 1), L);
        float s[8];
#pragma unroll
        for (int e = 0; e < 8; ++e) s[e] = 0.f;
        for (int tt = lo; tt < hi; ++tt) {
            const u32x4 v = *(const u32x4*)(UB + (size_t)(s0 + tt) * 512 + ch);
            s[0] += bflo(v.x); s[1] += bfhi(v.x); s[2] += bflo(v.y); s[3] += bfhi(v.y); s[4] += bflo(v.z); s[5] += bfhi(v.z); s[6] += bflo(v.w); s[7] += bfhi(v.w);
        }
        const float ic = 1.f / (float)(hi - lo);
        const u32x4 v = *(const u32x4*)(UB + (size_t)t * 512 + ch);
        u32x4 o;
        o.x = pk2(s[0] * ic - bflo(v.x), s[1] * ic - bfhi(v.x)); o.y = pk2(s[2] * ic - bflo(v.y), s[3] * ic - bfhi(v.y));
        o.z = pk2(s[4] * ic - bflo(v.z), s[5] * ic - bfhi(v.z)); o.w = pk2(s[6] * ic - bflo(v.w), s[7] * ic - bfhi(v.w));
        *(u32x4*)(AM + (size_t)t * 1024 + 512 + ch) = o;
    }
}

__device__ __forceinline__ void mixprep_phase(PP P, int j) {
    const int tid = otid(), lane = tid & 63, wave = tid >> 6;
    unsigned char* ws = P->ws;
    const float* O0 = (const float*)(ws + OFF_ODIR); const float* O1 = O0 + (size_t)NTOK * 512;
    const bf16_t* GT = (const bf16_t*)(ws + OFF_GATE);
    bf16_t* AM = (bf16_t*)(ws + OFF_AMIX);
    const int ch = lane * 8;
    const f32x4 g0 = *(const f32x4*)(P->in[I_GLAG] + j * 128 + (ch & 127)), g1 = *(const f32x4*)(P->in[I_GLAG] + j * 128 + (ch & 127) + 4);
    for (int r = obid() * 8 + wave; r < NTOK; r += gridDim.x * 8) {
        f32x4 a = *(const f32x4*)(O0 + (size_t)r * 512 + ch) + *(const f32x4*)(O1 + (size_t)r * 512 + ch);
        f32x4 b = *(const f32x4*)(O0 + (size_t)r * 512 + ch + 4) + *(const f32x4*)(O1 + (size_t)r * 512 + ch + 4);
        float ss = a[0] * a[0] + a[1] * a[1] + a[2] * a[2] + a[3] * a[3] + b[0] * b[0] + b[1] * b[1] + b[2] * b[2] + b[3] * b[3];
        ss += __shfl_xor(ss, 1); ss += __shfl_xor(ss, 2); ss += __shfl_xor(ss, 4); ss += __shfl_xor(ss, 8);
        const float rstd = rsqrtf(ss * (1.f / 128.f) + 1e-6f);
        const u32x4 gt = *(const u32x4*)(GT + (size_t)r * 512 + ch);
        a = a * rstd * g0; b = b * rstd * g1;
        u32x4 o;
        o.x = pk2(a[0] * bflo(gt.x), a[1] * bfhi(gt.x)); o.y = pk2(a[2] * bflo(gt.y), a[3] * bfhi(gt.y));
        o.z = pk2(b[0] * bflo(gt.z), b[1] * bfhi(gt.z)); o.w = pk2(b[2] * bflo(gt.w), b[3] * bfhi(gt.w));
        *(u32x4*)(AM + (size_t)r * 1024 + ch) = o;
    }
}

__device__ __forceinline__ void conv_phase(PP P, int j) {
    unsigned char* ws = P->ws;
    const bf16_t* XI = (const bf16_t*)(ws + OFF_XIN); const bf16_t* BGp = (const bf16_t*)(ws + OFF_BG); const bf16_t* CGp = (const bf16_t*)(ws + OFF_CG);
    bf16_t* AM = (bf16_t*)(ws + OFF_AMIX);
    for (int idx = obid() * 512 + otid(); idx < NTOK * 64; idx += gridDim.x * 512) {
        const int t = idx >> 6, ch = (idx & 63) * 8;
        int s0, L; if (t < NPROMPT) { s0 = t & ~255; L = 256; } else { s0 = NPROMPT + ((t - NPROMPT) & ~2047); L = 2048; }
        const int tl = t - s0;
        float cv[8];
        { const f32x4 b0 = *(const f32x4*)(P->in[I_CONVB] + j * 512 + ch), b1 = *(const f32x4*)(P->in[I_CONVB] + j * 512 + ch + 4);
          cv[0] = b0[0]; cv[1] = b0[1]; cv[2] = b0[2]; cv[3] = b0[3]; cv[4] = b1[0]; cv[5] = b1[1]; cv[6] = b1[2]; cv[7] = b1[3]; }
#pragma unroll
        for (int jj = 0; jj < 3; ++jj) {
            const int tt = tl + jj - 1;
            if (tt < 0 || tt >= L) continue;
            const u32x4 xv = *(const u32x4*)(XI + (size_t)(s0 + tt) * 512 + ch), cg = *(const u32x4*)(CGp + (size_t)(s0 + tt) * 512 + ch);
            const f32x4 w0 = *(const f32x4*)(P->in[I_CONVW] + (size_t)(j * 3 + jj) * 512 + ch), w1 = *(const f32x4*)(P->in[I_CONVW] + (size_t)(j * 3 + jj) * 512 + ch + 4);
            cv[0] += bflo(xv.x) * bflo(cg.x) * w0[0]; cv[1] += bfhi(xv.x) * bfhi(cg.x) * w0[1]; cv[2] += bflo(xv.y) * bflo(cg.y) * w0[2]; cv[3] += bfhi(xv.y) * bfhi(cg.y) * w0[3];
            cv[4] += bflo(xv.z) * bflo(cg.z) * w1[0]; cv[5] += bfhi(xv.z) * bfhi(cg.z) * w1[1]; cv[6] += bflo(xv.w) * bflo(cg.w) * w1[2]; cv[7] += bfhi(xv.w) * bfhi(cg.w) * w1[3];
        }
        const u32x4 bg = *(const u32x4*)(BGp + (size_t)t * 512 + ch);
        u32x4 o;
        o.x = pk2(cv[0] * bflo(bg.x), cv[1] * bfhi(bg.x)); o.y = pk2(cv[2] * bflo(bg.y), cv[3] * bfhi(bg.y));
        o.z = pk2(cv[4] * bflo(bg.z), cv[5] * bfhi(bg.z)); o.w = pk2(cv[6] * bflo(bg.w), cv[7] * bfhi(bg.w));
        *(u32x4*)(AM + (size_t)t * 1024 + 512 + ch) = o;
    }
}

__device__ __forceinline__ void convert_phase(PP P) {
    unsigned char* ws = P->ws;
    bf16_t* AM = (bf16_t*)(ws + OFF_AMIX);
    for (int idx = obid() * 512 + otid(); idx < NTOK * 64; idx += gridDim.x * 512) {
        const int t = idx >> 6, ch = (idx & 63) * 8;
        f32x4 a, b;
        if (t < NPROMPT) { const float* F = (const float*)(ws + OFF_FACCP) + (size_t)t * 512 + ch; a = *(const f32x4*)F; b = *(const f32x4*)(F + 4); }
        else {
            const float* F = (const float*)(ws + OFF_FACCS) + (size_t)(t - NPROMPT) * 512 + ch;
            a = *(const f32x4*)F; b = *(const f32x4*)(F + 4);
#pragma unroll
            for (int ks = 1; ks < 4; ++ks) { a += *(const f32x4*)(F + (size_t)ks * 8192 * 512); b += *(const f32x4*)(F + (size_t)ks * 8192 * 512 + 4); }
        }
        u32x4 o; o.x = pk2(a[0], a[1]); o.y = pk2(a[2], a[3]); o.z = pk2(b[0], b[1]); o.w = pk2(b[2], b[3]);
        *(u32x4*)(AM + (size_t)t * 1024 + ch) = o;
    }
}

__device__ __forceinline__ int permd(int d) { return (d & 32) | ((d & 12) << 1) | ((d & 16) >> 2) | (d & 3); }
__device__ __forceinline__ bf16x8 pack8(const f32x4& a, const f32x4& b) {
    u32x4 o; o.x = pk2(a[0], a[1]); o.y = pk2(a[2], a[3]); o.z = pk2(b[0], b[1]); o.w = pk2(b[2], b[3]);
    return __builtin_bit_cast(bf16x8, o);
}
__device__ __forceinline__ void gla_item(PP P, LAS unsigned char* lds, int j, int seg, int head, int dir, bool full) {
    const int tid = otid(), lane = tid & 63, w = tid >> 6, r = lane & 15, q = lane >> 4;
    unsigned char* ws = P->ws;
    const bf16_t* QB = (const bf16_t*)(ws + OFF_QB); const bf16_t* KB = (const bf16_t*)(ws + OFF_KB); const bf16_t* VT = (const bf16_t*)(ws + OFF_VT);
    const float* LOGF = (const float*)(ws + OFF_LOGF);
    float* ODIR = (float*)(ws + OFF_ODIR);
    float* Ubuf = (float*)(ws + OFF_U); float* Dtot = (float*)(ws + OFF_DTOT);
    LAS bf16_t* QT = (LAS bf16_t*)(lds);
    LAS bf16_t* KT = (LAS bf16_t*)(lds + 36864);
    LAS bf16_t* KH = (LAS bf16_t*)(lds + 73728);
    LAS float* DL = (LAS float*)(lds + 114688);
    LAS bf16x8* ATT = (LAS bf16x8*)(lds + 116736);
    const int tok0 = seg * 256;
    __syncthreads();
    {
        const int d = tid & 63, c = w, pd = permd(d);
        float b = 0.f;
        const float* lf = LOGF + (size_t)(tok0 + 32 * c) * 512 + dir * 256 + head * 64 + d;
        const bf16_t* qp = QB + (size_t)(tok0 + 32 * c) * 256 + head * 64 + d;
        const bf16_t* kp = KB + (size_t)(tok0 + 32 * c) * 256 + head * 64 + d;
#pragma unroll 8
        for (int ii = 0; ii < 32; ++ii) {
            const int il = dir ? 31 - ii : ii;
            b += lf[(size_t)il * 512];
            const float qv = bf2f(qp[(size_t)il * 256]), kv = bf2f(kp[(size_t)il * 256]);
            QT[(32 * c + il) * 72 + pd] = f2bf(qv * __expf(b));
            KT[(32 * c + il) * 72 + pd] = f2bf(kv * __expf(-b));
        }
        const float eT = __expf(b);
        DL[c * 64 + d] = eT;
#pragma unroll 8
        for (int il = 0; il < 32; ++il) KH[(c * 64 + d) * 40 + permd(il)] = f2bf(bf2f(KT[(32 * c + il) * 72 + pd]) * eT);
    }
    __syncthreads();
    if (full) {
        const int c = w;
        f32x4 at[2][2];
#pragma unroll
        for (int a = 0; a < 2; ++a)
#pragma unroll
            for (int b = 0; b < 2; ++b) at[a][b] = (f32x4){0.f, 0.f, 0.f, 0.f};
#pragma unroll
        for (int kk = 0; kk < 2; ++kk) {
            bf16x8 ka[2], qb[2];
#pragma unroll
            for (int t = 0; t < 2; ++t) { ka[t] = *(const LAS bf16x8*)(KT + (32 * c + 16 * t + r) * 72 + 32 * kk + 8 * q); qb[t] = *(const LAS bf16x8*)(QT + (32 * c + 16 * t + r) * 72 + 32 * kk + 8 * q); }
#pragma unroll
            for (int tj = 0; tj < 2; ++tj)
#pragma unroll
                for (int ti = 0; ti < 2; ++ti) at[tj][ti] = __builtin_amdgcn_mfma_f32_16x16x32_bf16(ka[tj], qb[ti], at[tj][ti], 0, 0, 0);
        }
#pragma unroll
        for (int ti = 0; ti < 2; ++ti) {
            const int i = 16 * ti + r;
#pragma unroll
            for (int tj = 0; tj < 2; ++tj)
#pragma unroll
                for (int jj = 0; jj < 4; ++jj) { const int jx = 16 * tj + 4 * q + jj; const bool keep = dir ? (jx >= i) : (jx <= i); if (!keep) at[tj][ti][jj] = 0.f; }
            ATT[(c * 2 + ti) * 64 + lane] = pack8(at[0][ti], at[1][ti]);
        }
    }
    __syncthreads();
    f32x4 S[4];
#pragma unroll
    for (int t = 0; t < 4; ++t) S[t] = (f32x4){0.f, 0.f, 0.f, 0.f};
    const int e = 16 * w + r;
    if (DBG_SINIT && full && seg >= 16) {
        const int sb = (seg - 16) >> 3, part = (seg - 16) & 7;
        const float* s0 = P->in[I_STATE] + ((size_t)(((sb * 2 + j) * 2 + dir) * 4 + head) * 64) * 128;
#pragma unroll
        for (int t = 0; t < 4; ++t)
#pragma unroll
            for (int jj = 0; jj < 4; ++jj) S[t][jj] = s0[(size_t)(16 * t + 4 * q + jj) * 128 + e];
        const int np = DBG_NP(dir ? 7 - part : part);
        for (int x = 0; x < np; ++x) {
            const int pp = dir ? 7 - x : x;
            const size_t ib = (size_t)(((sb * 8 + pp) * 4 + head) * 2 + dir) * 64;
#pragma unroll
            for (int t = 0; t < 4; ++t)
#pragma unroll
                for (int jj = 0; jj < 4; ++jj) { const int d = 16 * t + 4 * q + jj; S[t][jj] = S[t][jj] * Dtot[ib + d] + Ubuf[(ib + d) * 128 + e]; }
        }
    }
    const bf16_t* vt = VT + (size_t)(head * 128 + e) * NTOK + tok0;
    for (int cc = 0; cc < 8; ++cc) {
        const int c = dir ? 7 - cc : cc;
        const u32x2 v0 = *(const u32x2*)(vt + 32 * c + 4 * q), v1 = *(const u32x2*)(vt + 32 * c + 16 + 4 * q);
        u32x4 vv; vv.x = v0.x; vv.y = v0.y; vv.z = v1.x; vv.w = v1.y;
        const bf16x8 vb = __builtin_bit_cast(bf16x8, vv);
        if (full) {
            bf16x8 sb2[2];
            sb2[0] = pack8(S[0], S[1]); sb2[1] = pack8(S[2], S[3]);
#pragma unroll
            for (int mi = 0; mi < 2; ++mi) {
                f32x4 o = (f32x4){0.f, 0.f, 0.f, 0.f};
#pragma unroll
                for (int kk = 0; kk < 2; ++kk) {
                    const bf16x8 qa = *(const LAS bf16x8*)(QT + (32 * c + 16 * mi + r) * 72 + 32 * kk + 8 * q);
                    o = __builtin_amdgcn_mfma_f32_16x16x32_bf16(qa, sb2[kk], o, 0, 0, 0);
                }
                const bf16x8 aa = ATT[(c * 2 + mi) * 64 + lane];
                o = __builtin_amdgcn_mfma_f32_16x16x32_bf16(aa, vb, o, 0, 0, 0);
                float* op = ODIR + ((size_t)dir * NTOK + tok0 + 32 * c + 16 * mi + 4 * q) * 512 + head * 128 + e;
#pragma unroll
                for (int jj = 0; jj < 4; ++jj) op[(size_t)jj * 512] = o[jj];
            }
        }
#pragma unroll
        for (int t = 0; t < 4; ++t) {
            const f32x4 dv = *(const LAS f32x4*)(DL + c * 64 + 16 * t + 4 * q);
            S[t] = S[t] * dv;
            const bf16x8 ka = *(const LAS bf16x8*)(KH + (c * 64 + 16 * t + r) * 40 + 8 * q);
            S[t] = __builtin_amdgcn_mfma_f32_16x16x32_bf16(ka, vb, S[t], 0, 0, 0);
        }
    }
    if (full) {
        if (seg < 16) {
            float* so = P->out + OUT_STATE + ((size_t)(((seg * 2 + j) * 2 + dir) * 4 + head) * 64) * 128;
#pragma unroll
            for (int t = 0; t < 4; ++t)
#pragma unroll
                for (int jj = 0; jj < 4; ++jj) so[(size_t)(16 * t + 4 * q + jj) * 128 + e] = S[t][jj];
        }
    } else {
        const size_t ib = (size_t)(((seg - 16) * 4 + head) * 2 + dir) * 64;
#pragma unroll
        for (int t = 0; t < 4; ++t)
#pragma unroll
            for (int jj = 0; jj < 4; ++jj) Ubuf[(ib + 16 * t + 4 * q + jj) * 128 + e] = S[t][jj];
        if (tid < 64) { float p = 1.f;
#pragma unroll
            for (int c = 0; c < 8; ++c) p *= DL[c * 64 + tid];
            Dtot[ib + tid] = p; }
    }
}

__device__ __forceinline__ void gla_phase(PP P, LAS unsigned char* lds, int j, int sub) {
    const int G = gridDim.x;
    if (sub == 0) {
        for (int it = obid(); it < 384; it += G) {
            if (it >= 128 && it < 256) { const int pi = it - 128; gla_item(P, lds, j, pi >> 3, (pi >> 1) & 3, pi & 1, true); }
            else { const int li = it < 128 ? it : it - 128; gla_item(P, lds, j, 16 + (li >> 3), (li >> 1) & 3, li & 1, false); }
        }
    } else {
        for (int it = obid(); it < 256; it += G) gla_item(P, lds, j, 16 + (it >> 3), (it >> 1) & 3, it & 1, true);
    }
}


__device__ __forceinline__ void grid_barrier(unsigned* bar, unsigned target) {
    asm volatile("s_waitcnt vmcnt(0)" ::: "memory");
    __syncthreads();
    if (otid() == 0) {
        __builtin_amdgcn_fence(__ATOMIC_RELEASE, "agent");
        asm volatile("s_waitcnt vmcnt(0)" ::: "memory");
        __hip_atomic_fetch_add(bar, 1u, __ATOMIC_RELAXED, __HIP_MEMORY_SCOPE_AGENT);
        while (__hip_atomic_load(bar, __ATOMIC_RELAXED, __HIP_MEMORY_SCOPE_AGENT) < target) __builtin_amdgcn_s_sleep(8);
        __builtin_amdgcn_fence(__ATOMIC_ACQUIRE, "agent");
        asm volatile("s_waitcnt vmcnt(0)" ::: "memory");
    }
    __syncthreads();
}
enum { PT_PREP = 0, PT_NORM1, PT_GEMM_IN, PT_MIX_A, PT_MIX_B, PT_MIXPREP, PT_GEMM_OUT, PT_NORM2, PT_MLP1, PT_MLP2, PT_FINAL };

__global__ void __launch_bounds__(512, 2) mega_fwd(Params Pk) {
    extern __shared__ __attribute__((aligned(16))) unsigned char smem[];
    LAS unsigned char* lds = (LAS unsigned char*)smem;
#ifdef DBG_ZLDS
    for (int i = otid(); i < LDS_BYTES / 16; i += 512) ((LAS u32x4*)lds)[i] = (u32x4){0u, 0u, 0u, 0u};
    __syncthreads();
#endif
    unsigned nbar = 0;
    if (Pk.ph_hi < 0) cg::this_grid().sync();
    for (int ph = Pk.ph_lo; ph < Pk.ph_hi; ++ph) {
        PP P = (PP)__builtin_amdgcn_kernarg_segment_ptr();
        asm volatile("" : "+s"(P));
        int pt, l = 0;
        if (ph == 0) pt = PT_PREP;
        else if (ph == NPH - 1) pt = PT_FINAL;
        else {
            const int qq = ph - 1; int s;
            if (qq < 9) { l = 0; s = qq; } else if (qq < 17) { l = 1; s = qq - 9; } else if (qq < 26) { l = 2; s = qq - 17; } else { l = 3; s = qq - 26; }
            pt = (l & 1) ? (s < 4 ? s + 1 : s + 2) : s + 1;
        }
        const int j = l >> 1, odd = l & 1;
        const int nrep = (pt == REP_PT) ? 1 + REP_N : 1;
        for (int rep = 0; rep < nrep; ++rep) {
        int ngemm = 0; GemmCfg g; g.G = gridDim.x; g.c = obid(); g.j = j; g.l = l; g.nM = 48; g.ld = 1024; g.nt = 16; g.type = 0; g.nN = 0;
        switch (pt) {
        case PT_PREP: if (EN & 1) prep_phase(P, lds); break;
        case PT_NORM1: if (EN & 2) norm_phase(P, l, 0); break;
        case PT_GEMM_IN: ngemm = 1; g.type = odd ? T_IN_ODD : T_IN_EVEN; g.nN = 10; break;
        case PT_MIX_A: if (odd) { ngemm = 2; g.type = T_DFT_S; g.nM = 8; g.nN = 32; g.ld = 4096; g.nt = 16; } else { if (EN & 4) gla_phase(P, lds, j, 0); if (EN & 8) pool_phase(P); } break;
        case PT_MIX_B: if (odd) { if (EN & 8) convert_phase(P); } else { if (EN & 4) gla_phase(P, lds, j, 1); } break;
        case PT_MIXPREP: if (EN & 8) mixprep_phase(P, j); break;
        case PT_GEMM_OUT: ngemm = 1; g.type = odd ? T_OUT_ODD : T_OUT_EVEN; g.nN = 4; break;
        case PT_NORM2: if (EN & 2) norm_phase(P, l, 1); break;
        case PT_MLP1: ngemm = 1; g.type = T_MLP1; g.nN = 16; break;
        case PT_MLP2: ngemm = 1; g.type = T_MLP2; g.nN = 4; g.ld = 4096; g.nt = 64; break;
        default: if (EN & 2) norm_phase(P, 0, 2); break;
        }
        for (int gi = 0; gi < ngemm; ++gi) {
            if (gi == 1) { g.type = T_DFT_P; g.nM = 1; g.nN = 32; g.ld = 512; g.nt = 8; g.c = (obid() + gridDim.x - 32) % gridDim.x; }
            if (EN & 16) gemm_phase(lds, g);
        }
        if (pt == PT_MIX_A && odd && (EN & 8)) conv_phase(P, j);
        if (ph + 1 < Pk.ph_hi || rep + 1 < nrep) { ++nbar; grid_barrier((unsigned*)(P->ws + OFF_BAR), nbar * gridDim.x); }
        }

    }
}


#ifdef DBG_K
__device__ __forceinline__ float dgst(unsigned u) { return (float)(u & 0xffffu) + (float)(u >> 16); }
__global__ void dbg_dump(float* out, const unsigned char* ws) {
    const unsigned* Xu = (const unsigned*)(ws + OFF_X); const unsigned* Hu = (const unsigned*)(ws + OFF_H); const unsigned* Au = (const unsigned*)(ws + OFF_AMIX);
    const unsigned* Bu = (const unsigned*)(ws + OFF_BIG); const unsigned* Uu = (const unsigned*)(ws + OFF_U); const unsigned* Wu = (const unsigned*)(ws);
    for (size_t i = (size_t)blockIdx.x * blockDim.x + threadIdx.x; i < (size_t)NTOK * 1024; i += (size_t)gridDim.x * blockDim.x) {
        float v = 0.f;
        if (DBG_SEL & 1) v += dgst(Xu[i]);
        if (DBG_SEL & 2) v += dgst(Hu[i % 6291456]);
        if (DBG_SEL & 4) v += dgst(Au[i % 6291456]);
        if (DBG_SEL & 8) v += dgst(Bu[i]) + dgst(Bu[i + 12582912]) + dgst(Bu[(i + 25165824) % 34603008]);
        if (DBG_SEL & 16) v += dgst(Uu[i % 2113536]);
        if (DBG_SEL & 32) v += dgst(Wu[i]) + dgst(Wu[i + 12582912]) + dgst(Wu[(i + 25165824) % 28573696]);
        out[i] = v;
    }
}
#endif
extern "C" void kernel_launch(void* const* d_in, const int* in_sizes, int n_in, void* d_out, int out_size, void* d_ws, size_t ws_size, hipStream_t stream) {
    static int grid = 0;
    if (grid == 0) {
        if (n_in != 22 || ws_size < WS_NEED) { fprintf(stderr, "kernel_launch: unexpected n_in %d / ws_size %zu (need %zu)\n", n_in, ws_size, (size_t)WS_NEED); grid = -1; return; }
        int dev = 0, cus = 0, per_cu = 0;
        hipGetDevice(&dev);
        hipDeviceGetAttribute(&cus, hipDeviceAttributeMultiprocessorCount, dev);
        if (hipFuncSetAttribute((const void*)mega_fwd, hipFuncAttributeMaxDynamicSharedMemorySize, LDS_BYTES) != hipSuccess) { fprintf(stderr, "kernel_launch: hipFuncSetAttribute failed\n"); grid = -1; return; }
        hipOccupancyMaxActiveBlocksPerMultiprocessor(&per_cu, (const void*)mega_fwd, 512, LDS_BYTES);
        if (per_cu < 1) { fprintf(stderr, "kernel_launch: occupancy query says %d blocks/CU\n", per_cu); per_cu = 1; }
        (void)hipGetLastError();
        grid = cus;
    }
    if (grid < 0) return;
    Params p{};
    for (int i = 0; i < 22; ++i) p.in[i] = (const float*)d_in[i];
    p.out = (float*)d_out; p.ws = (unsigned char*)d_ws;
#if MULTI_LAUNCH
#ifdef DBG_K
    for (int ph = 0; ph < DBG_K; ++ph) {
        p.ph_lo = ph; p.ph_hi = ph + 1;
        hipLaunchKernelGGL(mega_fwd, dim3(grid), dim3(512), LDS_BYTES, stream, p);
    }
    hipLaunchKernelGGL(dbg_dump, dim3(2048), dim3(256), 0, stream, (float*)d_out, (const unsigned char*)d_ws);
#else
    for (int ph = 0; ph < NPH; ++ph) {
        p.ph_lo = ph; p.ph_hi = ph + 1;
        hipLaunchKernelGGL(mega_fwd, dim3(grid), dim3(512), LDS_BYTES, stream, p);
    }
#endif
#else
    p.ph_lo = 0; p.ph_hi = NPH;
    if (hipMemsetAsync((char*)d_ws + OFF_BAR, 0, 256, stream) != hipSuccess) { fprintf(stderr, "kernel_launch: memset of barrier word failed\n"); return; }
    void* args[] = {&p};
    hipError_t e = hipLaunchCooperativeKernel((const void*)mega_fwd, dim3(grid), dim3(512), args, LDS_BYTES, stream);
    if (e != hipSuccess) fprintf(stderr, "cooperative launch failed: %s (grid %d)\n", hipGetErrorString(e), grid);
#endif
}
```

```cpp
#include <hip/hip_runtime.h>
#include <hip/hip_cooperative_groups.h>
#include <cstdio>
#include <cstdint>
namespace cg = cooperative_groups;

#ifndef DBG_SEL
#define DBG_SEL 63
#endif
#ifndef DBG_NP
#define DBG_NP(x) (x)
#endif
#ifndef REP_PT
#define REP_PT -1
#endif
#ifndef REP_N
#define REP_N 1
#endif
#ifndef XSYNC
#define XSYNC 0
#endif
#ifndef DBG_SINIT
#define DBG_SINIT 1
#endif
#ifndef EN
#define EN 31
#endif
#ifndef MULTI_LAUNCH
#define MULTI_LAUNCH 0
#endif

#define LAS __attribute__((address_space(3)))
typedef unsigned short bf16_t;
typedef short bf16x8 __attribute__((ext_vector_type(8)));
typedef float f32x4 __attribute__((ext_vector_type(4)));
typedef unsigned u32x2 __attribute__((ext_vector_type(2)));
typedef unsigned u32x4 __attribute__((ext_vector_type(4)));

constexpr int DM = 1024, NTOK = 12288, NPROMPT = 4096, DFF = 4096;
constexpr int LDS_BYTES = 147456;
constexpr int NPH = 36;
constexpr size_t MBy = 1048576;
constexpr size_t OFF_W1T = 0, OFF_W2T = 32 * MBy, OFF_WIE = 64 * MBy, OFF_WOE = 74 * MBy, OFF_WIO = 78 * MBy, OFF_WOO = 88 * MBy;
constexpr size_t OFF_T2K = 92 * MBy, OFF_T256 = 108 * MBy, OFF_MOD = 108 * MBy + 262144, OFF_U = 109 * MBy, OFF_DTOT = 117 * MBy;
constexpr size_t OFF_X = 118 * MBy, OFF_H = 166 * MBy, OFF_AMIX = 190 * MBy, OFF_BIG = 214 * MBy, WS_NEED = 348 * MBy;
constexpr size_t OFF_HID = OFF_BIG;
constexpr size_t OFF_QB = OFF_BIG, OFF_KB = OFF_BIG + 6 * MBy, OFF_VT = OFF_BIG + 12 * MBy, OFF_GATE = OFF_BIG + 24 * MBy, OFF_LOGF = OFF_BIG + 36 * MBy;
constexpr size_t OFF_UB = OFF_BIG + 60 * MBy, OFF_ODIR = OFF_BIG + 72 * MBy;
constexpr size_t OFF_XTS = OFF_BIG, OFF_XTP = OFF_BIG + 16 * MBy, OFF_XIN = OFF_BIG + 24 * MBy, OFF_BG = OFF_BIG + 36 * MBy, OFF_CG = OFF_BIG + 48 * MBy;
constexpr size_t OFF_FACCP = OFF_BIG + 60 * MBy, OFF_FACCS = OFF_BIG + 68 * MBy;
constexpr size_t OFF_BAR = 117 * MBy + 524288;
constexpr size_t OUT_STATE = (size_t)NTOK * DM;

struct Params { const float* in[22]; float* out; unsigned char* ws; int ph_lo, ph_hi; };
typedef const __attribute__((address_space(4))) Params* PP;
enum { I_XP = 0, I_XS, I_STATE, I_C, I_CCTX, I_NORMG, I_FINALG, I_WADA, I_BADA, I_W1, I_W2, I_WINE, I_WA2, I_BA2, I_GLAG, I_POOLW, I_POOLS, I_WOUTE, I_WINO, I_CONVW, I_CONVB, I_WOUTO };

__device__ __forceinline__ int otid() { int t = __builtin_amdgcn_workitem_id_x(); asm volatile("" : "+v"(t)); return t; }
__device__ __forceinline__ int obid() { int b = __builtin_amdgcn_workgroup_id_x(); asm volatile("" : "+s"(b)); return b; }
typedef float f32x2 __attribute__((ext_vector_type(2)));
typedef __bf16 bf16x2v __attribute__((ext_vector_type(2)));
__device__ __forceinline__ unsigned pk2(float lo, float hi) { f32x2 v = {lo, hi}; bf16x2v b = __builtin_convertvector(v, bf16x2v); return __builtin_bit_cast(unsigned, b); }
__device__ __forceinline__ bf16_t f2bf(float x) { return (bf16_t)(pk2(x, 0.f) & 0xffffu); }
__device__ __forceinline__ float bf2f(bf16_t u) { return __uint_as_float(((unsigned)u) << 16); }
__device__ __forceinline__ float bflo(unsigned u) { return __uint_as_float(u << 16); }
__device__ __forceinline__ float bfhi(unsigned u) { return __uint_as_float(u & 0xffff0000u); }
__device__ __forceinline__ float wave_sum(float v) {
#pragma unroll
    for (int o = 1; o < 64; o <<= 1) v += __shfl_xor(v, o);
    return v;
}
__device__ __forceinline__ float siluf(float x) { return x * __builtin_amdgcn_rcpf(1.f + __expf(-x)); }
__device__ __forceinline__ float logsigmoidf(float x) { return fminf(x, 0.f) - __logf(1.f + __expf(-fabsf(x))); }
__device__ __forceinline__ int cond_of_seg(int pm) { return pm < 16 ? 0 : 1 + ((pm - 16) >> 3); }

namespace pg8 {
constexpr int BM = 256, BK = 64, HALF = 128, HTB = HALF * BK * 2, STAGE_BYTES = 8 * HTB, NXCD = 8, WGM = 8;
__host__ __device__ __forceinline__ int lds_byte(int r, int c) { const int st = (r >> 4) * 2 + (c >> 5), rr = r & 15, cc = c & 31, ob = rr * 64 + cc * 2; return st * 1024 + (ob ^ (((ob >> 9) & 1) << 5)); }
__host__ __device__ __forceinline__ void stage_rc(int b, int& R, int& C) { const int st = b / 1024, sb = b % 1024, swz = sb ^ (((sb >> 9) & 1) << 5); R = (st >> 1) * 16 + swz / 64; C = (st & 1) * 32 + (swz % 64) / 2; }
}

enum { KD_BF16 = 0, KD_SILU, KD_RELU2, KD_LOGF, KD_RES, KD_ATOM };
enum { T_IN_EVEN = 0, T_IN_ODD, T_OUT_EVEN, T_OUT_ODD, T_MLP1, T_MLP2, T_DFT_S, T_DFT_P };
struct Unit { int pm, pn; };
struct UnitIO { const char* A; const char* B; char* out; const float* aux; int kind; int ld; };
struct GemmCfg { int type, j, l, nM, nN, ld, nt, G, c; };

__device__ __forceinline__ void make_unit(const GemmCfg& g, int pm, int pn, UnitIO& u) {
    PP Pq = (PP)__builtin_amdgcn_kernarg_segment_ptr();
    unsigned char* ws = Pq->ws;
    const size_t rowA = (size_t)pm * 256 * 1024 * 2;
    u.aux = nullptr; u.kind = KD_BF16; u.ld = 512;
    const float* modp = (const float*)(ws + OFF_MOD) + (size_t)(g.l * 5 + cond_of_seg(pm)) * 6144;
    switch (g.type) {
    case T_IN_EVEN: {
        const char* W = (const char*)(ws + OFF_WIE) + (size_t)g.j * 2560 * 1024 * 2 + (size_t)pn * 256 * 1024 * 2;
        const char* Hh = (const char*)(ws + OFF_H) + rowA;
        u.A = Hh; u.B = W;
        if (pn == 0) { u.out = (char*)(ws + OFF_QB) + (size_t)pm * 256 * 256 * 2; u.ld = 256; }
        else if (pn == 1) { u.out = (char*)(ws + OFF_KB) + (size_t)pm * 256 * 256 * 2; u.ld = 256; }
        else if (pn < 4) { u.A = W; u.B = Hh; u.out = (char*)(ws + OFF_VT) + ((size_t)(pn - 2) * 256 * NTOK + (size_t)pm * 256) * 2; u.ld = NTOK; }
        else if (pn < 6) { u.out = (char*)(ws + OFF_GATE) + ((size_t)pm * 256 * 512 + (pn - 4) * 256) * 2; u.kind = KD_SILU; }
        else if (pn < 8) { u.out = (char*)(ws + OFF_LOGF) + ((size_t)pm * 256 * 512 + (pn - 6) * 256) * 4; u.kind = KD_LOGF; u.aux = Pq->in[I_BA2] + g.j * 512 + (pn - 6) * 256; }
        else { u.out = (char*)(ws + OFF_UB) + ((size_t)pm * 256 * 512 + (pn - 8) * 256) * 2; }
    } break;
    case T_IN_ODD: {
        const char* W = (const char*)(ws + OFF_WIO) + (size_t)g.j * 2560 * 1024 * 2 + (size_t)pn * 256 * 1024 * 2;
        const char* Hh = (const char*)(ws + OFF_H) + rowA;
        u.A = Hh; u.B = W;
        if (pn < 4) {
            u.A = W; u.B = Hh;
            const int z = pn >> 1, ch0 = (pn & 1) * 256;
            if (pm < 16) { u.out = (char*)(ws + OFF_XTP) + ((size_t)(pm * 512 + ch0) * 512 + z * 256) * 2; u.ld = 512; }
            else { const int b = (pm - 16) >> 3, part = (pm - 16) & 7; u.out = (char*)(ws + OFF_XTS) + ((size_t)(b * 512 + ch0) * 4096 + z * 2048 + part * 256) * 2; u.ld = 4096; }
        } else {
            const size_t base = (pn < 6) ? OFF_XIN : (pn < 8 ? OFF_BG : OFF_CG);
            u.out = (char*)(ws + base) + ((size_t)pm * 256 * 512 + (pn & 1) * 256) * 2;
        }
    } break;
    case T_OUT_EVEN: case T_OUT_ODD: {
        u.A = (const char*)(ws + OFF_AMIX) + rowA;
        u.B = (const char*)(ws + (g.type == T_OUT_EVEN ? OFF_WOE : OFF_WOO)) + (size_t)g.j * 1024 * 1024 * 2 + (size_t)pn * 256 * 1024 * 2;
        u.out = (char*)(ws + OFF_X) + ((size_t)pm * 256 * 1024 + pn * 256) * 4; u.ld = 1024; u.kind = KD_RES; u.aux = modp + 2048 + pn * 256;
    } break;
    case T_MLP1: {
        u.A = (const char*)(ws + OFF_H) + rowA;
        u.B = (const char*)(ws + OFF_W1T) + (size_t)g.l * 4096 * 1024 * 2 + (size_t)pn * 256 * 1024 * 2;
        u.out = (char*)(ws + OFF_HID) + ((size_t)pm * 256 * 4096 + pn * 256) * 2; u.ld = 4096; u.kind = KD_RELU2;
    } break;
    case T_MLP2: {
        u.A = (const char*)(ws + OFF_HID) + (size_t)pm * 256 * 4096 * 2;
        u.B = (const char*)(ws + OFF_W2T) + (size_t)g.l * 4096 * 1024 * 2 + (size_t)pn * 256 * 4096 * 2;
        u.out = (char*)(ws + OFF_X) + ((size_t)pm * 256 * 1024 + pn * 256) * 4; u.ld = 1024; u.kind = KD_RES; u.aux = modp + 5120 + pn * 256;
    } break;
    case T_DFT_S: {
        const int pnb = pn >> 2, ks = pn & 3;
        u.A = (const char*)(ws + OFF_T2K) + ((size_t)pm * 256 * 4096 + ks * 1024) * 2;
        u.B = (const char*)(ws + OFF_XTS) + ((size_t)pnb * 256 * 4096 + ks * 1024) * 2;
        u.out = (char*)(ws + OFF_FACCS) + ((size_t)ks * 8192 * 512 + (size_t)((pnb >> 1) * 2048 + pm * 256) * 512 + (pnb & 1) * 256) * 4; u.kind = KD_ATOM;
    } break;
    default: {
        u.A = (const char*)(ws + OFF_T256);
        u.B = (const char*)(ws + OFF_XTP) + (size_t)pn * 256 * 512 * 2;
        u.out = (char*)(ws + OFF_FACCP) + ((size_t)((pn >> 1) * 256) * 512 + (pn & 1) * 256) * 4; u.kind = KD_ATOM;
    } break;
    }
}

__device__ __forceinline__ bool next_unit(const GemmCfg& g, int i, Unit& u) {
    const int nwg = g.nM * g.nN;
    const long L = (long)i * g.G + g.c; if (L >= nwg) return false;
    int wgid = (int)L; { const int q = nwg / pg8::NXCD, r = nwg % pg8::NXCD, xcd = wgid % pg8::NXCD, off = wgid / pg8::NXCD; wgid = (xcd < r ? xcd * (q + 1) : r * (q + 1) + (xcd - r) * q) + off; }
    const int nig = pg8::WGM * g.nN, gid = wgid / nig, fm = gid * pg8::WGM, gsz = (g.nM - fm) < pg8::WGM ? (g.nM - fm) : pg8::WGM;
    const int pm = fm + ((wgid % nig) % gsz), pn = (wgid % nig) / gsz;
    u.pm = pm; u.pn = pn; return true;
}

__device__ __forceinline__ void epilogue(const f32x4 (&acc)[2][2][4][2], const GemmCfg& g, const Unit& uu, int wr, int wc, int fr, int fq) {
    UnitIO u; make_unit(g, uu.pm, uu.pn, u);
    const int row0 = wr * 64 + fr, col0 = wc * 32 + 4 * fq;
    const int kind = u.kind, ld = u.ld;
    if (kind <= KD_RELU2) {
        bf16_t* O = (bf16_t*)u.out;
#pragma unroll
        for (int ai = 0; ai < 2; ++ai)
#pragma unroll
            for (int m = 0; m < 4; ++m) {
                bf16_t* rowp = O + (size_t)(row0 + ai * 128 + m * 16) * ld + col0;
#pragma unroll
                for (int bj = 0; bj < 2; ++bj)
#pragma unroll
                    for (int n = 0; n < 2; ++n) {
                        f32x4 v = acc[ai][bj][m][n];
                        if (kind == KD_SILU) { v[0] = siluf(v[0]); v[1] = siluf(v[1]); v[2] = siluf(v[2]); v[3] = siluf(v[3]); }
                        else if (kind == KD_RELU2) { v[0] = fmaxf(v[0], 0.f); v[1] = fmaxf(v[1], 0.f); v[2] = fmaxf(v[2], 0.f); v[3] = fmaxf(v[3], 0.f); v = v * v; }
                        u32x2 o; o.x = pk2(v[0], v[1]); o.y = pk2(v[2], v[3]);
                        *(u32x2*)(rowp + bj * 128 + n * 16) = o;
                    }
            }
    } else if (kind == KD_RES) {
        float* O = (float*)u.out;
        f32x4 gv[2][2];
#pragma unroll
        for (int bj = 0; bj < 2; ++bj)
#pragma unroll
            for (int n = 0; n < 2; ++n) gv[bj][n] = *(const f32x4*)(u.aux + col0 + bj * 128 + n * 16);
#pragma unroll
        for (int ai = 0; ai < 2; ++ai)
#pragma unroll
            for (int m = 0; m < 4; ++m) {
                float* rowp = O + (size_t)(row0 + ai * 128 + m * 16) * ld + col0;
#pragma unroll
                for (int bj = 0; bj < 2; ++bj)
#pragma unroll
                    for (int n = 0; n < 2; ++n) { f32x4* p = (f32x4*)(rowp + bj * 128 + n * 16); *p = *p + gv[bj][n] * acc[ai][bj][m][n]; }
            }
    } else if (kind == KD_LOGF) {
        float* O = (float*)u.out;
#pragma unroll
        for (int bj = 0; bj < 2; ++bj)
#pragma unroll
            for (int n = 0; n < 2; ++n) {
                const f32x4 bv = *(const f32x4*)(u.aux + col0 + bj * 128 + n * 16);
#pragma unroll
                for (int ai = 0; ai < 2; ++ai)
#pragma unroll
                    for (int m = 0; m < 4; ++m) {
                        f32x4 v = acc[ai][bj][m][n] + bv;
                        v[0] = logsigmoidf(v[0]) * 0.0625f; v[1] = logsigmoidf(v[1]) * 0.0625f; v[2] = logsigmoidf(v[2]) * 0.0625f; v[3] = logsigmoidf(v[3]) * 0.0625f;
                        *(f32x4*)(O + (size_t)(row0 + ai * 128 + m * 16) * ld + col0 + bj * 128 + n * 16) = v;
                    }
            }
    } else {
        float* O = (float*)u.out;
#pragma unroll
        for (int ai = 0; ai < 2; ++ai)
#pragma unroll
            for (int m = 0; m < 4; ++m) {
                float* rowp = O + (size_t)(row0 + ai * 128 + m * 16) * ld + col0;
#pragma unroll
                for (int bj = 0; bj < 2; ++bj)
#pragma unroll
                    for (int n = 0; n < 2; ++n) {
                        *(f32x4*)(rowp + bj * 128 + n * 16) = acc[ai][bj][m][n];
                    }
            }
    }
}

__device__ __forceinline__ void gemm_phase(LAS unsigned char* lds, const GemmCfg& g) {
    using namespace pg8;
    const int tid = otid(), wid = __builtin_amdgcn_readfirstlane(tid >> 6), lane = tid & 63, wr = wid >> 2, wc = wid & 3, fr = lane & 15, fq = lane >> 4;
    const int nt = g.nt;
    unsigned voffA[2];
#pragma unroll
    for (int i = 0; i < 2; ++i) { int R, C; stage_rc(tid * 16 + i * 8192, R, C); voffA[i] = (unsigned)(R * g.ld + C) * 2u; }
#define voffB voffA
    const size_t kstep = (size_t)(BK * 2);
    const size_t hstepA = (size_t)HALF * g.ld * 2;
#define hstepB hstepA
    const unsigned ldsw = (unsigned)wid * 1024u;
    const int aoff = lds_byte(wr * 64 + fr, fq * 8), boff = lds_byte(wc * 32 + fr, fq * 8);
#define PG8_SA(b, h) (((b) * 2 + (h)) * HTB)
#define PG8_SB(b, h) ((4 + (b) * 2 + (h)) * HTB)
#define PG8_STAGE(bufoff, gbase, voff) do { _Pragma("unroll") for (int _i = 0; _i < 2; ++_i) \
        __builtin_amdgcn_global_load_lds((const unsigned*)((const char*)(gbase) + (voff)[_i]), (LAS unsigned*)(lds + (bufoff) + ldsw + _i * 8192), 16, 0, 0); } while (0)
#define PG8_LDA(dst, b, h) do { _Pragma("unroll") for (int m = 0; m < 4; ++m) _Pragma("unroll") for (int k = 0; k < 2; ++k) dst[m][k] = *(const LAS bf16x8*)(lds + PG8_SA(b, h) + aoff + m * 2048 + k * 1024); } while (0)
#define PG8_LDB(dst, b, h) do { _Pragma("unroll") for (int n = 0; n < 2; ++n) _Pragma("unroll") for (int k = 0; k < 2; ++k) dst[n][k] = *(const LAS bf16x8*)(lds + PG8_SB(b, h) + boff + n * 2048 + k * 1024); } while (0)
#define PG8_MMA(ai, bj, At, Bt) do { __builtin_amdgcn_s_setprio(1); _Pragma("unroll") for (int m = 0; m < 4; ++m) _Pragma("unroll") for (int n = 0; n < 2; ++n) _Pragma("unroll") for (int k = 0; k < 2; ++k) \
        acc[ai][bj][m][n] = __builtin_amdgcn_mfma_f32_16x16x32_bf16(Bt[n][k], At[m][k], acc[ai][bj][m][n], 0, 0, 0); __builtin_amdgcn_s_setprio(0); } while (0)
#define PG8_WAIT_V(n) asm volatile("s_waitcnt vmcnt(" #n ")" ::: "memory")
#define PG8_WAIT_L(n) asm volatile("s_waitcnt lgkmcnt(" #n ")" ::: "memory")
#define PG8_BAR __builtin_amdgcn_s_barrier()
#define PG8_SCHED __builtin_amdgcn_sched_barrier(0)
    Unit cur, nxt; int ui = 0;
    if (!next_unit(g, 0, cur)) return;
    f32x4 acc[2][2][4][2];
#pragma unroll
    for (int a = 0; a < 2; ++a)
#pragma unroll
        for (int b = 0; b < 2; ++b)
#pragma unroll
            for (int m = 0; m < 4; ++m)
#pragma unroll
                for (int n = 0; n < 2; ++n) acc[a][b][m][n] = (f32x4){0.f, 0.f, 0.f, 0.f};
    bf16x8 At[4][2], B0[2][2], B1[2][2];
    const char* cA; const char* cB; { UnitIO io; make_unit(g, cur.pm, cur.pn, io); cA = io.A; cB = io.B; }
    PG8_STAGE(PG8_SB(0, 0), cB, voffB); PG8_STAGE(PG8_SA(0, 0), cA, voffA); PG8_STAGE(PG8_SB(0, 1), cB + hstepB, voffB); PG8_STAGE(PG8_SA(0, 1), cA + hstepA, voffA);
    if (wr == 1) PG8_BAR;
    PG8_WAIT_V(4); PG8_BAR;
    PG8_STAGE(PG8_SB(1, 0), cB + kstep, voffB); PG8_STAGE(PG8_SA(1, 0), cA + kstep, voffA); PG8_STAGE(PG8_SB(1, 1), cB + hstepB + kstep, voffB);
    PG8_WAIT_V(6); PG8_BAR;
    for (;;) {
        const bool has_next = next_unit(g, ui + 1, nxt);
        const char* nA = cA; const char* nB = cB; if (has_next) { UnitIO io; make_unit(g, nxt.pm, nxt.pn, io); nA = io.A; nB = io.B; }
        for (int t = 0; t < nt; t += 2) {
            const bool last = (t == nt - 2);
            const char* a1 = cA + (size_t)(t + 1) * kstep;
            const char* a2 = last ? nA : cA + (size_t)(t + 2) * kstep; const char* b2 = last ? nB : cB + (size_t)(t + 2) * kstep;
            const char* a3 = a2 + kstep; const char* b3 = b2 + kstep;
            PG8_LDB(B0, 0, 0); PG8_SCHED; PG8_LDA(At, 0, 0); PG8_STAGE(PG8_SA(1, 1), a1 + hstepA, voffA);
            PG8_WAIT_L(8); PG8_BAR; PG8_WAIT_L(0); PG8_MMA(0, 0, At, B0); PG8_BAR; PG8_SCHED;
            PG8_LDB(B1, 0, 1); PG8_STAGE(PG8_SB(0, 0), b2, voffB);
            PG8_BAR; PG8_WAIT_L(0); PG8_MMA(0, 1, At, B1); PG8_BAR;
            PG8_LDA(At, 0, 1); PG8_STAGE(PG8_SA(0, 0), a2, voffA);
            PG8_BAR; PG8_WAIT_L(0); PG8_MMA(1, 0, At, B0); PG8_BAR; PG8_SCHED;
            PG8_STAGE(PG8_SB(0, 1), b2 + hstepB, voffB);
            PG8_WAIT_V(6); PG8_BAR; PG8_MMA(1, 1, At, B1); PG8_BAR;
            PG8_LDB(B0, 1, 0); PG8_SCHED; PG8_LDA(At, 1, 0); PG8_STAGE(PG8_SA(0, 1), a2 + hstepA, voffA);
            PG8_WAIT_L(8); PG8_BAR; PG8_WAIT_L(0); PG8_MMA(0, 0, At, B0); PG8_BAR; PG8_SCHED;
            PG8_LDB(B1, 1, 1); PG8_STAGE(PG8_SB(1, 0), b3, voffB);
            PG8_BAR; PG8_WAIT_L(0); PG8_MMA(0, 1, At, B1); PG8_BAR;
            PG8_LDA(At, 1, 1); PG8_STAGE(PG8_SA(1, 0), a3, voffA);
            PG8_BAR; PG8_WAIT_L(0); PG8_MMA(1, 0, At, B0); PG8_BAR; PG8_SCHED;
            PG8_STAGE(PG8_SB(1, 1), b3 + hstepB, voffB);
            PG8_WAIT_V(6); PG8_BAR; PG8_MMA(1, 1, At, B1); PG8_BAR;
        }
        epilogue(acc, g, cur, wr, wc, fr, fq);
        if (!has_next) break;
#pragma unroll
        for (int a = 0; a < 2; ++a)
#pragma unroll
            for (int b = 0; b < 2; ++b)
#pragma unroll
                for (int m = 0; m < 4; ++m)
#pragma unroll
                    for (int n = 0; n < 2; ++n) acc[a][b][m][n] = (f32x4){0.f, 0.f, 0.f, 0.f};
        cur = nxt; cA = nA; cB = nB; ++ui;
    }
    PG8_WAIT_V(0);
    if (wr == 0) PG8_BAR;
    PG8_BAR;
#undef voffB
#undef hstepB
#undef PG8_SA
#undef PG8_SB
#undef PG8_STAGE
#undef PG8_LDA
#undef PG8_LDB
#undef PG8_MMA
#undef PG8_WAIT_V
#undef PG8_WAIT_L
#undef PG8_BAR
#undef PG8_SCHED
}

__device__ __forceinline__ void transpose_item(const float* W, int ldn, int n0, int k0, bf16_t* WT, int drow0, int ldk, float scale, LAS float* scr, int lane) {
#pragma unroll 8
    for (int i = 0; i < 32; ++i) { const int kk = 2 * i + (lane >> 5); scr[kk * 33 + (lane & 31)] = W[(size_t)(k0 + kk) * ldn + n0 + (lane & 31)]; }
    asm volatile("s_waitcnt lgkmcnt(0)" ::: "memory");
    const int c = lane & 7;
#pragma unroll
    for (int jx = 0; jx < 4; ++jx) {
        const int n = (lane >> 3) + 8 * jx; const LAS float* s = scr + (8 * c) * 33 + n;
        u32x4 o; o.x = pk2(s[0] * scale, s[33] * scale); o.y = pk2(s[66] * scale, s[99] * scale); o.z = pk2(s[132] * scale, s[165] * scale); o.w = pk2(s[198] * scale, s[231] * scale);
        *(u32x4*)(WT + (size_t)(drow0 + n) * ldk + k0 + 8 * c) = o;
    }
    asm volatile("s_waitcnt lgkmcnt(0)" ::: "memory");
}

__device__ __forceinline__ void prep_phase(PP P, LAS unsigned char* lds) {
    const int tid = otid(), lane = tid & 63, wave = tid >> 6, G = gridDim.x, bx = obid();
    unsigned char* ws = P->ws;
    {
        LAS float* scr = (LAS float*)(lds + wave * 8704);
        constexpr int N1 = 4 * 16 * 128, N2 = 4 * 64 * 32, N3 = 2 * 16 * 64, N4 = 2 * 8 * 32, N5 = 2 * 16 * 48, N6 = 2 * 16 * 32;
        constexpr int NIT = N1 + N2 + N3 + N4 + N5 + N6;
        for (int it = bx * 8 + wave; it < NIT; it += G * 8) {
            int r = it;
            if (r < N1) { const int l = r / 2048, q = r % 2048, kb = q / 128, nb = q % 128;
                transpose_item(P->in[I_W1] + (size_t)l * 1024 * 4096, 4096, nb * 32, kb * 64, (bf16_t*)(ws + OFF_W1T) + (size_t)l * 4096 * 1024, nb * 32, 1024, 1.f, scr, lane); continue; }
            r -= N1;
            if (r < N2) { const int l = r / 2048, q = r % 2048, kb = q / 32, nb = q % 32;
                transpose_item(P->in[I_W2] + (size_t)l * 4096 * 1024, 1024, nb * 32, kb * 64, (bf16_t*)(ws + OFF_W2T) + (size_t)l * 1024 * 4096, nb * 32, 4096, 1.f, scr, lane); continue; }
            r -= N2;
            if (r < N3) { const int j = r / 1024, q = r % 1024, kb = q / 64, nb = q % 64; const int sb = nb < 48 ? nb : nb + 1; const int n0 = sb * 32;
                const int drow = n0 < 1536 ? n0 : n0 + 480;
                transpose_item(P->in[I_WINE] + (size_t)j * 1024 * 2080, 2080, n0, kb * 64, (bf16_t*)(ws + OFF_WIE) + (size_t)j * 2560 * 1024, drow, 1024, n0 < 256 ? 0.125f : 1.f, scr, lane); continue; }
            r -= N3;
            if (r < N4) { const int j = r / 256, q = r % 256, kb = q / 32, nb = q % 32;
                transpose_item(P->in[I_WOUTE] + (size_t)j * 1024 * 1024, 1024, nb * 32, kb * 64, (bf16_t*)(ws + OFF_WOE) + (size_t)j * 1024 * 1024, nb * 32, 1024, 1.f, scr, lane); continue; }
            r -= N4;
            if (r < N5) { const int j = r / 768, q = r % 768, kb = q / 48, nb = q % 48; const int n0 = 512 + nb * 32;
                transpose_item(P->in[I_WINO] + (size_t)j * 1024 * 2048, 2048, n0, kb * 64, (bf16_t*)(ws + OFF_WIO) + (size_t)j * 2560 * 1024, n0 + 512, 1024, 1.f, scr, lane); continue; }
            r -= N5;
            { const int j = r / 512, q = r % 512, kb = q / 32, nb = q % 32;
                transpose_item(P->in[I_WOUTO] + (size_t)j * 1024 * 1024, 1024, nb * 32, kb * 64, (bf16_t*)(ws + OFF_WOO) + (size_t)j * 1024 * 1024, nb * 32, 1024, 1.f, scr, lane); }
        }
    }
    {
        const int gt = bx * 512 + tid, GT = G * 512;
        for (int it = gt; it < 2048 * 512 + 256 * 64; it += GT) {
            int L, k, c0; bf16_t* T; float s;
            if (it < 2048 * 512) { L = 2048; k = it >> 9; c0 = (it & 511) * 8; T = (bf16_t*)(ws + OFF_T2K); s = 1.f / 512.f; }
            else { const int r = it - 2048 * 512; L = 256; k = r >> 6; c0 = (r & 63) * 8; T = (bf16_t*)(ws + OFF_T256); s = 0.00552427172801990f; }
            const int z = c0 >= L; const int l0 = c0 - z * L; const float invL = 1.f / (float)L;
            float v[8];
#pragma unroll
            for (int e = 0; e < 8; ++e) { const int ph = (k * (l0 + e)) & (L - 1); const float fr = (float)ph * invL; v[e] = z ? -__builtin_amdgcn_sinf(fr) * s : __builtin_amdgcn_cosf(fr) * s; }
            u32x4 o; o.x = pk2(v[0], v[1]); o.y = pk2(v[2], v[3]); o.z = pk2(v[4], v[5]); o.w = pk2(v[6], v[7]);
            *(u32x4*)(T + (size_t)k * (2 * L) + c0) = o;
        }
    }
    {
        float* X = (float*)(ws + OFF_X);
        for (int r = bx * 8 + wave; r < NTOK; r += G * 8) {
            if (r < NPROMPT) {
#pragma unroll
                for (int jj = 0; jj < 4; ++jj) *(f32x4*)(X + (size_t)r * 1024 + jj * 256 + lane * 4) = *(const f32x4*)(P->in[I_XP] + (size_t)r * 1024 + jj * 256 + lane * 4);
            } else {
                const int s = r - NPROMPT, t = s & 2047; const float gr = (float)(t >> 6), gc = (float)(t & 63);
#pragma unroll
                for (int jj = 0; jj < 4; ++jj) {
                    f32x4 v = *(const f32x4*)(P->in[I_XS] + (size_t)s * 1024 + jj * 256 + lane * 4);
#pragma unroll
                    for (int e = 0; e < 4; ++e) {
                        const float fq = exp2f(-(float)(lane * 4 + e) * (13.287712379549449f / 256.f));
                        const float ang = (jj < 2 ? gr : gc) * fq;
                        v[e] += (jj & 1) ? cosf(ang) : sinf(ang);
                    }
                    *(f32x4*)(X + (size_t)r * 1024 + jj * 256 + lane * 4) = v;
                }
            }
        }
    }
    __syncthreads();
    {
        LAS float* sc = (LAS float*)lds;
        LAS float* red = (LAS float*)(lds + 20480);
        bool staged = false;
        for (int it = bx; it < 192; it += G) {
            if (!staged) {
                for (int idx = tid; idx < 5120; idx += 512) { const int cnd = idx >> 10, k = idx & 1023; const float c = cnd == 0 ? P->in[I_CCTX][k] : P->in[I_C][(cnd - 1) * 1024 + k]; sc[idx] = siluf(c); }
                staged = true; __syncthreads();
            }
            const int l = it / 48, cb = it % 48, quad = tid & 31, kc = tid >> 5;
            const float* wp = P->in[I_WADA] + ((size_t)l * 1024 + kc * 64) * 6144 + cb * 128 + quad * 4;
            f32x4 a[5];
#pragma unroll
            for (int cnd = 0; cnd < 5; ++cnd) a[cnd] = (f32x4){0.f, 0.f, 0.f, 0.f};
#pragma unroll 8
            for (int kk = 0; kk < 64; ++kk) {
                const f32x4 w = *(const f32x4*)(wp + (size_t)kk * 6144);
#pragma unroll
                for (int cnd = 0; cnd < 5; ++cnd) a[cnd] += w * sc[cnd * 1024 + kc * 64 + kk];
            }
#pragma unroll
            for (int cnd = 0; cnd < 5; ++cnd) *(LAS f32x4*)(red + (kc * 5 + cnd) * 128 + quad * 4) = a[cnd];
            __syncthreads();
            for (int idx = tid; idx < 640; idx += 512) {
                const int cnd = idx >> 7, cc = idx & 127; float s = 0.f;
#pragma unroll
                for (int k2 = 0; k2 < 16; ++k2) s += red[(k2 * 5 + cnd) * 128 + cc];
                ((float*)(ws + OFF_MOD))[(size_t)(l * 5 + cnd) * 6144 + cb * 128 + cc] = s + P->in[I_BADA][l * 6144 + cb * 128 + cc];
            }
            __syncthreads();
        }
    }
    __syncthreads();
    {
        LAS float* wt = (LAS float*)lds;
        LAS float* tab = (LAS float*)(lds + 64 * 129 * 4);
        for (int it2 = bx; it2 < 256; it2 += G) {
            const int it = it2 >> 1, zsel = it2 & 1;
            const int j = it >> 6, g = (it >> 4) & 3, kb = it & 15;
            for (int idx = tid; idx < 64 * 128; idx += 512) { const int kk = idx >> 7, c = idx & 127; wt[kk * 129 + c] = P->in[I_WINO][((size_t)j * 1024 + kb * 64 + kk) * 2048 + g * 128 + c]; }
            if (tid < 128) { tab[tid] = __builtin_amdgcn_cosf((float)tid * (1.f / 128.f)); tab[128 + tid] = __builtin_amdgcn_sinf((float)tid * (1.f / 128.f)); }
            __syncthreads();
            const int k = tid & 63, zg = tid >> 6, z = zsel, m0 = zg * 16;
            float acc[16];
#pragma unroll
            for (int mm = 0; mm < 16; ++mm) acc[mm] = 0.f;
            for (int c = 0; c < 128; ++c) {
                const float a = wt[k * 129 + c];
#pragma unroll
                for (int mm = 0; mm < 16; ++mm) acc[mm] += a * tab[z * 128 + (((m0 + mm) * c) & 127)];
            }
            bf16_t* O = (bf16_t*)(ws + OFF_WIO) + (size_t)j * 2560 * 1024 + (size_t)(z * 512 + g * 128 + m0) * 1024 + kb * 64 + k;
#pragma unroll
            for (int mm = 0; mm < 16; ++mm) O[(size_t)mm * 1024] = f2bf(acc[mm]);
            __syncthreads();
        }
    }
    {
        LAS float* Pt = (LAS float*)lds;
        LAS float* Wd = (LAS float*)(lds + 65536);
        for (int it = (bx + G - (192 % G)) % G; it < 128; it += G) {
            const int j = it >> 6, g = (it >> 4) & 3, nb = it & 15;
            for (int idx = tid; idx < 128 * 128; idx += 512) { const int c = idx >> 7, d = idx & 127; Pt[d * 128 + c] = P->in[I_POOLW][((size_t)(j * 4 + g) * 128 + c) * 128 + d] * P->in[I_POOLS][j * 512 + g * 128 + d]; }
            for (int idx = tid; idx < 128 * 64; idx += 512) { const int d = idx >> 6, n = idx & 63; Wd[d * 64 + n] = P->in[I_WOUTE][((size_t)j * 1024 + 512 + g * 128 + d) * 1024 + nb * 64 + n]; }
            __syncthreads();
            const int c = tid & 127, ng = tid >> 7;
            float acc[16];
#pragma unroll
            for (int nn = 0; nn < 16; ++nn) acc[nn] = 0.f;
            for (int d = 0; d < 128; ++d) {
                const float p = Pt[d * 128 + c];
#pragma unroll
                for (int nn = 0; nn < 16; ++nn) acc[nn] += p * Wd[d * 64 + ng * 16 + nn];
            }
            bf16_t* O = (bf16_t*)(ws + OFF_WOE) + (size_t)j * 1024 * 1024 + (size_t)(nb * 64 + ng * 16) * 1024 + 512 + g * 128 + c;
#pragma unroll
            for (int nn = 0; nn < 16; ++nn) O[(size_t)nn * 1024] = f2bf(acc[nn]);
            __syncthreads();
        }
    }
    {
        LAS float* av = (LAS float*)lds;
        LAS float* w2 = (LAS float*)(lds + 16384);
        for (int it = (bx + G - (64 % G)) % G; it < 32; it += G) {
            const int j = it >> 4, kb = it & 15;
            for (int idx = tid; idx < 64 * 32; idx += 512) { const int kk = idx >> 5, r = idx & 31; av[kk * 33 + r] = P->in[I_WINE][((size_t)j * 1024 + kb * 64 + kk) * 2080 + 1536 + r]; }
            for (int idx = tid; idx < 8192; idx += 512) w2[idx] = P->in[I_WA2][(size_t)j * 8192 + idx];
            __syncthreads();
            const int k = tid & 63, grp = tid >> 6, z = grp >> 2, n0 = (grp & 3) * 64;
            float a[16];
#pragma unroll
            for (int r = 0; r < 16; ++r) a[r] = av[k * 33 + z * 16 + r];
            bf16_t* O = (bf16_t*)(ws + OFF_WIE) + (size_t)j * 2560 * 1024 + (size_t)(1536 + z * 256 + n0) * 1024 + kb * 64 + k;
            for (int nn = 0; nn < 64; ++nn) {
                float s = 0.f;
#pragma unroll
                for (int r = 0; r < 16; ++r) s += a[r] * w2[(z * 16 + r) * 256 + n0 + nn];
                O[(size_t)nn * 1024] = f2bf(s);
            }
            __syncthreads();
        }
    }
}

__device__ __forceinline__ void norm_phase(PP P, int l, int which) {
    const int tid = otid(), lane = tid & 63, wave = tid >> 6, G = gridDim.x, bx = obid();
    unsigned char* ws = P->ws;
    const float* X = (const float*)(ws + OFF_X);
    const float* gp = which == 2 ? P->in[I_FINALG] : P->in[I_NORMG] + (size_t)(l * 2 + which) * 1024;
    f32x4 gv[4];
#pragma unroll
    for (int jj = 0; jj < 4; ++jj) gv[jj] = *(const f32x4*)(gp + jj * 256 + lane * 4);
    for (int r0 = bx * 8 + wave; r0 < NTOK; r0 += G * 16) {
        f32x4 v[2][4]; float ss[2] = {0.f, 0.f};
#pragma unroll
        for (int u = 0; u < 2; ++u) { const int r = r0 + u * G * 8; if (r < NTOK) {
#pragma unroll
            for (int jj = 0; jj < 4; ++jj) v[u][jj] = *(const f32x4*)(X + (size_t)r * 1024 + jj * 256 + lane * 4); } }
#pragma unroll
        for (int u = 0; u < 2; ++u) {
            const int r = r0 + u * G * 8; if (r >= NTOK) continue;
#pragma unroll
            for (int jj = 0; jj < 4; ++jj) ss[u] += v[u][jj][0] * v[u][jj][0] + v[u][jj][1] * v[u][jj][1] + v[u][jj][2] * v[u][jj][2] + v[u][jj][3] * v[u][jj][3];
            const float rstd = rsqrtf(wave_sum(ss[u]) * (1.f / 1024.f) + 1e-6f);
            if (which == 2) {
#pragma unroll
                for (int jj = 0; jj < 4; ++jj) *(f32x4*)(P->out + (size_t)r * 1024 + jj * 256 + lane * 4) = v[u][jj] * rstd * gv[jj];
            } else {
                const int cnd = r < NPROMPT ? 0 : 1 + ((r - NPROMPT) >> 11);
                const float* mp = (const float*)(ws + OFF_MOD) + (size_t)(l * 5 + cnd) * 6144 + which * 3072;
                bf16_t* Hh = (bf16_t*)(ws + OFF_H) + (size_t)r * 1024;
#pragma unroll
                for (int jj = 0; jj < 4; ++jj) {
                    const f32x4 sh = *(const f32x4*)(mp + jj * 256 + lane * 4), sc = *(const f32x4*)(mp + 1024 + jj * 256 + lane * 4);
                    const f32x4 y = v[u][jj] * rstd * gv[jj] * (sc + 1.f) + sh;
                    u32x2 o; o.x = pk2(y[0], y[1]); o.y = pk2(y[2], y[3]);
                    *(u32x2*)(Hh + jj * 256 + lane * 4) = o;
                }
            }
        }
    }
}

__device__ __forceinline__ void pool_phase(PP P) {
    unsigned char* ws = P->ws;
    const bf16_t* UB = (const bf16_t*)(ws + OFF_UB);
    bf16_t* AM = (bf16_t*)(ws + OFF_AMIX);
    for (int idx = obid() * 512 + otid(); idx < NTOK * 64; idx += gridDim.x * 512) {
        const int t = idx >> 6, oc = idx & 63, ch = oc * 8, g = oc >> 4, w = 2 << g;
        int s0, L; if (t < NPROMPT) { s0 = t & ~255; L = 256; } else { s0 = NPROMPT + ((t - NPROMPT) & ~2047); L = 2048; }
        const int tl = t - s0; const int lo = max(tl - (w >> 1), 0), hi = min(tl + w - (w >> 1), L);
        float s[8];
#pragma unroll
        for (int e = 0; e < 8; ++e) s[e] = 0.f;
        for (int tt = lo; tt < hi; ++tt) {
            const u32x4 v = *(const u32x4*)(UB + (size_t)(s0 + tt) * 512 + ch);
            s[0] += bflo(v.x); s[1] += bfhi(v.x); s[2] += bflo(v.y); s[3] += bfhi(v.y); s[4] += bflo(v.z); s[5] += bfhi(v.z); s[6] += bflo(v.w); s[7] += bfhi(v.w);
        }
        const float ic = 1.f / (float)(hi - lo);
        const u32x4 v = *(const u32x4*)(UB + (size_t)t * 512 + ch);
        u32x4 o;
        o.x = pk2(s[0] * ic - bflo(v.x), s[1] * ic - bfhi(v.x)); o.y = pk2(s[2] * ic - bflo(v.y), s[3] * ic - bfhi(v.y));
        o.z = pk2(s[4] * ic - bflo(v.z), s[5] * ic - bfhi(v.z)); o.w = pk2(s[6] * ic - bflo(v.w), s[7] * ic - bfhi(v.w));
        *(u32x4*)(AM + (size_t)t * 1024 + 512 + ch) = o;
    }
}

__device__ __forceinline__ void mixprep_phase(PP P, int j) {
    const int tid = otid(), lane = tid & 63, wave = tid >> 6;
    unsigned char* ws = P->ws;
    const float* O0 = (const float*)(ws + OFF_ODIR); const float* O1 = O0 + (size_t)NTOK * 512;
    const bf16_t* GT = (const bf16_t*)(ws + OFF_GATE);
    bf16_t* AM = (bf16_t*)(ws + OFF_AMIX);
    const int ch = lane * 8;
    const f32x4 g0 = *(const f32x4*)(P->in[I_GLAG] + j * 128 + (ch & 127)), g1 = *(const f32x4*)(P->in[I_GLAG] + j * 128 + (ch & 127) + 4);
    const int G8 = gridDim.x * 8;
    for (int r0 = obid() * 8 + wave; r0 < NTOK; r0 += 2 * G8) {
        f32x4 a[2], b[2]; u32x4 gt[2];
#pragma unroll
        for (int u = 0; u < 2; ++u) { const int r = r0 + u * G8; if (r < NTOK) {
            a[u] = *(const f32x4*)(O0 + (size_t)r * 512 + ch) + *(const f32x4*)(O1 + (size_t)r * 512 + ch);
            b[u] = *(const f32x4*)(O0 + (size_t)r * 512 + ch + 4) + *(const f32x4*)(O1 + (size_t)r * 512 + ch + 4);
            gt[u] = *(const u32x4*)(GT + (size_t)r * 512 + ch); } }
#pragma unroll
        for (int u = 0; u < 2; ++u) {
            const int r = r0 + u * G8; if (r >= NTOK) continue;
            float ss = a[u][0] * a[u][0] + a[u][1] * a[u][1] + a[u][2] * a[u][2] + a[u][3] * a[u][3] + b[u][0] * b[u][0] + b[u][1] * b[u][1] + b[u][2] * b[u][2] + b[u][3] * b[u][3];
            ss += __shfl_xor(ss, 1); ss += __shfl_xor(ss, 2); ss += __shfl_xor(ss, 4); ss += __shfl_xor(ss, 8);
            const float rstd = rsqrtf(ss * (1.f / 128.f) + 1e-6f);
            const f32x4 aa = a[u] * rstd * g0, bb = b[u] * rstd * g1;
            u32x4 o;
            o.x = pk2(aa[0] * bflo(gt[u].x), aa[1] * bfhi(gt[u].x)); o.y = pk2(aa[2] * bflo(gt[u].y), aa[3] * bfhi(gt[u].y));
            o.z = pk2(bb[0] * bflo(gt[u].z), bb[1] * bfhi(gt[u].z)); o.w = pk2(bb[2] * bflo(gt[u].w), bb[3] * bfhi(gt[u].w));
            *(u32x4*)(AM + (size_t)r * 1024 + ch) = o;
        }
    }
}

__device__ __forceinline__ void conv_phase(PP P, int j) {
    unsigned char* ws = P->ws;
    const bf16_t* XI = (const bf16_t*)(ws + OFF_XIN); const bf16_t* BGp = (const bf16_t*)(ws + OFF_BG); const bf16_t* CGp = (const bf16_t*)(ws + OFF_CG);
    bf16_t* AM = (bf16_t*)(ws + OFF_AMIX);
    for (int idx = obid() * 512 + otid(); idx < NTOK * 64; idx += gridDim.x * 512) {
        const int t = idx >> 6, ch = (idx & 63) * 8;
        int s0, L; if (t < NPROMPT) { s0 = t & ~255; L = 256; } else { s0 = NPROMPT + ((t - NPROMPT) & ~2047); L = 2048; }
        const int tl = t - s0;
        float cv[8];
        { const f32x4 b0 = *(const f32x4*)(P->in[I_CONVB] + j * 512 + ch), b1 = *(const f32x4*)(P->in[I_CONVB] + j * 512 + ch + 4);
          cv[0] = b0[0]; cv[1] = b0[1]; cv[2] = b0[2]; cv[3] = b0[3]; cv[4] = b1[0]; cv[5] = b1[1]; cv[6] = b1[2]; cv[7] = b1[3]; }
#pragma unroll
        for (int jj = 0; jj < 3; ++jj) {
            const int tt = tl + jj - 1;
            if (tt < 0 || tt >= L) continue;
            const u32x4 xv = *(const u32x4*)(XI + (size_t)(s0 + tt) * 512 + ch), cg = *(const u32x4*)(CGp + (size_t)(s0 + tt) * 512 + ch);
            const f32x4 w0 = *(const f32x4*)(P->in[I_CONVW] + (size_t)(j * 3 + jj) * 512 + ch), w1 = *(const f32x4*)(P->in[I_CONVW] + (size_t)(j * 3 + jj) * 512 + ch + 4);
            cv[0] += bflo(xv.x) * bflo(cg.x) * w0[0]; cv[1] += bfhi(xv.x) * bfhi(cg.x) * w0[1]; cv[2] += bflo(xv.y) * bflo(cg.y) * w0[2]; cv[3] += bfhi(xv.y) * bfhi(cg.y) * w0[3];
            cv[4] += bflo(xv.z) * bflo(cg.z) * w1[0]; cv[5] += bfhi(xv.z) * bfhi(cg.z) * w1[1]; cv[6] += bflo(xv.w) * bflo(cg.w) * w1[2]; cv[7] += bfhi(xv.w) * bfhi(cg.w) * w1[3];
        }
        const u32x4 bg = *(const u32x4*)(BGp + (size_t)t * 512 + ch);
        u32x4 o;
        o.x = pk2(cv[0] * bflo(bg.x), cv[1] * bfhi(bg.x)); o.y = pk2(cv[2] * bflo(bg.y), cv[3] * bfhi(bg.y));
        o.z = pk2(cv[4] * bflo(bg.z), cv[5] * bfhi(bg.z)); o.w = pk2(cv[6] * bflo(bg.w), cv[7] * bfhi(bg.w));
        *(u32x4*)(AM + (size_t)t * 1024 + 512 + ch) = o;
    }
}

__device__ __forceinline__ void convert_phase(PP P) {
    unsigned char* ws = P->ws;
    bf16_t* AM = (bf16_t*)(ws + OFF_AMIX);
    for (int idx = obid() * 512 + otid(); idx < NTOK * 64; idx += gridDim.x * 512) {
        const int t = idx >> 6, ch = (idx & 63) * 8;
        f32x4 a, b;
        if (t < NPROMPT) { const float* F = (const float*)(ws + OFF_FACCP) + (size_t)t * 512 + ch; a = *(const f32x4*)F; b = *(const f32x4*)(F + 4); }
        else {
            const float* F = (const float*)(ws + OFF_FACCS) + (size_t)(t - NPROMPT) * 512 + ch;
            a = *(const f32x4*)F; b = *(const f32x4*)(F + 4);
#pragma unroll
            for (int ks = 1; ks < 4; ++ks) { a += *(const f32x4*)(F + (size_t)ks * 8192 * 512); b += *(const f32x4*)(F + (size_t)ks * 8192 * 512 + 4); }
        }
        u32x4 o; o.x = pk2(a[0], a[1]); o.y = pk2(a[2], a[3]); o.z = pk2(b[0], b[1]); o.w = pk2(b[2], b[3]);
        *(u32x4*)(AM + (size_t)t * 1024 + ch) = o;
    }
}

__device__ __forceinline__ int permd(int d) { return (d & 32) | ((d & 12) << 1) | ((d & 16) >> 2) | (d & 3); }
__device__ __forceinline__ bf16x8 pack8(const f32x4& a, const f32x4& b) {
    u32x4 o; o.x = pk2(a[0], a[1]); o.y = pk2(a[2], a[3]); o.z = pk2(b[0], b[1]); o.w = pk2(b[2], b[3]);
    return __builtin_bit_cast(bf16x8, o);
}
__device__ __forceinline__ void gla_item(PP P, LAS unsigned char* lds, int j, int seg, int head, int dir, bool full) {
    const int tid = otid(), lane = tid & 63, w = tid >> 6, r = lane & 15, q = lane >> 4;
    unsigned char* ws = P->ws;
    const bf16_t* QB = (const bf16_t*)(ws + OFF_QB); const bf16_t* KB = (const bf16_t*)(ws + OFF_KB); const bf16_t* VT = (const bf16_t*)(ws + OFF_VT);
    const float* LOGF = (const float*)(ws + OFF_LOGF);
    float* ODIR = (float*)(ws + OFF_ODIR);
    float* Ubuf = (float*)(ws + OFF_U); float* Dtot = (float*)(ws + OFF_DTOT);
    LAS bf16_t* QT = (LAS bf16_t*)(lds);
    LAS bf16_t* KT = (LAS bf16_t*)(lds + 36864);
    LAS bf16_t* KH = (LAS bf16_t*)(lds + 73728);
    LAS float* DL = (LAS float*)(lds + 114688);
    LAS bf16x8* ATT = (LAS bf16x8*)(lds + 116736);
    const int tok0 = seg * 256;
    __syncthreads();
    {
        const int d = tid & 63, c = w, pd = permd(d);
        float b = 0.f;
        const float* lf = LOGF + (size_t)(tok0 + 32 * c) * 512 + dir * 256 + head * 64 + d;
        const bf16_t* qp = QB + (size_t)(tok0 + 32 * c) * 256 + head * 64 + d;
        const bf16_t* kp = KB + (size_t)(tok0 + 32 * c) * 256 + head * 64 + d;
        float lfv[32]; bf16_t qv16[32], kv16[32];
#pragma unroll
        for (int ii = 0; ii < 32; ++ii) { const int il = dir ? 31 - ii : ii; lfv[ii] = lf[(size_t)il * 512]; qv16[ii] = qp[(size_t)il * 256]; kv16[ii] = kp[(size_t)il * 256]; }
#pragma unroll
        for (int ii = 0; ii < 32; ++ii) {
            const int il = dir ? 31 - ii : ii;
            b += lfv[ii];
            const float qv = bf2f(qv16[ii]), kv = bf2f(kv16[ii]);
            QT[(32 * c + il) * 72 + pd] = f2bf(qv * __expf(b));
            KT[(32 * c + il) * 72 + pd] = f2bf(kv * __expf(-b));
        }
        const float eT = __expf(b);
        DL[c * 64 + d] = eT;
#pragma unroll 8
        for (int il = 0; il < 32; ++il) KH[(c * 64 + d) * 40 + permd(il)] = f2bf(bf2f(KT[(32 * c + il) * 72 + pd]) * eT);
    }
    __syncthreads();
    if (full) {
        const int c = w;
        f32x4 at[2][2];
#pragma unroll
        for (int a = 0; a < 2; ++a)
#pragma unroll
            for (int b = 0; b < 2; ++b) at[a][b] = (f32x4){0.f, 0.f, 0.f, 0.f};
#pragma unroll
        for (int kk = 0; kk < 2; ++kk) {
            bf16x8 ka[2], qb[2];
#pragma unroll
            for (int t = 0; t < 2; ++t) { ka[t] = *(const LAS bf16x8*)(KT + (32 * c + 16 * t + r) * 72 + 32 * kk + 8 * q); qb[t] = *(const LAS bf16x8*)(QT + (32 * c + 16 * t + r) * 72 + 32 * kk + 8 * q); }
#pragma unroll
            for (int tj = 0; tj < 2; ++tj)
#pragma unroll
                for (int ti = 0; ti < 2; ++ti) at[tj][ti] = __builtin_amdgcn_mfma_f32_16x16x32_bf16(ka[tj], qb[ti], at[tj][ti], 0, 0, 0);
        }
#pragma unroll
        for (int ti = 0; ti < 2; ++ti) {
            const int i = 16 * ti + r;
#pragma unroll
            for (int tj = 0; tj < 2; ++tj)
#pragma unroll
                for (int jj = 0; jj < 4; ++jj) { const int jx = 16 * tj + 4 * q + jj; const bool keep = dir ? (jx >= i) : (jx <= i); if (!keep) at[tj][ti][jj] = 0.f; }
            ATT[(c * 2 + ti) * 64 + lane] = pack8(at[0][ti], at[1][ti]);
        }
    }
    __syncthreads();
    f32x4 S[4];
#pragma unroll
    for (int t = 0; t < 4; ++t) S[t] = (f32x4){0.f, 0.f, 0.f, 0.f};
    const int e = 16 * w + r;
    if (DBG_SINIT && full && seg >= 16) {
        const int sb = (seg - 16) >> 3, part = (seg - 16) & 7;
        const float* s0 = P->in[I_STATE] + ((size_t)(((sb * 2 + j) * 2 + dir) * 4 + head) * 64) * 128;
#pragma unroll
        for (int t = 0; t < 4; ++t)
#pragma unroll
            for (int jj = 0; jj < 4; ++jj) S[t][jj] = s0[(size_t)(16 * t + 4 * q + jj) * 128 + e];
        const int np = DBG_NP(dir ? 7 - part : part);
        for (int x = 0; x < np; ++x) {
            const int pp = dir ? 7 - x : x;
            const size_t ib = (size_t)(((sb * 8 + pp) * 4 + head) * 2 + dir) * 64;
#pragma unroll
            for (int t = 0; t < 4; ++t)
#pragma unroll
                for (int jj = 0; jj < 4; ++jj) { const int d = 16 * t + 4 * q + jj; S[t][jj] = S[t][jj] * Dtot[ib + d] + Ubuf[(ib + d) * 128 + e]; }
        }
    }
    const bf16_t* vt = VT + (size_t)(head * 128 + e) * NTOK + tok0;
    u32x2 vpre0[8], vpre1[8];
#pragma unroll
    for (int cc = 0; cc < 8; ++cc) { const int c = dir ? 7 - cc : cc; vpre0[cc] = *(const u32x2*)(vt + 32 * c + 4 * q); vpre1[cc] = *(const u32x2*)(vt + 32 * c + 16 + 4 * q); }
#pragma unroll
    for (int cc = 0; cc < 8; ++cc) {
        const int c = dir ? 7 - cc : cc;
        const u32x2 v0 = vpre0[cc], v1 = vpre1[cc];
        u32x4 vv; vv.x = v0.x; vv.y = v0.y; vv.z = v1.x; vv.w = v1.y;
        const bf16x8 vb = __builtin_bit_cast(bf16x8, vv);
        if (full) {
            bf16x8 sb2[2];
            sb2[0] = pack8(S[0], S[1]); sb2[1] = pack8(S[2], S[3]);
#pragma unroll
            for (int mi = 0; mi < 2; ++mi) {
                f32x4 o = (f32x4){0.f, 0.f, 0.f, 0.f};
#pragma unroll
                for (int kk = 0; kk < 2; ++kk) {
                    const bf16x8 qa = *(const LAS bf16x8*)(QT + (32 * c + 16 * mi + r) * 72 + 32 * kk + 8 * q);
                    o = __builtin_amdgcn_mfma_f32_16x16x32_bf16(qa, sb2[kk], o, 0, 0, 0);
                }
                const bf16x8 aa = ATT[(c * 2 + mi) * 64 + lane];
                o = __builtin_amdgcn_mfma_f32_16x16x32_bf16(aa, vb, o, 0, 0, 0);
                float* op = ODIR + ((size_t)dir * NTOK + tok0 + 32 * c + 16 * mi + 4 * q) * 512 + head * 128 + e;
#pragma unroll
                for (int jj = 0; jj < 4; ++jj) op[(size_t)jj * 512] = o[jj];
            }
        }
#pragma unroll
        for (int t = 0; t < 4; ++t) {
            const f32x4 dv = *(const LAS f32x4*)(DL + c * 64 + 16 * t + 4 * q);
            S[t] = S[t] * dv;
            const bf16x8 ka = *(const LAS bf16x8*)(KH + (c * 64 + 16 * t + r) * 40 + 8 * q);
            S[t] = __builtin_amdgcn_mfma_f32_16x16x32_bf16(ka, vb, S[t], 0, 0, 0);
        }
    }
    if (full) {
        if (seg < 16) {
            float* so = P->out + OUT_STATE + ((size_t)(((seg * 2 + j) * 2 + dir) * 4 + head) * 64) * 128;
#pragma unroll
            for (int t = 0; t < 4; ++t)
#pragma unroll
                for (int jj = 0; jj < 4; ++jj) so[(size_t)(16 * t + 4 * q + jj) * 128 + e] = S[t][jj];
        }
    } else {
        const size_t ib = (size_t)(((seg - 16) * 4 + head) * 2 + dir) * 64;
#pragma unroll
        for (int t = 0; t < 4; ++t)
#pragma unroll
            for (int jj = 0; jj < 4; ++jj) Ubuf[(ib + 16 * t + 4 * q + jj) * 128 + e] = S[t][jj];
        if (tid < 64) { float p = 1.f;
#pragma unroll
            for (int c = 0; c < 8; ++c) p *= DL[c * 64 + tid];
            Dtot[ib + tid] = p; }
    }
}

__device__ __forceinline__ void gla_phase(PP P, LAS unsigned char* lds, int j, int sub) {
    const int G = gridDim.x;
    if (sub == 0) {
        for (int it = obid(); it < 384; it += G) {
            if (it >= 128 && it < 256) { const int pi = it - 128; gla_item(P, lds, j, pi >> 3, (pi >> 1) & 3, pi & 1, true); }
            else { const int li = it < 128 ? it : it - 128; gla_item(P, lds, j, 16 + (li >> 3), (li >> 1) & 3, li & 1, false); }
        }
    } else {
        for (int it = obid(); it < 256; it += G) gla_item(P, lds, j, 16 + (it >> 3), (it >> 1) & 3, it & 1, true);
    }
}


#define XB_TMO      128
#define XB_XCNT(j)  (256  + 64 * (j))
#define XB_XSUB(j)  (1280 + 64 * (j))
#define XB_XGEN(j)  (2304 + 64 * (j))
#define XB_TOP      3328
#define XB_TOPGEN   3392
#define XCD_BAR_WORDS 3456
#define XB_SPIN_CAP (1u << 18)

__device__ __forceinline__ unsigned xb_ld(unsigned* p)              { return __hip_atomic_load(p, __ATOMIC_RELAXED, __HIP_MEMORY_SCOPE_AGENT); }
__device__ __forceinline__ unsigned xb_add(unsigned* p, unsigned v) { return __hip_atomic_fetch_add(p, v, __ATOMIC_RELAXED, __HIP_MEMORY_SCOPE_AGENT); }
__device__ __forceinline__ unsigned xb_xcc_id() { return (unsigned)__builtin_amdgcn_s_getreg((3 << 11) | 20) & 0xFu; }
#define XB_SPIN(cond, bar) do { unsigned _sp = 0; while (cond) { __builtin_amdgcn_s_sleep(1); \
    if ((++_sp & 255u) == 0u) { if (xb_ld(&(bar)[XB_TMO])) break; if (_sp > XB_SPIN_CAP) { atomicAdd(&(bar)[XB_TMO], 1u); break; } } } } while (0)

struct XcdBarrier {
    unsigned* bar; unsigned x;
    volatile LAS unsigned* st;
};

__device__ __forceinline__ XcdBarrier xcd_barrier_post(unsigned* bar, volatile LAS unsigned* st) {
    XcdBarrier b; b.bar = bar; b.x = xb_xcc_id(); b.st = st;
    if (threadIdx.x == 0) (void)xb_add(&bar[XB_XCNT(b.x)], 1u);
    return b;
}
__device__ __forceinline__ void xcd_barrier_complete(unsigned* bar, unsigned x, unsigned& nloc, unsigned& nx) {
    const unsigned G = gridDim.x * gridDim.y * gridDim.z;
    unsigned sum, cnt, mine, sp = 0u;
    for (;;) {
        sum = 0u; cnt = 0u; mine = 0u;
#pragma unroll
        for (unsigned j = 0; j < 16; ++j) { const unsigned c = xb_ld(&bar[XB_XCNT(j)]); sum += c; cnt += (c > 0u) ? 1u : 0u; mine = (j == x) ? c : mine; }
        if (sum == G) break;
        __builtin_amdgcn_s_sleep(1);
        if ((++sp & 255u) == 0u) { if (xb_ld(&bar[XB_TMO])) break; if (sp > XB_SPIN_CAP) { atomicAdd(&bar[XB_TMO], 1u); break; } }
    }
    nloc = mine > 0u ? mine : 1u; nx = cnt > 0u ? cnt : 1u;
}

__device__ __forceinline__ void xcd_barrier(const XcdBarrier& b) {
    asm volatile("s_waitcnt vmcnt(0)" ::: "memory");
    __syncthreads();
    if (threadIdx.x == 0) {
        unsigned* bar = b.bar;
        __builtin_amdgcn_s_waitcnt(0);
        unsigned nloc = b.st[0], nx = b.st[1];
        if (nloc == 0u) { xcd_barrier_complete(bar, b.x, nloc, nx); b.st[0] = nloc; b.st[1] = nx; }
        const unsigned old = xb_add(&bar[XB_XSUB(b.x)], 1u);
        const unsigned gen = old / nloc;
        if (old + 1u == (gen + 1u) * nloc) {
            __builtin_amdgcn_fence(__ATOMIC_RELEASE, "agent");
            asm volatile("s_waitcnt vmcnt(0)" ::: "memory");
            const unsigned og = xb_add(&bar[XB_TOP], 1u);
            const unsigned tg = og / nx;
            if (og + 1u == (tg + 1u) * nx) xb_add(&bar[XB_TOPGEN], 1u);
            else XB_SPIN(xb_ld(&bar[XB_TOPGEN]) == tg, bar);
            __builtin_amdgcn_fence(__ATOMIC_ACQUIRE, "agent");
            xb_add(&bar[XB_XGEN(b.x)], 1u);
            asm volatile("s_waitcnt vmcnt(0)" ::: "memory");
        } else {
            XB_SPIN(xb_ld(&bar[XB_XGEN(b.x)]) == gen, bar);
            __builtin_amdgcn_fence(__ATOMIC_ACQUIRE, "agent");
            asm volatile("s_waitcnt vmcnt(0)" ::: "memory");
        }
    }
    __syncthreads();
}

enum { PT_PREP = 0, PT_NORM1, PT_GEMM_IN, PT_MIX_A, PT_MIX_B, PT_MIXPREP, PT_GEMM_OUT, PT_NORM2, PT_MLP1, PT_MLP2, PT_FINAL };

__global__ void __launch_bounds__(512, 2) mega_fwd(Params Pk) {
    extern __shared__ __attribute__((aligned(16))) unsigned char smem[];
    LAS unsigned char* lds = (LAS unsigned char*)smem;
#ifdef DBG_ZLDS
    for (int i = otid(); i < LDS_BYTES / 16; i += 512) ((LAS u32x4*)lds)[i] = (u32x4){0u, 0u, 0u, 0u};
    __syncthreads();
#endif
    { volatile LAS unsigned* st0 = (volatile LAS unsigned*)(lds + LDS_BYTES - 64); if (otid() < 2) st0[otid()] = 0u; }
    __syncthreads();
    XcdBarrier gbar; gbar.bar = (unsigned*)(Pk.ws + OFF_BAR); gbar.x = 0; gbar.st = (volatile LAS unsigned*)(lds + LDS_BYTES - 64);
    if (Pk.ph_hi - Pk.ph_lo > 1) gbar = xcd_barrier_post((unsigned*)(Pk.ws + OFF_BAR), (volatile LAS unsigned*)(lds + LDS_BYTES - 64));
    if (Pk.ph_hi < 0) cg::this_grid().sync();
    for (int ph = Pk.ph_lo; ph < Pk.ph_hi; ++ph) {
        PP P = (PP)__builtin_amdgcn_kernarg_segment_ptr();
        asm volatile("" : "+s"(P));
        int pt, l = 0;
        if (ph == 0) pt = PT_PREP;
        else if (ph == NPH - 1) pt = PT_FINAL;
        else {
            const int qq = ph - 1; int s;
            if (qq < 9) { l = 0; s = qq; } else if (qq < 17) { l = 1; s = qq - 9; } else if (qq < 26) { l = 2; s = qq - 17; } else { l = 3; s = qq - 26; }
            pt = (l & 1) ? (s < 4 ? s + 1 : s + 2) : s + 1;
        }
        const int j = l >> 1, odd = l & 1;
        const int nrep = (pt == REP_PT) ? 1 + REP_N : 1;
        for (int rep = 0; rep < nrep; ++rep) {
        int ngemm = 0; GemmCfg g; g.G = gridDim.x; g.c = obid(); g.j = j; g.l = l; g.nM = 48; g.ld = 1024; g.nt = 16; g.type = 0; g.nN = 0;
        switch (pt) {
        case PT_PREP: if (EN & 1) prep_phase(P, lds); break;
        case PT_NORM1: if (EN & 2) norm_phase(P, l, 0); break;
        case PT_GEMM_IN: ngemm = 1; g.type = odd ? T_IN_ODD : T_IN_EVEN; g.nN = 10; break;
        case PT_MIX_A: if (odd) { ngemm = 2; g.type = T_DFT_S; g.nM = 8; g.nN = 32; g.ld = 4096; g.nt = 16; } else { if (EN & 4) gla_phase(P, lds, j, 0); if (EN & 8) pool_phase(P); } break;
        case PT_MIX_B: if (odd) { if (EN & 8) convert_phase(P); } else { if (EN & 4) gla_phase(P, lds, j, 1); } break;
        case PT_MIXPREP: if (EN & 8) mixprep_phase(P, j); break;
        case PT_GEMM_OUT: ngemm = 1; g.type = odd ? T_OUT_ODD : T_OUT_EVEN; g.nN = 4; break;
        case PT_NORM2: if (EN & 2) norm_phase(P, l, 1); break;
        case PT_MLP1: ngemm = 1; g.type = T_MLP1; g.nN = 16; break;
        case PT_MLP2: ngemm = 1; g.type = T_MLP2; g.nN = 4; g.ld = 4096; g.nt = 64; break;
        default: if (EN & 2) norm_phase(P, 0, 2); break;
        }
        for (int gi = 0; gi < ngemm; ++gi) {
            if (gi == 1) { g.type = T_DFT_P; g.nM = 1; g.nN = 32; g.ld = 512; g.nt = 8; g.c = (obid() + gridDim.x - 32) % gridDim.x; }
            if (EN & 16) gemm_phase(lds, g);
        }
        if (pt == PT_MIX_A && odd && (EN & 8)) conv_phase(P, j);
        if (ph + 1 < Pk.ph_hi || rep + 1 < nrep) xcd_barrier(gbar);
        }

    }
}


#ifdef DBG_K
__device__ __forceinline__ float dgst(unsigned u) { return (float)(u & 0xffffu) + (float)(u >> 16); }
__global__ void dbg_dump(float* out, const unsigned char* ws) {
    const unsigned* Xu = (const unsigned*)(ws + OFF_X); const unsigned* Hu = (const unsigned*)(ws + OFF_H); const unsigned* Au = (const unsigned*)(ws + OFF_AMIX);
    const unsigned* Bu = (const unsigned*)(ws + OFF_BIG); const unsigned* Uu = (const unsigned*)(ws + OFF_U); const unsigned* Wu = (const unsigned*)(ws);
    for (size_t i = (size_t)blockIdx.x * blockDim.x + threadIdx.x; i < (size_t)NTOK * 1024; i += (size_t)gridDim.x * blockDim.x) {
        float v = 0.f;
        if (DBG_SEL & 1) v += dgst(Xu[i]);
        if (DBG_SEL & 2) v += dgst(Hu[i % 6291456]);
        if (DBG_SEL & 4) v += dgst(Au[i % 6291456]);
        if (DBG_SEL & 8) v += dgst(Bu[i]) + dgst(Bu[i + 12582912]) + dgst(Bu[(i + 25165824) % 34603008]);
        if (DBG_SEL & 16) v += dgst(Uu[i % 2113536]);
        if (DBG_SEL & 32) v += dgst(Wu[i]) + dgst(Wu[i + 12582912]) + dgst(Wu[(i + 25165824) % 28573696]);
        out[i] = v;
    }
}
#endif
extern "C" void kernel_launch(void* const* d_in, const int* in_sizes, int n_in, void* d_out, int out_size, void* d_ws, size_t ws_size, hipStream_t stream) {
    static int grid = 0;
    if (grid == 0) {
        if (n_in != 22 || ws_size < WS_NEED) { fprintf(stderr, "kernel_launch: unexpected n_in %d / ws_size %zu (need %zu)\n", n_in, ws_size, (size_t)WS_NEED); grid = -1; return; }
        int dev = 0, cus = 0, per_cu = 0;
        hipGetDevice(&dev);
        hipDeviceGetAttribute(&cus, hipDeviceAttributeMultiprocessorCount, dev);
        if (hipFuncSetAttribute((const void*)mega_fwd, hipFuncAttributeMaxDynamicSharedMemorySize, LDS_BYTES) != hipSuccess) { fprintf(stderr, "kernel_launch: hipFuncSetAttribute failed\n"); grid = -1; return; }
        hipOccupancyMaxActiveBlocksPerMultiprocessor(&per_cu, (const void*)mega_fwd, 512, LDS_BYTES);
        if (per_cu < 1) { fprintf(stderr, "kernel_launch: occupancy query says %d blocks/CU\n", per_cu); per_cu = 1; }
        (void)hipGetLastError();
        grid = cus;
    }
    if (grid < 0) return;
    Params p{};
    for (int i = 0; i < 22; ++i) p.in[i] = (const float*)d_in[i];
    p.out = (float*)d_out; p.ws = (unsigned char*)d_ws;
#if MULTI_LAUNCH
#ifdef DBG_K
    for (int ph = 0; ph < DBG_K; ++ph) {
        p.ph_lo = ph; p.ph_hi = ph + 1;
        hipLaunchKernelGGL(mega_fwd, dim3(grid), dim3(512), LDS_BYTES, stream, p);
    }
    hipLaunchKernelGGL(dbg_dump, dim3(2048), dim3(256), 0, stream, (float*)d_out, (const unsigned char*)d_ws);
#else
    for (int ph = 0; ph < NPH; ++ph) {
        p.ph_lo = ph; p.ph_hi = ph + 1;
        hipLaunchKernelGGL(mega_fwd, dim3(grid), dim3(512), LDS_BYTES, stream, p);
    }
#endif
#else
    p.ph_lo = 0; p.ph_hi = NPH;
    if (hipMemsetAsync((char*)d_ws + OFF_BAR, 0, 16384, stream) != hipSuccess) { fprintf(stderr, "kernel_launch: memset of barrier word failed\n"); return; }
    void* args[] = {&p};
    hipError_t e = hipLaunchCooperativeKernel((const void*)mega_fwd, dim3(grid), dim3(512), args, LDS_BYTES, stream);
    if (e != hipSuccess) fprintf(stderr, "cooperative launch failed: %s (grid %d)\n", hipGetErrorString(e), grid);
#endif
}
```

```cpp
#include <hip/hip_runtime.h>
#include <hip/hip_cooperative_groups.h>
#include <cstdio>
#include <cstdint>
namespace cg = cooperative_groups;

#ifndef DBG_SEL
#define DBG_SEL 63
#endif
#ifndef DBG_NP
#define DBG_NP(x) (x)
#endif
#ifndef REP_PT
#define REP_PT -1
#endif
#ifndef REP_N
#define REP_N 1
#endif
#ifndef XSYNC
#define XSYNC 0
#endif
#ifndef DBG_SINIT
#define DBG_SINIT 1
#endif
#ifndef EN
#define EN 31
#endif
#ifndef MULTI_LAUNCH
#define MULTI_LAUNCH 0
#endif

#define LAS __attribute__((address_space(3)))
typedef unsigned short bf16_t;
typedef short bf16x8 __attribute__((ext_vector_type(8)));
typedef float f32x4 __attribute__((ext_vector_type(4)));
typedef unsigned u32x2 __attribute__((ext_vector_type(2)));
typedef unsigned u32x4 __attribute__((ext_vector_type(4)));

constexpr int DM = 1024, NTOK = 12288, NPROMPT = 4096, DFF = 4096;
constexpr int LDS_BYTES = 147456;
constexpr int NPH = 36;
constexpr size_t MBy = 1048576;
constexpr size_t OFF_W1T = 0, OFF_W2T = 32 * MBy, OFF_WIE = 64 * MBy, OFF_WOE = 74 * MBy, OFF_WIO = 78 * MBy, OFF_WOO = 88 * MBy;
constexpr size_t OFF_T2K = 92 * MBy, OFF_T256 = 108 * MBy, OFF_MOD = 108 * MBy + 262144, OFF_U = 109 * MBy, OFF_DTOT = 117 * MBy;
constexpr size_t OFF_X = 118 * MBy, OFF_H = 166 * MBy, OFF_AMIX = 190 * MBy, OFF_BIG = 214 * MBy, WS_NEED = 348 * MBy;
constexpr size_t OFF_HID = OFF_BIG;
constexpr size_t OFF_QB = OFF_BIG, OFF_KB = OFF_BIG + 6 * MBy, OFF_VT = OFF_BIG + 12 * MBy, OFF_GATE = OFF_BIG + 24 * MBy, OFF_LOGF = OFF_BIG + 36 * MBy;
constexpr size_t OFF_UB = OFF_BIG + 60 * MBy, OFF_ODIR = OFF_BIG + 72 * MBy;
constexpr size_t OFF_XTS = OFF_BIG, OFF_XTP = OFF_BIG + 16 * MBy, OFF_XIN = OFF_BIG + 24 * MBy, OFF_BG = OFF_BIG + 36 * MBy, OFF_CG = OFF_BIG + 48 * MBy;
constexpr size_t OFF_FACCP = OFF_BIG + 60 * MBy, OFF_FACCS = OFF_BIG + 68 * MBy;
constexpr size_t OFF_BAR = 117 * MBy + 524288;
constexpr size_t OUT_STATE = (size_t)NTOK * DM;

struct Params { const float* in[22]; float* out; unsigned char* ws; int ph_lo, ph_hi; };
typedef const __attribute__((address_space(4))) Params* PP;
enum { I_XP = 0, I_XS, I_STATE, I_C, I_CCTX, I_NORMG, I_FINALG, I_WADA, I_BADA, I_W1, I_W2, I_WINE, I_WA2, I_BA2, I_GLAG, I_POOLW, I_POOLS, I_WOUTE, I_WINO, I_CONVW, I_CONVB, I_WOUTO };

__device__ __forceinline__ int otid() { int t = __builtin_amdgcn_workitem_id_x(); asm volatile("" : "+v"(t)); return t; }
__device__ __forceinline__ int obid() { int b = __builtin_amdgcn_workgroup_id_x(); asm volatile("" : "+s"(b)); return b; }
typedef float f32x2 __attribute__((ext_vector_type(2)));
typedef __bf16 bf16x2v __attribute__((ext_vector_type(2)));
__device__ __forceinline__ unsigned pk2(float lo, float hi) { f32x2 v = {lo, hi}; bf16x2v b = __builtin_convertvector(v, bf16x2v); return __builtin_bit_cast(unsigned, b); }
__device__ __forceinline__ bf16_t f2bf(float x) { return (bf16_t)(pk2(x, 0.f) & 0xffffu); }
__device__ __forceinline__ float bf2f(bf16_t u) { return __uint_as_float(((unsigned)u) << 16); }
__device__ __forceinline__ float bflo(unsigned u) { return __uint_as_float(u << 16); }
__device__ __forceinline__ float bfhi(unsigned u) { return __uint_as_float(u & 0xffff0000u); }
__device__ __forceinline__ float wave_sum(float v) {
#pragma unroll
    for (int o = 1; o < 64; o <<= 1) v += __shfl_xor(v, o);
    return v;
}
__device__ __forceinline__ float siluf(float x) { return x * __builtin_amdgcn_rcpf(1.f + __expf(-x)); }
__device__ __forceinline__ float logsigmoidf(float x) { return fminf(x, 0.f) - __logf(1.f + __expf(-fabsf(x))); }
__device__ __forceinline__ int cond_of_seg(int pm) { return pm < 16 ? 0 : 1 + ((pm - 16) >> 3); }

namespace pg8 {
constexpr int BM = 256, BK = 64, HALF = 128, HTB = HALF * BK * 2, STAGE_BYTES = 8 * HTB, NXCD = 8, WGM = 8;
__host__ __device__ __forceinline__ int lds_byte(int r, int c) { const int st = (r >> 4) * 2 + (c >> 5), rr = r & 15, cc = c & 31, ob = rr * 64 + cc * 2; return st * 1024 + (ob ^ (((ob >> 9) & 1) << 5)); }
__host__ __device__ __forceinline__ void stage_rc(int b, int& R, int& C) { const int st = b / 1024, sb = b % 1024, swz = sb ^ (((sb >> 9) & 1) << 5); R = (st >> 1) * 16 + swz / 64; C = (st & 1) * 32 + (swz % 64) / 2; }
}

enum { KD_BF16 = 0, KD_SILU, KD_RELU2, KD_LOGF, KD_RES, KD_ATOM };
enum { T_IN_EVEN = 0, T_IN_ODD, T_OUT_EVEN, T_OUT_ODD, T_MLP1, T_MLP2, T_DFT_S, T_DFT_P };
struct Unit { int pm, pn; };
struct UnitIO { const char* A; const char* B; char* out; const float* aux; int kind; int ld; };
struct GemmCfg { int type, j, l, nM, nN, ld, nt, G, c; };

__device__ __forceinline__ void make_unit(const GemmCfg& g, int pm, int pn, UnitIO& u) {
    PP Pq = (PP)__builtin_amdgcn_kernarg_segment_ptr();
    unsigned char* ws = Pq->ws;
    const size_t rowA = (size_t)pm * 256 * 1024 * 2;
    u.aux = nullptr; u.kind = KD_BF16; u.ld = 512;
    const float* modp = (const float*)(ws + OFF_MOD) + (size_t)(g.l * 5 + cond_of_seg(pm)) * 6144;
    switch (g.type) {
    case T_IN_EVEN: {
        const char* W = (const char*)(ws + OFF_WIE) + (size_t)g.j * 2560 * 1024 * 2 + (size_t)pn * 256 * 1024 * 2;
        const char* Hh = (const char*)(ws + OFF_H) + rowA;
        u.A = Hh; u.B = W;
        if (pn == 0) { u.out = (char*)(ws + OFF_QB) + (size_t)pm * 256 * 256 * 2; u.ld = 256; }
        else if (pn == 1) { u.out = (char*)(ws + OFF_KB) + (size_t)pm * 256 * 256 * 2; u.ld = 256; }
        else if (pn < 4) { u.A = W; u.B = Hh; u.out = (char*)(ws + OFF_VT) + ((size_t)(pn - 2) * 256 * NTOK + (size_t)pm * 256) * 2; u.ld = NTOK; }
        else if (pn < 6) { u.out = (char*)(ws + OFF_GATE) + ((size_t)pm * 256 * 512 + (pn - 4) * 256) * 2; u.kind = KD_SILU; }
        else if (pn < 8) { u.out = (char*)(ws + OFF_LOGF) + ((size_t)pm * 256 * 512 + (pn - 6) * 256) * 4; u.kind = KD_LOGF; u.aux = Pq->in[I_BA2] + g.j * 512 + (pn - 6) * 256; }
        else { u.out = (char*)(ws + OFF_UB) + ((size_t)pm * 256 * 512 + (pn - 8) * 256) * 2; }
    } break;
    case T_IN_ODD: {
        const char* W = (const char*)(ws + OFF_WIO) + (size_t)g.j * 2560 * 1024 * 2 + (size_t)pn * 256 * 1024 * 2;
        const char* Hh = (const char*)(ws + OFF_H) + rowA;
        u.A = Hh; u.B = W;
        if (pn < 4) {
            u.A = W; u.B = Hh;
            const int z = pn >> 1, ch0 = (pn & 1) * 256;
            if (pm < 16) { u.out = (char*)(ws + OFF_XTP) + ((size_t)(pm * 512 + ch0) * 512 + z * 256) * 2; u.ld = 512; }
            else { const int b = (pm - 16) >> 3, part = (pm - 16) & 7; u.out = (char*)(ws + OFF_XTS) + ((size_t)(b * 512 + ch0) * 4096 + z * 2048 + part * 256) * 2; u.ld = 4096; }
        } else {
            const size_t base = (pn < 6) ? OFF_XIN : (pn < 8 ? OFF_BG : OFF_CG);
            u.out = (char*)(ws + base) + ((size_t)pm * 256 * 512 + (pn & 1) * 256) * 2;
        }
    } break;
    case T_OUT_EVEN: case T_OUT_ODD: {
        u.A = (const char*)(ws + OFF_AMIX) + rowA;
        u.B = (const char*)(ws + (g.type == T_OUT_EVEN ? OFF_WOE : OFF_WOO)) + (size_t)g.j * 1024 * 1024 * 2 + (size_t)pn * 256 * 1024 * 2;
        u.out = (char*)(ws + OFF_X) + ((size_t)pm * 256 * 1024 + pn * 256) * 4; u.ld = 1024; u.kind = KD_RES; u.aux = modp + 2048 + pn * 256;
    } break;
    case T_MLP1: {
        u.A = (const char*)(ws + OFF_H) + rowA;
        u.B = (const char*)(ws + OFF_W1T) + (size_t)g.l * 4096 * 1024 * 2 + (size_t)pn * 256 * 1024 * 2;
        u.out = (char*)(ws + OFF_HID) + ((size_t)pm * 256 * 4096 + pn * 256) * 2; u.ld = 4096; u.kind = KD_RELU2;
    } break;
    case T_MLP2: {
        u.A = (const char*)(ws + OFF_HID) + (size_t)pm * 256 * 4096 * 2;
        u.B = (const char*)(ws + OFF_W2T) + (size_t)g.l * 4096 * 1024 * 2 + (size_t)pn * 256 * 4096 * 2;
        u.out = (char*)(ws + OFF_X) + ((size_t)pm * 256 * 1024 + pn * 256) * 4; u.ld = 1024; u.kind = KD_RES; u.aux = modp + 5120 + pn * 256;
    } break;
    case T_DFT_S: {
        const int pnb = pn >> 2, ks = pn & 3;
        u.A = (const char*)(ws + OFF_T2K) + ((size_t)pm * 256 * 4096 + ks * 1024) * 2;
        u.B = (const char*)(ws + OFF_XTS) + ((size_t)pnb * 256 * 4096 + ks * 1024) * 2;
        u.out = (char*)(ws + OFF_FACCS) + ((size_t)ks * 8192 * 512 + (size_t)((pnb >> 1) * 2048 + pm * 256) * 512 + (pnb & 1) * 256) * 4; u.kind = KD_ATOM;
    } break;
    default: {
        u.A = (const char*)(ws + OFF_T256);
        u.B = (const char*)(ws + OFF_XTP) + (size_t)pn * 256 * 512 * 2;
        u.out = (char*)(ws + OFF_FACCP) + ((size_t)((pn >> 1) * 256) * 512 + (pn & 1) * 256) * 4; u.kind = KD_ATOM;
    } break;
    }
}

__device__ __forceinline__ bool next_unit(const GemmCfg& g, int i, Unit& u) {
    const int nwg = g.nM * g.nN;
    const long L = (long)i * g.G + g.c; if (L >= nwg) return false;
    int wgid = (int)L; { const int q = nwg / pg8::NXCD, r = nwg % pg8::NXCD, xcd = wgid % pg8::NXCD, off = wgid / pg8::NXCD; wgid = (xcd < r ? xcd * (q + 1) : r * (q + 1) + (xcd - r) * q) + off; }
    const int nig = pg8::WGM * g.nN, gid = wgid / nig, fm = gid * pg8::WGM, gsz = (g.nM - fm) < pg8::WGM ? (g.nM - fm) : pg8::WGM;
    const int pm = fm + ((wgid % nig) % gsz), pn = (wgid % nig) / gsz;
    u.pm = pm; u.pn = pn; return true;
}

__device__ __forceinline__ void epilogue(const f32x4 (&acc)[2][2][4][2], const GemmCfg& g, const Unit& uu, int wr, int wc, int fr, int fq) {
    UnitIO u; make_unit(g, uu.pm, uu.pn, u);
    const int row0 = wr * 64 + fr, col0 = wc * 32 + 4 * fq;
    const int kind = u.kind, ld = u.ld;
    if (kind <= KD_RELU2) {
        bf16_t* O = (bf16_t*)u.out;
#pragma unroll
        for (int ai = 0; ai < 2; ++ai)
#pragma unroll
            for (int m = 0; m < 4; ++m) {
                bf16_t* rowp = O + (size_t)(row0 + ai * 128 + m * 16) * ld + col0;
#pragma unroll
                for (int bj = 0; bj < 2; ++bj)
#pragma unroll
                    for (int n = 0; n < 2; ++n) {
                        f32x4 v = acc[ai][bj][m][n];
                        if (kind == KD_SILU) { v[0] = siluf(v[0]); v[1] = siluf(v[1]); v[2] = siluf(v[2]); v[3] = siluf(v[3]); }
                        else if (kind == KD_RELU2) { v[0] = fmaxf(v[0], 0.f); v[1] = fmaxf(v[1], 0.f); v[2] = fmaxf(v[2], 0.f); v[3] = fmaxf(v[3], 0.f); v = v * v; }
                        u32x2 o; o.x = pk2(v[0], v[1]); o.y = pk2(v[2], v[3]);
                        *(u32x2*)(rowp + bj * 128 + n * 16) = o;
                    }
            }
    } else if (kind == KD_RES) {
        float* O = (float*)u.out;
        f32x4 gv[2][2];
#pragma unroll
        for (int bj = 0; bj < 2; ++bj)
#pragma unroll
            for (int n = 0; n < 2; ++n) gv[bj][n] = *(const f32x4*)(u.aux + col0 + bj * 128 + n * 16);
#pragma unroll
        for (int ai = 0; ai < 2; ++ai)
#pragma unroll
            for (int m = 0; m < 4; ++m) {
                float* rowp = O + (size_t)(row0 + ai * 128 + m * 16) * ld + col0;
#pragma unroll
                for (int bj = 0; bj < 2; ++bj)
#pragma unroll
                    for (int n = 0; n < 2; ++n) { f32x4* p = (f32x4*)(rowp + bj * 128 + n * 16); *p = *p + gv[bj][n] * acc[ai][bj][m][n]; }
            }
    } else if (kind == KD_LOGF) {
        float* O = (float*)u.out;
#pragma unroll
        for (int bj = 0; bj < 2; ++bj)
#pragma unroll
            for (int n = 0; n < 2; ++n) {
                const f32x4 bv = *(const f32x4*)(u.aux + col0 + bj * 128 + n * 16);
#pragma unroll
                for (int ai = 0; ai < 2; ++ai)
#pragma unroll
                    for (int m = 0; m < 4; ++m) {
                        f32x4 v = acc[ai][bj][m][n] + bv;
                        v[0] = logsigmoidf(v[0]) * 0.0625f; v[1] = logsigmoidf(v[1]) * 0.0625f; v[2] = logsigmoidf(v[2]) * 0.0625f; v[3] = logsigmoidf(v[3]) * 0.0625f;
                        *(f32x4*)(O + (size_t)(row0 + ai * 128 + m * 16) * ld + col0 + bj * 128 + n * 16) = v;
                    }
            }
    } else {
        float* O = (float*)u.out;
#pragma unroll
        for (int ai = 0; ai < 2; ++ai)
#pragma unroll
            for (int m = 0; m < 4; ++m) {
                float* rowp = O + (size_t)(row0 + ai * 128 + m * 16) * ld + col0;
#pragma unroll
                for (int bj = 0; bj < 2; ++bj)
#pragma unroll
                    for (int n = 0; n < 2; ++n) {
                        *(f32x4*)(rowp + bj * 128 + n * 16) = acc[ai][bj][m][n];
                    }
            }
    }
}

__device__ __forceinline__ void gemm_phase(LAS unsigned char* lds, const GemmCfg& g) {
    using namespace pg8;
    const int tid = otid(), wid = __builtin_amdgcn_readfirstlane(tid >> 6), lane = tid & 63, wr = wid >> 2, wc = wid & 3, fr = lane & 15, fq = lane >> 4;
    const int nt = g.nt;
    unsigned voffA[2];
#pragma unroll
    for (int i = 0; i < 2; ++i) { int R, C; stage_rc(tid * 16 + i * 8192, R, C); voffA[i] = (unsigned)(R * g.ld + C) * 2u; }
#define voffB voffA
    const size_t kstep = (size_t)(BK * 2);
    const size_t hstepA = (size_t)HALF * g.ld * 2;
#define hstepB hstepA
    const unsigned ldsw = (unsigned)wid * 1024u;
    const int aoff = lds_byte(wr * 64 + fr, fq * 8), boff = lds_byte(wc * 32 + fr, fq * 8);
#define PG8_SA(b, h) (((b) * 2 + (h)) * HTB)
#define PG8_SB(b, h) ((4 + (b) * 2 + (h)) * HTB)
#define PG8_STAGE(bufoff, gbase, voff) do { _Pragma("unroll") for (int _i = 0; _i < 2; ++_i) \
        __builtin_amdgcn_global_load_lds((const unsigned*)((const char*)(gbase) + (voff)[_i]), (LAS unsigned*)(lds + (bufoff) + ldsw + _i * 8192), 16, 0, 0); } while (0)
#define PG8_LDA(dst, b, h) do { _Pragma("unroll") for (int m = 0; m < 4; ++m) _Pragma("unroll") for (int k = 0; k < 2; ++k) dst[m][k] = *(const LAS bf16x8*)(lds + PG8_SA(b, h) + aoff + m * 2048 + k * 1024); } while (0)
#define PG8_LDB(dst, b, h) do { _Pragma("unroll") for (int n = 0; n < 2; ++n) _Pragma("unroll") for (int k = 0; k < 2; ++k) dst[n][k] = *(const LAS bf16x8*)(lds + PG8_SB(b, h) + boff + n * 2048 + k * 1024); } while (0)
#define PG8_MMA(ai, bj, At, Bt) do { __builtin_amdgcn_s_setprio(1); _Pragma("unroll") for (int m = 0; m < 4; ++m) _Pragma("unroll") for (int n = 0; n < 2; ++n) _Pragma("unroll") for (int k = 0; k < 2; ++k) \
        acc[ai][bj][m][n] = __builtin_amdgcn_mfma_f32_16x16x32_bf16(Bt[n][k], At[m][k], acc[ai][bj][m][n], 0, 0, 0); __builtin_amdgcn_s_setprio(0); } while (0)
#define PG8_WAIT_V(n) asm volatile("s_waitcnt vmcnt(" #n ")" ::: "memory")
#define PG8_WAIT_L(n) asm volatile("s_waitcnt lgkmcnt(" #n ")" ::: "memory")
#define PG8_BAR __builtin_amdgcn_s_barrier()
#define PG8_SCHED __builtin_amdgcn_sched_barrier(0)
    Unit cur, nxt; int ui = 0;
    if (!next_unit(g, 0, cur)) return;
    f32x4 acc[2][2][4][2];
#pragma unroll
    for (int a = 0; a < 2; ++a)
#pragma unroll
        for (int b = 0; b < 2; ++b)
#pragma unroll
            for (int m = 0; m < 4; ++m)
#pragma unroll
                for (int n = 0; n < 2; ++n) acc[a][b][m][n] = (f32x4){0.f, 0.f, 0.f, 0.f};
    bf16x8 At[4][2], B0[2][2], B1[2][2];
    const char* cA; const char* cB; { UnitIO io; make_unit(g, cur.pm, cur.pn, io); cA = io.A; cB = io.B; }
    PG8_STAGE(PG8_SB(0, 0), cB, voffB); PG8_STAGE(PG8_SA(0, 0), cA, voffA); PG8_STAGE(PG8_SB(0, 1), cB + hstepB, voffB); PG8_STAGE(PG8_SA(0, 1), cA + hstepA, voffA);
    if (wr == 1) PG8_BAR;
    PG8_WAIT_V(4); PG8_BAR;
    PG8_STAGE(PG8_SB(1, 0), cB + kstep, voffB); PG8_STAGE(PG8_SA(1, 0), cA + kstep, voffA); PG8_STAGE(PG8_SB(1, 1), cB + hstepB + kstep, voffB);
    PG8_WAIT_V(6); PG8_BAR;
    for (;;) {
        const bool has_next = next_unit(g, ui + 1, nxt);
        const char* nA = cA; const char* nB = cB; if (has_next) { UnitIO io; make_unit(g, nxt.pm, nxt.pn, io); nA = io.A; nB = io.B; }
        for (int t = 0; t < nt; t += 2) {
            const bool last = (t == nt - 2);
            const char* a1 = cA + (size_t)(t + 1) * kstep;
            const char* a2 = last ? nA : cA + (size_t)(t + 2) * kstep; const char* b2 = last ? nB : cB + (size_t)(t + 2) * kstep;
            const char* a3 = a2 + kstep; const char* b3 = b2 + kstep;
            PG8_LDB(B0, 0, 0); PG8_SCHED; PG8_LDA(At, 0, 0); PG8_STAGE(PG8_SA(1, 1), a1 + hstepA, voffA);
            PG8_WAIT_L(8); PG8_BAR; PG8_WAIT_L(0); PG8_MMA(0, 0, At, B0); PG8_BAR; PG8_SCHED;
            PG8_LDB(B1, 0, 1); PG8_STAGE(PG8_SB(0, 0), b2, voffB);
            PG8_BAR; PG8_WAIT_L(0); PG8_MMA(0, 1, At, B1); PG8_BAR;
            PG8_LDA(At, 0, 1); PG8_STAGE(PG8_SA(0, 0), a2, voffA);
            PG8_BAR; PG8_WAIT_L(0); PG8_MMA(1, 0, At, B0); PG8_BAR; PG8_SCHED;
            PG8_STAGE(PG8_SB(0, 1), b2 + hstepB, voffB);
            PG8_WAIT_V(6); PG8_BAR; PG8_MMA(1, 1, At, B1); PG8_BAR;
            PG8_LDB(B0, 1, 0); PG8_SCHED; PG8_LDA(At, 1, 0); PG8_STAGE(PG8_SA(0, 1), a2 + hstepA, voffA);
            PG8_WAIT_L(8); PG8_BAR; PG8_WAIT_L(0); PG8_MMA(0, 0, At, B0); PG8_BAR; PG8_SCHED;
            PG8_LDB(B1, 1, 1); PG8_STAGE(PG8_SB(1, 0), b3, voffB);
            PG8_BAR; PG8_WAIT_L(0); PG8_MMA(0, 1, At, B1); PG8_BAR;
            PG8_LDA(At, 1, 1); PG8_STAGE(PG8_SA(1, 0), a3, voffA);
            PG8_BAR; PG8_WAIT_L(0); PG8_MMA(1, 0, At, B0); PG8_BAR; PG8_SCHED;
            PG8_STAGE(PG8_SB(1, 1), b3 + hstepB, voffB);
            PG8_WAIT_V(6); PG8_BAR; PG8_MMA(1, 1, At, B1); PG8_BAR;
        }
        epilogue(acc, g, cur, wr, wc, fr, fq);
        if (!has_next) break;
#pragma unroll
        for (int a = 0; a < 2; ++a)
#pragma unroll
            for (int b = 0; b < 2; ++b)
#pragma unroll
                for (int m = 0; m < 4; ++m)
#pragma unroll
                    for (int n = 0; n < 2; ++n) acc[a][b][m][n] = (f32x4){0.f, 0.f, 0.f, 0.f};
        cur = nxt; cA = nA; cB = nB; ++ui;
    }
    PG8_WAIT_V(0);
    if (wr == 0) PG8_BAR;
    PG8_BAR;
#undef voffB
#undef hstepB
#undef PG8_SA
#undef PG8_SB
#undef PG8_STAGE
#undef PG8_LDA
#undef PG8_LDB
#undef PG8_MMA
#undef PG8_WAIT_V
#undef PG8_WAIT_L
#undef PG8_BAR
#undef PG8_SCHED
}

__device__ __forceinline__ void transpose_item(const float* W, int ldn, int n0, int k0, bf16_t* WT, int drow0, int ldk, float scale, LAS float* scr, int lane) {
    float tv[32];
#pragma unroll
    for (int i = 0; i < 32; ++i) { const int kk = 2 * i + (lane >> 5); tv[i] = W[(size_t)(k0 + kk) * ldn + n0 + (lane & 31)]; }
#pragma unroll
    for (int i = 0; i < 32; ++i) { const int kk = 2 * i + (lane >> 5); scr[kk * 33 + (lane & 31)] = tv[i]; }
    asm volatile("s_waitcnt lgkmcnt(0)" ::: "memory");
    const int c = lane & 7;
#pragma unroll
    for (int jx = 0; jx < 4; ++jx) {
        const int n = (lane >> 3) + 8 * jx; const LAS float* s = scr + (8 * c) * 33 + n;
        u32x4 o; o.x = pk2(s[0] * scale, s[33] * scale); o.y = pk2(s[66] * scale, s[99] * scale); o.z = pk2(s[132] * scale, s[165] * scale); o.w = pk2(s[198] * scale, s[231] * scale);
        *(u32x4*)(WT + (size_t)(drow0 + n) * ldk + k0 + 8 * c) = o;
    }
    asm volatile("s_waitcnt lgkmcnt(0)" ::: "memory");
}

__device__ __forceinline__ void prep_phase(PP P, LAS unsigned char* lds) {
    const int tid = otid(), lane = tid & 63, wave = tid >> 6, G = gridDim.x, bx = obid();
    unsigned char* ws = P->ws;
    {
        LAS float* scr = (LAS float*)(lds + wave * 8704);
        constexpr int N1 = 4 * 16 * 128, N2 = 4 * 64 * 32, N3 = 2 * 16 * 64, N4 = 2 * 8 * 32, N5 = 2 * 16 * 48, N6 = 2 * 16 * 32;
        constexpr int NIT = N1 + N2 + N3 + N4 + N5 + N6;
        for (int it = bx * 8 + wave; it < NIT; it += G * 8) {
            int r = it;
            if (r < N1) { const int l = r / 2048, q = r % 2048, kb = q / 128, nb = q % 128;
                transpose_item(P->in[I_W1] + (size_t)l * 1024 * 4096, 4096, nb * 32, kb * 64, (bf16_t*)(ws + OFF_W1T) + (size_t)l * 4096 * 1024, nb * 32, 1024, 1.f, scr, lane); continue; }
            r -= N1;
            if (r < N2) { const int l = r / 2048, q = r % 2048, kb = q / 32, nb = q % 32;
                transpose_item(P->in[I_W2] + (size_t)l * 4096 * 1024, 1024, nb * 32, kb * 64, (bf16_t*)(ws + OFF_W2T) + (size_t)l * 1024 * 4096, nb * 32, 4096, 1.f, scr, lane); continue; }
            r -= N2;
            if (r < N3) { const int j = r / 1024, q = r % 1024, kb = q / 64, nb = q % 64; const int sb = nb < 48 ? nb : nb + 1; const int n0 = sb * 32;
                const int drow = n0 < 1536 ? n0 : n0 + 480;
                transpose_item(P->in[I_WINE] + (size_t)j * 1024 * 2080, 2080, n0, kb * 64, (bf16_t*)(ws + OFF_WIE) + (size_t)j * 2560 * 1024, drow, 1024, n0 < 256 ? 0.125f : 1.f, scr, lane); continue; }
            r -= N3;
            if (r < N4) { const int j = r / 256, q = r % 256, kb = q / 32, nb = q % 32;
                transpose_item(P->in[I_WOUTE] + (size_t)j * 1024 * 1024, 1024, nb * 32, kb * 64, (bf16_t*)(ws + OFF_WOE) + (size_t)j * 1024 * 1024, nb * 32, 1024, 1.f, scr, lane); continue; }
            r -= N4;
            if (r < N5) { const int j = r / 768, q = r % 768, kb = q / 48, nb = q % 48; const int n0 = 512 + nb * 32;
                transpose_item(P->in[I_WINO] + (size_t)j * 1024 * 2048, 2048, n0, kb * 64, (bf16_t*)(ws + OFF_WIO) + (size_t)j * 2560 * 1024, n0 + 512, 1024, 1.f, scr, lane); continue; }
            r -= N5;
            { const int j = r / 512, q = r % 512, kb = q / 32, nb = q % 32;
                transpose_item(P->in[I_WOUTO] + (size_t)j * 1024 * 1024, 1024, nb * 32, kb * 64, (bf16_t*)(ws + OFF_WOO) + (size_t)j * 1024 * 1024, nb * 32, 1024, 1.f, scr, lane); }
        }
    }
    {
        const int gt = bx * 512 + tid, GT = G * 512;
        for (int it = gt; it < 2048 * 512 + 256 * 64; it += GT) {
            int L, k, c0; bf16_t* T; float s;
            if (it < 2048 * 512) { L = 2048; k = it >> 9; c0 = (it & 511) * 8; T = (bf16_t*)(ws + OFF_T2K); s = 1.f / 512.f; }
            else { const int r = it - 2048 * 512; L = 256; k = r >> 6; c0 = (r & 63) * 8; T = (bf16_t*)(ws + OFF_T256); s = 0.00552427172801990f; }
            const int z = c0 >= L; const int l0 = c0 - z * L; const float invL = 1.f / (float)L;
            float v[8];
#pragma unroll
            for (int e = 0; e < 8; ++e) { const int ph = (k * (l0 + e)) & (L - 1); const float fr = (float)ph * invL; v[e] = z ? -__builtin_amdgcn_sinf(fr) * s : __builtin_amdgcn_cosf(fr) * s; }
            u32x4 o; o.x = pk2(v[0], v[1]); o.y = pk2(v[2], v[3]); o.z = pk2(v[4], v[5]); o.w = pk2(v[6], v[7]);
            *(u32x4*)(T + (size_t)k * (2 * L) + c0) = o;
        }
    }
    {
        float* X = (float*)(ws + OFF_X);
        for (int r = bx * 8 + wave; r < NTOK; r += G * 8) {
            if (r < NPROMPT) {
#pragma unroll
                for (int jj = 0; jj < 4; ++jj) *(f32x4*)(X + (size_t)r * 1024 + jj * 256 + lane * 4) = *(const f32x4*)(P->in[I_XP] + (size_t)r * 1024 + jj * 256 + lane * 4);
            } else {
                const int s = r - NPROMPT, t = s & 2047; const float gr = (float)(t >> 6), gc = (float)(t & 63);
#pragma unroll
                for (int jj = 0; jj < 4; ++jj) {
                    f32x4 v = *(const f32x4*)(P->in[I_XS] + (size_t)s * 1024 + jj * 256 + lane * 4);
#pragma unroll
                    for (int e = 0; e < 4; ++e) {
                        const float fq = __builtin_amdgcn_exp2f(-(float)(lane * 4 + e) * (13.287712379549449f / 256.f));
                        const float ang = (jj < 2 ? gr : gc) * fq;
                        v[e] += (jj & 1) ? __cosf(ang) : __sinf(ang);
                    }
                    *(f32x4*)(X + (size_t)r * 1024 + jj * 256 + lane * 4) = v;
                }
            }
        }
    }
    __syncthreads();
    {
        LAS float* sc = (LAS float*)lds;
        LAS float* red = (LAS float*)(lds + 20480);
        bool staged = false;
        for (int it = bx; it < 192; it += G) {
            if (!staged) {
                for (int idx = tid; idx < 5120; idx += 512) { const int cnd = idx >> 10, k = idx & 1023; const float c = cnd == 0 ? P->in[I_CCTX][k] : P->in[I_C][(cnd - 1) * 1024 + k]; sc[idx] = siluf(c); }
                staged = true; __syncthreads();
            }
            const int l = it / 48, cb = it % 48, quad = tid & 31, kc = tid >> 5;
            const float* wp = P->in[I_WADA] + ((size_t)l * 1024 + kc * 64) * 6144 + cb * 128 + quad * 4;
            f32x4 a[5];
#pragma unroll
            for (int cnd = 0; cnd < 5; ++cnd) a[cnd] = (f32x4){0.f, 0.f, 0.f, 0.f};
#pragma unroll 16
            for (int kk = 0; kk < 64; ++kk) {
                const f32x4 w = *(const f32x4*)(wp + (size_t)kk * 6144);
#pragma unroll
                for (int cnd = 0; cnd < 5; ++cnd) a[cnd] += w * sc[cnd * 1024 + kc * 64 + kk];
            }
#pragma unroll
            for (int cnd = 0; cnd < 5; ++cnd) *(LAS f32x4*)(red + (kc * 5 + cnd) * 128 + quad * 4) = a[cnd];
            __syncthreads();
            for (int idx = tid; idx < 640; idx += 512) {
                const int cnd = idx >> 7, cc = idx & 127; float s = 0.f;
#pragma unroll
                for (int k2 = 0; k2 < 16; ++k2) s += red[(k2 * 5 + cnd) * 128 + cc];
                ((float*)(ws + OFF_MOD))[(size_t)(l * 5 + cnd) * 6144 + cb * 128 + cc] = s + P->in[I_BADA][l * 6144 + cb * 128 + cc];
            }
            __syncthreads();
        }
    }
    __syncthreads();
    {
        LAS float* wt = (LAS float*)lds;
        LAS float* tab = (LAS float*)(lds + 64 * 129 * 4);
        for (int it = (bx + G - (192 % G)) % G; it < 128; it += G) {
            const int j = it >> 6, g = (it >> 4) & 3, kb = it & 15;
            for (int idx = tid; idx < 64 * 128; idx += 512) { const int kk = idx >> 7, c = idx & 127; wt[kk * 129 + c] = P->in[I_WINO][((size_t)j * 1024 + kb * 64 + kk) * 2048 + g * 128 + c]; }
            if (tid < 128) { tab[tid] = __builtin_amdgcn_cosf((float)tid * (1.f / 128.f)); tab[128 + tid] = __builtin_amdgcn_sinf((float)tid * (1.f / 128.f)); }
            __syncthreads();
            const int li = lane & 15, lq = lane >> 4;
            f32x4 acc[2][4];
#pragma unroll
            for (int ti = 0; ti < 2; ++ti)
#pragma unroll
                for (int u = 0; u < 4; ++u) acc[ti][u] = (f32x4){0.f, 0.f, 0.f, 0.f};
            const int zm0 = 16 * (2 * wave) + li, zm1 = zm0 + 16;
            for (int sx = 0; sx < 32; ++sx) {
                const int c = 4 * sx + lq;
                const float a0 = tab[(zm0 >> 7) * 128 + (((zm0 & 127) * c) & 127)], a1 = tab[(zm1 >> 7) * 128 + (((zm1 & 127) * c) & 127)];
#pragma unroll
                for (int u = 0; u < 4; ++u) {
                    const float b = wt[(16 * u + li) * 129 + c];
                    acc[0][u] = __builtin_amdgcn_mfma_f32_16x16x4f32(a0, b, acc[0][u], 0, 0, 0);
                    acc[1][u] = __builtin_amdgcn_mfma_f32_16x16x4f32(a1, b, acc[1][u], 0, 0, 0);
                }
            }
#pragma unroll
            for (int ti = 0; ti < 2; ++ti)
#pragma unroll
                for (int r = 0; r < 4; ++r) {
                    const int zm = 16 * (2 * wave + ti) + 4 * lq + r, z = zm >> 7, m = zm & 127;
                    bf16_t* O = (bf16_t*)(ws + OFF_WIO) + (size_t)j * 2560 * 1024 + (size_t)(z * 512 + g * 128 + m) * 1024 + kb * 64 + li;
#pragma unroll
                    for (int u = 0; u < 4; ++u) O[16 * u] = f2bf(acc[ti][u][r]);
                }
            __syncthreads();
        }
    }
    {
        LAS float* Pt = (LAS float*)lds;
        LAS float* Wd = (LAS float*)(lds + 65536);
        for (int it = (bx + G - (64 % G)) % G; it < 128; it += G) {
            const int j = it >> 6, g = (it >> 4) & 3, nb = it & 15;
            for (int idx = tid; idx < 128 * 128; idx += 512) { const int c = idx >> 7, d = idx & 127; Pt[d * 128 + c] = P->in[I_POOLW][((size_t)(j * 4 + g) * 128 + c) * 128 + d] * P->in[I_POOLS][j * 512 + g * 128 + d]; }
            for (int idx = tid; idx < 128 * 64; idx += 512) { const int d = idx >> 6, n = idx & 63; Wd[d * 64 + n] = P->in[I_WOUTE][((size_t)j * 1024 + 512 + g * 128 + d) * 1024 + nb * 64 + n]; }
            __syncthreads();
            const int c = tid & 127, ng = tid >> 7;
            float acc[16];
#pragma unroll
            for (int nn = 0; nn < 16; ++nn) acc[nn] = 0.f;
            for (int d = 0; d < 128; ++d) {
                const float p = Pt[d * 128 + c];
#pragma unroll
                for (int nn = 0; nn < 16; ++nn) acc[nn] += p * Wd[d * 64 + ng * 16 + nn];
            }
            bf16_t* O = (bf16_t*)(ws + OFF_WOE) + (size_t)j * 1024 * 1024 + (size_t)(nb * 64 + ng * 16) * 1024 + 512 + g * 128 + c;
#pragma unroll
            for (int nn = 0; nn < 16; ++nn) O[(size_t)nn * 1024] = f2bf(acc[nn]);
            __syncthreads();
        }
    }
    {
        LAS float* av = (LAS float*)lds;
        LAS float* w2 = (LAS float*)(lds + 16384);
        for (int it = (bx + G - (192 % G)) % G; it < 32; it += G) {
            const int j = it >> 4, kb = it & 15;
            for (int idx = tid; idx < 64 * 32; idx += 512) { const int kk = idx >> 5, r = idx & 31; av[kk * 33 + r] = P->in[I_WINE][((size_t)j * 1024 + kb * 64 + kk) * 2080 + 1536 + r]; }
            for (int idx = tid; idx < 8192; idx += 512) w2[idx] = P->in[I_WA2][(size_t)j * 8192 + idx];
            __syncthreads();
            const int k = tid & 63, grp = tid >> 6, z = grp >> 2, n0 = (grp & 3) * 64;
            float a[16];
#pragma unroll
            for (int r = 0; r < 16; ++r) a[r] = av[k * 33 + z * 16 + r];
            bf16_t* O = (bf16_t*)(ws + OFF_WIE) + (size_t)j * 2560 * 1024 + (size_t)(1536 + z * 256 + n0) * 1024 + kb * 64 + k;
            for (int nn = 0; nn < 64; ++nn) {
                float s = 0.f;
#pragma unroll
                for (int r = 0; r < 16; ++r) s += a[r] * w2[(z * 16 + r) * 256 + n0 + nn];
                O[(size_t)nn * 1024] = f2bf(s);
            }
            __syncthreads();
        }
    }
}

__device__ __forceinline__ void norm_phase(PP P, int l, int which) {
    const int tid = otid(), lane = tid & 63, wave = tid >> 6, G = gridDim.x, bx = obid();
    unsigned char* ws = P->ws;
    const float* X = (const float*)(ws + OFF_X);
    const float* gp = which == 2 ? P->in[I_FINALG] : P->in[I_NORMG] + (size_t)(l * 2 + which) * 1024;
    f32x4 gv[4];
#pragma unroll
    for (int jj = 0; jj < 4; ++jj) gv[jj] = *(const f32x4*)(gp + jj * 256 + lane * 4);
    for (int r0 = bx * 8 + wave; r0 < NTOK; r0 += G * 16) {
        f32x4 v[2][4]; float ss[2] = {0.f, 0.f};
#pragma unroll
        for (int u = 0; u < 2; ++u) { const int r = r0 + u * G * 8; if (r < NTOK) {
#pragma unroll
            for (int jj = 0; jj < 4; ++jj) v[u][jj] = *(const f32x4*)(X + (size_t)r * 1024 + jj * 256 + lane * 4); } }
#pragma unroll
        for (int u = 0; u < 2; ++u) {
            const int r = r0 + u * G * 8; if (r >= NTOK) continue;
#pragma unroll
            for (int jj = 0; jj < 4; ++jj) ss[u] += v[u][jj][0] * v[u][jj][0] + v[u][jj][1] * v[u][jj][1] + v[u][jj][2] * v[u][jj][2] + v[u][jj][3] * v[u][jj][3];
            const float rstd = rsqrtf(wave_sum(ss[u]) * (1.f / 1024.f) + 1e-6f);
            if (which == 2) {
#pragma unroll
                for (int jj = 0; jj < 4; ++jj) *(f32x4*)(P->out + (size_t)r * 1024 + jj * 256 + lane * 4) = v[u][jj] * rstd * gv[jj];
            } else {
                const int cnd = r < NPROMPT ? 0 : 1 + ((r - NPROMPT) >> 11);
                const float* mp = (const float*)(ws + OFF_MOD) + (size_t)(l * 5 + cnd) * 6144 + which * 3072;
                bf16_t* Hh = (bf16_t*)(ws + OFF_H) + (size_t)r * 1024;
#pragma unroll
                for (int jj = 0; jj < 4; ++jj) {
                    const f32x4 sh = *(const f32x4*)(mp + jj * 256 + lane * 4), sc = *(const f32x4*)(mp + 1024 + jj * 256 + lane * 4);
                    const f32x4 y = v[u][jj] * rstd * gv[jj] * (sc + 1.f) + sh;
                    u32x2 o; o.x = pk2(y[0], y[1]); o.y = pk2(y[2], y[3]);
                    *(u32x2*)(Hh + jj * 256 + lane * 4) = o;
                }
            }
        }
    }
}

__device__ __forceinline__ void pool_phase(PP P) {
    unsigned char* ws = P->ws;
    const bf16_t* UB = (const bf16_t*)(ws + OFF_UB);
    bf16_t* AM = (bf16_t*)(ws + OFF_AMIX);
    for (int idx = obid() * 512 + otid(); idx < NTOK * 64; idx += gridDim.x * 512) {
        const int t = idx >> 6, oc = idx & 63, ch = oc * 8, g = oc >> 4, w = 2 << g;
        int s0, L; if (t < NPROMPT) { s0 = t & ~255; L = 256; } else { s0 = NPROMPT + ((t - NPROMPT) & ~2047); L = 2048; }
        const int tl = t - s0; const int lo = max(tl - (w >> 1), 0), hi = min(tl + w - (w >> 1), L);
        float s[8];
#pragma unroll
        for (int e = 0; e < 8; ++e) s[e] = 0.f;
        for (int tt = lo; tt < hi; ++tt) {
            const u32x4 v = *(const u32x4*)(UB + (size_t)(s0 + tt) * 512 + ch);
            s[0] += bflo(v.x); s[1] += bfhi(v.x); s[2] += bflo(v.y); s[3] += bfhi(v.y); s[4] += bflo(v.z); s[5] += bfhi(v.z); s[6] += bflo(v.w); s[7] += bfhi(v.w);
        }
        const float ic = 1.f / (float)(hi - lo);
        const u32x4 v = *(const u32x4*)(UB + (size_t)t * 512 + ch);
        u32x4 o;
        o.x = pk2(s[0] * ic - bflo(v.x), s[1] * ic - bfhi(v.x)); o.y = pk2(s[2] * ic - bflo(v.y), s[3] * ic - bfhi(v.y));
        o.z = pk2(s[4] * ic - bflo(v.z), s[5] * ic - bfhi(v.z)); o.w = pk2(s[6] * ic - bflo(v.w), s[7] * ic - bfhi(v.w));
        *(u32x4*)(AM + (size_t)t * 1024 + 512 + ch) = o;
    }
}

__device__ __forceinline__ void mixprep_phase(PP P, int j) {
    const int tid = otid(), lane = tid & 63, wave = tid >> 6;
    unsigned char* ws = P->ws;
    const float* O0 = (const float*)(ws + OFF_ODIR); const float* O1 = O0 + (size_t)NTOK * 512;
    const bf16_t* GT = (const bf16_t*)(ws + OFF_GATE);
    bf16_t* AM = (bf16_t*)(ws + OFF_AMIX);
    const int ch = lane * 8;
    const f32x4 g0 = *(const f32x4*)(P->in[I_GLAG] + j * 128 + (ch & 127)), g1 = *(const f32x4*)(P->in[I_GLAG] + j * 128 + (ch & 127) + 4);
    const int G8 = gridDim.x * 8;
    for (int r0 = obid() * 8 + wave; r0 < NTOK; r0 += 2 * G8) {
        f32x4 a[2], b[2]; u32x4 gt[2];
#pragma unroll
        for (int u = 0; u < 2; ++u) { const int r = r0 + u * G8; if (r < NTOK) {
            a[u] = *(const f32x4*)(O0 + (size_t)r * 512 + ch) + *(const f32x4*)(O1 + (size_t)r * 512 + ch);
            b[u] = *(const f32x4*)(O0 + (size_t)r * 512 + ch + 4) + *(const f32x4*)(O1 + (size_t)r * 512 + ch + 4);
            gt[u] = *(const u32x4*)(GT + (size_t)r * 512 + ch); } }
#pragma unroll
        for (int u = 0; u < 2; ++u) {
            const int r = r0 + u * G8; if (r >= NTOK) continue;
            float ss = a[u][0] * a[u][0] + a[u][1] * a[u][1] + a[u][2] * a[u][2] + a[u][3] * a[u][3] + b[u][0] * b[u][0] + b[u][1] * b[u][1] + b[u][2] * b[u][2] + b[u][3] * b[u][3];
            ss += __shfl_xor(ss, 1); ss += __shfl_xor(ss, 2); ss += __shfl_xor(ss, 4); ss += __shfl_xor(ss, 8);
            const float rstd = rsqrtf(ss * (1.f / 128.f) + 1e-6f);
            const f32x4 aa = a[u] * rstd * g0, bb = b[u] * rstd * g1;
            u32x4 o;
            o.x = pk2(aa[0] * bflo(gt[u].x), aa[1] * bfhi(gt[u].x)); o.y = pk2(aa[2] * bflo(gt[u].y), aa[3] * bfhi(gt[u].y));
            o.z = pk2(bb[0] * bflo(gt[u].z), bb[1] * bfhi(gt[u].z)); o.w = pk2(bb[2] * bflo(gt[u].w), bb[3] * bfhi(gt[u].w));
            *(u32x4*)(AM + (size_t)r * 1024 + ch) = o;
        }
    }
}

__device__ __forceinline__ void conv_phase(PP P, int j) {
    unsigned char* ws = P->ws;
    const bf16_t* XI = (const bf16_t*)(ws + OFF_XIN); const bf16_t* BGp = (const bf16_t*)(ws + OFF_BG); const bf16_t* CGp = (const bf16_t*)(ws + OFF_CG);
    bf16_t* AM = (bf16_t*)(ws + OFF_AMIX);
    for (int idx = obid() * 512 + otid(); idx < NTOK * 64; idx += gridDim.x * 512) {
        const int t = idx >> 6, ch = (idx & 63) * 8;
        int s0, L; if (t < NPROMPT) { s0 = t & ~255; L = 256; } else { s0 = NPROMPT + ((t - NPROMPT) & ~2047); L = 2048; }
        const int tl = t - s0;
        float cv[8];
        { const f32x4 b0 = *(const f32x4*)(P->in[I_CONVB] + j * 512 + ch), b1 = *(const f32x4*)(P->in[I_CONVB] + j * 512 + ch + 4);
          cv[0] = b0[0]; cv[1] = b0[1]; cv[2] = b0[2]; cv[3] = b0[3]; cv[4] = b1[0]; cv[5] = b1[1]; cv[6] = b1[2]; cv[7] = b1[3]; }
#pragma unroll
        for (int jj = 0; jj < 3; ++jj) {
            const int tt = tl + jj - 1;
            if (tt < 0 || tt >= L) continue;
            const u32x4 xv = *(const u32x4*)(XI + (size_t)(s0 + tt) * 512 + ch), cg = *(const u32x4*)(CGp + (size_t)(s0 + tt) * 512 + ch);
            const f32x4 w0 = *(const f32x4*)(P->in[I_CONVW] + (size_t)(j * 3 + jj) * 512 + ch), w1 = *(const f32x4*)(P->in[I_CONVW] + (size_t)(j * 3 + jj) * 512 + ch + 4);
            cv[0] += bflo(xv.x) * bflo(cg.x) * w0[0]; cv[1] += bfhi(xv.x) * bfhi(cg.x) * w0[1]; cv[2] += bflo(xv.y) * bflo(cg.y) * w0[2]; cv[3] += bfhi(xv.y) * bfhi(cg.y) * w0[3];
            cv[4] += bflo(xv.z) * bflo(cg.z) * w1[0]; cv[5] += bfhi(xv.z) * bfhi(cg.z) * w1[1]; cv[6] += bflo(xv.w) * bflo(cg.w) * w1[2]; cv[7] += bfhi(xv.w) * bfhi(cg.w) * w1[3];
        }
        const u32x4 bg = *(const u32x4*)(BGp + (size_t)t * 512 + ch);
        u32x4 o;
        o.x = pk2(cv[0] * bflo(bg.x), cv[1] * bfhi(bg.x)); o.y = pk2(cv[2] * bflo(bg.y), cv[3] * bfhi(bg.y));
        o.z = pk2(cv[4] * bflo(bg.z), cv[5] * bfhi(bg.z)); o.w = pk2(cv[6] * bflo(bg.w), cv[7] * bfhi(bg.w));
        *(u32x4*)(AM + (size_t)t * 1024 + 512 + ch) = o;
    }
}

__device__ __forceinline__ void convert_phase(PP P) {
    unsigned char* ws = P->ws;
    bf16_t* AM = (bf16_t*)(ws + OFF_AMIX);
    for (int idx = obid() * 512 + otid(); idx < NTOK * 64; idx += gridDim.x * 512) {
        const int t = idx >> 6, ch = (idx & 63) * 8;
        f32x4 a, b;
        if (t < NPROMPT) { const float* F = (const float*)(ws + OFF_FACCP) + (size_t)t * 512 + ch; a = *(const f32x4*)F; b = *(const f32x4*)(F + 4); }
        else {
            const float* F = (const float*)(ws + OFF_FACCS) + (size_t)(t - NPROMPT) * 512 + ch;
            a = *(const f32x4*)F; b = *(const f32x4*)(F + 4);
#pragma unroll
            for (int ks = 1; ks < 4; ++ks) { a += *(const f32x4*)(F + (size_t)ks * 8192 * 512); b += *(const f32x4*)(F + (size_t)ks * 8192 * 512 + 4); }
        }
        u32x4 o; o.x = pk2(a[0], a[1]); o.y = pk2(a[2], a[3]); o.z = pk2(b[0], b[1]); o.w = pk2(b[2], b[3]);
        *(u32x4*)(AM + (size_t)t * 1024 + ch) = o;
    }
}

__device__ __forceinline__ int permd(int d) { return (d & 32) | ((d & 12) << 1) | ((d & 16) >> 2) | (d & 3); }
__device__ __forceinline__ bf16x8 pack8(const f32x4& a, const f32x4& b) {
    u32x4 o; o.x = pk2(a[0], a[1]); o.y = pk2(a[2], a[3]); o.z = pk2(b[0], b[1]); o.w = pk2(b[2], b[3]);
    return __builtin_bit_cast(bf16x8, o);
}
__device__ __forceinline__ void gla_item(PP P, LAS unsigned char* lds, int j, int seg, int head, int dir, bool full) {
    const int tid = otid(), lane = tid & 63, w = tid >> 6, r = lane & 15, q = lane >> 4;
    unsigned char* ws = P->ws;
    const bf16_t* QB = (const bf16_t*)(ws + OFF_QB); const bf16_t* KB = (const bf16_t*)(ws + OFF_KB); const bf16_t* VT = (const bf16_t*)(ws + OFF_VT);
    const float* LOGF = (const float*)(ws + OFF_LOGF);
    float* ODIR = (float*)(ws + OFF_ODIR);
    float* Ubuf = (float*)(ws + OFF_U); float* Dtot = (float*)(ws + OFF_DTOT);
    LAS bf16_t* QT = (LAS bf16_t*)(lds);
    LAS bf16_t* KT = (LAS bf16_t*)(lds + 36864);
    LAS bf16_t* KH = (LAS bf16_t*)(lds + 73728);
    LAS float* DL = (LAS float*)(lds + 114688);
    LAS bf16x8* ATT = (LAS bf16x8*)(lds + 116736);
    const int tok0 = seg * 256;
    __syncthreads();
    {
        const int d = tid & 63, c = w, pd = permd(d);
        float b = 0.f;
        const float* lf = LOGF + (size_t)(tok0 + 32 * c) * 512 + dir * 256 + head * 64 + d;
        const bf16_t* qp = QB + (size_t)(tok0 + 32 * c) * 256 + head * 64 + d;
        const bf16_t* kp = KB + (size_t)(tok0 + 32 * c) * 256 + head * 64 + d;
        float lfv[32]; bf16_t qv16[32], kv16[32];
#pragma unroll
        for (int ii = 0; ii < 32; ++ii) { const int il = dir ? 31 - ii : ii; lfv[ii] = lf[(size_t)il * 512]; qv16[ii] = qp[(size_t)il * 256]; kv16[ii] = kp[(size_t)il * 256]; }
#pragma unroll
        for (int ii = 0; ii < 32; ++ii) {
            const int il = dir ? 31 - ii : ii;
            b += lfv[ii];
            const float qv = bf2f(qv16[ii]), kv = bf2f(kv16[ii]);
            QT[(32 * c + il) * 72 + pd] = f2bf(qv * __expf(b));
            KT[(32 * c + il) * 72 + pd] = f2bf(kv * __expf(-b));
        }
        const float eT = __expf(b);
        DL[c * 64 + d] = eT;
#pragma unroll 8
        for (int il = 0; il < 32; ++il) KH[(c * 64 + d) * 40 + permd(il)] = f2bf(bf2f(KT[(32 * c + il) * 72 + pd]) * eT);
    }
    __syncthreads();
    if (full) {
        const int c = w;
        f32x4 at[2][2];
#pragma unroll
        for (int a = 0; a < 2; ++a)
#pragma unroll
            for (int b = 0; b < 2; ++b) at[a][b] = (f32x4){0.f, 0.f, 0.f, 0.f};
#pragma unroll
        for (int kk = 0; kk < 2; ++kk) {
            bf16x8 ka[2], qb[2];
#pragma unroll
            for (int t = 0; t < 2; ++t) { ka[t] = *(const LAS bf16x8*)(KT + (32 * c + 16 * t + r) * 72 + 32 * kk + 8 * q); qb[t] = *(const LAS bf16x8*)(QT + (32 * c + 16 * t + r) * 72 + 32 * kk + 8 * q); }
#pragma unroll
            for (int tj = 0; tj < 2; ++tj)
#pragma unroll
                for (int ti = 0; ti < 2; ++ti) at[tj][ti] = __builtin_amdgcn_mfma_f32_16x16x32_bf16(ka[tj], qb[ti], at[tj][ti], 0, 0, 0);
        }
#pragma unroll
        for (int ti = 0; ti < 2; ++ti) {
            const int i = 16 * ti + r;
#pragma unroll
            for (int tj = 0; tj < 2; ++tj)
#pragma unroll
                for (int jj = 0; jj < 4; ++jj) { const int jx = 16 * tj + 4 * q + jj; const bool keep = dir ? (jx >= i) : (jx <= i); if (!keep) at[tj][ti][jj] = 0.f; }
            ATT[(c * 2 + ti) * 64 + lane] = pack8(at[0][ti], at[1][ti]);
        }
    }
    __syncthreads();
    f32x4 S[4];
#pragma unroll
    for (int t = 0; t < 4; ++t) S[t] = (f32x4){0.f, 0.f, 0.f, 0.f};
    const int e = 16 * w + r;
    if (DBG_SINIT && full && seg >= 16) {
        const int sb = (seg - 16) >> 3, part = (seg - 16) & 7;
        const float* s0 = P->in[I_STATE] + ((size_t)(((sb * 2 + j) * 2 + dir) * 4 + head) * 64) * 128;
#pragma unroll
        for (int t = 0; t < 4; ++t)
#pragma unroll
            for (int jj = 0; jj < 4; ++jj) S[t][jj] = s0[(size_t)(16 * t + 4 * q + jj) * 128 + e];
        const int np = dir ? 7 - part : part;
#pragma unroll
        for (int xb = 0; xb < 8; xb += 4) {
            if (xb >= np) break;
            float dvv[4][16], uvv[4][16];
#pragma unroll
            for (int xi = 0; xi < 4; ++xi) {
                const int x = xb + xi; if (x >= 7) continue;
                const int pp = dir ? 7 - x : x;
                const size_t ib = (size_t)(((sb * 8 + pp) * 4 + head) * 2 + dir) * 64;
#pragma unroll
                for (int t = 0; t < 4; ++t)
#pragma unroll
                    for (int jj = 0; jj < 4; ++jj) { const int d = 16 * t + 4 * q + jj; dvv[xi][t * 4 + jj] = Dtot[ib + d]; uvv[xi][t * 4 + jj] = Ubuf[(ib + d) * 128 + e]; }
            }
#pragma unroll
            for (int xi = 0; xi < 4; ++xi) {
                const int x = xb + xi; if (x >= 7) continue;
                const bool on = x < np;
#pragma unroll
                for (int t = 0; t < 4; ++t)
#pragma unroll
                    for (int jj = 0; jj < 4; ++jj) S[t][jj] = on ? S[t][jj] * dvv[xi][t * 4 + jj] + uvv[xi][t * 4 + jj] : S[t][jj];
            }
        }
    }
    const bf16_t* vt = VT + (size_t)(head * 128 + e) * NTOK + tok0;
    u32x2 vpre0[8], vpre1[8];
#pragma unroll
    for (int cc = 0; cc < 8; ++cc) { const int c = dir ? 7 - cc : cc; vpre0[cc] = *(const u32x2*)(vt + 32 * c + 4 * q); vpre1[cc] = *(const u32x2*)(vt + 32 * c + 16 + 4 * q); }
#pragma unroll
    for (int cc = 0; cc < 8; ++cc) {
        const int c = dir ? 7 - cc : cc;
        const u32x2 v0 = vpre0[cc], v1 = vpre1[cc];
        u32x4 vv; vv.x = v0.x; vv.y = v0.y; vv.z = v1.x; vv.w = v1.y;
        const bf16x8 vb = __builtin_bit_cast(bf16x8, vv);
        if (full) {
            bf16x8 sb2[2];
            sb2[0] = pack8(S[0], S[1]); sb2[1] = pack8(S[2], S[3]);
#pragma unroll
            for (int mi = 0; mi < 2; ++mi) {
                f32x4 o = (f32x4){0.f, 0.f, 0.f, 0.f};
#pragma unroll
                for (int kk = 0; kk < 2; ++kk) {
                    const bf16x8 qa = *(const LAS bf16x8*)(QT + (32 * c + 16 * mi + r) * 72 + 32 * kk + 8 * q);
                    o = __builtin_amdgcn_mfma_f32_16x16x32_bf16(qa, sb2[kk], o, 0, 0, 0);
                }
                const bf16x8 aa = ATT[(c * 2 + mi) * 64 + lane];
                o = __builtin_amdgcn_mfma_f32_16x16x32_bf16(aa, vb, o, 0, 0, 0);
                float* op = ODIR + ((size_t)dir * NTOK + tok0 + 32 * c + 16 * mi + 4 * q) * 512 + head * 128 + e;
#pragma unroll
                for (int jj = 0; jj < 4; ++jj) op[(size_t)jj * 512] = o[jj];
            }
        }
#pragma unroll
        for (int t = 0; t < 4; ++t) {
            const f32x4 dv = *(const LAS f32x4*)(DL + c * 64 + 16 * t + 4 * q);
            S[t] = S[t] * dv;
            const bf16x8 ka = *(const LAS bf16x8*)(KH + (c * 64 + 16 * t + r) * 40 + 8 * q);
            S[t] = __builtin_amdgcn_mfma_f32_16x16x32_bf16(ka, vb, S[t], 0, 0, 0);
        }
    }
    if (full) {
        if (seg < 16) {
            float* so = P->out + OUT_STATE + ((size_t)(((seg * 2 + j) * 2 + dir) * 4 + head) * 64) * 128;
#pragma unroll
            for (int t = 0; t < 4; ++t)
#pragma unroll
                for (int jj = 0; jj < 4; ++jj) so[(size_t)(16 * t + 4 * q + jj) * 128 + e] = S[t][jj];
        }
    } else {
        const size_t ib = (size_t)(((seg - 16) * 4 + head) * 2 + dir) * 64;
#pragma unroll
        for (int t = 0; t < 4; ++t)
#pragma unroll
            for (int jj = 0; jj < 4; ++jj) Ubuf[(ib + 16 * t + 4 * q + jj) * 128 + e] = S[t][jj];
        if (tid < 64) { float p = 1.f;
#pragma unroll
            for (int c = 0; c < 8; ++c) p *= DL[c * 64 + tid];
            Dtot[ib + tid] = p; }
    }
}

__device__ __forceinline__ void gla_phase(PP P, LAS unsigned char* lds, int j, int sub) {
    const int G = gridDim.x;
    if (sub == 0) {
        for (int it = obid(); it < 384; it += G) {
            if (it >= 128 && it < 256) { const int pi = it - 128; gla_item(P, lds, j, pi >> 3, (pi >> 1) & 3, pi & 1, true); }
            else { const int li = it < 128 ? it : it - 128; gla_item(P, lds, j, 16 + (li >> 3), (li >> 1) & 3, li & 1, false); }
        }
    } else {
        for (int it = obid(); it < 256; it += G) gla_item(P, lds, j, 16 + (it >> 3), (it >> 1) & 3, it & 1, true);
    }
}


#define XB_TMO      128
#define XB_XCNT(j)  (256  + 64 * (j))
#define XB_XSUB(j)  (1280 + 64 * (j))
#define XB_XGEN(j)  (2304 + 64 * (j))
#define XB_TOP      3328
#define XB_TOPGEN   3392
#define XCD_BAR_WORDS 3456
#define XB_SPIN_CAP (1u << 18)

__device__ __forceinline__ unsigned xb_ld(unsigned* p)              { return __hip_atomic_load(p, __ATOMIC_RELAXED, __HIP_MEMORY_SCOPE_AGENT); }
__device__ __forceinline__ unsigned xb_add(unsigned* p, unsigned v) { return __hip_atomic_fetch_add(p, v, __ATOMIC_RELAXED, __HIP_MEMORY_SCOPE_AGENT); }
__device__ __forceinline__ unsigned xb_xcc_id() { return (unsigned)__builtin_amdgcn_s_getreg((3 << 11) | 20) & 0xFu; }
#define XB_SPIN(cond, bar) do { unsigned _sp = 0; while (cond) { __builtin_amdgcn_s_sleep(1); \
    if ((++_sp & 255u) == 0u) { if (xb_ld(&(bar)[XB_TMO])) break; if (_sp > XB_SPIN_CAP) { atomicAdd(&(bar)[XB_TMO], 1u); break; } } } } while (0)

struct XcdBarrier {
    unsigned* bar; unsigned x;
    volatile LAS unsigned* st;
};

__device__ __forceinline__ XcdBarrier xcd_barrier_post(unsigned* bar, volatile LAS unsigned* st) {
    XcdBarrier b; b.bar = bar; b.x = xb_xcc_id(); b.st = st;
    if (threadIdx.x == 0) (void)xb_add(&bar[XB_XCNT(b.x)], 1u);
    return b;
}
__device__ __forceinline__ void xcd_barrier_complete(unsigned* bar, unsigned x, unsigned& nloc, unsigned& nx) {
    const unsigned G = gridDim.x * gridDim.y * gridDim.z;
    unsigned sum, cnt, mine, sp = 0u;
    for (;;) {
        sum = 0u; cnt = 0u; mine = 0u;
#pragma unroll
        for (unsigned j = 0; j < 16; ++j) { const unsigned c = xb_ld(&bar[XB_XCNT(j)]); sum += c; cnt += (c > 0u) ? 1u : 0u; mine = (j == x) ? c : mine; }
        if (sum == G) break;
        __builtin_amdgcn_s_sleep(1);
        if ((++sp & 255u) == 0u) { if (xb_ld(&bar[XB_TMO])) break; if (sp > XB_SPIN_CAP) { atomicAdd(&bar[XB_TMO], 1u); break; } }
    }
    nloc = mine > 0u ? mine : 1u; nx = cnt > 0u ? cnt : 1u;
}

__device__ __forceinline__ void xcd_barrier(const XcdBarrier& b) {
    asm volatile("s_waitcnt vmcnt(0)" ::: "memory");
    __syncthreads();
    if (threadIdx.x == 0) {
        unsigned* bar = b.bar;
        __builtin_amdgcn_s_waitcnt(0);
        unsigned nloc = b.st[0], nx = b.st[1];
        if (nloc == 0u) { xcd_barrier_complete(bar, b.x, nloc, nx); b.st[0] = nloc; b.st[1] = nx; }
        const unsigned old = xb_add(&bar[XB_XSUB(b.x)], 1u);
        const unsigned gen = old / nloc;
        if (old + 1u == (gen + 1u) * nloc) {
            __builtin_amdgcn_fence(__ATOMIC_RELEASE, "agent");
            asm volatile("s_waitcnt vmcnt(0)" ::: "memory");
            const unsigned og = xb_add(&bar[XB_TOP], 1u);
            const unsigned tg = og / nx;
            if (og + 1u == (tg + 1u) * nx) xb_add(&bar[XB_TOPGEN], 1u);
            else XB_SPIN(xb_ld(&bar[XB_TOPGEN]) == tg, bar);
            __builtin_amdgcn_fence(__ATOMIC_ACQUIRE, "agent");
            xb_add(&bar[XB_XGEN(b.x)], 1u);
            asm volatile("s_waitcnt vmcnt(0)" ::: "memory");
        } else {
            XB_SPIN(xb_ld(&bar[XB_XGEN(b.x)]) == gen, bar);
            __builtin_amdgcn_fence(__ATOMIC_ACQUIRE, "agent");
            asm volatile("s_waitcnt vmcnt(0)" ::: "memory");
        }
    }
    __syncthreads();
}

enum { PT_PREP = 0, PT_NORM1, PT_GEMM_IN, PT_MIX_A, PT_MIX_B, PT_MIXPREP, PT_GEMM_OUT, PT_NORM2, PT_MLP1, PT_MLP2, PT_FINAL };

__global__ void __launch_bounds__(512, 2) mega_fwd(Params Pk) {
    extern __shared__ __attribute__((aligned(16))) unsigned char smem[];
    LAS unsigned char* lds = (LAS unsigned char*)smem;
#ifdef DBG_ZLDS
    for (int i = otid(); i < LDS_BYTES / 16; i += 512) ((LAS u32x4*)lds)[i] = (u32x4){0u, 0u, 0u, 0u};
    __syncthreads();
#endif
    { volatile LAS unsigned* st0 = (volatile LAS unsigned*)(lds + LDS_BYTES - 64); if (otid() < 2) st0[otid()] = 0u; }
    __syncthreads();
    XcdBarrier gbar; gbar.bar = (unsigned*)(Pk.ws + OFF_BAR); gbar.x = 0; gbar.st = (volatile LAS unsigned*)(lds + LDS_BYTES - 64);
    if (Pk.ph_hi - Pk.ph_lo > 1) gbar = xcd_barrier_post((unsigned*)(Pk.ws + OFF_BAR), (volatile LAS unsigned*)(lds + LDS_BYTES - 64));
    if (Pk.ph_hi < 0) cg::this_grid().sync();
    for (int ph = Pk.ph_lo; ph < Pk.ph_hi; ++ph) {
        PP P = (PP)__builtin_amdgcn_kernarg_segment_ptr();
        asm volatile("" : "+s"(P));
        int pt, l = 0;
        if (ph == 0) pt = PT_PREP;
        else if (ph == NPH - 1) pt = PT_FINAL;
        else {
            const int qq = ph - 1; int s;
            if (qq < 9) { l = 0; s = qq; } else if (qq < 17) { l = 1; s = qq - 9; } else if (qq < 26) { l = 2; s = qq - 17; } else { l = 3; s = qq - 26; }
            pt = (l & 1) ? (s < 4 ? s + 1 : s + 2) : s + 1;
        }
        const int j = l >> 1, odd = l & 1;
        const int nrep = (pt == REP_PT) ? 1 + REP_N : 1;
        for (int rep = 0; rep < nrep; ++rep) {
        int ngemm = 0; GemmCfg g; g.G = gridDim.x; g.c = obid(); g.j = j; g.l = l; g.nM = 48; g.ld = 1024; g.nt = 16; g.type = 0; g.nN = 0;
        switch (pt) {
        case PT_PREP: if (EN & 1) prep_phase(P, lds); break;
        case PT_NORM1: if (EN & 2) norm_phase(P, l, 0); break;
        case PT_GEMM_IN: ngemm = 1; g.type = odd ? T_IN_ODD : T_IN_EVEN; g.nN = 10; break;
        case PT_MIX_A: if (odd) { ngemm = 2; g.type = T_DFT_S; g.nM = 8; g.nN = 32; g.ld = 4096; g.nt = 16; } else { if (EN & 4) gla_phase(P, lds, j, 0); if (EN & 8) pool_phase(P); } break;
        case PT_MIX_B: if (odd) { if (EN & 8) convert_phase(P); } else { if (EN & 4) gla_phase(P, lds, j, 1); } break;
        case PT_MIXPREP: if (EN & 8) mixprep_phase(P, j); break;
        case PT_GEMM_OUT: ngemm = 1; g.type = odd ? T_OUT_ODD : T_OUT_EVEN; g.nN = 4; break;
        case PT_NORM2: if (EN & 2) norm_phase(P, l, 1); break;
        case PT_MLP1: ngemm = 1; g.type = T_MLP1; g.nN = 16; break;
        case PT_MLP2: ngemm = 1; g.type = T_MLP2; g.nN = 4; g.ld = 4096; g.nt = 64; break;
        default: if (EN & 2) norm_phase(P, 0, 2); break;
        }
        for (int gi = 0; gi < ngemm; ++gi) {
            if (gi == 1) { g.type = T_DFT_P; g.nM = 1; g.nN = 32; g.ld = 512; g.nt = 8; g.c = (obid() + gridDim.x - 32) % gridDim.x; }
            if (EN & 16) gemm_phase(lds, g);
        }
        if (pt == PT_MIX_A && odd && (EN & 8)) conv_phase(P, j);
        if (ph + 1 < Pk.ph_hi || rep + 1 < nrep) xcd_barrier(gbar);
        }

    }
}


#ifdef DBG_K
__device__ __forceinline__ float dgst(unsigned u) { return (float)(u & 0xffffu) + (float)(u >> 16); }
__global__ void dbg_dump(float* out, const unsigned char* ws) {
    const unsigned* Xu = (const unsigned*)(ws + OFF_X); const unsigned* Hu = (const unsigned*)(ws + OFF_H); const unsigned* Au = (const unsigned*)(ws + OFF_AMIX);
    const unsigned* Bu = (const unsigned*)(ws + OFF_BIG); const unsigned* Uu = (const unsigned*)(ws + OFF_U); const unsigned* Wu = (const unsigned*)(ws);
    for (size_t i = (size_t)blockIdx.x * blockDim.x + threadIdx.x; i < (size_t)NTOK * 1024; i += (size_t)gridDim.x * blockDim.x) {
        float v = 0.f;
        if (DBG_SEL & 1) v += dgst(Xu[i]);
        if (DBG_SEL & 2) v += dgst(Hu[i % 6291456]);
        if (DBG_SEL & 4) v += dgst(Au[i % 6291456]);
        if (DBG_SEL & 8) v += dgst(Bu[i]) + dgst(Bu[i + 12582912]) + dgst(Bu[(i + 25165824) % 34603008]);
        if (DBG_SEL & 16) v += dgst(Uu[i % 2113536]);
        if (DBG_SEL & 32) v += dgst(Wu[i]) + dgst(Wu[i + 12582912]) + dgst(Wu[(i + 25165824) % 28573696]);
        out[i] = v;
    }
}
#endif
extern "C" void kernel_launch(void* const* d_in, const int* in_sizes, int n_in, void* d_out, int out_size, void* d_ws, size_t ws_size, hipStream_t stream) {
    static int grid = 0;
    if (grid == 0) {
        if (n_in != 22 || ws_size < WS_NEED) { fprintf(stderr, "kernel_launch: unexpected n_in %d / ws_size %zu (need %zu)\n", n_in, ws_size, (size_t)WS_NEED); grid = -1; return; }
        int dev = 0, cus = 0, per_cu = 0;
        hipGetDevice(&dev);
        hipDeviceGetAttribute(&cus, hipDeviceAttributeMultiprocessorCount, dev);
        if (hipFuncSetAttribute((const void*)mega_fwd, hipFuncAttributeMaxDynamicSharedMemorySize, LDS_BYTES) != hipSuccess) { fprintf(stderr, "kernel_launch: hipFuncSetAttribute failed\n"); grid = -1; return; }
        hipOccupancyMaxActiveBlocksPerMultiprocessor(&per_cu, (const void*)mega_fwd, 512, LDS_BYTES);
        if (per_cu < 1) { fprintf(stderr, "kernel_launch: occupancy query says %d blocks/CU\n", per_cu); per_cu = 1; }
        (void)hipGetLastError();
        grid = cus;
    }
    if (grid < 0) return;
    Params p{};
    for (int i = 0; i < 22; ++i) p.in[i] = (const float*)d_in[i];
    p.out = (float*)d_out; p.ws = (unsigned char*)d_ws;
#if MULTI_LAUNCH
#ifdef DBG_K
    for (int ph = 0; ph < DBG_K; ++ph) {
        p.ph_lo = ph; p.ph_hi = ph + 1;
        hipLaunchKernelGGL(mega_fwd, dim3(grid), dim3(512), LDS_BYTES, stream, p);
    }
    hipLaunchKernelGGL(dbg_dump, dim3(2048), dim3(256), 0, stream, (float*)d_out, (const unsigned char*)d_ws);
#else
    for (int ph = 0; ph < NPH; ++ph) {
        p.ph_lo = ph; p.ph_hi = ph + 1;
        hipLaunchKernelGGL(mega_fwd, dim3(grid), dim3(512), LDS_BYTES, stream, p);
    }
#endif
#else
    p.ph_lo = 0; p.ph_hi = NPH;
    if (hipMemsetAsync((char*)d_ws + OFF_BAR, 0, 16384, stream) != hipSuccess) { fprintf(stderr, "kernel_launch: memset of barrier word failed\n"); return; }
    void* args[] = {&p};
    hipError_t e = hipLaunchCooperativeKernel((const void*)mega_fwd, dim3(grid), dim3(512), args, LDS_BYTES, stream);
    if (e != hipSuccess) fprintf(stderr, "cooperative launch failed: %s (grid %d)\n", hipGetErrorString(e), grid);
#endif
}
```

```cpp
#include <hip/hip_runtime.h>
#include <hip/hip_cooperative_groups.h>
#include <cstdio>
#include <cstdint>
namespace cg = cooperative_groups;

#ifndef DBG_SEL
#define DBG_SEL 63
#endif
#ifndef DBG_NP
#define DBG_NP(x) (x)
#endif
#ifndef REP_PT
#define REP_PT -1
#endif
#ifndef REP_N
#define REP_N 1
#endif
#ifndef XSYNC
#define XSYNC 0
#endif
#ifndef DBG_SINIT
#define DBG_SINIT 1
#endif
#ifndef EN
#define EN 31
#endif
#ifndef MULTI_LAUNCH
#define MULTI_LAUNCH 0
#endif

#define LAS __attribute__((address_space(3)))
typedef unsigned short bf16_t;
typedef short bf16x8 __attribute__((ext_vector_type(8)));
typedef float f32x4 __attribute__((ext_vector_type(4)));
typedef unsigned u32x2 __attribute__((ext_vector_type(2)));
typedef unsigned u32x4 __attribute__((ext_vector_type(4)));

constexpr int DM = 1024, NTOK = 12288, NPROMPT = 4096, DFF = 4096;
constexpr int LDS_BYTES = 147456;
constexpr int NPH = 36;
constexpr size_t MBy = 1048576;
constexpr size_t OFF_W1T = 0, OFF_W2T = 32 * MBy, OFF_WIE = 64 * MBy, OFF_WOE = 74 * MBy, OFF_WIO = 78 * MBy, OFF_WOO = 88 * MBy;
constexpr size_t OFF_T2K = 92 * MBy, OFF_T256 = 108 * MBy, OFF_MOD = 108 * MBy + 262144, OFF_U = 109 * MBy, OFF_DTOT = 117 * MBy;
constexpr size_t OFF_X = 118 * MBy, OFF_H = 166 * MBy, OFF_AMIX = 190 * MBy, OFF_BIG = 214 * MBy, WS_NEED = 348 * MBy;
constexpr size_t OFF_HID = OFF_BIG;
constexpr size_t OFF_QB = OFF_BIG, OFF_KB = OFF_BIG + 6 * MBy, OFF_VT = OFF_BIG + 12 * MBy, OFF_GATE = OFF_BIG + 24 * MBy, OFF_LOGF = OFF_BIG + 36 * MBy;
constexpr size_t OFF_UB = OFF_BIG + 60 * MBy, OFF_ODIR = OFF_BIG + 72 * MBy;
constexpr size_t OFF_XTS = OFF_BIG, OFF_XTP = OFF_BIG + 16 * MBy, OFF_XIN = OFF_BIG + 24 * MBy, OFF_BG = OFF_BIG + 36 * MBy, OFF_CG = OFF_BIG + 48 * MBy;
constexpr size_t OFF_FACCP = OFF_BIG + 60 * MBy, OFF_FACCS = OFF_BIG + 68 * MBy;
constexpr size_t OFF_BAR = 117 * MBy + 524288;
constexpr size_t OUT_STATE = (size_t)NTOK * DM;

struct Params { const float* in[22]; float* out; unsigned char* ws; int ph_lo, ph_hi; };
typedef const __attribute__((address_space(4))) Params* PP;
enum { I_XP = 0, I_XS, I_STATE, I_C, I_CCTX, I_NORMG, I_FINALG, I_WADA, I_BADA, I_W1, I_W2, I_WINE, I_WA2, I_BA2, I_GLAG, I_POOLW, I_POOLS, I_WOUTE, I_WINO, I_CONVW, I_CONVB, I_WOUTO };

__device__ __forceinline__ int otid() { int t = __builtin_amdgcn_workitem_id_x(); asm volatile("" : "+v"(t)); return t; }
__device__ __forceinline__ int obid() { int b = __builtin_amdgcn_workgroup_id_x(); asm volatile("" : "+s"(b)); return b; }
typedef float f32x2 __attribute__((ext_vector_type(2)));
typedef __bf16 bf16x2v __attribute__((ext_vector_type(2)));
__device__ __forceinline__ unsigned pk2(float lo, float hi) { f32x2 v = {lo, hi}; bf16x2v b = __builtin_convertvector(v, bf16x2v); return __builtin_bit_cast(unsigned, b); }
__device__ __forceinline__ bf16_t f2bf(float x) { return (bf16_t)(pk2(x, 0.f) & 0xffffu); }
__device__ __forceinline__ float bf2f(bf16_t u) { return __uint_as_float(((unsigned)u) << 16); }
__device__ __forceinline__ float bflo(unsigned u) { return __uint_as_float(u << 16); }
__device__ __forceinline__ float bfhi(unsigned u) { return __uint_as_float(u & 0xffff0000u); }
__device__ __forceinline__ float wave_sum(float v) {
#pragma unroll
    for (int o = 1; o < 64; o <<= 1) v += __shfl_xor(v, o);
    return v;
}
__device__ __forceinline__ float siluf(float x) { return x * __builtin_amdgcn_rcpf(1.f + __expf(-x)); }
__device__ __forceinline__ float logsigmoidf(float x) { return fminf(x, 0.f) - __logf(1.f + __expf(-fabsf(x))); }
__device__ __forceinline__ int cond_of_seg(int pm) { return pm < 16 ? 0 : 1 + ((pm - 16) >> 3); }

namespace pg8 {
constexpr int BM = 256, BK = 64, HALF = 128, HTB = HALF * BK * 2, STAGE_BYTES = 8 * HTB, NXCD = 8, WGM = 8;
__host__ __device__ __forceinline__ int lds_byte(int r, int c) { const int st = (r >> 4) * 2 + (c >> 5), rr = r & 15, cc = c & 31, ob = rr * 64 + cc * 2; return st * 1024 + (ob ^ (((ob >> 9) & 1) << 5)); }
__host__ __device__ __forceinline__ int perm32(int rho) { const int n = rho >> 4, i = rho & 15; return 8 * (i >> 2) + 4 * n + (i & 3); }
__host__ __device__ __forceinline__ void stage_rc(int b, int& R, int& C) { const int st = b / 1024, sb = b % 1024, swz = sb ^ (((sb >> 9) & 1) << 5); R = (st >> 1) * 16 + swz / 64; C = (st & 1) * 32 + (swz % 64) / 2; }
}

enum { KD_BF16 = 0, KD_SILU, KD_RELU2, KD_LOGF, KD_RES, KD_ATOM };
enum { T_IN_EVEN = 0, T_IN_ODD, T_OUT_EVEN, T_OUT_ODD, T_MLP1, T_MLP2, T_DFT_S, T_DFT_P };
struct Unit { int pm, pn; };
struct UnitIO { const char* A; const char* B; char* out; const float* aux; int kind; int ld; };
struct GemmCfg { int type, j, l, nM, nN, ld, nt, G, c; };

__device__ __forceinline__ void make_unit(const GemmCfg& g, int pm, int pn, UnitIO& u) {
    PP Pq = (PP)__builtin_amdgcn_kernarg_segment_ptr();
    unsigned char* ws = Pq->ws;
    const size_t rowA = (size_t)pm * 256 * 1024 * 2;
    u.aux = nullptr; u.kind = KD_BF16; u.ld = 512;
    const float* modp = (const float*)(ws + OFF_MOD) + (size_t)(g.l * 5 + cond_of_seg(pm)) * 6144;
    switch (g.type) {
    case T_IN_EVEN: {
        const char* W = (const char*)(ws + OFF_WIE) + (size_t)g.j * 2560 * 1024 * 2 + (size_t)pn * 256 * 1024 * 2;
        const char* Hh = (const char*)(ws + OFF_H) + rowA;
        u.A = Hh; u.B = W;
        if (pn == 0) { u.out = (char*)(ws + OFF_QB) + (size_t)pm * 256 * 256 * 2; u.ld = 256; }
        else if (pn == 1) { u.out = (char*)(ws + OFF_KB) + (size_t)pm * 256 * 256 * 2; u.ld = 256; }
        else if (pn < 4) { u.A = W; u.B = Hh; u.out = (char*)(ws + OFF_VT) + ((size_t)(pn - 2) * 256 * NTOK + (size_t)pm * 256) * 2; u.ld = NTOK; }
        else if (pn < 6) { u.out = (char*)(ws + OFF_GATE) + ((size_t)pm * 256 * 512 + (pn - 4) * 256) * 2; u.kind = KD_SILU; }
        else if (pn < 8) { u.out = (char*)(ws + OFF_LOGF) + ((size_t)pm * 256 * 512 + (pn - 6) * 256) * 4; u.kind = KD_LOGF; u.aux = Pq->in[I_BA2] + g.j * 512 + (pn - 6) * 256; }
        else { u.out = (char*)(ws + OFF_UB) + ((size_t)pm * 256 * 512 + (pn - 8) * 256) * 2; }
    } break;
    case T_IN_ODD: {
        const char* W = (const char*)(ws + OFF_WIO) + (size_t)g.j * 2560 * 1024 * 2 + (size_t)pn * 256 * 1024 * 2;
        const char* Hh = (const char*)(ws + OFF_H) + rowA;
        u.A = Hh; u.B = W;
        if (pn < 4) {
            u.A = W; u.B = Hh;
            const int z = pn >> 1, ch0 = (pn & 1) * 256;
            if (pm < 16) { u.out = (char*)(ws + OFF_XTP) + ((size_t)(pm * 512 + ch0) * 512 + z * 256) * 2; u.ld = 512; }
            else { const int b = (pm - 16) >> 3, part = (pm - 16) & 7; u.out = (char*)(ws + OFF_XTS) + ((size_t)(b * 512 + ch0) * 4096 + z * 2048 + part * 256) * 2; u.ld = 4096; }
        } else {
            const size_t base = (pn < 6) ? OFF_XIN : (pn < 8 ? OFF_BG : OFF_CG);
            u.out = (char*)(ws + base) + ((size_t)pm * 256 * 512 + (pn & 1) * 256) * 2;
        }
    } break;
    case T_OUT_EVEN: case T_OUT_ODD: {
        u.A = (const char*)(ws + OFF_AMIX) + rowA;
        u.B = (const char*)(ws + (g.type == T_OUT_EVEN ? OFF_WOE : OFF_WOO)) + (size_t)g.j * 1024 * 1024 * 2 + (size_t)pn * 256 * 1024 * 2;
        u.out = (char*)(ws + OFF_X) + ((size_t)pm * 256 * 1024 + pn * 256) * 4; u.ld = 1024; u.kind = KD_RES; u.aux = modp + 2048 + pn * 256;
    } break;
    case T_MLP1: {
        u.A = (const char*)(ws + OFF_H) + rowA;
        u.B = (const char*)(ws + OFF_W1T) + (size_t)g.l * 4096 * 1024 * 2 + (size_t)pn * 256 * 1024 * 2;
        u.out = (char*)(ws + OFF_HID) + ((size_t)pm * 256 * 4096 + pn * 256) * 2; u.ld = 4096; u.kind = KD_RELU2;
    } break;
    case T_MLP2: {
        u.A = (const char*)(ws + OFF_HID) + (size_t)pm * 256 * 4096 * 2;
        u.B = (const char*)(ws + OFF_W2T) + (size_t)g.l * 4096 * 1024 * 2 + (size_t)pn * 256 * 4096 * 2;
        u.out = (char*)(ws + OFF_X) + ((size_t)pm * 256 * 1024 + pn * 256) * 4; u.ld = 1024; u.kind = KD_RES; u.aux = modp + 5120 + pn * 256;
    } break;
    case T_DFT_S: {
        const int pnb = pn >> 2, ks = pn & 3;
        u.A = (const char*)(ws + OFF_T2K) + ((size_t)pm * 256 * 4096 + ks * 1024) * 2;
        u.B = (const char*)(ws + OFF_XTS) + ((size_t)pnb * 256 * 4096 + ks * 1024) * 2;
        u.out = (char*)(ws + OFF_FACCS) + ((size_t)ks * 8192 * 512 + (size_t)((pnb >> 1) * 2048 + pm * 256) * 512 + (pnb & 1) * 256) * 4; u.kind = KD_ATOM;
    } break;
    default: {
        u.A = (const char*)(ws + OFF_T256);
        u.B = (const char*)(ws + OFF_XTP) + (size_t)pn * 256 * 512 * 2;
        u.out = (char*)(ws + OFF_FACCP) + ((size_t)((pn >> 1) * 256) * 512 + (pn & 1) * 256) * 4; u.kind = KD_ATOM;
    } break;
    }
}

__device__ __forceinline__ bool next_unit(const GemmCfg& g, int i, Unit& u) {
    const int nwg = g.nM * g.nN;
    const long L = (long)i * g.G + g.c; if (L >= nwg) return false;
    int wgid = (int)L; { const int q = nwg / pg8::NXCD, r = nwg % pg8::NXCD, xcd = wgid % pg8::NXCD, off = wgid / pg8::NXCD; wgid = (xcd < r ? xcd * (q + 1) : r * (q + 1) + (xcd - r) * q) + off; }
    const int nig = pg8::WGM * g.nN, gid = wgid / nig, fm = gid * pg8::WGM, gsz = (g.nM - fm) < pg8::WGM ? (g.nM - fm) : pg8::WGM;
    const int pm = fm + ((wgid % nig) % gsz), pn = (wgid % nig) / gsz;
    u.pm = pm; u.pn = pn; return true;
}

__device__ __forceinline__ void epilogue(const f32x4 (&acc)[2][2][4][2], const GemmCfg& g, const Unit& uu, int wr, int wc, int fr, int fq) {
    UnitIO u; make_unit(g, uu.pm, uu.pn, u);
    const int row0 = wr * 64 + fr, col0 = wc * 32 + 8 * fq;
    const int kind = u.kind, ld = u.ld;
    if (kind <= KD_RELU2) {
        bf16_t* O = (bf16_t*)u.out;
#pragma unroll
        for (int ai = 0; ai < 2; ++ai)
#pragma unroll
            for (int m = 0; m < 4; ++m) {
                bf16_t* rowp = O + (size_t)(row0 + ai * 128 + m * 16) * ld + col0;
#pragma unroll
                for (int bj = 0; bj < 2; ++bj) {
                    f32x4 v0 = acc[ai][bj][m][0], v1 = acc[ai][bj][m][1];
                    if (kind == KD_SILU) { v0[0] = siluf(v0[0]); v0[1] = siluf(v0[1]); v0[2] = siluf(v0[2]); v0[3] = siluf(v0[3]); v1[0] = siluf(v1[0]); v1[1] = siluf(v1[1]); v1[2] = siluf(v1[2]); v1[3] = siluf(v1[3]); }
                    else if (kind == KD_RELU2) {
                        v0[0] = fmaxf(v0[0], 0.f); v0[1] = fmaxf(v0[1], 0.f); v0[2] = fmaxf(v0[2], 0.f); v0[3] = fmaxf(v0[3], 0.f); v0 = v0 * v0;
                        v1[0] = fmaxf(v1[0], 0.f); v1[1] = fmaxf(v1[1], 0.f); v1[2] = fmaxf(v1[2], 0.f); v1[3] = fmaxf(v1[3], 0.f); v1 = v1 * v1; }
                    u32x4 o; o.x = pk2(v0[0], v0[1]); o.y = pk2(v0[2], v0[3]); o.z = pk2(v1[0], v1[1]); o.w = pk2(v1[2], v1[3]);
                    *(u32x4*)(rowp + bj * 128) = o;
                }
            }
    } else if (kind == KD_RES) {
        float* O = (float*)u.out;
        f32x4 gv[2][2];
#pragma unroll
        for (int bj = 0; bj < 2; ++bj)
#pragma unroll
            for (int n = 0; n < 2; ++n) gv[bj][n] = *(const f32x4*)(u.aux + col0 + bj * 128 + n * 4);
#pragma unroll
        for (int ai = 0; ai < 2; ++ai)
#pragma unroll
            for (int m = 0; m < 4; ++m) {
                float* rowp = O + (size_t)(row0 + ai * 128 + m * 16) * ld + col0;
#pragma unroll
                for (int bj = 0; bj < 2; ++bj)
#pragma unroll
                    for (int n = 0; n < 2; ++n) { f32x4* p = (f32x4*)(rowp + bj * 128 + n * 4); *p = *p + gv[bj][n] * acc[ai][bj][m][n]; }
            }
    } else if (kind == KD_LOGF) {
        float* O = (float*)u.out;
#pragma unroll
        for (int bj = 0; bj < 2; ++bj)
#pragma unroll
            for (int n = 0; n < 2; ++n) {
                const f32x4 bv = *(const f32x4*)(u.aux + col0 + bj * 128 + n * 4);
#pragma unroll
                for (int ai = 0; ai < 2; ++ai)
#pragma unroll
                    for (int m = 0; m < 4; ++m) {
                        f32x4 v = acc[ai][bj][m][n] + bv;
                        v[0] = logsigmoidf(v[0]) * 0.0625f; v[1] = logsigmoidf(v[1]) * 0.0625f; v[2] = logsigmoidf(v[2]) * 0.0625f; v[3] = logsigmoidf(v[3]) * 0.0625f;
                        *(f32x4*)(O + (size_t)(row0 + ai * 128 + m * 16) * ld + col0 + bj * 128 + n * 4) = v;
                    }
            }
    } else {
        float* O = (float*)u.out;
#pragma unroll
        for (int ai = 0; ai < 2; ++ai)
#pragma unroll
            for (int m = 0; m < 4; ++m) {
                float* rowp = O + (size_t)(row0 + ai * 128 + m * 16) * ld + col0;
#pragma unroll
                for (int bj = 0; bj < 2; ++bj)
#pragma unroll
                    for (int n = 0; n < 2; ++n) {
                        *(f32x4*)(rowp + bj * 128 + n * 4) = acc[ai][bj][m][n];
                    }
            }
    }
}

__device__ __forceinline__ void gemm_phase(LAS unsigned char* lds, const GemmCfg& g) {
    using namespace pg8;
    const int tid = otid(), wid = __builtin_amdgcn_readfirstlane(tid >> 6), lane = tid & 63, wr = wid >> 2, wc = wid & 3, fr = lane & 15, fq = lane >> 4;
    const int nt = g.nt;
    unsigned voffA[2], voffB[2];
#pragma unroll
    for (int i = 0; i < 2; ++i) { int R, C; stage_rc(tid * 16 + i * 8192, R, C); const int Rb = (R & ~31) + perm32(R & 31); voffA[i] = (unsigned)(R * g.ld + C) * 2u; voffB[i] = (unsigned)(Rb * g.ld + C) * 2u; }
    const size_t kstep = (size_t)(BK * 2);
    const size_t hstepA = (size_t)HALF * g.ld * 2;
#define hstepB hstepA
    const unsigned ldsw = (unsigned)wid * 1024u;
    const int aoff = lds_byte(wr * 64 + fr, fq * 8), boff = lds_byte(wc * 32 + fr, fq * 8);
#define PG8_SA(b, h) (((b) * 2 + (h)) * HTB)
#define PG8_SB(b, h) ((4 + (b) * 2 + (h)) * HTB)
#define PG8_STAGE(bufoff, gbase, voff) do { _Pragma("unroll") for (int _i = 0; _i < 2; ++_i) \
        __builtin_amdgcn_global_load_lds((const unsigned*)((const char*)(gbase) + (voff)[_i]), (LAS unsigned*)(lds + (bufoff) + ldsw + _i * 8192), 16, 0, 0); } while (0)
#define PG8_LDA(dst, b, h) do { _Pragma("unroll") for (int m = 0; m < 4; ++m) _Pragma("unroll") for (int k = 0; k < 2; ++k) dst[m][k] = *(const LAS bf16x8*)(lds + PG8_SA(b, h) + aoff + m * 2048 + k * 1024); } while (0)
#define PG8_LDB(dst, b, h) do { _Pragma("unroll") for (int n = 0; n < 2; ++n) _Pragma("unroll") for (int k = 0; k < 2; ++k) dst[n][k] = *(const LAS bf16x8*)(lds + PG8_SB(b, h) + boff + n * 2048 + k * 1024); } while (0)
#define PG8_MMA(ai, bj, At, Bt) do { __builtin_amdgcn_s_setprio(1); _Pragma("unroll") for (int m = 0; m < 4; ++m) _Pragma("unroll") for (int n = 0; n < 2; ++n) _Pragma("unroll") for (int k = 0; k < 2; ++k) \
        acc[ai][bj][m][n] = __builtin_amdgcn_mfma_f32_16x16x32_bf16(Bt[n][k], At[m][k], acc[ai][bj][m][n], 0, 0, 0); __builtin_amdgcn_s_setprio(0); } while (0)
#define PG8_WAIT_V(n) asm volatile("s_waitcnt vmcnt(" #n ")" ::: "memory")
#define PG8_WAIT_L(n) asm volatile("s_waitcnt lgkmcnt(" #n ")" ::: "memory")
#define PG8_BAR __builtin_amdgcn_s_barrier()
#define PG8_SCHED __builtin_amdgcn_sched_barrier(0)
    Unit cur, nxt; int ui = 0;
    if (!next_unit(g, 0, cur)) return;
    f32x4 acc[2][2][4][2];
#pragma unroll
    for (int a = 0; a < 2; ++a)
#pragma unroll
        for (int b = 0; b < 2; ++b)
#pragma unroll
            for (int m = 0; m < 4; ++m)
#pragma unroll
                for (int n = 0; n < 2; ++n) acc[a][b][m][n] = (f32x4){0.f, 0.f, 0.f, 0.f};
    bf16x8 At[4][2], B0[2][2], B1[2][2];
    const char* cA; const char* cB; { UnitIO io; make_unit(g, cur.pm, cur.pn, io); cA = io.A; cB = io.B; }
    PG8_STAGE(PG8_SB(0, 0), cB, voffB); PG8_STAGE(PG8_SA(0, 0), cA, voffA); PG8_STAGE(PG8_SB(0, 1), cB + hstepB, voffB); PG8_STAGE(PG8_SA(0, 1), cA + hstepA, voffA);
    if (wr == 1) PG8_BAR;
    PG8_WAIT_V(4); PG8_BAR;
    PG8_STAGE(PG8_SB(1, 0), cB + kstep, voffB); PG8_STAGE(PG8_SA(1, 0), cA + kstep, voffA); PG8_STAGE(PG8_SB(1, 1), cB + hstepB + kstep, voffB);
    PG8_WAIT_V(6); PG8_BAR;
    for (;;) {
        const bool has_next = next_unit(g, ui + 1, nxt);
        const char* nA = cA; const char* nB = cB; if (has_next) { UnitIO io; make_unit(g, nxt.pm, nxt.pn, io); nA = io.A; nB = io.B; }
        for (int t = 0; t < nt; t += 2) {
            const bool last = (t == nt - 2);
            const char* a1 = cA + (size_t)(t + 1) * kstep;
            const char* a2 = last ? nA : cA + (size_t)(t + 2) * kstep; const char* b2 = last ? nB : cB + (size_t)(t + 2) * kstep;
            const char* a3 = a2 + kstep; const char* b3 = b2 + kstep;
            PG8_LDB(B0, 0, 0); PG8_SCHED; PG8_LDA(At, 0, 0); PG8_STAGE(PG8_SA(1, 1), a1 + hstepA, voffA);
            PG8_WAIT_L(8); PG8_BAR; PG8_WAIT_L(0); PG8_MMA(0, 0, At, B0); PG8_BAR; PG8_SCHED;
            PG8_LDB(B1, 0, 1); PG8_STAGE(PG8_SB(0, 0), b2, voffB);
            PG8_BAR; PG8_WAIT_L(0); PG8_MMA(0, 1, At, B1); PG8_BAR;
            PG8_LDA(At, 0, 1); PG8_STAGE(PG8_SA(0, 0), a2, voffA);
            PG8_BAR; PG8_WAIT_L(0); PG8_MMA(1, 0, At, B0); PG8_BAR; PG8_SCHED;
            PG8_STAGE(PG8_SB(0, 1), b2 + hstepB, voffB);
            PG8_WAIT_V(6); PG8_BAR; PG8_MMA(1, 1, At, B1); PG8_BAR;
            PG8_LDB(B0, 1, 0); PG8_SCHED; PG8_LDA(At, 1, 0); PG8_STAGE(PG8_SA(0, 1), a2 + hstepA, voffA);
            PG8_WAIT_L(8); PG8_BAR; PG8_WAIT_L(0); PG8_MMA(0, 0, At, B0); PG8_BAR; PG8_SCHED;
            PG8_LDB(B1, 1, 1); PG8_STAGE(PG8_SB(1, 0), b3, voffB);
            PG8_BAR; PG8_WAIT_L(0); PG8_MMA(0, 1, At, B1); PG8_BAR;
            PG8_LDA(At, 1, 1); PG8_STAGE(PG8_SA(1, 0), a3, voffA);
            PG8_BAR; PG8_WAIT_L(0); PG8_MMA(1, 0, At, B0); PG8_BAR; PG8_SCHED;
            PG8_STAGE(PG8_SB(1, 1), b3 + hstepB, voffB);
            PG8_WAIT_V(6); PG8_BAR; PG8_MMA(1, 1, At, B1); PG8_BAR;
        }
        epilogue(acc, g, cur, wr, wc, fr, fq);
        if (!has_next) break;
#pragma unroll
        for (int a = 0; a < 2; ++a)
#pragma unroll
            for (int b = 0; b < 2; ++b)
#pragma unroll
                for (int m = 0; m < 4; ++m)
#pragma unroll
                    for (int n = 0; n < 2; ++n) acc[a][b][m][n] = (f32x4){0.f, 0.f, 0.f, 0.f};
        cur = nxt; cA = nA; cB = nB; ++ui;
    }
    PG8_WAIT_V(0);
    if (wr == 0) PG8_BAR;
    PG8_BAR;
#undef hstepB
#undef PG8_SA
#undef PG8_SB
#undef PG8_STAGE
#undef PG8_LDA
#undef PG8_LDB
#undef PG8_MMA
#undef PG8_WAIT_V
#undef PG8_WAIT_L
#undef PG8_BAR
#undef PG8_SCHED
}

__device__ __forceinline__ void transpose_item(const float* W, int ldn, int n0, int k0, bf16_t* WT, int drow0, int ldk, float scale, LAS float* scr, int lane) {
    float tv[32];
#pragma unroll
    for (int i = 0; i < 32; ++i) { const int kk = 2 * i + (lane >> 5); tv[i] = W[(size_t)(k0 + kk) * ldn + n0 + (lane & 31)]; }
#pragma unroll
    for (int i = 0; i < 32; ++i) { const int kk = 2 * i + (lane >> 5); scr[kk * 33 + (lane & 31)] = tv[i]; }
    asm volatile("s_waitcnt lgkmcnt(0)" ::: "memory");
    const int c = lane & 7;
#pragma unroll
    for (int jx = 0; jx < 4; ++jx) {
        const int n = (lane >> 3) + 8 * jx; const LAS float* s = scr + (8 * c) * 33 + n;
        u32x4 o; o.x = pk2(s[0] * scale, s[33] * scale); o.y = pk2(s[66] * scale, s[99] * scale); o.z = pk2(s[132] * scale, s[165] * scale); o.w = pk2(s[198] * scale, s[231] * scale);
        *(u32x4*)(WT + (size_t)(drow0 + n) * ldk + k0 + 8 * c) = o;
    }
    asm volatile("s_waitcnt lgkmcnt(0)" ::: "memory");
}

__device__ __forceinline__ void prep_phase(PP P, LAS unsigned char* lds) {
    const int tid = otid(), lane = tid & 63, wave = tid >> 6, G = gridDim.x, bx = obid();
    unsigned char* ws = P->ws;
    {
        LAS float* scr = (LAS float*)(lds + wave * 8704);
        constexpr int N1 = 4 * 16 * 128, N2 = 4 * 64 * 32, N3 = 2 * 16 * 64, N4 = 2 * 8 * 32, N5 = 2 * 16 * 48, N6 = 2 * 16 * 32;
        constexpr int NIT = N1 + N2 + N3 + N4 + N5 + N6;
        for (int it = bx * 8 + wave; it < NIT; it += G * 8) {
            int r = it;
            if (r < N1) { const int l = r / 2048, q = r % 2048, kb = q / 128, nb = q % 128;
                transpose_item(P->in[I_W1] + (size_t)l * 1024 * 4096, 4096, nb * 32, kb * 64, (bf16_t*)(ws + OFF_W1T) + (size_t)l * 4096 * 1024, nb * 32, 1024, 1.f, scr, lane); continue; }
            r -= N1;
            if (r < N2) { const int l = r / 2048, q = r % 2048, kb = q / 32, nb = q % 32;
                transpose_item(P->in[I_W2] + (size_t)l * 4096 * 1024, 1024, nb * 32, kb * 64, (bf16_t*)(ws + OFF_W2T) + (size_t)l * 1024 * 4096, nb * 32, 4096, 1.f, scr, lane); continue; }
            r -= N2;
            if (r < N3) { const int j = r / 1024, q = r % 1024, kb = q / 64, nb = q % 64; const int sb = nb < 48 ? nb : nb + 1; const int n0 = sb * 32;
                const int drow = n0 < 1536 ? n0 : n0 + 480;
                transpose_item(P->in[I_WINE] + (size_t)j * 1024 * 2080, 2080, n0, kb * 64, (bf16_t*)(ws + OFF_WIE) + (size_t)j * 2560 * 1024, drow, 1024, n0 < 256 ? 0.125f : 1.f, scr, lane); continue; }
            r -= N3;
            if (r < N4) { const int j = r / 256, q = r % 256, kb = q / 32, nb = q % 32;
                transpose_item(P->in[I_WOUTE] + (size_t)j * 1024 * 1024, 1024, nb * 32, kb * 64, (bf16_t*)(ws + OFF_WOE) + (size_t)j * 1024 * 1024, nb * 32, 1024, 1.f, scr, lane); continue; }
            r -= N4;
            if (r < N5) { const int j = r / 768, q = r % 768, kb = q / 48, nb = q % 48; const int n0 = 512 + nb * 32;
                transpose_item(P->in[I_WINO] + (size_t)j * 1024 * 2048, 2048, n0, kb * 64, (bf16_t*)(ws + OFF_WIO) + (size_t)j * 2560 * 1024, n0 + 512, 1024, 1.f, scr, lane); continue; }
            r -= N5;
            { const int j = r / 512, q = r % 512, kb = q / 32, nb = q % 32;
                transpose_item(P->in[I_WOUTO] + (size_t)j * 1024 * 1024, 1024, nb * 32, kb * 64, (bf16_t*)(ws + OFF_WOO) + (size_t)j * 1024 * 1024, nb * 32, 1024, 1.f, scr, lane); }
        }
    }
    {
        const int gt = bx * 512 + tid, GT = G * 512;
        for (int it = gt; it < 2048 * 512 + 256 * 64; it += GT) {
            int L, k, c0; bf16_t* T; float s;
            if (it < 2048 * 512) { L = 2048; k = it >> 9; c0 = (it & 511) * 8; T = (bf16_t*)(ws + OFF_T2K); s = 1.f / 512.f; }
            else { const int r = it - 2048 * 512; L = 256; k = r >> 6; c0 = (r & 63) * 8; T = (bf16_t*)(ws + OFF_T256); s = 0.00552427172801990f; }
            const int z = c0 >= L; const int l0 = c0 - z * L; const float invL = 1.f / (float)L;
            float v[8];
#pragma unroll
            for (int e = 0; e < 8; ++e) { const int ph = (k * (l0 + e)) & (L - 1); const float fr = (float)ph * invL; v[e] = z ? -__builtin_amdgcn_sinf(fr) * s : __builtin_amdgcn_cosf(fr) * s; }
            u32x4 o; o.x = pk2(v[0], v[1]); o.y = pk2(v[2], v[3]); o.z = pk2(v[4], v[5]); o.w = pk2(v[6], v[7]);
            *(u32x4*)(T + (size_t)k * (2 * L) + c0) = o;
        }
    }
    {
        float* X = (float*)(ws + OFF_X);
        for (int r = bx * 8 + wave; r < NTOK; r += G * 8) {
            if (r < NPROMPT) {
#pragma unroll
                for (int jj = 0; jj < 4; ++jj) *(f32x4*)(X + (size_t)r * 1024 + jj * 256 + lane * 4) = *(const f32x4*)(P->in[I_XP] + (size_t)r * 1024 + jj * 256 + lane * 4);
            } else {
                const int s = r - NPROMPT, t = s & 2047; const float gr = (float)(t >> 6), gc = (float)(t & 63);
#pragma unroll
                for (int jj = 0; jj < 4; ++jj) {
                    f32x4 v = *(const f32x4*)(P->in[I_XS] + (size_t)s * 1024 + jj * 256 + lane * 4);
#pragma unroll
                    for (int e = 0; e < 4; ++e) {
                        const float fq = __builtin_amdgcn_exp2f(-(float)(lane * 4 + e) * (13.287712379549449f / 256.f));
                        const float ang = (jj < 2 ? gr : gc) * fq;
                        v[e] += (jj & 1) ? __cosf(ang) : __sinf(ang);
                    }
                    *(f32x4*)(X + (size_t)r * 1024 + jj * 256 + lane * 4) = v;
                }
            }
        }
    }
    __syncthreads();
    {
        LAS float* sc = (LAS float*)lds;
        LAS float* red = (LAS float*)(lds + 20480);
        bool staged = false;
        for (int it = bx; it < 192; it += G) {
            if (!staged) {
                for (int idx = tid; idx < 5120; idx += 512) { const int cnd = idx >> 10, k = idx & 1023; const float c = cnd == 0 ? P->in[I_CCTX][k] : P->in[I_C][(cnd - 1) * 1024 + k]; sc[idx] = siluf(c); }
                staged = true; __syncthreads();
            }
            const int l = it / 48, cb = it % 48, quad = tid & 31, kc = tid >> 5;
            const float* wp = P->in[I_WADA] + ((size_t)l * 1024 + kc * 64) * 6144 + cb * 128 + quad * 4;
            f32x4 a[5];
#pragma unroll
            for (int cnd = 0; cnd < 5; ++cnd) a[cnd] = (f32x4){0.f, 0.f, 0.f, 0.f};
#pragma unroll 16
            for (int kk = 0; kk < 64; ++kk) {
                const f32x4 w = *(const f32x4*)(wp + (size_t)kk * 6144);
#pragma unroll
                for (int cnd = 0; cnd < 5; ++cnd) a[cnd] += w * sc[cnd * 1024 + kc * 64 + kk];
            }
#pragma unroll
            for (int cnd = 0; cnd < 5; ++cnd) *(LAS f32x4*)(red + (kc * 5 + cnd) * 128 + quad * 4) = a[cnd];
            __syncthreads();
            for (int idx = tid; idx < 640; idx += 512) {
                const int cnd = idx >> 7, cc = idx & 127; float s = 0.f;
#pragma unroll
                for (int k2 = 0; k2 < 16; ++k2) s += red[(k2 * 5 + cnd) * 128 + cc];
                ((float*)(ws + OFF_MOD))[(size_t)(l * 5 + cnd) * 6144 + cb * 128 + cc] = s + P->in[I_BADA][l * 6144 + cb * 128 + cc];
            }
            __syncthreads();
        }
    }
    __syncthreads();
    {
        LAS float* wt = (LAS float*)lds;
        LAS float* tab = (LAS float*)(lds + 64 * 129 * 4);
        for (int it = (bx + G - (192 % G)) % G; it < 128; it += G) {
            const int j = it >> 6, g = (it >> 4) & 3, kb = it & 15;
            for (int idx = tid; idx < 64 * 128; idx += 512) { const int kk = idx >> 7, c = idx & 127; wt[kk * 129 + c] = P->in[I_WINO][((size_t)j * 1024 + kb * 64 + kk) * 2048 + g * 128 + c]; }
            if (tid < 128) { tab[tid] = __builtin_amdgcn_cosf((float)tid * (1.f / 128.f)); tab[128 + tid] = __builtin_amdgcn_sinf((float)tid * (1.f / 128.f)); }
            __syncthreads();
            const int li = lane & 15, lq = lane >> 4;
            f32x4 acc[2][4];
#pragma unroll
            for (int ti = 0; ti < 2; ++ti)
#pragma unroll
                for (int u = 0; u < 4; ++u) acc[ti][u] = (f32x4){0.f, 0.f, 0.f, 0.f};
            const int zm0 = 16 * (2 * wave) + li, zm1 = zm0 + 16;
            for (int sx = 0; sx < 32; ++sx) {
                const int c = 4 * sx + lq;
                const float a0 = tab[(zm0 >> 7) * 128 + (((zm0 & 127) * c) & 127)], a1 = tab[(zm1 >> 7) * 128 + (((zm1 & 127) * c) & 127)];
#pragma unroll
                for (int u = 0; u < 4; ++u) {
                    const float b = wt[(16 * u + li) * 129 + c];
                    acc[0][u] = __builtin_amdgcn_mfma_f32_16x16x4f32(a0, b, acc[0][u], 0, 0, 0);
                    acc[1][u] = __builtin_amdgcn_mfma_f32_16x16x4f32(a1, b, acc[1][u], 0, 0, 0);
                }
            }
#pragma unroll
            for (int ti = 0; ti < 2; ++ti)
#pragma unroll
                for (int r = 0; r < 4; ++r) {
                    const int zm = 16 * (2 * wave + ti) + 4 * lq + r, z = zm >> 7, m = zm & 127;
                    bf16_t* O = (bf16_t*)(ws + OFF_WIO) + (size_t)j * 2560 * 1024 + (size_t)(z * 512 + g * 128 + m) * 1024 + kb * 64 + li;
#pragma unroll
                    for (int u = 0; u < 4; ++u) O[16 * u] = f2bf(acc[ti][u][r]);
                }
            __syncthreads();
        }
    }
    {
        LAS float* Pt = (LAS float*)lds;
        LAS float* Wd = (LAS float*)(lds + 65536);
        for (int it = (bx + G - (64 % G)) % G; it < 128; it += G) {
            const int j = it >> 6, g = (it >> 4) & 3, nb = it & 15;
            for (int idx = tid; idx < 128 * 128; idx += 512) { const int c = idx >> 7, d = idx & 127; Pt[d * 128 + c] = P->in[I_POOLW][((size_t)(j * 4 + g) * 128 + c) * 128 + d] * P->in[I_POOLS][j * 512 + g * 128 + d]; }
            for (int idx = tid; idx < 128 * 64; idx += 512) { const int d = idx >> 6, n = idx & 63; Wd[d * 64 + n] = P->in[I_WOUTE][((size_t)j * 1024 + 512 + g * 128 + d) * 1024 + nb * 64 + n]; }
            __syncthreads();
            const int c = tid & 127, ng = tid >> 7;
            float acc[16];
#pragma unroll
            for (int nn = 0; nn < 16; ++nn) acc[nn] = 0.f;
            for (int d = 0; d < 128; ++d) {
                const float p = Pt[d * 128 + c];
#pragma unroll
                for (int nn = 0; nn < 16; ++nn) acc[nn] += p * Wd[d * 64 + ng * 16 + nn];
            }
            bf16_t* O = (bf16_t*)(ws + OFF_WOE) + (size_t)j * 1024 * 1024 + (size_t)(nb * 64 + ng * 16) * 1024 + 512 + g * 128 + c;
#pragma unroll
            for (int nn = 0; nn < 16; ++nn) O[(size_t)nn * 1024] = f2bf(acc[nn]);
            __syncthreads();
        }
    }
    {
        LAS float* av = (LAS float*)lds;
        LAS float* w2 = (LAS float*)(lds + 16384);
        for (int it = (bx + G - (192 % G)) % G; it < 32; it += G) {
            const int j = it >> 4, kb = it & 15;
            for (int idx = tid; idx < 64 * 32; idx += 512) { const int kk = idx >> 5, r = idx & 31; av[kk * 33 + r] = P->in[I_WINE][((size_t)j * 1024 + kb * 64 + kk) * 2080 + 1536 + r]; }
            for (int idx = tid; idx < 8192; idx += 512) w2[idx] = P->in[I_WA2][(size_t)j * 8192 + idx];
            __syncthreads();
            const int k = tid & 63, grp = tid >> 6, z = grp >> 2, n0 = (grp & 3) * 64;
            float a[16];
#pragma unroll
            for (int r = 0; r < 16; ++r) a[r] = av[k * 33 + z * 16 + r];
            bf16_t* O = (bf16_t*)(ws + OFF_WIE) + (size_t)j * 2560 * 1024 + (size_t)(1536 + z * 256 + n0) * 1024 + kb * 64 + k;
            for (int nn = 0; nn < 64; ++nn) {
                float s = 0.f;
#pragma unroll
                for (int r = 0; r < 16; ++r) s += a[r] * w2[(z * 16 + r) * 256 + n0 + nn];
                O[(size_t)nn * 1024] = f2bf(s);
            }
            __syncthreads();
        }
    }
}

__device__ __forceinline__ void norm_phase(PP P, int l, int which) {
    const int tid = otid(), lane = tid & 63, wave = tid >> 6, G = gridDim.x, bx = obid();
    unsigned char* ws = P->ws;
    const float* X = (const float*)(ws + OFF_X);
    const float* gp = which == 2 ? P->in[I_FINALG] : P->in[I_NORMG] + (size_t)(l * 2 + which) * 1024;
    f32x4 gv[4];
#pragma unroll
    for (int jj = 0; jj < 4; ++jj) gv[jj] = *(const f32x4*)(gp + jj * 256 + lane * 4);
    for (int r0 = bx * 8 + wave; r0 < NTOK; r0 += G * 16) {
        f32x4 v[2][4]; float ss[2] = {0.f, 0.f};
#pragma unroll
        for (int u = 0; u < 2; ++u) { const int r = r0 + u * G * 8; if (r < NTOK) {
#pragma unroll
            for (int jj = 0; jj < 4; ++jj) v[u][jj] = *(const f32x4*)(X + (size_t)r * 1024 + jj * 256 + lane * 4); } }
#pragma unroll
        for (int u = 0; u < 2; ++u) {
            const int r = r0 + u * G * 8; if (r >= NTOK) continue;
#pragma unroll
            for (int jj = 0; jj < 4; ++jj) ss[u] += v[u][jj][0] * v[u][jj][0] + v[u][jj][1] * v[u][jj][1] + v[u][jj][2] * v[u][jj][2] + v[u][jj][3] * v[u][jj][3];
            const float rstd = rsqrtf(wave_sum(ss[u]) * (1.f / 1024.f) + 1e-6f);
            if (which == 2) {
#pragma unroll
                for (int jj = 0; jj < 4; ++jj) *(f32x4*)(P->out + (size_t)r * 1024 + jj * 256 + lane * 4) = v[u][jj] * rstd * gv[jj];
            } else {
                const int cnd = r < NPROMPT ? 0 : 1 + ((r - NPROMPT) >> 11);
                const float* mp = (const float*)(ws + OFF_MOD) + (size_t)(l * 5 + cnd) * 6144 + which * 3072;
                bf16_t* Hh = (bf16_t*)(ws + OFF_H) + (size_t)r * 1024;
#pragma unroll
                for (int jj = 0; jj < 4; ++jj) {
                    const f32x4 sh = *(const f32x4*)(mp + jj * 256 + lane * 4), sc = *(const f32x4*)(mp + 1024 + jj * 256 + lane * 4);
                    const f32x4 y = v[u][jj] * rstd * gv[jj] * (sc + 1.f) + sh;
                    u32x2 o; o.x = pk2(y[0], y[1]); o.y = pk2(y[2], y[3]);
                    *(u32x2*)(Hh + jj * 256 + lane * 4) = o;
                }
            }
        }
    }
}

__device__ __forceinline__ void pool_phase(PP P) {
    unsigned char* ws = P->ws;
    const bf16_t* UB = (const bf16_t*)(ws + OFF_UB);
    bf16_t* AM = (bf16_t*)(ws + OFF_AMIX);
    for (int idx = obid() * 512 + otid(); idx < NTOK * 64; idx += gridDim.x * 512) {
        const int t = idx >> 6, oc = idx & 63, ch = oc * 8, g = oc >> 4, w = 2 << g;
        int s0, L; if (t < NPROMPT) { s0 = t & ~255; L = 256; } else { s0 = NPROMPT + ((t - NPROMPT) & ~2047); L = 2048; }
        const int tl = t - s0; const int lo = max(tl - (w >> 1), 0), hi = min(tl + w - (w >> 1), L);
        float s[8];
#pragma unroll
        for (int e = 0; e < 8; ++e) s[e] = 0.f;
        for (int tt = lo; tt < hi; ++tt) {
            const u32x4 v = *(const u32x4*)(UB + (size_t)(s0 + tt) * 512 + ch);
            s[0] += bflo(v.x); s[1] += bfhi(v.x); s[2] += bflo(v.y); s[3] += bfhi(v.y); s[4] += bflo(v.z); s[5] += bfhi(v.z); s[6] += bflo(v.w); s[7] += bfhi(v.w);
        }
        const float ic = 1.f / (float)(hi - lo);
        const u32x4 v = *(const u32x4*)(UB + (size_t)t * 512 + ch);
        u32x4 o;
        o.x = pk2(s[0] * ic - bflo(v.x), s[1] * ic - bfhi(v.x)); o.y = pk2(s[2] * ic - bflo(v.y), s[3] * ic - bfhi(v.y));
        o.z = pk2(s[4] * ic - bflo(v.z), s[5] * ic - bfhi(v.z)); o.w = pk2(s[6] * ic - bflo(v.w), s[7] * ic - bfhi(v.w));
        *(u32x4*)(AM + (size_t)t * 1024 + 512 + ch) = o;
    }
}

__device__ __forceinline__ void mixprep_phase(PP P, int j) {
    const int tid = otid(), lane = tid & 63, wave = tid >> 6;
    unsigned char* ws = P->ws;
    const float* O0 = (const float*)(ws + OFF_ODIR); const float* O1 = O0 + (size_t)NTOK * 512;
    const bf16_t* GT = (const bf16_t*)(ws + OFF_GATE);
    bf16_t* AM = (bf16_t*)(ws + OFF_AMIX);
    const int ch = lane * 8;
    const f32x4 g0 = *(const f32x4*)(P->in[I_GLAG] + j * 128 + (ch & 127)), g1 = *(const f32x4*)(P->in[I_GLAG] + j * 128 + (ch & 127) + 4);
    const int G8 = gridDim.x * 8;
    for (int r0 = obid() * 8 + wave; r0 < NTOK; r0 += 2 * G8) {
        f32x4 a[2], b[2]; u32x4 gt[2];
#pragma unroll
        for (int u = 0; u < 2; ++u) { const int r = r0 + u * G8; if (r < NTOK) {
            a[u] = *(const f32x4*)(O0 + (size_t)r * 512 + ch) + *(const f32x4*)(O1 + (size_t)r * 512 + ch);
            b[u] = *(const f32x4*)(O0 + (size_t)r * 512 + ch + 4) + *(const f32x4*)(O1 + (size_t)r * 512 + ch + 4);
            gt[u] = *(const u32x4*)(GT + (size_t)r * 512 + ch); } }
#pragma unroll
        for (int u = 0; u < 2; ++u) {
            const int r = r0 + u * G8; if (r >= NTOK) continue;
            float ss = a[u][0] * a[u][0] + a[u][1] * a[u][1] + a[u][2] * a[u][2] + a[u][3] * a[u][3] + b[u][0] * b[u][0] + b[u][1] * b[u][1] + b[u][2] * b[u][2] + b[u][3] * b[u][3];
            ss += __shfl_xor(ss, 1); ss += __shfl_xor(ss, 2); ss += __shfl_xor(ss, 4); ss += __shfl_xor(ss, 8);
            const float rstd = rsqrtf(ss * (1.f / 128.f) + 1e-6f);
            const f32x4 aa = a[u] * rstd * g0, bb = b[u] * rstd * g1;
            u32x4 o;
            o.x = pk2(aa[0] * bflo(gt[u].x), aa[1] * bfhi(gt[u].x)); o.y = pk2(aa[2] * bflo(gt[u].y), aa[3] * bfhi(gt[u].y));
            o.z = pk2(bb[0] * bflo(gt[u].z), bb[1] * bfhi(gt[u].z)); o.w = pk2(bb[2] * bflo(gt[u].w), bb[3] * bfhi(gt[u].w));
            *(u32x4*)(AM + (size_t)r * 1024 + ch) = o;
        }
    }
}

__device__ __forceinline__ void conv_phase(PP P, int j) {
    unsigned char* ws = P->ws;
    const bf16_t* XI = (const bf16_t*)(ws + OFF_XIN); const bf16_t* BGp = (const bf16_t*)(ws + OFF_BG); const bf16_t* CGp = (const bf16_t*)(ws + OFF_CG);
    bf16_t* AM = (bf16_t*)(ws + OFF_AMIX);
    for (int idx = obid() * 512 + otid(); idx < NTOK * 64; idx += gridDim.x * 512) {
        const int t = idx >> 6, ch = (idx & 63) * 8;
        int s0, L; if (t < NPROMPT) { s0 = t & ~255; L = 256; } else { s0 = NPROMPT + ((t - NPROMPT) & ~2047); L = 2048; }
        const int tl = t - s0;
        float cv[8];
        { const f32x4 b0 = *(const f32x4*)(P->in[I_CONVB] + j * 512 + ch), b1 = *(const f32x4*)(P->in[I_CONVB] + j * 512 + ch + 4);
          cv[0] = b0[0]; cv[1] = b0[1]; cv[2] = b0[2]; cv[3] = b0[3]; cv[4] = b1[0]; cv[5] = b1[1]; cv[6] = b1[2]; cv[7] = b1[3]; }
#pragma unroll
        for (int jj = 0; jj < 3; ++jj) {
            const int tt = tl + jj - 1;
            if (tt < 0 || tt >= L) continue;
            const u32x4 xv = *(const u32x4*)(XI + (size_t)(s0 + tt) * 512 + ch), cg = *(const u32x4*)(CGp + (size_t)(s0 + tt) * 512 + ch);
            const f32x4 w0 = *(const f32x4*)(P->in[I_CONVW] + (size_t)(j * 3 + jj) * 512 + ch), w1 = *(const f32x4*)(P->in[I_CONVW] + (size_t)(j * 3 + jj) * 512 + ch + 4);
            cv[0] += bflo(xv.x) * bflo(cg.x) * w0[0]; cv[1] += bfhi(xv.x) * bfhi(cg.x) * w0[1]; cv[2] += bflo(xv.y) * bflo(cg.y) * w0[2]; cv[3] += bfhi(xv.y) * bfhi(cg.y) * w0[3];
            cv[4] += bflo(xv.z) * bflo(cg.z) * w1[0]; cv[5] += bfhi(xv.z) * bfhi(cg.z) * w1[1]; cv[6] += bflo(xv.w) * bflo(cg.w) * w1[2]; cv[7] += bfhi(xv.w) * bfhi(cg.w) * w1[3];
        }
        const u32x4 bg = *(const u32x4*)(BGp + (size_t)t * 512 + ch);
        u32x4 o;
        o.x = pk2(cv[0] * bflo(bg.x), cv[1] * bfhi(bg.x)); o.y = pk2(cv[2] * bflo(bg.y), cv[3] * bfhi(bg.y));
        o.z = pk2(cv[4] * bflo(bg.z), cv[5] * bfhi(bg.z)); o.w = pk2(cv[6] * bflo(bg.w), cv[7] * bfhi(bg.w));
        *(u32x4*)(AM + (size_t)t * 1024 + 512 + ch) = o;
    }
}

__device__ __forceinline__ void convert_phase(PP P) {
    unsigned char* ws = P->ws;
    bf16_t* AM = (bf16_t*)(ws + OFF_AMIX);
    for (int idx = obid() * 512 + otid(); idx < NTOK * 64; idx += gridDim.x * 512) {
        const int t = idx >> 6, ch = (idx & 63) * 8;
        f32x4 a, b;
        if (t < NPROMPT) { const float* F = (const float*)(ws + OFF_FACCP) + (size_t)t * 512 + ch; a = *(const f32x4*)F; b = *(const f32x4*)(F + 4); }
        else {
            const float* F = (const float*)(ws + OFF_FACCS) + (size_t)(t - NPROMPT) * 512 + ch;
            a = *(const f32x4*)F; b = *(const f32x4*)(F + 4);
#pragma unroll
            for (int ks = 1; ks < 4; ++ks) { a += *(const f32x4*)(F + (size_t)ks * 8192 * 512); b += *(const f32x4*)(F + (size_t)ks * 8192 * 512 + 4); }
        }
        u32x4 o; o.x = pk2(a[0], a[1]); o.y = pk2(a[2], a[3]); o.z = pk2(b[0], b[1]); o.w = pk2(b[2], b[3]);
        *(u32x4*)(AM + (size_t)t * 1024 + ch) = o;
    }
}

__device__ __forceinline__ int permd(int d) { return (d & 32) | ((d & 12) << 1) | ((d & 16) >> 2) | (d & 3); }
__device__ __forceinline__ bf16x8 pack8(const f32x4& a, const f32x4& b) {
    u32x4 o; o.x = pk2(a[0], a[1]); o.y = pk2(a[2], a[3]); o.z = pk2(b[0], b[1]); o.w = pk2(b[2], b[3]);
    return __builtin_bit_cast(bf16x8, o);
}
__device__ __forceinline__ void gla_item(PP P, LAS unsigned char* lds, int j, int seg, int head, int dir, bool full) {
    const int tid = otid(), lane = tid & 63, w = tid >> 6, r = lane & 15, q = lane >> 4;
    unsigned char* ws = P->ws;
    const bf16_t* QB = (const bf16_t*)(ws + OFF_QB); const bf16_t* KB = (const bf16_t*)(ws + OFF_KB); const bf16_t* VT = (const bf16_t*)(ws + OFF_VT);
    const float* LOGF = (const float*)(ws + OFF_LOGF);
    float* ODIR = (float*)(ws + OFF_ODIR);
    float* Ubuf = (float*)(ws + OFF_U); float* Dtot = (float*)(ws + OFF_DTOT);
    LAS bf16_t* QT = (LAS bf16_t*)(lds);
    LAS bf16_t* KT = (LAS bf16_t*)(lds + 36864);
    LAS bf16_t* KH = (LAS bf16_t*)(lds + 73728);
    LAS float* DL = (LAS float*)(lds + 114688);
    LAS bf16x8* ATT = (LAS bf16x8*)(lds + 116736);
    const int tok0 = seg * 256;
    __syncthreads();
    {
        const int d = tid & 63, c = w, pd = permd(d);
        float b = 0.f;
        const float* lf = LOGF + (size_t)(tok0 + 32 * c) * 512 + dir * 256 + head * 64 + d;
        const bf16_t* qp = QB + (size_t)(tok0 + 32 * c) * 256 + head * 64 + d;
        const bf16_t* kp = KB + (size_t)(tok0 + 32 * c) * 256 + head * 64 + d;
        float lfv[32]; bf16_t qv16[32], kv16[32];
#pragma unroll
        for (int ii = 0; ii < 32; ++ii) { const int il = dir ? 31 - ii : ii; lfv[ii] = lf[(size_t)il * 512]; qv16[ii] = qp[(size_t)il * 256]; kv16[ii] = kp[(size_t)il * 256]; }
#pragma unroll
        for (int ii = 0; ii < 32; ++ii) {
            const int il = dir ? 31 - ii : ii;
            b += lfv[ii];
            const float qv = bf2f(qv16[ii]), kv = bf2f(kv16[ii]);
            QT[(32 * c + il) * 72 + pd] = f2bf(qv * __expf(b));
            KT[(32 * c + il) * 72 + pd] = f2bf(kv * __expf(-b));
        }
        const float eT = __expf(b);
        DL[c * 64 + d] = eT;
#pragma unroll 8
        for (int il = 0; il < 32; ++il) KH[(c * 64 + d) * 40 + permd(il)] = f2bf(bf2f(KT[(32 * c + il) * 72 + pd]) * eT);
    }
    __syncthreads();
    if (full) {
        const int c = w;
        f32x4 at[2][2];
#pragma unroll
        for (int a = 0; a < 2; ++a)
#pragma unroll
            for (int b = 0; b < 2; ++b) at[a][b] = (f32x4){0.f, 0.f, 0.f, 0.f};
#pragma unroll
        for (int kk = 0; kk < 2; ++kk) {
            bf16x8 ka[2], qb[2];
#pragma unroll
            for (int t = 0; t < 2; ++t) { ka[t] = *(const LAS bf16x8*)(KT + (32 * c + 16 * t + r) * 72 + 32 * kk + 8 * q); qb[t] = *(const LAS bf16x8*)(QT + (32 * c + 16 * t + r) * 72 + 32 * kk + 8 * q); }
#pragma unroll
            for (int tj = 0; tj < 2; ++tj)
#pragma unroll
                for (int ti = 0; ti < 2; ++ti) at[tj][ti] = __builtin_amdgcn_mfma_f32_16x16x32_bf16(ka[tj], qb[ti], at[tj][ti], 0, 0, 0);
        }
#pragma unroll
        for (int ti = 0; ti < 2; ++ti) {
            const int i = 16 * ti + r;
#pragma unroll
            for (int tj = 0; tj < 2; ++tj)
#pragma unroll
                for (int jj = 0; jj < 4; ++jj) { const int jx = 16 * tj + 4 * q + jj; const bool keep = dir ? (jx >= i) : (jx <= i); if (!keep) at[tj][ti][jj] = 0.f; }
            ATT[(c * 2 + ti) * 64 + lane] = pack8(at[0][ti], at[1][ti]);
        }
    }
    __syncthreads();
    f32x4 S[4];
#pragma unroll
    for (int t = 0; t < 4; ++t) S[t] = (f32x4){0.f, 0.f, 0.f, 0.f};
    const int e = 16 * w + r;
    if (DBG_SINIT && full && seg >= 16) {
        const int sb = (seg - 16) >> 3, part = (seg - 16) & 7;
        const float* s0 = P->in[I_STATE] + ((size_t)(((sb * 2 + j) * 2 + dir) * 4 + head) * 64) * 128;
#pragma unroll
        for (int t = 0; t < 4; ++t)
#pragma unroll
            for (int jj = 0; jj < 4; ++jj) S[t][jj] = s0[(size_t)(16 * t + 4 * q + jj) * 128 + e];
        const int np = dir ? 7 - part : part;
#pragma unroll
        for (int xb = 0; xb < 8; xb += 4) {
            if (xb >= np) break;
            float dvv[4][16], uvv[4][16];
#pragma unroll
            for (int xi = 0; xi < 4; ++xi) {
                const int x = xb + xi; if (x >= 7) continue;
                const int pp = dir ? 7 - x : x;
                const size_t ib = (size_t)(((sb * 8 + pp) * 4 + head) * 2 + dir) * 64;
#pragma unroll
                for (int t = 0; t < 4; ++t)
#pragma unroll
                    for (int jj = 0; jj < 4; ++jj) { const int d = 16 * t + 4 * q + jj; dvv[xi][t * 4 + jj] = Dtot[ib + d]; uvv[xi][t * 4 + jj] = Ubuf[(ib + d) * 128 + e]; }
            }
#pragma unroll
            for (int xi = 0; xi < 4; ++xi) {
                const int x = xb + xi; if (x >= 7) continue;
                const bool on = x < np;
#pragma unroll
                for (int t = 0; t < 4; ++t)
#pragma unroll
                    for (int jj = 0; jj < 4; ++jj) S[t][jj] = on ? S[t][jj] * dvv[xi][t * 4 + jj] + uvv[xi][t * 4 + jj] : S[t][jj];
            }
        }
    }
    const bf16_t* vt = VT + (size_t)(head * 128 + e) * NTOK + tok0;
    u32x2 vpre0[8], vpre1[8];
#pragma unroll
    for (int cc = 0; cc < 8; ++cc) { const int c = dir ? 7 - cc : cc; vpre0[cc] = *(const u32x2*)(vt + 32 * c + 4 * q); vpre1[cc] = *(const u32x2*)(vt + 32 * c + 16 + 4 * q); }
#pragma unroll
    for (int cc = 0; cc < 8; ++cc) {
        const int c = dir ? 7 - cc : cc;
        const u32x2 v0 = vpre0[cc], v1 = vpre1[cc];
        u32x4 vv; vv.x = v0.x; vv.y = v0.y; vv.z = v1.x; vv.w = v1.y;
        const bf16x8 vb = __builtin_bit_cast(bf16x8, vv);
        if (full) {
            bf16x8 sb2[2];
            sb2[0] = pack8(S[0], S[1]); sb2[1] = pack8(S[2], S[3]);
#pragma unroll
            for (int mi = 0; mi < 2; ++mi) {
                f32x4 o = (f32x4){0.f, 0.f, 0.f, 0.f};
#pragma unroll
                for (int kk = 0; kk < 2; ++kk) {
                    const bf16x8 qa = *(const LAS bf16x8*)(QT + (32 * c + 16 * mi + r) * 72 + 32 * kk + 8 * q);
                    o = __builtin_amdgcn_mfma_f32_16x16x32_bf16(qa, sb2[kk], o, 0, 0, 0);
                }
                const bf16x8 aa = ATT[(c * 2 + mi) * 64 + lane];
                o = __builtin_amdgcn_mfma_f32_16x16x32_bf16(aa, vb, o, 0, 0, 0);
                float* op = ODIR + ((size_t)dir * NTOK + tok0 + 32 * c + 16 * mi + 4 * q) * 512 + head * 128 + e;
#pragma unroll
                for (int jj = 0; jj < 4; ++jj) op[(size_t)jj * 512] = o[jj];
            }
        }
#pragma unroll
        for (int t = 0; t < 4; ++t) {
            const f32x4 dv = *(const LAS f32x4*)(DL + c * 64 + 16 * t + 4 * q);
            S[t] = S[t] * dv;
            const bf16x8 ka = *(const LAS bf16x8*)(KH + (c * 64 + 16 * t + r) * 40 + 8 * q);
            S[t] = __builtin_amdgcn_mfma_f32_16x16x32_bf16(ka, vb, S[t], 0, 0, 0);
        }
    }
    if (full) {
        if (seg < 16) {
            float* so = P->out + OUT_STATE + ((size_t)(((seg * 2 + j) * 2 + dir) * 4 + head) * 64) * 128;
#pragma unroll
            for (int t = 0; t < 4; ++t)
#pragma unroll
                for (int jj = 0; jj < 4; ++jj) so[(size_t)(16 * t + 4 * q + jj) * 128 + e] = S[t][jj];
        }
    } else {
        const size_t ib = (size_t)(((seg - 16) * 4 + head) * 2 + dir) * 64;
#pragma unroll
        for (int t = 0; t < 4; ++t)
#pragma unroll
            for (int jj = 0; jj < 4; ++jj) Ubuf[(ib + 16 * t + 4 * q + jj) * 128 + e] = S[t][jj];
        if (tid < 64) { float p = 1.f;
#pragma unroll
            for (int c = 0; c < 8; ++c) p *= DL[c * 64 + tid];
            Dtot[ib + tid] = p; }
    }
}

__device__ __forceinline__ void gla_phase(PP P, LAS unsigned char* lds, int j, int sub) {
    const int G = gridDim.x;
    if (sub == 0) {
        for (int it = obid(); it < 384; it += G) {
            if (it >= 128 && it < 256) { const int pi = it - 128; gla_item(P, lds, j, pi >> 3, (pi >> 1) & 3, pi & 1, true); }
            else { const int li = it < 128 ? it : it - 128; gla_item(P, lds, j, 16 + (li >> 3), (li >> 1) & 3, li & 1, false); }
        }
    } else {
        for (int it = obid(); it < 256; it += G) gla_item(P, lds, j, 16 + (it >> 3), (it >> 1) & 3, it & 1, true);
    }
}


#define XB_TMO      128
#define XB_XCNT(j)  (256  + 64 * (j))
#define XB_XSUB(j)  (1280 + 64 * (j))
#define XB_XGEN(j)  (2304 + 64 * (j))
#define XB_TOP      3328
#define XB_TOPGEN   3392
#define XCD_BAR_WORDS 3456
#define XB_SPIN_CAP (1u << 18)

__device__ __forceinline__ unsigned xb_ld(unsigned* p)              { return __hip_atomic_load(p, __ATOMIC_RELAXED, __HIP_MEMORY_SCOPE_AGENT); }
__device__ __forceinline__ unsigned xb_add(unsigned* p, unsigned v) { return __hip_atomic_fetch_add(p, v, __ATOMIC_RELAXED, __HIP_MEMORY_SCOPE_AGENT); }
__device__ __forceinline__ unsigned xb_xcc_id() { return (unsigned)__builtin_amdgcn_s_getreg((3 << 11) | 20) & 0xFu; }
#define XB_SPIN(cond, bar) do { unsigned _sp = 0; while (cond) { __builtin_amdgcn_s_sleep(1); \
    if ((++_sp & 255u) == 0u) { if (xb_ld(&(bar)[XB_TMO])) break; if (_sp > XB_SPIN_CAP) { atomicAdd(&(bar)[XB_TMO], 1u); break; } } } } while (0)

struct XcdBarrier {
    unsigned* bar; unsigned x;
    volatile LAS unsigned* st;
};

__device__ __forceinline__ XcdBarrier xcd_barrier_post(unsigned* bar, volatile LAS unsigned* st) {
    XcdBarrier b; b.bar = bar; b.x = xb_xcc_id(); b.st = st;
    if (threadIdx.x == 0) (void)xb_add(&bar[XB_XCNT(b.x)], 1u);
    return b;
}
__device__ __forceinline__ void xcd_barrier_complete(unsigned* bar, unsigned x, unsigned& nloc, unsigned& nx) {
    const unsigned G = gridDim.x * gridDim.y * gridDim.z;
    unsigned sum, cnt, mine, sp = 0u;
    for (;;) {
        sum = 0u; cnt = 0u; mine = 0u;
#pragma unroll
        for (unsigned j = 0; j < 16; ++j) { const unsigned c = xb_ld(&bar[XB_XCNT(j)]); sum += c; cnt += (c > 0u) ? 1u : 0u; mine = (j == x) ? c : mine; }
        if (sum == G) break;
        __builtin_amdgcn_s_sleep(1);
        if ((++sp & 255u) == 0u) { if (xb_ld(&bar[XB_TMO])) break; if (sp > XB_SPIN_CAP) { atomicAdd(&bar[XB_TMO], 1u); break; } }
    }
    nloc = mine > 0u ? mine : 1u; nx = cnt > 0u ? cnt : 1u;
}

__device__ __forceinline__ void xcd_barrier(const XcdBarrier& b) {
    asm volatile("s_waitcnt vmcnt(0)" ::: "memory");
    __syncthreads();
    if (threadIdx.x == 0) {
        unsigned* bar = b.bar;
        __builtin_amdgcn_s_waitcnt(0);
        unsigned nloc = b.st[0], nx = b.st[1];
        if (nloc == 0u) { xcd_barrier_complete(bar, b.x, nloc, nx); b.st[0] = nloc; b.st[1] = nx; }
        const unsigned old = xb_add(&bar[XB_XSUB(b.x)], 1u);
        const unsigned gen = old / nloc;
        if (old + 1u == (gen + 1u) * nloc) {
            __builtin_amdgcn_fence(__ATOMIC_RELEASE, "agent");
            asm volatile("s_waitcnt vmcnt(0)" ::: "memory");
            const unsigned og = xb_add(&bar[XB_TOP], 1u);
            const unsigned tg = og / nx;
            if (og + 1u == (tg + 1u) * nx) xb_add(&bar[XB_TOPGEN], 1u);
            else XB_SPIN(xb_ld(&bar[XB_TOPGEN]) == tg, bar);
            __builtin_amdgcn_fence(__ATOMIC_ACQUIRE, "agent");
            xb_add(&bar[XB_XGEN(b.x)], 1u);
            asm volatile("s_waitcnt vmcnt(0)" ::: "memory");
        } else {
            XB_SPIN(xb_ld(&bar[XB_XGEN(b.x)]) == gen, bar);
            __builtin_amdgcn_fence(__ATOMIC_ACQUIRE, "agent");
            asm volatile("s_waitcnt vmcnt(0)" ::: "memory");
        }
    }
    __syncthreads();
}

enum { PT_PREP = 0, PT_NORM1, PT_GEMM_IN, PT_MIX_A, PT_MIX_B, PT_MIXPREP, PT_GEMM_OUT, PT_NORM2, PT_MLP1, PT_MLP2, PT_FINAL };

__global__ void __launch_bounds__(512, 2) mega_fwd(Params Pk) {
    extern __shared__ __attribute__((aligned(16))) unsigned char smem[];
    LAS unsigned char* lds = (LAS unsigned char*)smem;
#ifdef DBG_ZLDS
    for (int i = otid(); i < LDS_BYTES / 16; i += 512) ((LAS u32x4*)lds)[i] = (u32x4){0u, 0u, 0u, 0u};
    __syncthreads();
#endif
    { volatile LAS unsigned* st0 = (volatile LAS unsigned*)(lds + LDS_BYTES - 64); if (otid() < 2) st0[otid()] = 0u; }
    __syncthreads();
    XcdBarrier gbar; gbar.bar = (unsigned*)(Pk.ws + OFF_BAR); gbar.x = 0; gbar.st = (volatile LAS unsigned*)(lds + LDS_BYTES - 64);
    if (Pk.ph_hi - Pk.ph_lo > 1) gbar = xcd_barrier_post((unsigned*)(Pk.ws + OFF_BAR), (volatile LAS unsigned*)(lds + LDS_BYTES - 64));
    if (Pk.ph_hi < 0) cg::this_grid().sync();
    for (int ph = Pk.ph_lo; ph < Pk.ph_hi; ++ph) {
        PP P = (PP)__builtin_amdgcn_kernarg_segment_ptr();
        asm volatile("" : "+s"(P));
        int pt, l = 0;
        if (ph == 0) pt = PT_PREP;
        else if (ph == NPH - 1) pt = PT_FINAL;
        else {
            const int qq = ph - 1; int s;
            if (qq < 9) { l = 0; s = qq; } else if (qq < 17) { l = 1; s = qq - 9; } else if (qq < 26) { l = 2; s = qq - 17; } else { l = 3; s = qq - 26; }
            pt = (l & 1) ? (s < 4 ? s + 1 : s + 2) : s + 1;
        }
        const int j = l >> 1, odd = l & 1;
        const int nrep = (pt == REP_PT) ? 1 + REP_N : 1;
        for (int rep = 0; rep < nrep; ++rep) {
        int ngemm = 0; GemmCfg g; g.G = gridDim.x; g.c = obid(); g.j = j; g.l = l; g.nM = 48; g.ld = 1024; g.nt = 16; g.type = 0; g.nN = 0;
        switch (pt) {
        case PT_PREP: if (EN & 1) prep_phase(P, lds); break;
        case PT_NORM1: if (EN & 2) norm_phase(P, l, 0); break;
        case PT_GEMM_IN: ngemm = 1; g.type = odd ? T_IN_ODD : T_IN_EVEN; g.nN = 10; break;
        case PT_MIX_A: if (odd) { ngemm = 2; g.type = T_DFT_S; g.nM = 8; g.nN = 32; g.ld = 4096; g.nt = 16; } else { if (EN & 4) gla_phase(P, lds, j, 0); if (EN & 8) pool_phase(P); } break;
        case PT_MIX_B: if (odd) { if (EN & 8) convert_phase(P); } else { if (EN & 4) gla_phase(P, lds, j, 1); } break;
        case PT_MIXPREP: if (EN & 8) mixprep_phase(P, j); break;
        case PT_GEMM_OUT: ngemm = 1; g.type = odd ? T_OUT_ODD : T_OUT_EVEN; g.nN = 4; break;
        case PT_NORM2: if (EN & 2) norm_phase(P, l, 1); break;
        case PT_MLP1: ngemm = 1; g.type = T_MLP1; g.nN = 16; break;
        case PT_MLP2: ngemm = 1; g.type = T_MLP2; g.nN = 4; g.ld = 4096; g.nt = 64; break;
        default: if (EN & 2) norm_phase(P, 0, 2); break;
        }
        for (int gi = 0; gi < ngemm; ++gi) {
            if (gi == 1) { g.type = T_DFT_P; g.nM = 1; g.nN = 32; g.ld = 512; g.nt = 8; g.c = (obid() + gridDim.x - 32) % gridDim.x; }
            if (EN & 16) gemm_phase(lds, g);
        }
        if (pt == PT_MIX_A && odd && (EN & 8)) conv_phase(P, j);
        if (ph + 1 < Pk.ph_hi || rep + 1 < nrep) xcd_barrier(gbar);
        }

    }
}


#ifdef DBG_K
__device__ __forceinline__ float dgst(unsigned u) { return (float)(u & 0xffffu) + (float)(u >> 16); }
__global__ void dbg_dump(float* out, const unsigned char* ws) {
    const unsigned* Xu = (const unsigned*)(ws + OFF_X); const unsigned* Hu = (const unsigned*)(ws + OFF_H); const unsigned* Au = (const unsigned*)(ws + OFF_AMIX);
    const unsigned* Bu = (const unsigned*)(ws + OFF_BIG); const unsigned* Uu = (const unsigned*)(ws + OFF_U); const unsigned* Wu = (const unsigned*)(ws);
    for (size_t i = (size_t)blockIdx.x * blockDim.x + threadIdx.x; i < (size_t)NTOK * 1024; i += (size_t)gridDim.x * blockDim.x) {
        float v = 0.f;
        if (DBG_SEL & 1) v += dgst(Xu[i]);
        if (DBG_SEL & 2) v += dgst(Hu[i % 6291456]);
        if (DBG_SEL & 4) v += dgst(Au[i % 6291456]);
        if (DBG_SEL & 8) v += dgst(Bu[i]) + dgst(Bu[i + 12582912]) + dgst(Bu[(i + 25165824) % 34603008]);
        if (DBG_SEL & 16) v += dgst(Uu[i % 2113536]);
        if (DBG_SEL & 32) v += dgst(Wu[i]) + dgst(Wu[i + 12582912]) + dgst(Wu[(i + 25165824) % 28573696]);
        out[i] = v;
    }
}
#endif
extern "C" void kernel_launch(void* const* d_in, const int* in_sizes, int n_in, void* d_out, int out_size, void* d_ws, size_t ws_size, hipStream_t stream) {
    static int grid = 0;
    if (grid == 0) {
        if (n_in != 22 || ws_size < WS_NEED) { fprintf(stderr, "kernel_launch: unexpected n_in %d / ws_size %zu (need %zu)\n", n_in, ws_size, (size_t)WS_NEED); grid = -1; return; }
        int dev = 0, cus = 0, per_cu = 0;
        hipGetDevice(&dev);
        hipDeviceGetAttribute(&cus, hipDeviceAttributeMultiprocessorCount, dev);
        if (hipFuncSetAttribute((const void*)mega_fwd, hipFuncAttributeMaxDynamicSharedMemorySize, LDS_BYTES) != hipSuccess) { fprintf(stderr, "kernel_launch: hipFuncSetAttribute failed\n"); grid = -1; return; }
        hipOccupancyMaxActiveBlocksPerMultiprocessor(&per_cu, (const void*)mega_fwd, 512, LDS_BYTES);
        if (per_cu < 1) { fprintf(stderr, "kernel_launch: occupancy query says %d blocks/CU\n", per_cu); per_cu = 1; }
        (void)hipGetLastError();
        grid = cus;
    }
    if (grid < 0) return;
    Params p{};
    for (int i = 0; i < 22; ++i) p.in[i] = (const float*)d_in[i];
    p.out = (float*)d_out; p.ws = (unsigned char*)d_ws;
#if MULTI_LAUNCH
#ifdef DBG_K
    for (int ph = 0; ph < DBG_K; ++ph) {
        p.ph_lo = ph; p.ph_hi = ph + 1;
        hipLaunchKernelGGL(mega_fwd, dim3(grid), dim3(512), LDS_BYTES, stream, p);
    }
    hipLaunchKernelGGL(dbg_dump, dim3(2048), dim3(256), 0, stream, (float*)d_out, (const unsigned char*)d_ws);
#else
    for (int ph = 0; ph < NPH; ++ph) {
        p.ph_lo = ph; p.ph_hi = ph + 1;
        hipLaunchKernelGGL(mega_fwd, dim3(grid), dim3(512), LDS_BYTES, stream, p);
    }
#endif
#else
    p.ph_lo = 0; p.ph_hi = NPH;
    if (hipMemsetAsync((char*)d_ws + OFF_BAR, 0, 16384, stream) != hipSuccess) { fprintf(stderr, "kernel_launch: memset of barrier word failed\n"); return; }
    void* args[] = {&p};
    hipError_t e = hipLaunchCooperativeKernel((const void*)mega_fwd, dim3(grid), dim3(512), args, LDS_BYTES, stream);
    if (e != hipSuccess) fprintf(stderr, "cooperative launch failed: %s (grid %d)\n", hipGetErrorString(e), grid);
#endif
}
```

```cpp
#include <hip/hip_runtime.h>
#include <hip/hip_cooperative_groups.h>
#include <cstdio>
#include <cstdint>
namespace cg = cooperative_groups;

#ifndef DBG_SEL
#define DBG_SEL 63
#endif
#ifndef DBG_NP
#define DBG_NP(x) (x)
#endif
#ifndef REP_PT
#define REP_PT -1
#endif
#ifndef REP_N
#define REP_N 1
#endif
#ifndef XSYNC
#define XSYNC 0
#endif
#ifndef DBG_SINIT
#define DBG_SINIT 1
#endif
#ifndef EN
#define EN 31
#endif
#ifndef MULTI_LAUNCH
#define MULTI_LAUNCH 0
#endif

#define LAS __attribute__((address_space(3)))
typedef unsigned short bf16_t;
typedef short bf16x8 __attribute__((ext_vector_type(8)));
typedef float f32x4 __attribute__((ext_vector_type(4)));
typedef unsigned u32x2 __attribute__((ext_vector_type(2)));
typedef unsigned u32x4 __attribute__((ext_vector_type(4)));

constexpr int DM = 1024, NTOK = 12288, NPROMPT = 4096, DFF = 4096;
constexpr int LDS_BYTES = 147456;
constexpr int NPH = 36;
constexpr size_t MBy = 1048576;
constexpr size_t OFF_W1T = 0, OFF_W2T = 32 * MBy, OFF_WIE = 64 * MBy, OFF_WOE = 74 * MBy, OFF_WIO = 78 * MBy, OFF_WOO = 88 * MBy;
constexpr size_t OFF_T2K = 92 * MBy, OFF_T256 = 108 * MBy, OFF_MOD = 108 * MBy + 262144, OFF_U = 109 * MBy, OFF_DTOT = 117 * MBy;
constexpr size_t OFF_X = 118 * MBy, OFF_H = 166 * MBy, OFF_AMIX = 190 * MBy, OFF_BIG = 214 * MBy, WS_NEED = 348 * MBy;
constexpr size_t OFF_HID = OFF_BIG;
constexpr size_t OFF_QB = OFF_BIG, OFF_KB = OFF_BIG + 6 * MBy, OFF_VT = OFF_BIG + 12 * MBy, OFF_GATE = OFF_BIG + 24 * MBy, OFF_LOGF = OFF_BIG + 36 * MBy;
constexpr size_t OFF_UB = OFF_BIG + 60 * MBy, OFF_ODIR = OFF_BIG + 72 * MBy;
constexpr size_t OFF_XTS = OFF_BIG, OFF_XTP = OFF_BIG + 16 * MBy, OFF_XIN = OFF_BIG + 24 * MBy, OFF_BG = OFF_BIG + 36 * MBy, OFF_CG = OFF_BIG + 48 * MBy;
constexpr size_t OFF_FACCP = OFF_BIG + 60 * MBy, OFF_FACCS = OFF_BIG + 68 * MBy;
constexpr size_t OFF_BAR = 117 * MBy + 524288;
constexpr size_t OUT_STATE = (size_t)NTOK * DM;

struct Params { const float* in[22]; float* out; unsigned char* ws; int ph_lo, ph_hi; };
typedef const __attribute__((address_space(4))) Params* PP;
enum { I_XP = 0, I_XS, I_STATE, I_C, I_CCTX, I_NORMG, I_FINALG, I_WADA, I_BADA, I_W1, I_W2, I_WINE, I_WA2, I_BA2, I_GLAG, I_POOLW, I_POOLS, I_WOUTE, I_WINO, I_CONVW, I_CONVB, I_WOUTO };

__device__ __forceinline__ int otid() { int t = __builtin_amdgcn_workitem_id_x(); asm volatile("" : "+v"(t)); return t; }
__device__ __forceinline__ int obid() { int b = __builtin_amdgcn_workgroup_id_x(); asm volatile("" : "+s"(b)); return b; }
typedef float f32x2 __attribute__((ext_vector_type(2)));
typedef __bf16 bf16x2v __attribute__((ext_vector_type(2)));
__device__ __forceinline__ unsigned pk2(float lo, float hi) { f32x2 v = {lo, hi}; bf16x2v b = __builtin_convertvector(v, bf16x2v); return __builtin_bit_cast(unsigned, b); }
__device__ __forceinline__ bf16_t f2bf(float x) { return (bf16_t)(pk2(x, 0.f) & 0xffffu); }
__device__ __forceinline__ float bf2f(bf16_t u) { return __uint_as_float(((unsigned)u) << 16); }
__device__ __forceinline__ float bflo(unsigned u) { return __uint_as_float(u << 16); }
__device__ __forceinline__ float bfhi(unsigned u) { return __uint_as_float(u & 0xffff0000u); }
__device__ __forceinline__ float wave_sum(float v) {
#pragma unroll
    for (int o = 1; o < 64; o <<= 1) v += __shfl_xor(v, o);
    return v;
}
__device__ __forceinline__ float siluf(float x) { return x * __builtin_amdgcn_rcpf(1.f + __expf(-x)); }
__device__ __forceinline__ float logsigmoidf(float x) { return fminf(x, 0.f) - __logf(1.f + __expf(-fabsf(x))); }
__device__ __forceinline__ int cond_of_seg(int pm) { return pm < 16 ? 0 : 1 + ((pm - 16) >> 3); }

namespace pg8 {
constexpr int BM = 256, BK = 64, HALF = 128, HTB = HALF * BK * 2, STAGE_BYTES = 8 * HTB, NXCD = 8, WGM = 8;
__host__ __device__ __forceinline__ int lds_byte(int r, int c) { const int st = (r >> 4) * 2 + (c >> 5), rr = r & 15, cc = c & 31, ob = rr * 64 + cc * 2; return st * 1024 + (ob ^ (((ob >> 9) & 1) << 5)); }
__host__ __device__ __forceinline__ int perm32(int rho) { const int n = rho >> 4, i = rho & 15; return 8 * (i >> 2) + 4 * n + (i & 3); }
__host__ __device__ __forceinline__ void stage_rc(int b, int& R, int& C) { const int st = b / 1024, sb = b % 1024, swz = sb ^ (((sb >> 9) & 1) << 5); R = (st >> 1) * 16 + swz / 64; C = (st & 1) * 32 + (swz % 64) / 2; }
}

enum { KD_BF16 = 0, KD_SILU, KD_RELU2, KD_LOGF, KD_RES, KD_ATOM };
enum { T_IN_EVEN = 0, T_IN_ODD, T_OUT_EVEN, T_OUT_ODD, T_MLP1, T_MLP2, T_DFT_S, T_DFT_P };
struct Unit { int pm, pn; };
struct UnitIO { const char* A; const char* B; char* out; const float* aux; int kind; int ld; };
struct GemmCfg { int type, j, l, nM, nN, ld, nt, G, c; };

__device__ __forceinline__ void make_unit(const GemmCfg& g, int pm, int pn, UnitIO& u) {
    PP Pq = (PP)__builtin_amdgcn_kernarg_segment_ptr();
    unsigned char* ws = Pq->ws;
    const size_t rowA = (size_t)pm * 256 * 1024 * 2;
    u.aux = nullptr; u.kind = KD_BF16; u.ld = 512;
    const float* modp = (const float*)(ws + OFF_MOD) + (size_t)(g.l * 5 + cond_of_seg(pm)) * 6144;
    switch (g.type) {
    case T_IN_EVEN: {
        const char* W = (const char*)(ws + OFF_WIE) + (size_t)g.j * 2560 * 1024 * 2 + (size_t)pn * 256 * 1024 * 2;
        const char* Hh = (const char*)(ws + OFF_H) + rowA;
        u.A = Hh; u.B = W;
        if (pn == 0) { u.out = (char*)(ws + OFF_QB) + (size_t)pm * 256 * 256 * 2; u.ld = 256; }
        else if (pn == 1) { u.out = (char*)(ws + OFF_KB) + (size_t)pm * 256 * 256 * 2; u.ld = 256; }
        else if (pn < 4) { u.A = W; u.B = Hh; u.out = (char*)(ws + OFF_VT) + ((size_t)(pn - 2) * 256 * NTOK + (size_t)pm * 256) * 2; u.ld = NTOK; }
        else if (pn < 6) { u.out = (char*)(ws + OFF_GATE) + ((size_t)pm * 256 * 512 + (pn - 4) * 256) * 2; u.kind = KD_SILU; }
        else if (pn < 8) { u.out = (char*)(ws + OFF_LOGF) + ((size_t)pm * 256 * 512 + (pn - 6) * 256) * 4; u.kind = KD_LOGF; u.aux = Pq->in[I_BA2] + g.j * 512 + (pn - 6) * 256; }
        else { u.out = (char*)(ws + OFF_UB) + ((size_t)pm * 256 * 512 + (pn - 8) * 256) * 2; }
    } break;
    case T_IN_ODD: {
        const char* W = (const char*)(ws + OFF_WIO) + (size_t)g.j * 2560 * 1024 * 2 + (size_t)pn * 256 * 1024 * 2;
        const char* Hh = (const char*)(ws + OFF_H) + rowA;
        u.A = Hh; u.B = W;
        if (pn < 4) {
            u.A = W; u.B = Hh;
            const int z = pn >> 1, ch0 = (pn & 1) * 256;
            if (pm < 16) { u.out = (char*)(ws + OFF_XTP) + ((size_t)(pm * 512 + ch0) * 512 + z * 256) * 2; u.ld = 512; }
            else { const int b = (pm - 16) >> 3, part = (pm - 16) & 7; u.out = (char*)(ws + OFF_XTS) + ((size_t)(b * 512 + ch0) * 4096 + z * 2048 + part * 256) * 2; u.ld = 4096; }
        } else {
            const size_t base = (pn < 6) ? OFF_XIN : (pn < 8 ? OFF_BG : OFF_CG);
            u.out = (char*)(ws + base) + ((size_t)pm * 256 * 512 + (pn & 1) * 256) * 2;
        }
    } break;
    case T_OUT_EVEN: case T_OUT_ODD: {
        u.A = (const char*)(ws + OFF_AMIX) + rowA;
        u.B = (const char*)(ws + (g.type == T_OUT_EVEN ? OFF_WOE : OFF_WOO)) + (size_t)g.j * 1024 * 1024 * 2 + (size_t)pn * 256 * 1024 * 2;
        u.out = (char*)(ws + OFF_X) + ((size_t)pm * 256 * 1024 + pn * 256) * 4; u.ld = 1024; u.kind = KD_RES; u.aux = modp + 2048 + pn * 256;
    } break;
    case T_MLP1: {
        u.A = (const char*)(ws + OFF_H) + rowA;
        u.B = (const char*)(ws + OFF_W1T) + (size_t)g.l * 4096 * 1024 * 2 + (size_t)pn * 256 * 1024 * 2;
        u.out = (char*)(ws + OFF_HID) + ((size_t)pm * 256 * 4096 + pn * 256) * 2; u.ld = 4096; u.kind = KD_RELU2;
    } break;
    case T_MLP2: {
        u.A = (const char*)(ws + OFF_HID) + (size_t)pm * 256 * 4096 * 2;
        u.B = (const char*)(ws + OFF_W2T) + (size_t)g.l * 4096 * 1024 * 2 + (size_t)pn * 256 * 4096 * 2;
        u.out = (char*)(ws + OFF_X) + ((size_t)pm * 256 * 1024 + pn * 256) * 4; u.ld = 1024; u.kind = KD_RES; u.aux = modp + 5120 + pn * 256;
    } break;
    case T_DFT_S: {
        const int pnb = pn >> 2, ks = pn & 3;
        u.A = (const char*)(ws + OFF_T2K) + ((size_t)pm * 256 * 4096 + ks * 1024) * 2;
        u.B = (const char*)(ws + OFF_XTS) + ((size_t)pnb * 256 * 4096 + ks * 1024) * 2;
        u.out = (char*)(ws + OFF_FACCS) + ((size_t)ks * 8192 * 512 + (size_t)((pnb >> 1) * 2048 + pm * 256) * 512 + (pnb & 1) * 256) * 4; u.kind = KD_ATOM;
    } break;
    default: {
        u.A = (const char*)(ws + OFF_T256);
        u.B = (const char*)(ws + OFF_XTP) + (size_t)pn * 256 * 512 * 2;
        u.out = (char*)(ws + OFF_FACCP) + ((size_t)((pn >> 1) * 256) * 512 + (pn & 1) * 256) * 4; u.kind = KD_ATOM;
    } break;
    }
}

__device__ __forceinline__ bool next_unit(const GemmCfg& g, int i, Unit& u) {
    const int nwg = g.nM * g.nN;
    const long L = (long)i * g.G + g.c; if (L >= nwg) return false;
    int wgid = (int)L; { const int q = nwg / pg8::NXCD, r = nwg % pg8::NXCD, xcd = wgid % pg8::NXCD, off = wgid / pg8::NXCD; wgid = (xcd < r ? xcd * (q + 1) : r * (q + 1) + (xcd - r) * q) + off; }
    const int nig = pg8::WGM * g.nN, gid = wgid / nig, fm = gid * pg8::WGM, gsz = (g.nM - fm) < pg8::WGM ? (g.nM - fm) : pg8::WGM;
    const int pm = fm + ((wgid % nig) % gsz), pn = (wgid % nig) / gsz;
    u.pm = pm; u.pn = pn; return true;
}

__device__ __forceinline__ void epilogue(const f32x4 (&acc)[2][2][4][2], const GemmCfg& g, const Unit& uu, int wr, int wc, int fr, int fq) {
    UnitIO u; make_unit(g, uu.pm, uu.pn, u);
    const int row0 = wr * 64 + fr, col0 = wc * 32 + 8 * fq;
    const int kind = u.kind, ld = u.ld;
    if (kind <= KD_RELU2) {
        bf16_t* O = (bf16_t*)u.out;
#pragma unroll
        for (int ai = 0; ai < 2; ++ai)
#pragma unroll
            for (int m = 0; m < 4; ++m) {
                bf16_t* rowp = O + (size_t)(row0 + ai * 128 + m * 16) * ld + col0;
#pragma unroll
                for (int bj = 0; bj < 2; ++bj) {
                    f32x4 v0 = acc[ai][bj][m][0], v1 = acc[ai][bj][m][1];
                    if (kind == KD_SILU) { v0[0] = siluf(v0[0]); v0[1] = siluf(v0[1]); v0[2] = siluf(v0[2]); v0[3] = siluf(v0[3]); v1[0] = siluf(v1[0]); v1[1] = siluf(v1[1]); v1[2] = siluf(v1[2]); v1[3] = siluf(v1[3]); }
                    else if (kind == KD_RELU2) {
                        v0[0] = fmaxf(v0[0], 0.f); v0[1] = fmaxf(v0[1], 0.f); v0[2] = fmaxf(v0[2], 0.f); v0[3] = fmaxf(v0[3], 0.f); v0 = v0 * v0;
                        v1[0] = fmaxf(v1[0], 0.f); v1[1] = fmaxf(v1[1], 0.f); v1[2] = fmaxf(v1[2], 0.f); v1[3] = fmaxf(v1[3], 0.f); v1 = v1 * v1; }
                    u32x4 o; o.x = pk2(v0[0], v0[1]); o.y = pk2(v0[2], v0[3]); o.z = pk2(v1[0], v1[1]); o.w = pk2(v1[2], v1[3]);
                    *(u32x4*)(rowp + bj * 128) = o;
                }
            }
    } else if (kind == KD_RES) {
        float* O = (float*)u.out;
        f32x4 gv[2][2];
#pragma unroll
        for (int bj = 0; bj < 2; ++bj)
#pragma unroll
            for (int n = 0; n < 2; ++n) gv[bj][n] = *(const f32x4*)(u.aux + col0 + bj * 128 + n * 4);
#pragma unroll
        for (int ai = 0; ai < 2; ++ai)
#pragma unroll
            for (int m = 0; m < 4; ++m) {
                float* rowp = O + (size_t)(row0 + ai * 128 + m * 16) * ld + col0;
#pragma unroll
                for (int bj = 0; bj < 2; ++bj)
#pragma unroll
                    for (int n = 0; n < 2; ++n) { f32x4* p = (f32x4*)(rowp + bj * 128 + n * 4); *p = *p + gv[bj][n] * acc[ai][bj][m][n]; }
            }
    } else if (kind == KD_LOGF) {
        float* O = (float*)u.out;
#pragma unroll
        for (int bj = 0; bj < 2; ++bj)
#pragma unroll
            for (int n = 0; n < 2; ++n) {
                const f32x4 bv = *(const f32x4*)(u.aux + col0 + bj * 128 + n * 4);
#pragma unroll
                for (int ai = 0; ai < 2; ++ai)
#pragma unroll
                    for (int m = 0; m < 4; ++m) {
                        f32x4 v = acc[ai][bj][m][n] + bv;
                        v[0] = logsigmoidf(v[0]) * 0.0625f; v[1] = logsigmoidf(v[1]) * 0.0625f; v[2] = logsigmoidf(v[2]) * 0.0625f; v[3] = logsigmoidf(v[3]) * 0.0625f;
                        *(f32x4*)(O + (size_t)(row0 + ai * 128 + m * 16) * ld + col0 + bj * 128 + n * 4) = v;
                    }
            }
    } else {
        float* O = (float*)u.out;
#pragma unroll
        for (int ai = 0; ai < 2; ++ai)
#pragma unroll
            for (int m = 0; m < 4; ++m) {
                float* rowp = O + (size_t)(row0 + ai * 128 + m * 16) * ld + col0;
#pragma unroll
                for (int bj = 0; bj < 2; ++bj)
#pragma unroll
                    for (int n = 0; n < 2; ++n) {
                        *(f32x4*)(rowp + bj * 128 + n * 4) = acc[ai][bj][m][n];
                    }
            }
    }
}

__device__ __forceinline__ void gemm_phase(LAS unsigned char* lds, const GemmCfg& g) {
    using namespace pg8;
    const int tid = otid(), wid = __builtin_amdgcn_readfirstlane(tid >> 6), lane = tid & 63, wr = wid >> 2, wc = wid & 3, fr = lane & 15, fq = lane >> 4;
    const int nt = g.nt;
    unsigned voffA[2], voffB[2];
#pragma unroll
    for (int i = 0; i < 2; ++i) { int R, C; stage_rc(tid * 16 + i * 8192, R, C); const int Rb = (R & ~31) + perm32(R & 31); voffA[i] = (unsigned)(R * g.ld + C) * 2u; voffB[i] = (unsigned)(Rb * g.ld + C) * 2u; }
    const size_t kstep = (size_t)(BK * 2);
    const size_t hstepA = (size_t)HALF * g.ld * 2;
#define hstepB hstepA
    const unsigned ldsw = (unsigned)wid * 1024u;
    const int aoff = lds_byte(wr * 64 + fr, fq * 8), boff = lds_byte(wc * 32 + fr, fq * 8);
#define PG8_SA(b, h) (((b) * 2 + (h)) * HTB)
#define PG8_SB(b, h) ((4 + (b) * 2 + (h)) * HTB)
#define PG8_STAGE(bufoff, gbase, voff) do { _Pragma("unroll") for (int _i = 0; _i < 2; ++_i) \
        __builtin_amdgcn_global_load_lds((const unsigned*)((const char*)(gbase) + (voff)[_i]), (LAS unsigned*)(lds + (bufoff) + ldsw + _i * 8192), 16, 0, 0); } while (0)
#define PG8_LDA(dst, b, h) do { _Pragma("unroll") for (int m = 0; m < 4; ++m) _Pragma("unroll") for (int k = 0; k < 2; ++k) dst[m][k] = *(const LAS bf16x8*)(lds + PG8_SA(b, h) + aoff + m * 2048 + k * 1024); } while (0)
#define PG8_LDB(dst, b, h) do { _Pragma("unroll") for (int n = 0; n < 2; ++n) _Pragma("unroll") for (int k = 0; k < 2; ++k) dst[n][k] = *(const LAS bf16x8*)(lds + PG8_SB(b, h) + boff + n * 2048 + k * 1024); } while (0)
#define PG8_MMA(ai, bj, At, Bt) do { __builtin_amdgcn_s_setprio(1); _Pragma("unroll") for (int m = 0; m < 4; ++m) _Pragma("unroll") for (int n = 0; n < 2; ++n) _Pragma("unroll") for (int k = 0; k < 2; ++k) \
        acc[ai][bj][m][n] = __builtin_amdgcn_mfma_f32_16x16x32_bf16(Bt[n][k], At[m][k], acc[ai][bj][m][n], 0, 0, 0); __builtin_amdgcn_s_setprio(0); } while (0)
#define PG8_WAIT_V(n) asm volatile("s_waitcnt vmcnt(" #n ")" ::: "memory")
#define PG8_WAIT_L(n) asm volatile("s_waitcnt lgkmcnt(" #n ")" ::: "memory")
#define PG8_BAR __builtin_amdgcn_s_barrier()
#define PG8_SCHED __builtin_amdgcn_sched_barrier(0)
    Unit cur, nxt; int ui = 0;
    if (!next_unit(g, 0, cur)) return;
    f32x4 acc[2][2][4][2];
#pragma unroll
    for (int a = 0; a < 2; ++a)
#pragma unroll
        for (int b = 0; b < 2; ++b)
#pragma unroll
            for (int m = 0; m < 4; ++m)
#pragma unroll
                for (int n = 0; n < 2; ++n) acc[a][b][m][n] = (f32x4){0.f, 0.f, 0.f, 0.f};
    bf16x8 At[4][2], B0[2][2], B1[2][2];
    const char* cA; const char* cB; { UnitIO io; make_unit(g, cur.pm, cur.pn, io); cA = io.A; cB = io.B; }
    PG8_STAGE(PG8_SB(0, 0), cB, voffB); PG8_STAGE(PG8_SA(0, 0), cA, voffA); PG8_STAGE(PG8_SB(0, 1), cB + hstepB, voffB); PG8_STAGE(PG8_SA(0, 1), cA + hstepA, voffA);
    if (wr == 1) PG8_BAR;
    PG8_WAIT_V(4); PG8_BAR;
    PG8_STAGE(PG8_SB(1, 0), cB + kstep, voffB); PG8_STAGE(PG8_SA(1, 0), cA + kstep, voffA); PG8_STAGE(PG8_SB(1, 1), cB + hstepB + kstep, voffB);
    PG8_WAIT_V(6); PG8_BAR;
    for (;;) {
        const bool has_next = next_unit(g, ui + 1, nxt);
        const char* nA = cA; const char* nB = cB; if (has_next) { UnitIO io; make_unit(g, nxt.pm, nxt.pn, io); nA = io.A; nB = io.B; }
        for (int t = 0; t < nt; t += 2) {
            const bool last = (t == nt - 2);
            const char* a1 = cA + (size_t)(t + 1) * kstep;
            const char* a2 = last ? nA : cA + (size_t)(t + 2) * kstep; const char* b2 = last ? nB : cB + (size_t)(t + 2) * kstep;
            const char* a3 = a2 + kstep; const char* b3 = b2 + kstep;
            PG8_LDB(B0, 0, 0); PG8_SCHED; PG8_LDA(At, 0, 0); PG8_STAGE(PG8_SA(1, 1), a1 + hstepA, voffA);
            PG8_WAIT_L(8); PG8_BAR; PG8_WAIT_L(0); PG8_MMA(0, 0, At, B0); PG8_BAR; PG8_SCHED;
            PG8_LDB(B1, 0, 1); PG8_STAGE(PG8_SB(0, 0), b2, voffB);
            PG8_BAR; PG8_WAIT_L(0); PG8_MMA(0, 1, At, B1); PG8_BAR;
            PG8_LDA(At, 0, 1); PG8_STAGE(PG8_SA(0, 0), a2, voffA);
            PG8_BAR; PG8_WAIT_L(0); PG8_MMA(1, 0, At, B0); PG8_BAR; PG8_SCHED;
            PG8_STAGE(PG8_SB(0, 1), b2 + hstepB, voffB);
            PG8_WAIT_V(6); PG8_BAR; PG8_MMA(1, 1, At, B1); PG8_BAR;
            PG8_LDB(B0, 1, 0); PG8_SCHED; PG8_LDA(At, 1, 0); PG8_STAGE(PG8_SA(0, 1), a2 + hstepA, voffA);
            PG8_WAIT_L(8); PG8_BAR; PG8_WAIT_L(0); PG8_MMA(0, 0, At, B0); PG8_BAR; PG8_SCHED;
            PG8_LDB(B1, 1, 1); PG8_STAGE(PG8_SB(1, 0), b3, voffB);
            PG8_BAR; PG8_WAIT_L(0); PG8_MMA(0, 1, At, B1); PG8_BAR;
            PG8_LDA(At, 1, 1); PG8_STAGE(PG8_SA(1, 0), a3, voffA);
            PG8_BAR; PG8_WAIT_L(0); PG8_MMA(1, 0, At, B0); PG8_BAR; PG8_SCHED;
            PG8_STAGE(PG8_SB(1, 1), b3 + hstepB, voffB);
            PG8_WAIT_V(6); PG8_BAR; PG8_MMA(1, 1, At, B1); PG8_BAR;
        }
        epilogue(acc, g, cur, wr, wc, fr, fq);
        if (!has_next) break;
#pragma unroll
        for (int a = 0; a < 2; ++a)
#pragma unroll
            for (int b = 0; b < 2; ++b)
#pragma unroll
                for (int m = 0; m < 4; ++m)
#pragma unroll
                    for (int n = 0; n < 2; ++n) acc[a][b][m][n] = (f32x4){0.f, 0.f, 0.f, 0.f};
        cur = nxt; cA = nA; cB = nB; ++ui;
    }
    PG8_WAIT_V(0);
    if (wr == 0) PG8_BAR;
    PG8_BAR;
#undef hstepB
#undef PG8_SA
#undef PG8_SB
#undef PG8_STAGE
#undef PG8_LDA
#undef PG8_LDB
#undef PG8_MMA
#undef PG8_WAIT_V
#undef PG8_WAIT_L
#undef PG8_BAR
#undef PG8_SCHED
}

__device__ __forceinline__ void transpose_item(const float* W, int ldn, int n0, int k0, bf16_t* WT, int drow0, int ldk, float scale, LAS float* scr, int lane) {
    float tv[32];
#pragma unroll
    for (int i = 0; i < 32; ++i) { const int kk = 2 * i + (lane >> 5); tv[i] = W[(size_t)(k0 + kk) * ldn + n0 + (lane & 31)]; }
#pragma unroll
    for (int i = 0; i < 32; ++i) { const int kk = 2 * i + (lane >> 5); scr[kk * 33 + (lane & 31)] = tv[i]; }
    asm volatile("s_waitcnt lgkmcnt(0)" ::: "memory");
    const int c = lane & 7;
#pragma unroll
    for (int jx = 0; jx < 4; ++jx) {
        const int n = (lane >> 3) + 8 * jx; const LAS float* s = scr + (8 * c) * 33 + n;
        u32x4 o; o.x = pk2(s[0] * scale, s[33] * scale); o.y = pk2(s[66] * scale, s[99] * scale); o.z = pk2(s[132] * scale, s[165] * scale); o.w = pk2(s[198] * scale, s[231] * scale);
        *(u32x4*)(WT + (size_t)(drow0 + n) * ldk + k0 + 8 * c) = o;
    }
    asm volatile("s_waitcnt lgkmcnt(0)" ::: "memory");
}

__device__ __forceinline__ void convert_layer(PP P, LAS unsigned char* lds, int l, int vb, int nb) {
    const int tid = otid(), lane = tid & 63, wave = tid >> 6;
    unsigned char* ws = P->ws;
    const int j = l >> 1, odd = l & 1;
    __syncthreads();
    {
        LAS float* scr = (LAS float*)(lds + wave * 8704);
        for (int it = vb * 8 + wave; it < 5376; it += nb * 8) {
            int r = it;
            if (r < 2048) { const int kb = r / 128, nbk = r % 128;
                transpose_item(P->in[I_W1] + (size_t)l * 1024 * 4096, 4096, nbk * 32, kb * 64, (bf16_t*)(ws + OFF_W1T) + (size_t)l * 4096 * 1024, nbk * 32, 1024, 1.f, scr, lane); continue; }
            r -= 2048;
            if (r < 2048) { const int kb = r / 32, nbk = r % 32;
                transpose_item(P->in[I_W2] + (size_t)l * 4096 * 1024, 1024, nbk * 32, kb * 64, (bf16_t*)(ws + OFF_W2T) + (size_t)l * 1024 * 4096, nbk * 32, 4096, 1.f, scr, lane); continue; }
            r -= 2048;
            if (!odd) {
                if (r < 1024) { const int kb = r / 64, nbk = r % 64; const int sb = nbk < 48 ? nbk : nbk + 1; const int n0 = sb * 32; const int drow = n0 < 1536 ? n0 : n0 + 480;
                    transpose_item(P->in[I_WINE] + (size_t)j * 1024 * 2080, 2080, n0, kb * 64, (bf16_t*)(ws + OFF_WIE) + (size_t)j * 2560 * 1024, drow, 1024, n0 < 256 ? 0.125f : 1.f, scr, lane); continue; }
                r -= 1024;
                { const int kb = r / 32, nbk = r % 32;
                    transpose_item(P->in[I_WOUTE] + (size_t)j * 1024 * 1024, 1024, nbk * 32, kb * 64, (bf16_t*)(ws + OFF_WOE) + (size_t)j * 1024 * 1024, nbk * 32, 1024, 1.f, scr, lane); }
            } else {
                if (r < 768) { const int kb = r / 48, nbk = r % 48; const int n0 = 512 + nbk * 32;
                    transpose_item(P->in[I_WINO] + (size_t)j * 1024 * 2048, 2048, n0, kb * 64, (bf16_t*)(ws + OFF_WIO) + (size_t)j * 2560 * 1024, n0 + 512, 1024, 1.f, scr, lane); continue; }
                r -= 768;
                { const int kb = r / 32, nbk = r % 32;
                    transpose_item(P->in[I_WOUTO] + (size_t)j * 1024 * 1024, 1024, nbk * 32, kb * 64, (bf16_t*)(ws + OFF_WOO) + (size_t)j * 1024 * 1024, nbk * 32, 1024, 1.f, scr, lane); }
            }
        }
    }
    __syncthreads();
    if (odd) {
    {
        LAS float* wt = (LAS float*)lds;
        LAS float* tab = (LAS float*)(lds + 64 * 129 * 4);
        for (int it = vb; it < 64; it += nb) {
            const int g = (it >> 4) & 3, kb = it & 15;
            for (int idx = tid; idx < 64 * 128; idx += 512) { const int kk = idx >> 7, c = idx & 127; wt[kk * 129 + c] = P->in[I_WINO][((size_t)j * 1024 + kb * 64 + kk) * 2048 + g * 128 + c]; }
            if (tid < 128) { tab[tid] = __builtin_amdgcn_cosf((float)tid * (1.f / 128.f)); tab[128 + tid] = __builtin_amdgcn_sinf((float)tid * (1.f / 128.f)); }
            __syncthreads();
            const int li = lane & 15, lq = lane >> 4;
            f32x4 acc[2][4];
#pragma unroll
            for (int ti = 0; ti < 2; ++ti)
#pragma unroll
                for (int u = 0; u < 4; ++u) acc[ti][u] = (f32x4){0.f, 0.f, 0.f, 0.f};
            const int zm0 = 16 * (2 * wave) + li, zm1 = zm0 + 16;
            for (int sx = 0; sx < 32; ++sx) {
                const int c = 4 * sx + lq;
                const float a0 = tab[(zm0 >> 7) * 128 + (((zm0 & 127) * c) & 127)], a1 = tab[(zm1 >> 7) * 128 + (((zm1 & 127) * c) & 127)];
#pragma unroll
                for (int u = 0; u < 4; ++u) {
                    const float b = wt[(16 * u + li) * 129 + c];
                    acc[0][u] = __builtin_amdgcn_mfma_f32_16x16x4f32(a0, b, acc[0][u], 0, 0, 0);
                    acc[1][u] = __builtin_amdgcn_mfma_f32_16x16x4f32(a1, b, acc[1][u], 0, 0, 0);
                }
            }
#pragma unroll
            for (int ti = 0; ti < 2; ++ti)
#pragma unroll
                for (int r = 0; r < 4; ++r) {
                    const int zm = 16 * (2 * wave + ti) + 4 * lq + r, z = zm >> 7, m = zm & 127;
                    bf16_t* O = (bf16_t*)(ws + OFF_WIO) + (size_t)j * 2560 * 1024 + (size_t)(z * 512 + g * 128 + m) * 1024 + kb * 64 + li;
#pragma unroll
                    for (int u = 0; u < 4; ++u) O[16 * u] = f2bf(acc[ti][u][r]);
                }
            __syncthreads();
        }
    }
    } else {
    {
        LAS float* Pt = (LAS float*)lds;
        LAS float* Wd = (LAS float*)(lds + 65536);
        for (int it = vb; it < 64; it += nb) {
            const int g = (it >> 4) & 3, nbk = it & 15;
            for (int idx = tid; idx < 128 * 128; idx += 512) { const int c = idx >> 7, d = idx & 127; Pt[d * 128 + c] = P->in[I_POOLW][((size_t)(j * 4 + g) * 128 + c) * 128 + d] * P->in[I_POOLS][j * 512 + g * 128 + d]; }
            for (int idx = tid; idx < 128 * 64; idx += 512) { const int d = idx >> 6, n = idx & 63; Wd[d * 64 + n] = P->in[I_WOUTE][((size_t)j * 1024 + 512 + g * 128 + d) * 1024 + nbk * 64 + n]; }
            __syncthreads();
            const int c = tid & 127, ng = tid >> 7;
            float acc[16];
#pragma unroll
            for (int nn = 0; nn < 16; ++nn) acc[nn] = 0.f;
            for (int d = 0; d < 128; ++d) {
                const float p = Pt[d * 128 + c];
#pragma unroll
                for (int nn = 0; nn < 16; ++nn) acc[nn] += p * Wd[d * 64 + ng * 16 + nn];
            }
            bf16_t* O = (bf16_t*)(ws + OFF_WOE) + (size_t)j * 1024 * 1024 + (size_t)(nbk * 64 + ng * 16) * 1024 + 512 + g * 128 + c;
#pragma unroll
            for (int nn = 0; nn < 16; ++nn) O[(size_t)nn * 1024] = f2bf(acc[nn]);
            __syncthreads();
        }
    }
    {
        LAS float* av = (LAS float*)lds;
        LAS float* w2 = (LAS float*)(lds + 16384);
        for (int it = (vb + nb - (nb > 16 ? 16 : 0)) % nb; it < 16; it += nb) {
            const int kb = it & 15;
            for (int idx = tid; idx < 64 * 32; idx += 512) { const int kk = idx >> 5, r = idx & 31; av[kk * 33 + r] = P->in[I_WINE][((size_t)j * 1024 + kb * 64 + kk) * 2080 + 1536 + r]; }
            for (int idx = tid; idx < 8192; idx += 512) w2[idx] = P->in[I_WA2][(size_t)j * 8192 + idx];
            __syncthreads();
            const int k = tid & 63, grp = tid >> 6, z = grp >> 2, n0 = (grp & 3) * 64;
            float a[16];
#pragma unroll
            for (int r = 0; r < 16; ++r) a[r] = av[k * 33 + z * 16 + r];
            bf16_t* O = (bf16_t*)(ws + OFF_WIE) + (size_t)j * 2560 * 1024 + (size_t)(1536 + z * 256 + n0) * 1024 + kb * 64 + k;
            for (int nn = 0; nn < 64; ++nn) {
                float s = 0.f;
#pragma unroll
                for (int r = 0; r < 16; ++r) s += a[r] * w2[(z * 16 + r) * 256 + n0 + nn];
                O[(size_t)nn * 1024] = f2bf(s);
            }
            __syncthreads();
        }
    }
    }
}

__device__ __forceinline__ void tgen_part(PP P, int vb, int nb) {
    const int tid = otid(); unsigned char* ws = P->ws;
    {
        const int gt = vb * 512 + tid, GT = nb * 512;
        for (int it = gt; it < 2048 * 512 + 256 * 64; it += GT) {
            int L, k, c0; bf16_t* T; float s;
            if (it < 2048 * 512) { L = 2048; k = it >> 9; c0 = (it & 511) * 8; T = (bf16_t*)(ws + OFF_T2K); s = 1.f / 512.f; }
            else { const int r = it - 2048 * 512; L = 256; k = r >> 6; c0 = (r & 63) * 8; T = (bf16_t*)(ws + OFF_T256); s = 0.00552427172801990f; }
            const int z = c0 >= L; const int l0 = c0 - z * L; const float invL = 1.f / (float)L;
            float v[8];
#pragma unroll
            for (int e = 0; e < 8; ++e) { const int ph = (k * (l0 + e)) & (L - 1); const float fr = (float)ph * invL; v[e] = z ? -__builtin_amdgcn_sinf(fr) * s : __builtin_amdgcn_cosf(fr) * s; }
            u32x4 o; o.x = pk2(v[0], v[1]); o.y = pk2(v[2], v[3]); o.z = pk2(v[4], v[5]); o.w = pk2(v[6], v[7]);
            *(u32x4*)(T + (size_t)k * (2 * L) + c0) = o;
        }
    }
}
__device__ __forceinline__ void gemv_mod(PP P, LAS unsigned char* lds, int l, int vb, int nb) {
    const int tid = otid(); unsigned char* ws = P->ws;
    __syncthreads();
    {
        LAS float* sc = (LAS float*)lds;
        LAS float* red = (LAS float*)(lds + 20480);
        bool staged = false;
        for (int it = vb; it < 48; it += nb) {
            if (!staged) {
                for (int idx = tid; idx < 5120; idx += 512) { const int cnd = idx >> 10, k = idx & 1023; const float c = cnd == 0 ? P->in[I_CCTX][k] : P->in[I_C][(cnd - 1) * 1024 + k]; sc[idx] = siluf(c); }
                staged = true; __syncthreads();
            }
            const int cb = it, quad = tid & 31, kc = tid >> 5;
            const float* wp = P->in[I_WADA] + ((size_t)l * 1024 + kc * 64) * 6144 + cb * 128 + quad * 4;
            f32x4 a[5];
#pragma unroll
            for (int cnd = 0; cnd < 5; ++cnd) a[cnd] = (f32x4){0.f, 0.f, 0.f, 0.f};
#pragma unroll 16
            for (int kk = 0; kk < 64; ++kk) {
                const f32x4 w = *(const f32x4*)(wp + (size_t)kk * 6144);
#pragma unroll
                for (int cnd = 0; cnd < 5; ++cnd) a[cnd] += w * sc[cnd * 1024 + kc * 64 + kk];
            }
#pragma unroll
            for (int cnd = 0; cnd < 5; ++cnd) *(LAS f32x4*)(red + (kc * 5 + cnd) * 128 + quad * 4) = a[cnd];
            __syncthreads();
            for (int idx = tid; idx < 640; idx += 512) {
                const int cnd = idx >> 7, cc = idx & 127; float s = 0.f;
#pragma unroll
                for (int k2 = 0; k2 < 16; ++k2) s += red[(k2 * 5 + cnd) * 128 + cc];
                ((float*)(ws + OFF_MOD))[(size_t)(l * 5 + cnd) * 6144 + cb * 128 + cc] = s + P->in[I_BADA][l * 6144 + cb * 128 + cc];
            }
            __syncthreads();
        }
    }
    __syncthreads();
}

__device__ __forceinline__ void prep_phase(PP P, LAS unsigned char* lds) {
    const int tid = otid(), lane = tid & 63, wave = tid >> 6, G = gridDim.x, bx = obid();
    unsigned char* ws = P->ws;
    convert_layer(P, lds, 0, (bx + 64) % G, G);
    {
        float* X = (float*)(ws + OFF_X);
        for (int r = bx * 8 + wave; r < NTOK; r += G * 8) {
            if (r < NPROMPT) {
#pragma unroll
                for (int jj = 0; jj < 4; ++jj) *(f32x4*)(X + (size_t)r * 1024 + jj * 256 + lane * 4) = *(const f32x4*)(P->in[I_XP] + (size_t)r * 1024 + jj * 256 + lane * 4);
            } else {
                const int s = r - NPROMPT, t = s & 2047; const float gr = (float)(t >> 6), gc = (float)(t & 63);
#pragma unroll
                for (int jj = 0; jj < 4; ++jj) {
                    f32x4 v = *(const f32x4*)(P->in[I_XS] + (size_t)s * 1024 + jj * 256 + lane * 4);
#pragma unroll
                    for (int e = 0; e < 4; ++e) {
                        const float fq = __builtin_amdgcn_exp2f(-(float)(lane * 4 + e) * (13.287712379549449f / 256.f));
                        const float ang = (jj < 2 ? gr : gc) * fq;
                        v[e] += (jj & 1) ? __cosf(ang) : __sinf(ang);
                    }
                    *(f32x4*)(X + (size_t)r * 1024 + jj * 256 + lane * 4) = v;
                }
            }
        }
    }
    __syncthreads();
    gemv_mod(P, lds, 0, (bx + 128) % G, G);
}

__device__ __forceinline__ void norm_phase(PP P, int l, int which) {
    const int tid = otid(), lane = tid & 63, wave = tid >> 6, G = gridDim.x, bx = obid();
    unsigned char* ws = P->ws;
    const float* X = (const float*)(ws + OFF_X);
    const float* gp = which == 2 ? P->in[I_FINALG] : P->in[I_NORMG] + (size_t)(l * 2 + which) * 1024;
    f32x4 gv[4];
#pragma unroll
    for (int jj = 0; jj < 4; ++jj) gv[jj] = *(const f32x4*)(gp + jj * 256 + lane * 4);
    for (int r0 = bx * 8 + wave; r0 < NTOK; r0 += G * 16) {
        f32x4 v[2][4]; float ss[2] = {0.f, 0.f};
#pragma unroll
        for (int u = 0; u < 2; ++u) { const int r = r0 + u * G * 8; if (r < NTOK) {
#pragma unroll
            for (int jj = 0; jj < 4; ++jj) v[u][jj] = *(const f32x4*)(X + (size_t)r * 1024 + jj * 256 + lane * 4); } }
#pragma unroll
        for (int u = 0; u < 2; ++u) {
            const int r = r0 + u * G * 8; if (r >= NTOK) continue;
#pragma unroll
            for (int jj = 0; jj < 4; ++jj) ss[u] += v[u][jj][0] * v[u][jj][0] + v[u][jj][1] * v[u][jj][1] + v[u][jj][2] * v[u][jj][2] + v[u][jj][3] * v[u][jj][3];
            const float rstd = rsqrtf(wave_sum(ss[u]) * (1.f / 1024.f) + 1e-6f);
            if (which == 2) {
#pragma unroll
                for (int jj = 0; jj < 4; ++jj) *(f32x4*)(P->out + (size_t)r * 1024 + jj * 256 + lane * 4) = v[u][jj] * rstd * gv[jj];
            } else {
                const int cnd = r < NPROMPT ? 0 : 1 + ((r - NPROMPT) >> 11);
                const float* mp = (const float*)(ws + OFF_MOD) + (size_t)(l * 5 + cnd) * 6144 + which * 3072;
                bf16_t* Hh = (bf16_t*)(ws + OFF_H) + (size_t)r * 1024;
#pragma unroll
                for (int jj = 0; jj < 4; ++jj) {
                    const f32x4 sh = *(const f32x4*)(mp + jj * 256 + lane * 4), sc = *(const f32x4*)(mp + 1024 + jj * 256 + lane * 4);
                    const f32x4 y = v[u][jj] * rstd * gv[jj] * (sc + 1.f) + sh;
                    u32x2 o; o.x = pk2(y[0], y[1]); o.y = pk2(y[2], y[3]);
                    *(u32x2*)(Hh + jj * 256 + lane * 4) = o;
                }
            }
        }
    }
}

__device__ __forceinline__ void pool_phase(PP P) {
    unsigned char* ws = P->ws;
    const bf16_t* UB = (const bf16_t*)(ws + OFF_UB);
    bf16_t* AM = (bf16_t*)(ws + OFF_AMIX);
    for (int idx = obid() * 512 + otid(); idx < NTOK * 64; idx += gridDim.x * 512) {
        const int t = idx >> 6, oc = idx & 63, ch = oc * 8, g = oc >> 4, w = 2 << g;
        int s0, L; if (t < NPROMPT) { s0 = t & ~255; L = 256; } else { s0 = NPROMPT + ((t - NPROMPT) & ~2047); L = 2048; }
        const int tl = t - s0; const int lo = max(tl - (w >> 1), 0), hi = min(tl + w - (w >> 1), L);
        float s[8];
#pragma unroll
        for (int e = 0; e < 8; ++e) s[e] = 0.f;
        for (int tt = lo; tt < hi; ++tt) {
            const u32x4 v = *(const u32x4*)(UB + (size_t)(s0 + tt) * 512 + ch);
            s[0] += bflo(v.x); s[1] += bfhi(v.x); s[2] += bflo(v.y); s[3] += bfhi(v.y); s[4] += bflo(v.z); s[5] += bfhi(v.z); s[6] += bflo(v.w); s[7] += bfhi(v.w);
        }
        const float ic = 1.f / (float)(hi - lo);
        const u32x4 v = *(const u32x4*)(UB + (size_t)t * 512 + ch);
        u32x4 o;
        o.x = pk2(s[0] * ic - bflo(v.x), s[1] * ic - bfhi(v.x)); o.y = pk2(s[2] * ic - bflo(v.y), s[3] * ic - bfhi(v.y));
        o.z = pk2(s[4] * ic - bflo(v.z), s[5] * ic - bfhi(v.z)); o.w = pk2(s[6] * ic - bflo(v.w), s[7] * ic - bfhi(v.w));
        *(u32x4*)(AM + (size_t)t * 1024 + 512 + ch) = o;
    }
}

__device__ __forceinline__ void mixprep_phase(PP P, int j) {
    const int tid = otid(), lane = tid & 63, wave = tid >> 6;
    unsigned char* ws = P->ws;
    const float* O0 = (const float*)(ws + OFF_ODIR); const float* O1 = O0 + (size_t)NTOK * 512;
    const bf16_t* GT = (const bf16_t*)(ws + OFF_GATE);
    bf16_t* AM = (bf16_t*)(ws + OFF_AMIX);
    const int ch = lane * 8;
    const f32x4 g0 = *(const f32x4*)(P->in[I_GLAG] + j * 128 + (ch & 127)), g1 = *(const f32x4*)(P->in[I_GLAG] + j * 128 + (ch & 127) + 4);
    const int G8 = gridDim.x * 8;
    for (int r0 = obid() * 8 + wave; r0 < NTOK; r0 += 2 * G8) {
        f32x4 a[2], b[2]; u32x4 gt[2];
#pragma unroll
        for (int u = 0; u < 2; ++u) { const int r = r0 + u * G8; if (r < NTOK) {
            a[u] = *(const f32x4*)(O0 + (size_t)r * 512 + ch) + *(const f32x4*)(O1 + (size_t)r * 512 + ch);
            b[u] = *(const f32x4*)(O0 + (size_t)r * 512 + ch + 4) + *(const f32x4*)(O1 + (size_t)r * 512 + ch + 4);
            gt[u] = *(const u32x4*)(GT + (size_t)r * 512 + ch); } }
#pragma unroll
        for (int u = 0; u < 2; ++u) {
            const int r = r0 + u * G8; if (r >= NTOK) continue;
            float ss = a[u][0] * a[u][0] + a[u][1] * a[u][1] + a[u][2] * a[u][2] + a[u][3] * a[u][3] + b[u][0] * b[u][0] + b[u][1] * b[u][1] + b[u][2] * b[u][2] + b[u][3] * b[u][3];
            ss += __shfl_xor(ss, 1); ss += __shfl_xor(ss, 2); ss += __shfl_xor(ss, 4); ss += __shfl_xor(ss, 8);
            const float rstd = rsqrtf(ss * (1.f / 128.f) + 1e-6f);
            const f32x4 aa = a[u] * rstd * g0, bb = b[u] * rstd * g1;
            u32x4 o;
            o.x = pk2(aa[0] * bflo(gt[u].x), aa[1] * bfhi(gt[u].x)); o.y = pk2(aa[2] * bflo(gt[u].y), aa[3] * bfhi(gt[u].y));
            o.z = pk2(bb[0] * bflo(gt[u].z), bb[1] * bfhi(gt[u].z)); o.w = pk2(bb[2] * bflo(gt[u].w), bb[3] * bfhi(gt[u].w));
            *(u32x4*)(AM + (size_t)r * 1024 + ch) = o;
        }
    }
}

__device__ __forceinline__ void conv_phase(PP P, int j) {
    unsigned char* ws = P->ws;
    const bf16_t* XI = (const bf16_t*)(ws + OFF_XIN); const bf16_t* BGp = (const bf16_t*)(ws + OFF_BG); const bf16_t* CGp = (const bf16_t*)(ws + OFF_CG);
    bf16_t* AM = (bf16_t*)(ws + OFF_AMIX);
    for (int idx = obid() * 512 + otid(); idx < NTOK * 64; idx += gridDim.x * 512) {
        const int t = idx >> 6, ch = (idx & 63) * 8;
        int s0, L; if (t < NPROMPT) { s0 = t & ~255; L = 256; } else { s0 = NPROMPT + ((t - NPROMPT) & ~2047); L = 2048; }
        const int tl = t - s0;
        float cv[8];
        { const f32x4 b0 = *(const f32x4*)(P->in[I_CONVB] + j * 512 + ch), b1 = *(const f32x4*)(P->in[I_CONVB] + j * 512 + ch + 4);
          cv[0] = b0[0]; cv[1] = b0[1]; cv[2] = b0[2]; cv[3] = b0[3]; cv[4] = b1[0]; cv[5] = b1[1]; cv[6] = b1[2]; cv[7] = b1[3]; }
#pragma unroll
        for (int jj = 0; jj < 3; ++jj) {
            const int tt = tl + jj - 1;
            if (tt < 0 || tt >= L) continue;
            const u32x4 xv = *(const u32x4*)(XI + (size_t)(s0 + tt) * 512 + ch), cg = *(const u32x4*)(CGp + (size_t)(s0 + tt) * 512 + ch);
            const f32x4 w0 = *(const f32x4*)(P->in[I_CONVW] + (size_t)(j * 3 + jj) * 512 + ch), w1 = *(const f32x4*)(P->in[I_CONVW] + (size_t)(j * 3 + jj) * 512 + ch + 4);
            cv[0] += bflo(xv.x) * bflo(cg.x) * w0[0]; cv[1] += bfhi(xv.x) * bfhi(cg.x) * w0[1]; cv[2] += bflo(xv.y) * bflo(cg.y) * w0[2]; cv[3] += bfhi(xv.y) * bfhi(cg.y) * w0[3];
            cv[4] += bflo(xv.z) * bflo(cg.z) * w1[0]; cv[5] += bfhi(xv.z) * bfhi(cg.z) * w1[1]; cv[6] += bflo(xv.w) * bflo(cg.w) * w1[2]; cv[7] += bfhi(xv.w) * bfhi(cg.w) * w1[3];
        }
        const u32x4 bg = *(const u32x4*)(BGp + (size_t)t * 512 + ch);
        u32x4 o;
        o.x = pk2(cv[0] * bflo(bg.x), cv[1] * bfhi(bg.x)); o.y = pk2(cv[2] * bflo(bg.y), cv[3] * bfhi(bg.y));
        o.z = pk2(cv[4] * bflo(bg.z), cv[5] * bfhi(bg.z)); o.w = pk2(cv[6] * bflo(bg.w), cv[7] * bfhi(bg.w));
        *(u32x4*)(AM + (size_t)t * 1024 + 512 + ch) = o;
    }
}

__device__ __forceinline__ void convert_phase(PP P) {
    unsigned char* ws = P->ws;
    bf16_t* AM = (bf16_t*)(ws + OFF_AMIX);
    for (int idx = obid() * 512 + otid(); idx < NTOK * 64; idx += gridDim.x * 512) {
        const int t = idx >> 6, ch = (idx & 63) * 8;
        f32x4 a, b;
        if (t < NPROMPT) { const float* F = (const float*)(ws + OFF_FACCP) + (size_t)t * 512 + ch; a = *(const f32x4*)F; b = *(const f32x4*)(F + 4); }
        else {
            const float* F = (const float*)(ws + OFF_FACCS) + (size_t)(t - NPROMPT) * 512 + ch;
            a = *(const f32x4*)F; b = *(const f32x4*)(F + 4);
#pragma unroll
            for (int ks = 1; ks < 4; ++ks) { a += *(const f32x4*)(F + (size_t)ks * 8192 * 512); b += *(const f32x4*)(F + (size_t)ks * 8192 * 512 + 4); }
        }
        u32x4 o; o.x = pk2(a[0], a[1]); o.y = pk2(a[2], a[3]); o.z = pk2(b[0], b[1]); o.w = pk2(b[2], b[3]);
        *(u32x4*)(AM + (size_t)t * 1024 + ch) = o;
    }
}

__device__ __forceinline__ int permd(int d) { return (d & 32) | ((d & 12) << 1) | ((d & 16) >> 2) | (d & 3); }
__device__ __forceinline__ bf16x8 pack8(const f32x4& a, const f32x4& b) {
    u32x4 o; o.x = pk2(a[0], a[1]); o.y = pk2(a[2], a[3]); o.z = pk2(b[0], b[1]); o.w = pk2(b[2], b[3]);
    return __builtin_bit_cast(bf16x8, o);
}
__device__ __forceinline__ void gla_item(PP P, LAS unsigned char* lds, int j, int seg, int head, int dir, bool full) {
    const int tid = otid(), lane = tid & 63, w = tid >> 6, r = lane & 15, q = lane >> 4;
    unsigned char* ws = P->ws;
    const bf16_t* QB = (const bf16_t*)(ws + OFF_QB); const bf16_t* KB = (const bf16_t*)(ws + OFF_KB); const bf16_t* VT = (const bf16_t*)(ws + OFF_VT);
    const float* LOGF = (const float*)(ws + OFF_LOGF);
    float* ODIR = (float*)(ws + OFF_ODIR);
    float* Ubuf = (float*)(ws + OFF_U); float* Dtot = (float*)(ws + OFF_DTOT);
    LAS bf16_t* QT = (LAS bf16_t*)(lds);
    LAS bf16_t* KT = (LAS bf16_t*)(lds + 36864);
    LAS bf16_t* KH = (LAS bf16_t*)(lds + 73728);
    LAS float* DL = (LAS float*)(lds + 114688);
    LAS bf16x8* ATT = (LAS bf16x8*)(lds + 116736);
    const int tok0 = seg * 256;
    __syncthreads();
    {
        const int d = tid & 63, c = w, pd = permd(d);
        float b = 0.f;
        const float* lf = LOGF + (size_t)(tok0 + 32 * c) * 512 + dir * 256 + head * 64 + d;
        const bf16_t* qp = QB + (size_t)(tok0 + 32 * c) * 256 + head * 64 + d;
        const bf16_t* kp = KB + (size_t)(tok0 + 32 * c) * 256 + head * 64 + d;
        float lfv[32]; bf16_t qv16[32], kv16[32];
#pragma unroll
        for (int ii = 0; ii < 32; ++ii) { const int il = dir ? 31 - ii : ii; lfv[ii] = lf[(size_t)il * 512]; qv16[ii] = qp[(size_t)il * 256]; kv16[ii] = kp[(size_t)il * 256]; }
#pragma unroll
        for (int ii = 0; ii < 32; ++ii) {
            const int il = dir ? 31 - ii : ii;
            b += lfv[ii];
            const float qv = bf2f(qv16[ii]), kv = bf2f(kv16[ii]);
            QT[(32 * c + il) * 72 + pd] = f2bf(qv * __expf(b));
            KT[(32 * c + il) * 72 + pd] = f2bf(kv * __expf(-b));
        }
        const float eT = __expf(b);
        DL[c * 64 + d] = eT;
#pragma unroll 8
        for (int il = 0; il < 32; ++il) KH[(c * 64 + d) * 40 + permd(il)] = f2bf(bf2f(KT[(32 * c + il) * 72 + pd]) * eT);
    }
    __syncthreads();
    if (full) {
        const int c = w;
        f32x4 at[2][2];
#pragma unroll
        for (int a = 0; a < 2; ++a)
#pragma unroll
            for (int b = 0; b < 2; ++b) at[a][b] = (f32x4){0.f, 0.f, 0.f, 0.f};
#pragma unroll
        for (int kk = 0; kk < 2; ++kk) {
            bf16x8 ka[2], qb[2];
#pragma unroll
            for (int t = 0; t < 2; ++t) { ka[t] = *(const LAS bf16x8*)(KT + (32 * c + 16 * t + r) * 72 + 32 * kk + 8 * q); qb[t] = *(const LAS bf16x8*)(QT + (32 * c + 16 * t + r) * 72 + 32 * kk + 8 * q); }
#pragma unroll
            for (int tj = 0; tj < 2; ++tj)
#pragma unroll
                for (int ti = 0; ti < 2; ++ti) at[tj][ti] = __builtin_amdgcn_mfma_f32_16x16x32_bf16(ka[tj], qb[ti], at[tj][ti], 0, 0, 0);
        }
#pragma unroll
        for (int ti = 0; ti < 2; ++ti) {
            const int i = 16 * ti + r;
#pragma unroll
            for (int tj = 0; tj < 2; ++tj)
#pragma unroll
                for (int jj = 0; jj < 4; ++jj) { const int jx = 16 * tj + 4 * q + jj; const bool keep = dir ? (jx >= i) : (jx <= i); if (!keep) at[tj][ti][jj] = 0.f; }
            ATT[(c * 2 + ti) * 64 + lane] = pack8(at[0][ti], at[1][ti]);
        }
    }
    __syncthreads();
    f32x4 S[4];
#pragma unroll
    for (int t = 0; t < 4; ++t) S[t] = (f32x4){0.f, 0.f, 0.f, 0.f};
    const int e = 16 * w + r;
    if (DBG_SINIT && full && seg >= 16) {
        const int sb = (seg - 16) >> 3, part = (seg - 16) & 7;
        const float* s0 = P->in[I_STATE] + ((size_t)(((sb * 2 + j) * 2 + dir) * 4 + head) * 64) * 128;
#pragma unroll
        for (int t = 0; t < 4; ++t)
#pragma unroll
            for (int jj = 0; jj < 4; ++jj) S[t][jj] = s0[(size_t)(16 * t + 4 * q + jj) * 128 + e];
        const int np = dir ? 7 - part : part;
#pragma unroll
        for (int xb = 0; xb < 8; xb += 4) {
            if (xb >= np) break;
            float dvv[4][16], uvv[4][16];
#pragma unroll
            for (int xi = 0; xi < 4; ++xi) {
                const int x = xb + xi; if (x >= 7) continue;
                const int pp = dir ? 7 - x : x;
                const size_t ib = (size_t)(((sb * 8 + pp) * 4 + head) * 2 + dir) * 64;
#pragma unroll
                for (int t = 0; t < 4; ++t)
#pragma unroll
                    for (int jj = 0; jj < 4; ++jj) { const int d = 16 * t + 4 * q + jj; dvv[xi][t * 4 + jj] = Dtot[ib + d]; uvv[xi][t * 4 + jj] = Ubuf[(ib + d) * 128 + e]; }
            }
#pragma unroll
            for (int xi = 0; xi < 4; ++xi) {
                const int x = xb + xi; if (x >= 7) continue;
                const bool on = x < np;
#pragma unroll
                for (int t = 0; t < 4; ++t)
#pragma unroll
                    for (int jj = 0; jj < 4; ++jj) S[t][jj] = on ? S[t][jj] * dvv[xi][t * 4 + jj] + uvv[xi][t * 4 + jj] : S[t][jj];
            }
        }
    }
    const bf16_t* vt = VT + (size_t)(head * 128 + e) * NTOK + tok0;
    u32x2 vpre0[8], vpre1[8];
#pragma unroll
    for (int cc = 0; cc < 8; ++cc) { const int c = dir ? 7 - cc : cc; vpre0[cc] = *(const u32x2*)(vt + 32 * c + 4 * q); vpre1[cc] = *(const u32x2*)(vt + 32 * c + 16 + 4 * q); }
#pragma unroll
    for (int cc = 0; cc < 8; ++cc) {
        const int c = dir ? 7 - cc : cc;
        const u32x2 v0 = vpre0[cc], v1 = vpre1[cc];
        u32x4 vv; vv.x = v0.x; vv.y = v0.y; vv.z = v1.x; vv.w = v1.y;
        const bf16x8 vb = __builtin_bit_cast(bf16x8, vv);
        if (full) {
            bf16x8 sb2[2];
            sb2[0] = pack8(S[0], S[1]); sb2[1] = pack8(S[2], S[3]);
#pragma unroll
            for (int mi = 0; mi < 2; ++mi) {
                f32x4 o = (f32x4){0.f, 0.f, 0.f, 0.f};
#pragma unroll
                for (int kk = 0; kk < 2; ++kk) {
                    const bf16x8 qa = *(const LAS bf16x8*)(QT + (32 * c + 16 * mi + r) * 72 + 32 * kk + 8 * q);
                    o = __builtin_amdgcn_mfma_f32_16x16x32_bf16(qa, sb2[kk], o, 0, 0, 0);
                }
                const bf16x8 aa = ATT[(c * 2 + mi) * 64 + lane];
                o = __builtin_amdgcn_mfma_f32_16x16x32_bf16(aa, vb, o, 0, 0, 0);
                float* op = ODIR + ((size_t)dir * NTOK + tok0 + 32 * c + 16 * mi + 4 * q) * 512 + head * 128 + e;
#pragma unroll
                for (int jj = 0; jj < 4; ++jj) op[(size_t)jj * 512] = o[jj];
            }
        }
#pragma unroll
        for (int t = 0; t < 4; ++t) {
            const f32x4 dv = *(const LAS f32x4*)(DL + c * 64 + 16 * t + 4 * q);
            S[t] = S[t] * dv;
            const bf16x8 ka = *(const LAS bf16x8*)(KH + (c * 64 + 16 * t + r) * 40 + 8 * q);
            S[t] = __builtin_amdgcn_mfma_f32_16x16x32_bf16(ka, vb, S[t], 0, 0, 0);
        }
    }
    if (full) {
        if (seg < 16) {
            float* so = P->out + OUT_STATE + ((size_t)(((seg * 2 + j) * 2 + dir) * 4 + head) * 64) * 128;
#pragma unroll
            for (int t = 0; t < 4; ++t)
#pragma unroll
                for (int jj = 0; jj < 4; ++jj) so[(size_t)(16 * t + 4 * q + jj) * 128 + e] = S[t][jj];
        }
    } else {
        const size_t ib = (size_t)(((seg - 16) * 4 + head) * 2 + dir) * 64;
#pragma unroll
        for (int t = 0; t < 4; ++t)
#pragma unroll
            for (int jj = 0; jj < 4; ++jj) Ubuf[(ib + 16 * t + 4 * q + jj) * 128 + e] = S[t][jj];
        if (tid < 64) { float p = 1.f;
#pragma unroll
            for (int c = 0; c < 8; ++c) p *= DL[c * 64 + tid];
            Dtot[ib + tid] = p; }
    }
}

__device__ __forceinline__ void gla_phase(PP P, LAS unsigned char* lds, int j, int sub) {
    const int G = gridDim.x;
    if (sub == 0) {
        for (int it = obid(); it < 384; it += G) {
            if (it >= 128 && it < 256) { const int pi = it - 128; gla_item(P, lds, j, pi >> 3, (pi >> 1) & 3, pi & 1, true); }
            else { const int li = it < 128 ? it : it - 128; gla_item(P, lds, j, 16 + (li >> 3), (li >> 1) & 3, li & 1, false); }
        }
    } else {
        for (int it = obid(); it < 256; it += G) gla_item(P, lds, j, 16 + (it >> 3), (it >> 1) & 3, it & 1, true);
    }
}


#define XB_TMO      128
#define XB_XCNT(j)  (256  + 64 * (j))
#define XB_XSUB(j)  (1280 + 64 * (j))
#define XB_XGEN(j)  (2304 + 64 * (j))
#define XB_TOP      3328
#define XB_TOPGEN   3392
#define XCD_BAR_WORDS 3456
#define XB_SPIN_CAP (1u << 18)

__device__ __forceinline__ unsigned xb_ld(unsigned* p)              { return __hip_atomic_load(p, __ATOMIC_RELAXED, __HIP_MEMORY_SCOPE_AGENT); }
__device__ __forceinline__ unsigned xb_add(unsigned* p, unsigned v) { return __hip_atomic_fetch_add(p, v, __ATOMIC_RELAXED, __HIP_MEMORY_SCOPE_AGENT); }
__device__ __forceinline__ unsigned xb_xcc_id() { return (unsigned)__builtin_amdgcn_s_getreg((3 << 11) | 20) & 0xFu; }
#define XB_SPIN(cond, bar) do { unsigned _sp = 0; while (cond) { __builtin_amdgcn_s_sleep(1); \
    if ((++_sp & 255u) == 0u) { if (xb_ld(&(bar)[XB_TMO])) break; if (_sp > XB_SPIN_CAP) { atomicAdd(&(bar)[XB_TMO], 1u); break; } } } } while (0)

struct XcdBarrier {
    unsigned* bar; unsigned x;
    volatile LAS unsigned* st;
};

__device__ __forceinline__ XcdBarrier xcd_barrier_post(unsigned* bar, volatile LAS unsigned* st) {
    XcdBarrier b; b.bar = bar; b.x = xb_xcc_id(); b.st = st;
    if (threadIdx.x == 0) (void)xb_add(&bar[XB_XCNT(b.x)], 1u);
    return b;
}
__device__ __forceinline__ void xcd_barrier_complete(unsigned* bar, unsigned x, unsigned& nloc, unsigned& nx) {
    const unsigned G = gridDim.x * gridDim.y * gridDim.z;
    unsigned sum, cnt, mine, sp = 0u;
    for (;;) {
        sum = 0u; cnt = 0u; mine = 0u;
#pragma unroll
        for (unsigned j = 0; j < 16; ++j) { const unsigned c = xb_ld(&bar[XB_XCNT(j)]); sum += c; cnt += (c > 0u) ? 1u : 0u; mine = (j == x) ? c : mine; }
        if (sum == G) break;
        __builtin_amdgcn_s_sleep(1);
        if ((++sp & 255u) == 0u) { if (xb_ld(&bar[XB_TMO])) break; if (sp > XB_SPIN_CAP) { atomicAdd(&bar[XB_TMO], 1u); break; } }
    }
    nloc = mine > 0u ? mine : 1u; nx = cnt > 0u ? cnt : 1u;
}

__device__ __forceinline__ void xcd_barrier(const XcdBarrier& b) {
    asm volatile("s_waitcnt vmcnt(0)" ::: "memory");
    __syncthreads();
    if (threadIdx.x == 0) {
        unsigned* bar = b.bar;
        __builtin_amdgcn_s_waitcnt(0);
        unsigned nloc = b.st[0], nx = b.st[1];
        if (nloc == 0u) { xcd_barrier_complete(bar, b.x, nloc, nx); b.st[0] = nloc; b.st[1] = nx; }
        const unsigned old = xb_add(&bar[XB_XSUB(b.x)], 1u);
        const unsigned gen = old / nloc;
        if (old + 1u == (gen + 1u) * nloc) {
            __builtin_amdgcn_fence(__ATOMIC_RELEASE, "agent");
            asm volatile("s_waitcnt vmcnt(0)" ::: "memory");
            const unsigned og = xb_add(&bar[XB_TOP], 1u);
            const unsigned tg = og / nx;
            if (og + 1u == (tg + 1u) * nx) xb_add(&bar[XB_TOPGEN], 1u);
            else XB_SPIN(xb_ld(&bar[XB_TOPGEN]) == tg, bar);
            __builtin_amdgcn_fence(__ATOMIC_ACQUIRE, "agent");
            xb_add(&bar[XB_XGEN(b.x)], 1u);
            asm volatile("s_waitcnt vmcnt(0)" ::: "memory");
        } else {
            XB_SPIN(xb_ld(&bar[XB_XGEN(b.x)]) == gen, bar);
            __builtin_amdgcn_fence(__ATOMIC_ACQUIRE, "agent");
            asm volatile("s_waitcnt vmcnt(0)" ::: "memory");
        }
    }
    __syncthreads();
}

enum { PT_PREP = 0, PT_NORM1, PT_GEMM_IN, PT_MIX_A, PT_MIX_B, PT_MIXPREP, PT_GEMM_OUT, PT_NORM2, PT_MLP1, PT_MLP2, PT_FINAL };

__global__ void __launch_bounds__(512, 2) mega_fwd(Params Pk) {
    extern __shared__ __attribute__((aligned(16))) unsigned char smem[];
    LAS unsigned char* lds = (LAS unsigned char*)smem;
#ifdef DBG_ZLDS
    for (int i = otid(); i < LDS_BYTES / 16; i += 512) ((LAS u32x4*)lds)[i] = (u32x4){0u, 0u, 0u, 0u};
    __syncthreads();
#endif
    { volatile LAS unsigned* st0 = (volatile LAS unsigned*)(lds + LDS_BYTES - 64); if (otid() < 2) st0[otid()] = 0u; }
    __syncthreads();
    XcdBarrier gbar; gbar.bar = (unsigned*)(Pk.ws + OFF_BAR); gbar.x = 0; gbar.st = (volatile LAS unsigned*)(lds + LDS_BYTES - 64);
    if (Pk.ph_hi - Pk.ph_lo > 1) gbar = xcd_barrier_post((unsigned*)(Pk.ws + OFF_BAR), (volatile LAS unsigned*)(lds + LDS_BYTES - 64));
    if (Pk.ph_hi < 0) cg::this_grid().sync();
    for (int ph = Pk.ph_lo; ph < Pk.ph_hi; ++ph) {
        PP P = (PP)__builtin_amdgcn_kernarg_segment_ptr();
        asm volatile("" : "+s"(P));
        int pt, l = 0;
        if (ph == 0) pt = PT_PREP;
        else if (ph == NPH - 1) pt = PT_FINAL;
        else {
            const int qq = ph - 1; int s;
            if (qq < 9) { l = 0; s = qq; } else if (qq < 17) { l = 1; s = qq - 9; } else if (qq < 26) { l = 2; s = qq - 17; } else { l = 3; s = qq - 26; }
            pt = (l & 1) ? (s < 4 ? s + 1 : s + 2) : s + 1;
        }
        const int j = l >> 1, odd = l & 1;
        const int nrep = (pt == REP_PT) ? 1 + REP_N : 1;
        for (int rep = 0; rep < nrep; ++rep) {
        int ngemm = 0; GemmCfg g; g.G = gridDim.x; g.c = obid(); g.j = j; g.l = l; g.nM = 48; g.ld = 1024; g.nt = 16; g.type = 0; g.nN = 0;
        switch (pt) {
        case PT_PREP: if (EN & 1) prep_phase(P, lds); break;
        case PT_NORM1: if (EN & 2) norm_phase(P, l, 0); break;
        case PT_GEMM_IN: ngemm = 1; g.type = odd ? T_IN_ODD : T_IN_EVEN; g.nN = 10; break;
        case PT_MIX_A: if (odd) { ngemm = 2; g.type = T_DFT_S; g.nM = 8; g.nN = 32; g.ld = 4096; g.nt = 16; } else { if (EN & 4) gla_phase(P, lds, j, 0); if (EN & 8) pool_phase(P); } break;
        case PT_MIX_B: if (odd) { if (EN & 8) convert_phase(P); } else { if (EN & 4) gla_phase(P, lds, j, 1); } break;
        case PT_MIXPREP: if (EN & 8) mixprep_phase(P, j); break;
        case PT_GEMM_OUT: ngemm = 1; g.type = odd ? T_OUT_ODD : T_OUT_EVEN; g.nN = 4; break;
        case PT_NORM2: if (EN & 2) norm_phase(P, l, 1); break;
        case PT_MLP1: ngemm = 1; g.type = T_MLP1; g.nN = 16; break;
        case PT_MLP2: ngemm = 1; g.type = T_MLP2; g.nN = 4; g.ld = 4096; g.nt = 64; break;
        default: if (EN & 2) norm_phase(P, 0, 2); break;
        }
        for (int gi = 0; gi < ngemm; ++gi) {
            if (gi == 1) { g.type = T_DFT_P; g.nM = 1; g.nN = 32; g.ld = 512; g.nt = 8; g.c = (obid() + gridDim.x - 32) % gridDim.x; }
            if (EN & 16) gemm_phase(lds, g);
        }
        if (pt == PT_MIX_A && odd && (EN & 8)) conv_phase(P, j);
        if (pt == PT_MLP2 && l < 3) { const int G2 = gridDim.x, bq = obid(); if (G2 > 192) { if (bq >= 192) { convert_layer(P, lds, l + 1, bq - 192, G2 - 192); gemv_mod(P, lds, l + 1, bq - 192, G2 - 192); if (l == 0) tgen_part(P, bq - 192, G2 - 192); } } else { convert_layer(P, lds, l + 1, bq, G2); gemv_mod(P, lds, l + 1, bq, G2); if (l == 0) tgen_part(P, bq, G2); } }
        if (ph + 1 < Pk.ph_hi || rep + 1 < nrep) xcd_barrier(gbar);
        }

    }
}


#ifdef DBG_K
__device__ __forceinline__ float dgst(unsigned u) { return (float)(u & 0xffffu) + (float)(u >> 16); }
__global__ void dbg_dump(float* out, const unsigned char* ws) {
    const unsigned* Xu = (const unsigned*)(ws + OFF_X); const unsigned* Hu = (const unsigned*)(ws + OFF_H); const unsigned* Au = (const unsigned*)(ws + OFF_AMIX);
    const unsigned* Bu = (const unsigned*)(ws + OFF_BIG); const unsigned* Uu = (const unsigned*)(ws + OFF_U); const unsigned* Wu = (const unsigned*)(ws);
    for (size_t i = (size_t)blockIdx.x * blockDim.x + threadIdx.x; i < (size_t)NTOK * 1024; i += (size_t)gridDim.x * blockDim.x) {
        float v = 0.f;
        if (DBG_SEL & 1) v += dgst(Xu[i]);
        if (DBG_SEL & 2) v += dgst(Hu[i % 6291456]);
        if (DBG_SEL & 4) v += dgst(Au[i % 6291456]);
        if (DBG_SEL & 8) v += dgst(Bu[i]) + dgst(Bu[i + 12582912]) + dgst(Bu[(i + 25165824) % 34603008]);
        if (DBG_SEL & 16) v += dgst(Uu[i % 2113536]);
        if (DBG_SEL & 32) v += dgst(Wu[i]) + dgst(Wu[i + 12582912]) + dgst(Wu[(i + 25165824) % 28573696]);
        out[i] = v;
    }
}
#endif
extern "C" void kernel_launch(void* const* d_in, const int* in_sizes, int n_in, void* d_out, int out_size, void* d_ws, size_t ws_size, hipStream_t stream) {
    static int grid = 0;
    if (grid == 0) {
        if (n_in != 22 || ws_size < WS_NEED) { fprintf(stderr, "kernel_launch: unexpected n_in %d / ws_size %zu (need %zu)\n", n_in, ws_size, (size_t)WS_NEED); grid = -1; return; }
        int dev = 0, cus = 0, per_cu = 0;
        hipGetDevice(&dev);
        hipDeviceGetAttribute(&cus, hipDeviceAttributeMultiprocessorCount, dev);
        if (hipFuncSetAttribute((const void*)mega_fwd, hipFuncAttributeMaxDynamicSharedMemorySize, LDS_BYTES) != hipSuccess) { fprintf(stderr, "kernel_launch: hipFuncSetAttribute failed\n"); grid = -1; return; }
        hipOccupancyMaxActiveBlocksPerMultiprocessor(&per_cu, (const void*)mega_fwd, 512, LDS_BYTES);
        if (per_cu < 1) { fprintf(stderr, "kernel_launch: occupancy query says %d blocks/CU\n", per_cu); per_cu = 1; }
        (void)hipGetLastError();
        grid = cus;
    }
    if (grid < 0) return;
    Params p{};
    for (int i = 0; i < 22; ++i) p.in[i] = (const float*)d_in[i];
    p.out = (float*)d_out; p.ws = (unsigned char*)d_ws;
#if MULTI_LAUNCH
#ifdef DBG_K
    for (int ph = 0; ph < DBG_K; ++ph) {
        p.ph_lo = ph; p.ph_hi = ph + 1;
        hipLaunchKernelGGL(mega_fwd, dim3(grid), dim3(512), LDS_BYTES, stream, p);
    }
    hipLaunchKernelGGL(dbg_dump, dim3(2048), dim3(256), 0, stream, (float*)d_out, (const unsigned char*)d_ws);
#else
    for (int ph = 0; ph < NPH; ++ph) {
        p.ph_lo = ph; p.ph_hi = ph + 1;
        hipLaunchKernelGGL(mega_fwd, dim3(grid), dim3(512), LDS_BYTES, stream, p);
    }
#endif
#else
    p.ph_lo = 0; p.ph_hi = NPH;
    if (hipMemsetAsync((char*)d_ws + OFF_BAR, 0, 16384, stream) != hipSuccess) { fprintf(stderr, "kernel_launch: memset of barrier word failed\n"); return; }
    void* args[] = {&p};
    hipError_t e = hipLaunchCooperativeKernel((const void*)mega_fwd, dim3(grid), dim3(512), args, LDS_BYTES, stream);
    if (e != hipSuccess) fprintf(stderr, "cooperative launch failed: %s (grid %d)\n", hipGetErrorString(e), grid);
#endif
}
```

```cpp
#include <hip/hip_runtime.h>
#include <hip/hip_cooperative_groups.h>
#include <cstdio>
#include <cstdint>
namespace cg = cooperative_groups;

#ifndef DBG_SEL
#define DBG_SEL 63
#endif
#ifndef DBG_NP
#define DBG_NP(x) (x)
#endif
#ifndef REP_PT
#define REP_PT -1
#endif
#ifndef REP_L
#define REP_L -1
#endif
#ifndef REP_N
#define REP_N 1
#endif
#ifndef XSYNC
#define XSYNC 0
#endif
#ifndef DBG_SINIT
#define DBG_SINIT 1
#endif
#ifndef EN
#define EN 31
#endif
#ifndef MULTI_LAUNCH
#define MULTI_LAUNCH 0
#endif

#define LAS __attribute__((address_space(3)))
typedef unsigned short bf16_t;
typedef short bf16x8 __attribute__((ext_vector_type(8)));
typedef float f32x4 __attribute__((ext_vector_type(4)));
typedef unsigned u32x2 __attribute__((ext_vector_type(2)));
typedef unsigned u32x4 __attribute__((ext_vector_type(4)));

constexpr int DM = 1024, NTOK = 12288, NPROMPT = 4096, DFF = 4096;
constexpr int LDS_BYTES = 147456;
constexpr int NPH = 36;
constexpr size_t MBy = 1048576;
constexpr size_t OFF_W1T = 0, OFF_W2T = 32 * MBy, OFF_WIE = 64 * MBy, OFF_WOE = 74 * MBy, OFF_WIO = 78 * MBy, OFF_WOO = 88 * MBy;
constexpr size_t OFF_T2K = 92 * MBy, OFF_T256 = 108 * MBy, OFF_MOD = 108 * MBy + 262144, OFF_U = 109 * MBy, OFF_DTOT = 117 * MBy;
constexpr size_t OFF_X = 118 * MBy, OFF_H = 166 * MBy, OFF_AMIX = 190 * MBy, OFF_BIG = 214 * MBy, WS_NEED = 348 * MBy;
constexpr size_t OFF_HID = OFF_BIG;
constexpr size_t OFF_QB = OFF_BIG, OFF_KB = OFF_BIG + 6 * MBy, OFF_VT = OFF_BIG + 12 * MBy, OFF_GATE = OFF_BIG + 24 * MBy, OFF_LOGF = OFF_BIG + 36 * MBy;
constexpr size_t OFF_UB = OFF_BIG + 60 * MBy, OFF_ODIR = OFF_BIG + 72 * MBy;
constexpr size_t OFF_XTS = OFF_BIG, OFF_XTP = OFF_BIG + 16 * MBy, OFF_XIN = OFF_BIG + 24 * MBy, OFF_BG = OFF_BIG + 36 * MBy, OFF_CG = OFF_BIG + 48 * MBy;
constexpr size_t OFF_FACCP = OFF_BIG + 60 * MBy, OFF_FACCS = OFF_BIG + 68 * MBy;
constexpr size_t OFF_BAR = 117 * MBy + 524288;
constexpr size_t OUT_STATE = (size_t)NTOK * DM;

struct Params { const float* in[22]; float* out; unsigned char* ws; int ph_lo, ph_hi; };
typedef const __attribute__((address_space(4))) Params* PP;
enum { I_XP = 0, I_XS, I_STATE, I_C, I_CCTX, I_NORMG, I_FINALG, I_WADA, I_BADA, I_W1, I_W2, I_WINE, I_WA2, I_BA2, I_GLAG, I_POOLW, I_POOLS, I_WOUTE, I_WINO, I_CONVW, I_CONVB, I_WOUTO };

__device__ __forceinline__ int otid() { int t = __builtin_amdgcn_workitem_id_x(); asm volatile("" : "+v"(t)); return t; }
__device__ __forceinline__ int obid() { int b = __builtin_amdgcn_workgroup_id_x(); asm volatile("" : "+s"(b)); return b; }
typedef float f32x2 __attribute__((ext_vector_type(2)));
typedef __bf16 bf16x2v __attribute__((ext_vector_type(2)));
__device__ __forceinline__ unsigned pk2(float lo, float hi) { f32x2 v = {lo, hi}; bf16x2v b = __builtin_convertvector(v, bf16x2v); return __builtin_bit_cast(unsigned, b); }
__device__ __forceinline__ bf16_t f2bf(float x) { return (bf16_t)(pk2(x, 0.f) & 0xffffu); }
__device__ __forceinline__ float bf2f(bf16_t u) { return __uint_as_float(((unsigned)u) << 16); }
__device__ __forceinline__ float bflo(unsigned u) { return __uint_as_float(u << 16); }
__device__ __forceinline__ float bfhi(unsigned u) { return __uint_as_float(u & 0xffff0000u); }
__device__ __forceinline__ float wave_sum(float v) {
#pragma unroll
    for (int o = 1; o < 64; o <<= 1) v += __shfl_xor(v, o);
    return v;
}
__device__ __forceinline__ float siluf(float x) { return x * __builtin_amdgcn_rcpf(1.f + __expf(-x)); }
__device__ __forceinline__ float logsigmoidf(float x) { return fminf(x, 0.f) - __logf(1.f + __expf(-fabsf(x))); }
__device__ __forceinline__ int cond_of_seg(int pm) { return pm < 16 ? 0 : 1 + ((pm - 16) >> 3); }

namespace pg8 {
constexpr int BM = 256, BK = 64, HALF = 128, HTB = HALF * BK * 2, STAGE_BYTES = 8 * HTB, NXCD = 8, WGM = 8;
__host__ __device__ __forceinline__ int lds_byte(int r, int c) { const int st = (r >> 4) * 2 + (c >> 5), rr = r & 15, cc = c & 31, ob = rr * 64 + cc * 2; return st * 1024 + (ob ^ (((ob >> 9) & 1) << 5)); }
__host__ __device__ __forceinline__ int perm32(int rho) { const int n = rho >> 4, i = rho & 15; return 8 * (i >> 2) + 4 * n + (i & 3); }
__host__ __device__ __forceinline__ void stage_rc(int b, int& R, int& C) { const int st = b / 1024, sb = b % 1024, swz = sb ^ (((sb >> 9) & 1) << 5); R = (st >> 1) * 16 + swz / 64; C = (st & 1) * 32 + (swz % 64) / 2; }
}

enum { KD_BF16 = 0, KD_SILU, KD_RELU2, KD_LOGF, KD_RES, KD_ATOM };
enum { T_IN_EVEN = 0, T_IN_ODD, T_OUT_EVEN, T_OUT_ODD, T_MLP1, T_MLP2, T_DFT_S, T_DFT_P };
struct Unit { int pm, pn; };
struct UnitIO { const char* A; const char* B; char* out; const float* aux; int kind; int ld; };
struct GemmCfg { int type, j, l, nM, nN, ld, nt, G, c; };

__device__ __forceinline__ void make_unit(const GemmCfg& g, int pm, int pn, UnitIO& u) {
    PP Pq = (PP)__builtin_amdgcn_kernarg_segment_ptr();
    unsigned char* ws = Pq->ws;
    const size_t rowA = (size_t)pm * 256 * 1024 * 2;
    u.aux = nullptr; u.kind = KD_BF16; u.ld = 512;
    const float* modp = (const float*)(ws + OFF_MOD) + (size_t)(g.l * 5 + cond_of_seg(pm)) * 6144;
    switch (g.type) {
    case T_IN_EVEN: {
        const char* W = (const char*)(ws + OFF_WIE) + (size_t)g.j * 2560 * 1024 * 2 + (size_t)pn * 256 * 1024 * 2;
        const char* Hh = (const char*)(ws + OFF_H) + rowA;
        u.A = Hh; u.B = W;
        if (pn == 0) { u.out = (char*)(ws + OFF_QB) + (size_t)pm * 256 * 256 * 2; u.ld = 256; }
        else if (pn == 1) { u.out = (char*)(ws + OFF_KB) + (size_t)pm * 256 * 256 * 2; u.ld = 256; }
        else if (pn < 4) { u.A = W; u.B = Hh; u.out = (char*)(ws + OFF_VT) + ((size_t)(pn - 2) * 256 * NTOK + (size_t)pm * 256) * 2; u.ld = NTOK; }
        else if (pn < 6) { u.out = (char*)(ws + OFF_GATE) + ((size_t)pm * 256 * 512 + (pn - 4) * 256) * 2; u.kind = KD_SILU; }
        else if (pn < 8) { u.out = (char*)(ws + OFF_LOGF) + ((size_t)pm * 256 * 512 + (pn - 6) * 256) * 4; u.kind = KD_LOGF; u.aux = Pq->in[I_BA2] + g.j * 512 + (pn - 6) * 256; }
        else { u.out = (char*)(ws + OFF_UB) + ((size_t)pm * 256 * 512 + (pn - 8) * 256) * 2; }
    } break;
    case T_IN_ODD: {
        const char* W = (const char*)(ws + OFF_WIO) + (size_t)g.j * 2560 * 1024 * 2 + (size_t)pn * 256 * 1024 * 2;
        const char* Hh = (const char*)(ws + OFF_H) + rowA;
        u.A = Hh; u.B = W;
        if (pn < 4) {
            u.A = W; u.B = Hh;
            const int z = pn >> 1, ch0 = (pn & 1) * 256;
            if (pm < 16) { u.out = (char*)(ws + OFF_XTP) + ((size_t)(pm * 512 + ch0) * 512 + z * 256) * 2; u.ld = 512; }
            else { const int b = (pm - 16) >> 3, part = (pm - 16) & 7; u.out = (char*)(ws + OFF_XTS) + ((size_t)(b * 512 + ch0) * 4096 + z * 2048 + part * 256) * 2; u.ld = 4096; }
        } else {
            const size_t base = (pn < 6) ? OFF_XIN : (pn < 8 ? OFF_BG : OFF_CG);
            u.out = (char*)(ws + base) + ((size_t)pm * 256 * 512 + (pn & 1) * 256) * 2;
        }
    } break;
    case T_OUT_EVEN: case T_OUT_ODD: {
        u.A = (const char*)(ws + OFF_AMIX) + rowA;
        u.B = (const char*)(ws + (g.type == T_OUT_EVEN ? OFF_WOE : OFF_WOO)) + (size_t)g.j * 1024 * 1024 * 2 + (size_t)pn * 256 * 1024 * 2;
        u.out = (char*)(ws + OFF_X) + ((size_t)pm * 256 * 1024 + pn * 256) * 4; u.ld = 1024; u.kind = KD_RES; u.aux = modp + 2048 + pn * 256;
    } break;
    case T_MLP1: {
        u.A = (const char*)(ws + OFF_H) + rowA;
        u.B = (const char*)(ws + OFF_W1T) + (size_t)g.l * 4096 * 1024 * 2 + (size_t)pn * 256 * 1024 * 2;
        u.out = (char*)(ws + OFF_HID) + ((size_t)pm * 256 * 4096 + pn * 256) * 2; u.ld = 4096; u.kind = KD_RELU2;
    } break;
    case T_MLP2: {
        u.A = (const char*)(ws + OFF_HID) + (size_t)pm * 256 * 4096 * 2;
        u.B = (const char*)(ws + OFF_W2T) + (size_t)g.l * 4096 * 1024 * 2 + (size_t)pn * 256 * 4096 * 2;
        u.out = (char*)(ws + OFF_X) + ((size_t)pm * 256 * 1024 + pn * 256) * 4; u.ld = 1024; u.kind = KD_RES; u.aux = modp + 5120 + pn * 256;
    } break;
    case T_DFT_S: {
        const int pnb = pn >> 2, ks = pn & 3;
        u.A = (const char*)(ws + OFF_T2K) + ((size_t)pm * 256 * 4096 + ks * 1024) * 2;
        u.B = (const char*)(ws + OFF_XTS) + ((size_t)pnb * 256 * 4096 + ks * 1024) * 2;
        u.out = (char*)(ws + OFF_FACCS) + ((size_t)ks * 8192 * 512 + (size_t)((pnb >> 1) * 2048 + pm * 256) * 512 + (pnb & 1) * 256) * 4; u.kind = KD_ATOM;
    } break;
    default: {
        u.A = (const char*)(ws + OFF_T256);
        u.B = (const char*)(ws + OFF_XTP) + (size_t)pn * 256 * 512 * 2;
        u.out = (char*)(ws + OFF_FACCP) + ((size_t)((pn >> 1) * 256) * 512 + (pn & 1) * 256) * 4; u.kind = KD_ATOM;
    } break;
    }
}

__device__ __forceinline__ bool next_unit(const GemmCfg& g, int i, Unit& u) {
    const int nwg = g.nM * g.nN;
    const long L = (long)i * g.G + g.c; if (L >= nwg) return false;
    int wgid = (int)L; { const int q = nwg / pg8::NXCD, r = nwg % pg8::NXCD, xcd = wgid % pg8::NXCD, off = wgid / pg8::NXCD; wgid = (xcd < r ? xcd * (q + 1) : r * (q + 1) + (xcd - r) * q) + off; }
    const int nig = pg8::WGM * g.nN, gid = wgid / nig, fm = gid * pg8::WGM, gsz = (g.nM - fm) < pg8::WGM ? (g.nM - fm) : pg8::WGM;
    const int pm = fm + ((wgid % nig) % gsz), pn = (wgid % nig) / gsz;
    u.pm = pm; u.pn = pn; return true;
}

__device__ __forceinline__ void epilogue(const f32x4 (&acc)[2][2][4][2], const GemmCfg& g, const Unit& uu, int wr, int wc, int fr, int fq) {
    UnitIO u; make_unit(g, uu.pm, uu.pn, u);
    const int row0 = wr * 64 + fr, col0 = wc * 32 + 8 * fq;
    const int kind = u.kind, ld = u.ld;
    if (kind <= KD_RELU2) {
        bf16_t* O = (bf16_t*)u.out;
#pragma unroll
        for (int ai = 0; ai < 2; ++ai)
#pragma unroll
            for (int m = 0; m < 4; ++m) {
                bf16_t* rowp = O + (size_t)(row0 + ai * 128 + m * 16) * ld + col0;
#pragma unroll
                for (int bj = 0; bj < 2; ++bj) {
                    f32x4 v0 = acc[ai][bj][m][0], v1 = acc[ai][bj][m][1];
                    if (kind == KD_SILU) { v0[0] = siluf(v0[0]); v0[1] = siluf(v0[1]); v0[2] = siluf(v0[2]); v0[3] = siluf(v0[3]); v1[0] = siluf(v1[0]); v1[1] = siluf(v1[1]); v1[2] = siluf(v1[2]); v1[3] = siluf(v1[3]); }
                    else if (kind == KD_RELU2) {
                        v0[0] = fmaxf(v0[0], 0.f); v0[1] = fmaxf(v0[1], 0.f); v0[2] = fmaxf(v0[2], 0.f); v0[3] = fmaxf(v0[3], 0.f); v0 = v0 * v0;
                        v1[0] = fmaxf(v1[0], 0.f); v1[1] = fmaxf(v1[1], 0.f); v1[2] = fmaxf(v1[2], 0.f); v1[3] = fmaxf(v1[3], 0.f); v1 = v1 * v1; }
                    u32x4 o; o.x = pk2(v0[0], v0[1]); o.y = pk2(v0[2], v0[3]); o.z = pk2(v1[0], v1[1]); o.w = pk2(v1[2], v1[3]);
                    *(u32x4*)(rowp + bj * 128) = o;
                }
            }
    } else if (kind == KD_RES) {
        float* O = (float*)u.out;
        f32x4 gv[2][2];
#pragma unroll
        for (int bj = 0; bj < 2; ++bj)
#pragma unroll
            for (int n = 0; n < 2; ++n) gv[bj][n] = *(const f32x4*)(u.aux + col0 + bj * 128 + n * 4);
#pragma unroll
        for (int ai = 0; ai < 2; ++ai)
#pragma unroll
            for (int m = 0; m < 4; ++m) {
                float* rowp = O + (size_t)(row0 + ai * 128 + m * 16) * ld + col0;
#pragma unroll
                for (int bj = 0; bj < 2; ++bj)
#pragma unroll
                    for (int n = 0; n < 2; ++n) { f32x4* p = (f32x4*)(rowp + bj * 128 + n * 4); *p = *p + gv[bj][n] * acc[ai][bj][m][n]; }
            }
    } else if (kind == KD_LOGF) {
        float* O = (float*)u.out;
#pragma unroll
        for (int bj = 0; bj < 2; ++bj)
#pragma unroll
            for (int n = 0; n < 2; ++n) {
                const f32x4 bv = *(const f32x4*)(u.aux + col0 + bj * 128 + n * 4);
#pragma unroll
                for (int ai = 0; ai < 2; ++ai)
#pragma unroll
                    for (int m = 0; m < 4; ++m) {
                        f32x4 v = acc[ai][bj][m][n] + bv;
                        v[0] = logsigmoidf(v[0]) * 0.0625f; v[1] = logsigmoidf(v[1]) * 0.0625f; v[2] = logsigmoidf(v[2]) * 0.0625f; v[3] = logsigmoidf(v[3]) * 0.0625f;
                        *(f32x4*)(O + (size_t)(row0 + ai * 128 + m * 16) * ld + col0 + bj * 128 + n * 4) = v;
                    }
            }
    } else {
        float* O = (float*)u.out;
#pragma unroll
        for (int ai = 0; ai < 2; ++ai)
#pragma unroll
            for (int m = 0; m < 4; ++m) {
                float* rowp = O + (size_t)(row0 + ai * 128 + m * 16) * ld + col0;
#pragma unroll
                for (int bj = 0; bj < 2; ++bj)
#pragma unroll
                    for (int n = 0; n < 2; ++n) {
                        *(f32x4*)(rowp + bj * 128 + n * 4) = acc[ai][bj][m][n];
                    }
            }
    }
}

__device__ __forceinline__ void gemm_phase(LAS unsigned char* lds, const GemmCfg& g) {
    using namespace pg8;
    const int tid = otid(), wid = __builtin_amdgcn_readfirstlane(tid >> 6), lane = tid & 63, wr = wid >> 2, wc = wid & 3, fr = lane & 15, fq = lane >> 4;
    const int nt = g.nt;
    unsigned voffA[2], voffB[2];
#pragma unroll
    for (int i = 0; i < 2; ++i) { int R, C; stage_rc(tid * 16 + i * 8192, R, C); const int Rb = (R & ~31) + perm32(R & 31); voffA[i] = (unsigned)(R * g.ld + C) * 2u; voffB[i] = (unsigned)(Rb * g.ld + C) * 2u; }
    const size_t kstep = (size_t)(BK * 2);
    const size_t hstepA = (size_t)HALF * g.ld * 2;
#define hstepB hstepA
    const unsigned ldsw = (unsigned)wid * 1024u;
    const int aoff = lds_byte(wr * 64 + fr, fq * 8), boff = lds_byte(wc * 32 + fr, fq * 8);
#define PG8_SA(b, h) (((b) * 2 + (h)) * HTB)
#define PG8_SB(b, h) ((4 + (b) * 2 + (h)) * HTB)
#define PG8_STAGE(bufoff, gbase, voff) do { _Pragma("unroll") for (int _i = 0; _i < 2; ++_i) \
        __builtin_amdgcn_global_load_lds((const unsigned*)((const char*)(gbase) + (voff)[_i]), (LAS unsigned*)(lds + (bufoff) + ldsw + _i * 8192), 16, 0, 0); } while (0)
#define PG8_LDA(dst, b, h) do { _Pragma("unroll") for (int m = 0; m < 4; ++m) _Pragma("unroll") for (int k = 0; k < 2; ++k) dst[m][k] = *(const LAS bf16x8*)(lds + PG8_SA(b, h) + aoff + m * 2048 + k * 1024); } while (0)
#define PG8_LDB(dst, b, h) do { _Pragma("unroll") for (int n = 0; n < 2; ++n) _Pragma("unroll") for (int k = 0; k < 2; ++k) dst[n][k] = *(const LAS bf16x8*)(lds + PG8_SB(b, h) + boff + n * 2048 + k * 1024); } while (0)
#define PG8_MMA(ai, bj, At, Bt) do { __builtin_amdgcn_s_setprio(1); _Pragma("unroll") for (int m = 0; m < 4; ++m) _Pragma("unroll") for (int n = 0; n < 2; ++n) _Pragma("unroll") for (int k = 0; k < 2; ++k) \
        acc[ai][bj][m][n] = __builtin_amdgcn_mfma_f32_16x16x32_bf16(Bt[n][k], At[m][k], acc[ai][bj][m][n], 0, 0, 0); __builtin_amdgcn_s_setprio(0); } while (0)
#define PG8_WAIT_V(n) asm volatile("s_waitcnt vmcnt(" #n ")" ::: "memory")
#define PG8_WAIT_L(n) asm volatile("s_waitcnt lgkmcnt(" #n ")" ::: "memory")
#define PG8_BAR __builtin_amdgcn_s_barrier()
#define PG8_SCHED __builtin_amdgcn_sched_barrier(0)
    Unit cur, nxt; int ui = 0;
    if (!next_unit(g, 0, cur)) return;
    f32x4 acc[2][2][4][2];
#pragma unroll
    for (int a = 0; a < 2; ++a)
#pragma unroll
        for (int b = 0; b < 2; ++b)
#pragma unroll
            for (int m = 0; m < 4; ++m)
#pragma unroll
                for (int n = 0; n < 2; ++n) acc[a][b][m][n] = (f32x4){0.f, 0.f, 0.f, 0.f};
    bf16x8 At[4][2], B0[2][2], B1[2][2];
    const char* cA; const char* cB; { UnitIO io; make_unit(g, cur.pm, cur.pn, io); cA = io.A; cB = io.B; }
    PG8_STAGE(PG8_SB(0, 0), cB, voffB); PG8_STAGE(PG8_SA(0, 0), cA, voffA); PG8_STAGE(PG8_SB(0, 1), cB + hstepB, voffB); PG8_STAGE(PG8_SA(0, 1), cA + hstepA, voffA);
    if (wr == 1) PG8_BAR;
    PG8_WAIT_V(4); PG8_BAR;
    PG8_STAGE(PG8_SB(1, 0), cB + kstep, voffB); PG8_STAGE(PG8_SA(1, 0), cA + kstep, voffA); PG8_STAGE(PG8_SB(1, 1), cB + hstepB + kstep, voffB);
    PG8_WAIT_V(6); PG8_BAR;
    for (;;) {
        const bool has_next = next_unit(g, ui + 1, nxt);
        const char* nA = cA; const char* nB = cB; if (has_next) { UnitIO io; make_unit(g, nxt.pm, nxt.pn, io); nA = io.A; nB = io.B; }
        for (int t = 0; t < nt; t += 2) {
            const bool last = (t == nt - 2);
            const char* a1 = cA + (size_t)(t + 1) * kstep;
            const char* a2 = last ? nA : cA + (size_t)(t + 2) * kstep; const char* b2 = last ? nB : cB + (size_t)(t + 2) * kstep;
            const char* a3 = a2 + kstep; const char* b3 = b2 + kstep;
            PG8_LDB(B0, 0, 0); PG8_SCHED; PG8_LDA(At, 0, 0); PG8_STAGE(PG8_SA(1, 1), a1 + hstepA, voffA);
            PG8_WAIT_L(8); PG8_BAR; PG8_WAIT_L(0); PG8_MMA(0, 0, At, B0); PG8_BAR; PG8_SCHED;
            PG8_LDB(B1, 0, 1); PG8_STAGE(PG8_SB(0, 0), b2, voffB);
            PG8_BAR; PG8_WAIT_L(0); PG8_MMA(0, 1, At, B1); PG8_BAR;
            PG8_LDA(At, 0, 1); PG8_STAGE(PG8_SA(0, 0), a2, voffA);
            PG8_BAR; PG8_WAIT_L(0); PG8_MMA(1, 0, At, B0); PG8_BAR; PG8_SCHED;
            PG8_STAGE(PG8_SB(0, 1), b2 + hstepB, voffB);
            PG8_WAIT_V(6); PG8_BAR; PG8_MMA(1, 1, At, B1); PG8_BAR;
            PG8_LDB(B0, 1, 0); PG8_SCHED; PG8_LDA(At, 1, 0); PG8_STAGE(PG8_SA(0, 1), a2 + hstepA, voffA);
            PG8_WAIT_L(8); PG8_BAR; PG8_WAIT_L(0); PG8_MMA(0, 0, At, B0); PG8_BAR; PG8_SCHED;
            PG8_LDB(B1, 1, 1); PG8_STAGE(PG8_SB(1, 0), b3, voffB);
            PG8_BAR; PG8_WAIT_L(0); PG8_MMA(0, 1, At, B1); PG8_BAR;
            PG8_LDA(At, 1, 1); PG8_STAGE(PG8_SA(1, 0), a3, voffA);
            PG8_BAR; PG8_WAIT_L(0); PG8_MMA(1, 0, At, B0); PG8_BAR; PG8_SCHED;
            PG8_STAGE(PG8_SB(1, 1), b3 + hstepB, voffB);
            PG8_WAIT_V(6); PG8_BAR; PG8_MMA(1, 1, At, B1); PG8_BAR;
        }
        epilogue(acc, g, cur, wr, wc, fr, fq);
        if (!has_next) break;
#pragma unroll
        for (int a = 0; a < 2; ++a)
#pragma unroll
            for (int b = 0; b < 2; ++b)
#pragma unroll
                for (int m = 0; m < 4; ++m)
#pragma unroll
                    for (int n = 0; n < 2; ++n) acc[a][b][m][n] = (f32x4){0.f, 0.f, 0.f, 0.f};
        cur = nxt; cA = nA; cB = nB; ++ui;
    }
    PG8_WAIT_V(0);
    if (wr == 0) PG8_BAR;
    PG8_BAR;
#undef hstepB
#undef PG8_SA
#undef PG8_SB
#undef PG8_STAGE
#undef PG8_LDA
#undef PG8_LDB
#undef PG8_MMA
#undef PG8_WAIT_V
#undef PG8_WAIT_L
#undef PG8_BAR
#undef PG8_SCHED
}

__device__ __forceinline__ void transpose_item(const float* W, int ldn, int n0, int k0, bf16_t* WT, int drow0, int ldk, float scale, LAS float* scr, int lane) {
    float tv[32];
#pragma unroll
    for (int i = 0; i < 32; ++i) { const int kk = 2 * i + (lane >> 5); tv[i] = W[(size_t)(k0 + kk) * ldn + n0 + (lane & 31)]; }
#pragma unroll
    for (int i = 0; i < 32; ++i) { const int kk = 2 * i + (lane >> 5); scr[kk * 33 + (lane & 31)] = tv[i]; }
    asm volatile("s_waitcnt lgkmcnt(0)" ::: "memory");
    const int c = lane & 7;
#pragma unroll
    for (int jx = 0; jx < 4; ++jx) {
        const int n = (lane >> 3) + 8 * jx; const LAS float* s = scr + (8 * c) * 33 + n;
        u32x4 o; o.x = pk2(s[0] * scale, s[33] * scale); o.y = pk2(s[66] * scale, s[99] * scale); o.z = pk2(s[132] * scale, s[165] * scale); o.w = pk2(s[198] * scale, s[231] * scale);
        *(u32x4*)(WT + (size_t)(drow0 + n) * ldk + k0 + 8 * c) = o;
    }
    asm volatile("s_waitcnt lgkmcnt(0)" ::: "memory");
}

__device__ __forceinline__ void convert_layer(PP P, LAS unsigned char* lds, int l, int vb, int nb) {
    const int tid = otid(), lane = tid & 63, wave = tid >> 6;
    unsigned char* ws = P->ws;
    const int j = l >> 1, odd = l & 1;
    __syncthreads();
    {
        LAS float* scr = (LAS float*)(lds + wave * 8704);
        for (int it = vb * 8 + wave; it < 5376; it += nb * 8) {
            int r = it;
            if (r < 2048) { const int kb = r / 128, nbk = r % 128;
                transpose_item(P->in[I_W1] + (size_t)l * 1024 * 4096, 4096, nbk * 32, kb * 64, (bf16_t*)(ws + OFF_W1T) + (size_t)l * 4096 * 1024, nbk * 32, 1024, 1.f, scr, lane); continue; }
            r -= 2048;
            if (r < 2048) { const int kb = r / 32, nbk = r % 32;
                transpose_item(P->in[I_W2] + (size_t)l * 4096 * 1024, 1024, nbk * 32, kb * 64, (bf16_t*)(ws + OFF_W2T) + (size_t)l * 1024 * 4096, nbk * 32, 4096, 1.f, scr, lane); continue; }
            r -= 2048;
            if (!odd) {
                if (r < 1024) { const int kb = r / 64, nbk = r % 64; const int sb = nbk < 48 ? nbk : nbk + 1; const int n0 = sb * 32; const int drow = n0 < 1536 ? n0 : n0 + 480;
                    transpose_item(P->in[I_WINE] + (size_t)j * 1024 * 2080, 2080, n0, kb * 64, (bf16_t*)(ws + OFF_WIE) + (size_t)j * 2560 * 1024, drow, 1024, n0 < 256 ? 0.125f : 1.f, scr, lane); continue; }
                r -= 1024;
                { const int kb = r / 32, nbk = r % 32;
                    transpose_item(P->in[I_WOUTE] + (size_t)j * 1024 * 1024, 1024, nbk * 32, kb * 64, (bf16_t*)(ws + OFF_WOE) + (size_t)j * 1024 * 1024, nbk * 32, 1024, 1.f, scr, lane); }
            } else {
                if (r < 768) { const int kb = r / 48, nbk = r % 48; const int n0 = 512 + nbk * 32;
                    transpose_item(P->in[I_WINO] + (size_t)j * 1024 * 2048, 2048, n0, kb * 64, (bf16_t*)(ws + OFF_WIO) + (size_t)j * 2560 * 1024, n0 + 512, 1024, 1.f, scr, lane); continue; }
                r -= 768;
                { const int kb = r / 32, nbk = r % 32;
                    transpose_item(P->in[I_WOUTO] + (size_t)j * 1024 * 1024, 1024, nbk * 32, kb * 64, (bf16_t*)(ws + OFF_WOO) + (size_t)j * 1024 * 1024, nbk * 32, 1024, 1.f, scr, lane); }
            }
        }
    }
    __syncthreads();
    if (odd) {
    {
        LAS float* wt = (LAS float*)lds;
        LAS float* tab = (LAS float*)(lds + 64 * 129 * 4);
        for (int it = vb; it < 64; it += nb) {
            const int g = (it >> 4) & 3, kb = it & 15;
            for (int idx = tid; idx < 64 * 128; idx += 512) { const int kk = idx >> 7, c = idx & 127; wt[kk * 129 + c] = P->in[I_WINO][((size_t)j * 1024 + kb * 64 + kk) * 2048 + g * 128 + c]; }
            if (tid < 128) { tab[tid] = __builtin_amdgcn_cosf((float)tid * (1.f / 128.f)); tab[128 + tid] = __builtin_amdgcn_sinf((float)tid * (1.f / 128.f)); }
            __syncthreads();
            const int li = lane & 15, lq = lane >> 4;
            f32x4 acc[2][4];
#pragma unroll
            for (int ti = 0; ti < 2; ++ti)
#pragma unroll
                for (int u = 0; u < 4; ++u) acc[ti][u] = (f32x4){0.f, 0.f, 0.f, 0.f};
            const int zm0 = 16 * (2 * wave) + li, zm1 = zm0 + 16;
            for (int sx = 0; sx < 32; ++sx) {
                const int c = 4 * sx + lq;
                const float a0 = tab[(zm0 >> 7) * 128 + (((zm0 & 127) * c) & 127)], a1 = tab[(zm1 >> 7) * 128 + (((zm1 & 127) * c) & 127)];
#pragma unroll
                for (int u = 0; u < 4; ++u) {
                    const float b = wt[(16 * u + li) * 129 + c];
                    acc[0][u] = __builtin_amdgcn_mfma_f32_16x16x4f32(a0, b, acc[0][u], 0, 0, 0);
                    acc[1][u] = __builtin_amdgcn_mfma_f32_16x16x4f32(a1, b, acc[1][u], 0, 0, 0);
                }
            }
#pragma unroll
            for (int ti = 0; ti < 2; ++ti)
#pragma unroll
                for (int r = 0; r < 4; ++r) {
                    const int zm = 16 * (2 * wave + ti) + 4 * lq + r, z = zm >> 7, m = zm & 127;
                    bf16_t* O = (bf16_t*)(ws + OFF_WIO) + (size_t)j * 2560 * 1024 + (size_t)(z * 512 + g * 128 + m) * 1024 + kb * 64 + li;
#pragma unroll
                    for (int u = 0; u < 4; ++u) O[16 * u] = f2bf(acc[ti][u][r]);
                }
            __syncthreads();
        }
    }
    } else {
    {
        LAS float* Pt = (LAS float*)lds;
        LAS float* Wd = (LAS float*)(lds + 65536);
        for (int it = vb; it < 64; it += nb) {
            const int g = (it >> 4) & 3, nbk = it & 15;
            for (int idx = tid; idx < 128 * 128; idx += 512) { const int c = idx >> 7, d = idx & 127; Pt[d * 128 + c] = P->in[I_POOLW][((size_t)(j * 4 + g) * 128 + c) * 128 + d] * P->in[I_POOLS][j * 512 + g * 128 + d]; }
            for (int idx = tid; idx < 128 * 64; idx += 512) { const int d = idx >> 6, n = idx & 63; Wd[d * 64 + n] = P->in[I_WOUTE][((size_t)j * 1024 + 512 + g * 128 + d) * 1024 + nbk * 64 + n]; }
            __syncthreads();
            const int c = tid & 127, ng = tid >> 7;
            float acc[16];
#pragma unroll
            for (int nn = 0; nn < 16; ++nn) acc[nn] = 0.f;
            for (int d = 0; d < 128; ++d) {
                const float p = Pt[d * 128 + c];
#pragma unroll
                for (int nn = 0; nn < 16; ++nn) acc[nn] += p * Wd[d * 64 + ng * 16 + nn];
            }
            bf16_t* O = (bf16_t*)(ws + OFF_WOE) + (size_t)j * 1024 * 1024 + (size_t)(nbk * 64 + ng * 16) * 1024 + 512 + g * 128 + c;
#pragma unroll
            for (int nn = 0; nn < 16; ++nn) O[(size_t)nn * 1024] = f2bf(acc[nn]);
            __syncthreads();
        }
    }
    {
        LAS float* av = (LAS float*)lds;
        LAS float* w2 = (LAS float*)(lds + 16384);
        for (int it = (vb + nb - (nb > 16 ? 16 : 0)) % nb; it < 16; it += nb) {
            const int kb = it & 15;
            for (int idx = tid; idx < 64 * 32; idx += 512) { const int kk = idx >> 5, r = idx & 31; av[kk * 33 + r] = P->in[I_WINE][((size_t)j * 1024 + kb * 64 + kk) * 2080 + 1536 + r]; }
            for (int idx = tid; idx < 8192; idx += 512) w2[idx] = P->in[I_WA2][(size_t)j * 8192 + idx];
            __syncthreads();
            const int k = tid & 63, grp = tid >> 6, z = grp >> 2, n0 = (grp & 3) * 64;
            float a[16];
#pragma unroll
            for (int r = 0; r < 16; ++r) a[r] = av[k * 33 + z * 16 + r];
            bf16_t* O = (bf16_t*)(ws + OFF_WIE) + (size_t)j * 2560 * 1024 + (size_t)(1536 + z * 256 + n0) * 1024 + kb * 64 + k;
            for (int nn = 0; nn < 64; ++nn) {
                float s = 0.f;
#pragma unroll
                for (int r = 0; r < 16; ++r) s += a[r] * w2[(z * 16 + r) * 256 + n0 + nn];
                O[(size_t)nn * 1024] = f2bf(s);
            }
            __syncthreads();
        }
    }
    }
}

__device__ __forceinline__ void tgen_part(PP P, int vb, int nb) {
    const int tid = otid(); unsigned char* ws = P->ws;
    {
        const int gt = vb * 512 + tid, GT = nb * 512;
        for (int it = gt; it < 2048 * 512 + 256 * 64; it += GT) {
            int L, k, c0; bf16_t* T; float s;
            if (it < 2048 * 512) { L = 2048; k = it >> 9; c0 = (it & 511) * 8; T = (bf16_t*)(ws + OFF_T2K); s = 1.f / 512.f; }
            else { const int r = it - 2048 * 512; L = 256; k = r >> 6; c0 = (r & 63) * 8; T = (bf16_t*)(ws + OFF_T256); s = 0.00552427172801990f; }
            const int z = c0 >= L; const int l0 = c0 - z * L; const float invL = 1.f / (float)L;
            float v[8];
#pragma unroll
            for (int e = 0; e < 8; ++e) { const int ph = (k * (l0 + e)) & (L - 1); const float fr = (float)ph * invL; v[e] = z ? -__builtin_amdgcn_sinf(fr) * s : __builtin_amdgcn_cosf(fr) * s; }
            u32x4 o; o.x = pk2(v[0], v[1]); o.y = pk2(v[2], v[3]); o.z = pk2(v[4], v[5]); o.w = pk2(v[6], v[7]);
            *(u32x4*)(T + (size_t)k * (2 * L) + c0) = o;
        }
    }
}
__device__ __forceinline__ void gemv_mod(PP P, LAS unsigned char* lds, int l, int vb, int nb) {
    const int tid = otid(); unsigned char* ws = P->ws;
    __syncthreads();
    {
        LAS float* sc = (LAS float*)lds;
        LAS float* red = (LAS float*)(lds + 20480);
        bool staged = false;
        for (int it = vb; it < 48; it += nb) {
            if (!staged) {
                for (int idx = tid; idx < 5120; idx += 512) { const int cnd = idx >> 10, k = idx & 1023; const float c = cnd == 0 ? P->in[I_CCTX][k] : P->in[I_C][(cnd - 1) * 1024 + k]; sc[idx] = siluf(c); }
                staged = true; __syncthreads();
            }
            const int cb = it, quad = tid & 31, kc = tid >> 5;
            const float* wp = P->in[I_WADA] + ((size_t)l * 1024 + kc * 64) * 6144 + cb * 128 + quad * 4;
            f32x4 a[5];
#pragma unroll
            for (int cnd = 0; cnd < 5; ++cnd) a[cnd] = (f32x4){0.f, 0.f, 0.f, 0.f};
#pragma unroll 16
            for (int kk = 0; kk < 64; ++kk) {
                const f32x4 w = *(const f32x4*)(wp + (size_t)kk * 6144);
#pragma unroll
                for (int cnd = 0; cnd < 5; ++cnd) a[cnd] += w * sc[cnd * 1024 + kc * 64 + kk];
            }
#pragma unroll
            for (int cnd = 0; cnd < 5; ++cnd) *(LAS f32x4*)(red + (kc * 5 + cnd) * 128 + quad * 4) = a[cnd];
            __syncthreads();
            for (int idx = tid; idx < 640; idx += 512) {
                const int cnd = idx >> 7, cc = idx & 127; float s = 0.f;
#pragma unroll
                for (int k2 = 0; k2 < 16; ++k2) s += red[(k2 * 5 + cnd) * 128 + cc];
                ((float*)(ws + OFF_MOD))[(size_t)(l * 5 + cnd) * 6144 + cb * 128 + cc] = s + P->in[I_BADA][l * 6144 + cb * 128 + cc];
            }
            __syncthreads();
        }
    }
    __syncthreads();
}

__device__ __forceinline__ void prep_phase(PP P, LAS unsigned char* lds) {
    const int tid = otid(), lane = tid & 63, wave = tid >> 6, G = gridDim.x, bx = obid();
    unsigned char* ws = P->ws;
    convert_layer(P, lds, 0, (bx + 64) % G, G);
    {
        float* X = (float*)(ws + OFF_X);
        for (int r = bx * 8 + wave; r < NTOK; r += G * 8) {
            if (r < NPROMPT) {
#pragma unroll
                for (int jj = 0; jj < 4; ++jj) *(f32x4*)(X + (size_t)r * 1024 + jj * 256 + lane * 4) = *(const f32x4*)(P->in[I_XP] + (size_t)r * 1024 + jj * 256 + lane * 4);
            } else {
                const int s = r - NPROMPT, t = s & 2047; const float gr = (float)(t >> 6), gc = (float)(t & 63);
#pragma unroll
                for (int jj = 0; jj < 4; ++jj) {
                    f32x4 v = *(const f32x4*)(P->in[I_XS] + (size_t)s * 1024 + jj * 256 + lane * 4);
#pragma unroll
                    for (int e = 0; e < 4; ++e) {
                        const float fq = __builtin_amdgcn_exp2f(-(float)(lane * 4 + e) * (13.287712379549449f / 256.f));
                        const float ang = (jj < 2 ? gr : gc) * fq;
                        v[e] += (jj & 1) ? __cosf(ang) : __sinf(ang);
                    }
                    *(f32x4*)(X + (size_t)r * 1024 + jj * 256 + lane * 4) = v;
                }
            }
        }
    }
    __syncthreads();
    gemv_mod(P, lds, 0, (bx + 128) % G, G);
}

__device__ __forceinline__ void norm_phase(PP P, int l, int which) {
    const int tid = otid(), lane = tid & 63, wave = tid >> 6, G = gridDim.x, bx = obid();
    unsigned char* ws = P->ws;
    const float* X = (const float*)(ws + OFF_X);
    const float* gp = which == 2 ? P->in[I_FINALG] : P->in[I_NORMG] + (size_t)(l * 2 + which) * 1024;
    f32x4 gv[4];
#pragma unroll
    for (int jj = 0; jj < 4; ++jj) gv[jj] = *(const f32x4*)(gp + jj * 256 + lane * 4);
    for (int r0 = bx * 8 + wave; r0 < NTOK; r0 += G * 16) {
        f32x4 v[2][4]; float ss[2] = {0.f, 0.f};
#pragma unroll
        for (int u = 0; u < 2; ++u) { const int r = r0 + u * G * 8; if (r < NTOK) {
#pragma unroll
            for (int jj = 0; jj < 4; ++jj) v[u][jj] = *(const f32x4*)(X + (size_t)r * 1024 + jj * 256 + lane * 4); } }
#pragma unroll
        for (int u = 0; u < 2; ++u) {
            const int r = r0 + u * G * 8; if (r >= NTOK) continue;
#pragma unroll
            for (int jj = 0; jj < 4; ++jj) ss[u] += v[u][jj][0] * v[u][jj][0] + v[u][jj][1] * v[u][jj][1] + v[u][jj][2] * v[u][jj][2] + v[u][jj][3] * v[u][jj][3];
            const float rstd = rsqrtf(wave_sum(ss[u]) * (1.f / 1024.f) + 1e-6f);
            if (which == 2) {
#pragma unroll
                for (int jj = 0; jj < 4; ++jj) *(f32x4*)(P->out + (size_t)r * 1024 + jj * 256 + lane * 4) = v[u][jj] * rstd * gv[jj];
            } else {
                const int cnd = r < NPROMPT ? 0 : 1 + ((r - NPROMPT) >> 11);
                const float* mp = (const float*)(ws + OFF_MOD) + (size_t)(l * 5 + cnd) * 6144 + which * 3072;
                bf16_t* Hh = (bf16_t*)(ws + OFF_H) + (size_t)r * 1024;
#pragma unroll
                for (int jj = 0; jj < 4; ++jj) {
                    const f32x4 sh = *(const f32x4*)(mp + jj * 256 + lane * 4), sc = *(const f32x4*)(mp + 1024 + jj * 256 + lane * 4);
                    const f32x4 y = v[u][jj] * rstd * gv[jj] * (sc + 1.f) + sh;
                    u32x2 o; o.x = pk2(y[0], y[1]); o.y = pk2(y[2], y[3]);
                    *(u32x2*)(Hh + jj * 256 + lane * 4) = o;
                }
            }
        }
    }
}

template <int W> __device__ __forceinline__ void pool_item(const bf16_t* UB, bf16_t* AM, int t, int ch) {
    int s0, L; if (t < NPROMPT) { s0 = t & ~255; L = 256; } else { s0 = NPROMPT + ((t - NPROMPT) & ~2047); L = 2048; }
    const int tl = t - s0;
    u32x4 v[W];
#pragma unroll
    for (int jx = 0; jx < W; ++jx) { int tt = tl - W / 2 + jx; tt = tt < 0 ? 0 : (tt >= L ? L - 1 : tt); v[jx] = *(const u32x4*)(UB + (size_t)(s0 + tt) * 512 + ch); }
    const u32x4 c = *(const u32x4*)(UB + (size_t)t * 512 + ch);
    float s[8];
#pragma unroll
    for (int e = 0; e < 8; ++e) s[e] = 0.f;
#pragma unroll
    for (int jx = 0; jx < W; ++jx) {
        const int tt = tl - W / 2 + jx; const float m = (tt >= 0 && tt < L) ? 1.f : 0.f;
        s[0] += m * bflo(v[jx].x); s[1] += m * bfhi(v[jx].x); s[2] += m * bflo(v[jx].y); s[3] += m * bfhi(v[jx].y);
        s[4] += m * bflo(v[jx].z); s[5] += m * bfhi(v[jx].z); s[6] += m * bflo(v[jx].w); s[7] += m * bfhi(v[jx].w);
    }
    const int lo = max(tl - W / 2, 0), hi = min(tl + W - W / 2, L);
    const float ic = 1.f / (float)(hi - lo);
    u32x4 o;
    o.x = pk2(s[0] * ic - bflo(c.x), s[1] * ic - bfhi(c.x)); o.y = pk2(s[2] * ic - bflo(c.y), s[3] * ic - bfhi(c.y));
    o.z = pk2(s[4] * ic - bflo(c.z), s[5] * ic - bfhi(c.z)); o.w = pk2(s[6] * ic - bflo(c.w), s[7] * ic - bfhi(c.w));
    *(u32x4*)(AM + (size_t)t * 1024 + 512 + ch) = o;
}
__device__ __forceinline__ void pool_phase(PP P) {
    unsigned char* ws = P->ws;
    const bf16_t* UB = (const bf16_t*)(ws + OFF_UB);
    bf16_t* AM = (bf16_t*)(ws + OFF_AMIX);
    const int tid = otid(), lane = tid & 63, wave = tid >> 6;
    for (int wi = obid() * 8 + wave; wi < 4 * (NTOK / 4); wi += gridDim.x * 8) {
        const int g = wi & 3, t = (wi >> 2) * 4 + (lane >> 4), ch = (g * 16 + (lane & 15)) * 8;
        if (g == 0) pool_item<2>(UB, AM, t, ch);
        else if (g == 1) pool_item<4>(UB, AM, t, ch);
        else if (g == 2) pool_item<8>(UB, AM, t, ch);
        else pool_item<16>(UB, AM, t, ch);
    }
}

__device__ __forceinline__ void mixprep_phase(PP P, int j) {
    const int tid = otid(), lane = tid & 63, wave = tid >> 6;
    unsigned char* ws = P->ws;
    const float* O0 = (const float*)(ws + OFF_ODIR); const float* O1 = O0 + (size_t)NTOK * 512;
    const bf16_t* GT = (const bf16_t*)(ws + OFF_GATE);
    bf16_t* AM = (bf16_t*)(ws + OFF_AMIX);
    const int ch = lane * 8;
    const f32x4 g0 = *(const f32x4*)(P->in[I_GLAG] + j * 128 + (ch & 127)), g1 = *(const f32x4*)(P->in[I_GLAG] + j * 128 + (ch & 127) + 4);
    const int G8 = gridDim.x * 8;
    for (int r0 = obid() * 8 + wave; r0 < NTOK; r0 += 2 * G8) {
        f32x4 a[2], b[2]; u32x4 gt[2];
#pragma unroll
        for (int u = 0; u < 2; ++u) { const int r = r0 + u * G8; if (r < NTOK) {
            a[u] = *(const f32x4*)(O0 + (size_t)r * 512 + ch) + *(const f32x4*)(O1 + (size_t)r * 512 + ch);
            b[u] = *(const f32x4*)(O0 + (size_t)r * 512 + ch + 4) + *(const f32x4*)(O1 + (size_t)r * 512 + ch + 4);
            gt[u] = *(const u32x4*)(GT + (size_t)r * 512 + ch); } }
#pragma unroll
        for (int u = 0; u < 2; ++u) {
            const int r = r0 + u * G8; if (r >= NTOK) continue;
            float ss = a[u][0] * a[u][0] + a[u][1] * a[u][1] + a[u][2] * a[u][2] + a[u][3] * a[u][3] + b[u][0] * b[u][0] + b[u][1] * b[u][1] + b[u][2] * b[u][2] + b[u][3] * b[u][3];
            ss += __shfl_xor(ss, 1); ss += __shfl_xor(ss, 2); ss += __shfl_xor(ss, 4); ss += __shfl_xor(ss, 8);
            const float rstd = rsqrtf(ss * (1.f / 128.f) + 1e-6f);
            const f32x4 aa = a[u] * rstd * g0, bb = b[u] * rstd * g1;
            u32x4 o;
            o.x = pk2(aa[0] * bflo(gt[u].x), aa[1] * bfhi(gt[u].x)); o.y = pk2(aa[2] * bflo(gt[u].y), aa[3] * bfhi(gt[u].y));
            o.z = pk2(bb[0] * bflo(gt[u].z), bb[1] * bfhi(gt[u].z)); o.w = pk2(bb[2] * bflo(gt[u].w), bb[3] * bfhi(gt[u].w));
            *(u32x4*)(AM + (size_t)r * 1024 + ch) = o;
        }
    }
}

__device__ __forceinline__ void conv_phase(PP P, int j) {
    unsigned char* ws = P->ws;
    const bf16_t* XI = (const bf16_t*)(ws + OFF_XIN); const bf16_t* BGp = (const bf16_t*)(ws + OFF_BG); const bf16_t* CGp = (const bf16_t*)(ws + OFF_CG);
    bf16_t* AM = (bf16_t*)(ws + OFF_AMIX);
    for (int idx = obid() * 512 + otid(); idx < NTOK * 64; idx += gridDim.x * 512) {
        const int t = idx >> 6, ch = (idx & 63) * 8;
        int s0, L; if (t < NPROMPT) { s0 = t & ~255; L = 256; } else { s0 = NPROMPT + ((t - NPROMPT) & ~2047); L = 2048; }
        const int tl = t - s0;
        float cv[8];
        { const f32x4 b0 = *(const f32x4*)(P->in[I_CONVB] + j * 512 + ch), b1 = *(const f32x4*)(P->in[I_CONVB] + j * 512 + ch + 4);
          cv[0] = b0[0]; cv[1] = b0[1]; cv[2] = b0[2]; cv[3] = b0[3]; cv[4] = b1[0]; cv[5] = b1[1]; cv[6] = b1[2]; cv[7] = b1[3]; }
#pragma unroll
        for (int jj = 0; jj < 3; ++jj) {
            const int tt = tl + jj - 1;
            if (tt < 0 || tt >= L) continue;
            const u32x4 xv = *(const u32x4*)(XI + (size_t)(s0 + tt) * 512 + ch), cg = *(const u32x4*)(CGp + (size_t)(s0 + tt) * 512 + ch);
            const f32x4 w0 = *(const f32x4*)(P->in[I_CONVW] + (size_t)(j * 3 + jj) * 512 + ch), w1 = *(const f32x4*)(P->in[I_CONVW] + (size_t)(j * 3 + jj) * 512 + ch + 4);
            cv[0] += bflo(xv.x) * bflo(cg.x) * w0[0]; cv[1] += bfhi(xv.x) * bfhi(cg.x) * w0[1]; cv[2] += bflo(xv.y) * bflo(cg.y) * w0[2]; cv[3] += bfhi(xv.y) * bfhi(cg.y) * w0[3];
            cv[4] += bflo(xv.z) * bflo(cg.z) * w1[0]; cv[5] += bfhi(xv.z) * bfhi(cg.z) * w1[1]; cv[6] += bflo(xv.w) * bflo(cg.w) * w1[2]; cv[7] += bfhi(xv.w) * bfhi(cg.w) * w1[3];
        }
        const u32x4 bg = *(const u32x4*)(BGp + (size_t)t * 512 + ch);
        u32x4 o;
        o.x = pk2(cv[0] * bflo(bg.x), cv[1] * bfhi(bg.x)); o.y = pk2(cv[2] * bflo(bg.y), cv[3] * bfhi(bg.y));
        o.z = pk2(cv[4] * bflo(bg.z), cv[5] * bfhi(bg.z)); o.w = pk2(cv[6] * bflo(bg.w), cv[7] * bfhi(bg.w));
        *(u32x4*)(AM + (size_t)t * 1024 + 512 + ch) = o;
    }
}

__device__ __forceinline__ void convert_phase(PP P) {
    unsigned char* ws = P->ws;
    bf16_t* AM = (bf16_t*)(ws + OFF_AMIX);
    for (int idx = obid() * 512 + otid(); idx < NTOK * 64; idx += gridDim.x * 512) {
        const int t = idx >> 6, ch = (idx & 63) * 8;
        f32x4 a, b;
        if (t < NPROMPT) { const float* F = (const float*)(ws + OFF_FACCP) + (size_t)t * 512 + ch; a = *(const f32x4*)F; b = *(const f32x4*)(F + 4); }
        else {
            const float* F = (const float*)(ws + OFF_FACCS) + (size_t)(t - NPROMPT) * 512 + ch;
            a = *(const f32x4*)F; b = *(const f32x4*)(F + 4);
#pragma unroll
            for (int ks = 1; ks < 4; ++ks) { a += *(const f32x4*)(F + (size_t)ks * 8192 * 512); b += *(const f32x4*)(F + (size_t)ks * 8192 * 512 + 4); }
        }
        u32x4 o; o.x = pk2(a[0], a[1]); o.y = pk2(a[2], a[3]); o.z = pk2(b[0], b[1]); o.w = pk2(b[2], b[3]);
        *(u32x4*)(AM + (size_t)t * 1024 + ch) = o;
    }
}

__device__ __forceinline__ int permd(int d) { return (d & 32) | ((d & 12) << 1) | ((d & 16) >> 2) | (d & 3); }
__device__ __forceinline__ bf16x8 pack8(const f32x4& a, const f32x4& b) {
    u32x4 o; o.x = pk2(a[0], a[1]); o.y = pk2(a[2], a[3]); o.z = pk2(b[0], b[1]); o.w = pk2(b[2], b[3]);
    return __builtin_bit_cast(bf16x8, o);
}
__device__ __forceinline__ void gla_item(PP P, LAS unsigned char* lds, int j, int seg, int head, int dir, bool full) {
    const int tid = otid(), lane = tid & 63, w = tid >> 6, r = lane & 15, q = lane >> 4;
    unsigned char* ws = P->ws;
    const bf16_t* QB = (const bf16_t*)(ws + OFF_QB); const bf16_t* KB = (const bf16_t*)(ws + OFF_KB); const bf16_t* VT = (const bf16_t*)(ws + OFF_VT);
    const float* LOGF = (const float*)(ws + OFF_LOGF);
    float* ODIR = (float*)(ws + OFF_ODIR);
    float* Ubuf = (float*)(ws + OFF_U); float* Dtot = (float*)(ws + OFF_DTOT);
    LAS bf16_t* QT = (LAS bf16_t*)(lds);
    LAS bf16_t* KT = (LAS bf16_t*)(lds + 36864);
    LAS bf16_t* KH = (LAS bf16_t*)(lds + 73728);
    LAS float* DL = (LAS float*)(lds + 114688);
    LAS bf16x8* ATT = (LAS bf16x8*)(lds + 116736);
    const int tok0 = seg * 256;
    __syncthreads();
    {
        const int d = tid & 63, c = w, pd = permd(d);
        float b = 0.f;
        const float* lf = LOGF + (size_t)(tok0 + 32 * c) * 512 + dir * 256 + head * 64 + d;
        const bf16_t* qp = QB + (size_t)(tok0 + 32 * c) * 256 + head * 64 + d;
        const bf16_t* kp = KB + (size_t)(tok0 + 32 * c) * 256 + head * 64 + d;
        float lfv[32]; bf16_t qv16[32], kv16[32];
#pragma unroll
        for (int ii = 0; ii < 32; ++ii) { const int il = dir ? 31 - ii : ii; lfv[ii] = lf[(size_t)il * 512]; qv16[ii] = qp[(size_t)il * 256]; kv16[ii] = kp[(size_t)il * 256]; }
#pragma unroll
        for (int ii = 0; ii < 32; ++ii) {
            const int il = dir ? 31 - ii : ii;
            b += lfv[ii];
            const float qv = bf2f(qv16[ii]), kv = bf2f(kv16[ii]);
            QT[(32 * c + il) * 72 + pd] = f2bf(qv * __expf(b));
            KT[(32 * c + il) * 72 + pd] = f2bf(kv * __expf(-b));
        }
        const float eT = __expf(b);
        DL[c * 64 + d] = eT;
#pragma unroll 8
        for (int il = 0; il < 32; ++il) KH[(c * 64 + d) * 40 + permd(il)] = f2bf(bf2f(KT[(32 * c + il) * 72 + pd]) * eT);
    }
    __syncthreads();
    if (full) {
        const int c = w;
        f32x4 at[2][2];
#pragma unroll
        for (int a = 0; a < 2; ++a)
#pragma unroll
            for (int b = 0; b < 2; ++b) at[a][b] = (f32x4){0.f, 0.f, 0.f, 0.f};
#pragma unroll
        for (int kk = 0; kk < 2; ++kk) {
            bf16x8 ka[2], qb[2];
#pragma unroll
            for (int t = 0; t < 2; ++t) { ka[t] = *(const LAS bf16x8*)(KT + (32 * c + 16 * t + r) * 72 + 32 * kk + 8 * q); qb[t] = *(const LAS bf16x8*)(QT + (32 * c + 16 * t + r) * 72 + 32 * kk + 8 * q); }
#pragma unroll
            for (int tj = 0; tj < 2; ++tj)
#pragma unroll
                for (int ti = 0; ti < 2; ++ti) at[tj][ti] = __builtin_amdgcn_mfma_f32_16x16x32_bf16(ka[tj], qb[ti], at[tj][ti], 0, 0, 0);
        }
#pragma unroll
        for (int ti = 0; ti < 2; ++ti) {
            const int i = 16 * ti + r;
#pragma unroll
            for (int tj = 0; tj < 2; ++tj)
#pragma unroll
                for (int jj = 0; jj < 4; ++jj) { const int jx = 16 * tj + 4 * q + jj; const bool keep = dir ? (jx >= i) : (jx <= i); if (!keep) at[tj][ti][jj] = 0.f; }
            ATT[(c * 2 + ti) * 64 + lane] = pack8(at[0][ti], at[1][ti]);
        }
    }
    __syncthreads();
    f32x4 S[4];
#pragma unroll
    for (int t = 0; t < 4; ++t) S[t] = (f32x4){0.f, 0.f, 0.f, 0.f};
    const int e = 16 * w + r;
    if (DBG_SINIT && full && seg >= 16) {
        const int sb = (seg - 16) >> 3, part = (seg - 16) & 7;
        const float* s0 = P->in[I_STATE] + ((size_t)(((sb * 2 + j) * 2 + dir) * 4 + head) * 64) * 128;
#pragma unroll
        for (int t = 0; t < 4; ++t)
#pragma unroll
            for (int jj = 0; jj < 4; ++jj) S[t][jj] = s0[(size_t)(16 * t + 4 * q + jj) * 128 + e];
        const int np = dir ? 7 - part : part;
#pragma unroll
        for (int xb = 0; xb < 8; xb += 4) {
            if (xb >= np) break;
            float dvv[4][16], uvv[4][16];
#pragma unroll
            for (int xi = 0; xi < 4; ++xi) {
                const int x = xb + xi; if (x >= 7) continue;
                const int pp = dir ? 7 - x : x;
                const size_t ib = (size_t)(((sb * 8 + pp) * 4 + head) * 2 + dir) * 64;
#pragma unroll
                for (int t = 0; t < 4; ++t)
#pragma unroll
                    for (int jj = 0; jj < 4; ++jj) { const int d = 16 * t + 4 * q + jj; dvv[xi][t * 4 + jj] = Dtot[ib + d]; uvv[xi][t * 4 + jj] = Ubuf[(ib + d) * 128 + e]; }
            }
#pragma unroll
            for (int xi = 0; xi < 4; ++xi) {
                const int x = xb + xi; if (x >= 7) continue;
                const bool on = x < np;
#pragma unroll
                for (int t = 0; t < 4; ++t)
#pragma unroll
                    for (int jj = 0; jj < 4; ++jj) S[t][jj] = on ? S[t][jj] * dvv[xi][t * 4 + jj] + uvv[xi][t * 4 + jj] : S[t][jj];
            }
        }
    }
    const bf16_t* vt = VT + (size_t)(head * 128 + e) * NTOK + tok0;
    u32x2 vpre0[8], vpre1[8];
#pragma unroll
    for (int cc = 0; cc < 8; ++cc) { const int c = dir ? 7 - cc : cc; vpre0[cc] = *(const u32x2*)(vt + 32 * c + 4 * q); vpre1[cc] = *(const u32x2*)(vt + 32 * c + 16 + 4 * q); }
#pragma unroll
    for (int cc = 0; cc < 8; ++cc) {
        const int c = dir ? 7 - cc : cc;
        const u32x2 v0 = vpre0[cc], v1 = vpre1[cc];
        u32x4 vv; vv.x = v0.x; vv.y = v0.y; vv.z = v1.x; vv.w = v1.y;
        const bf16x8 vb = __builtin_bit_cast(bf16x8, vv);
        if (full) {
            bf16x8 sb2[2];
            sb2[0] = pack8(S[0], S[1]); sb2[1] = pack8(S[2], S[3]);
#pragma unroll
            for (int mi = 0; mi < 2; ++mi) {
                f32x4 o = (f32x4){0.f, 0.f, 0.f, 0.f};
#pragma unroll
                for (int kk = 0; kk < 2; ++kk) {
                    const bf16x8 qa = *(const LAS bf16x8*)(QT + (32 * c + 16 * mi + r) * 72 + 32 * kk + 8 * q);
                    o = __builtin_amdgcn_mfma_f32_16x16x32_bf16(qa, sb2[kk], o, 0, 0, 0);
                }
                const bf16x8 aa = ATT[(c * 2 + mi) * 64 + lane];
                o = __builtin_amdgcn_mfma_f32_16x16x32_bf16(aa, vb, o, 0, 0, 0);
                float* op = ODIR + ((size_t)dir * NTOK + tok0 + 32 * c + 16 * mi + 4 * q) * 512 + head * 128 + e;
#pragma unroll
                for (int jj = 0; jj < 4; ++jj) op[(size_t)jj * 512] = o[jj];
            }
        }
#pragma unroll
        for (int t = 0; t < 4; ++t) {
            const f32x4 dv = *(const LAS f32x4*)(DL + c * 64 + 16 * t + 4 * q);
            S[t] = S[t] * dv;
            const bf16x8 ka = *(const LAS bf16x8*)(KH + (c * 64 + 16 * t + r) * 40 + 8 * q);
            S[t] = __builtin_amdgcn_mfma_f32_16x16x32_bf16(ka, vb, S[t], 0, 0, 0);
        }
    }
    if (full) {
        if (seg < 16) {
            float* so = P->out + OUT_STATE + ((size_t)(((seg * 2 + j) * 2 + dir) * 4 + head) * 64) * 128;
#pragma unroll
            for (int t = 0; t < 4; ++t)
#pragma unroll
                for (int jj = 0; jj < 4; ++jj) so[(size_t)(16 * t + 4 * q + jj) * 128 + e] = S[t][jj];
        }
    } else {
        const size_t ib = (size_t)(((seg - 16) * 4 + head) * 2 + dir) * 64;
#pragma unroll
        for (int t = 0; t < 4; ++t)
#pragma unroll
            for (int jj = 0; jj < 4; ++jj) Ubuf[(ib + 16 * t + 4 * q + jj) * 128 + e] = S[t][jj];
        if (tid < 64) { float p = 1.f;
#pragma unroll
            for (int c = 0; c < 8; ++c) p *= DL[c * 64 + tid];
            Dtot[ib + tid] = p; }
    }
}

__device__ __forceinline__ void gla_phase(PP P, LAS unsigned char* lds, int j, int sub) {
    const int G = gridDim.x;
    if (sub == 0) {
        for (int it = obid(); it < 384; it += G) {
            if (it >= 128 && it < 256) { const int pi = it - 128; gla_item(P, lds, j, pi >> 3, (pi >> 1) & 3, pi & 1, true); }
            else { const int li = it < 128 ? it : it - 128; gla_item(P, lds, j, 16 + (li >> 3), (li >> 1) & 3, li & 1, false); }
        }
    } else {
        for (int it = obid(); it < 256; it += G) gla_item(P, lds, j, 16 + (it >> 3), (it >> 1) & 3, it & 1, true);
    }
}


#define XB_TMO      128
#define XB_XCNT(j)  (256  + 64 * (j))
#define XB_XSUB(j)  (1280 + 64 * (j))
#define XB_XGEN(j)  (2304 + 64 * (j))
#define XB_TOP      3328
#define XB_TOPGEN   3392
#define XCD_BAR_WORDS 3456
#define XB_SPIN_CAP (1u << 18)

__device__ __forceinline__ unsigned xb_ld(unsigned* p)              { return __hip_atomic_load(p, __ATOMIC_RELAXED, __HIP_MEMORY_SCOPE_AGENT); }
__device__ __forceinline__ unsigned xb_add(unsigned* p, unsigned v) { return __hip_atomic_fetch_add(p, v, __ATOMIC_RELAXED, __HIP_MEMORY_SCOPE_AGENT); }
__device__ __forceinline__ unsigned xb_xcc_id() { return (unsigned)__builtin_amdgcn_s_getreg((3 << 11) | 20) & 0xFu; }
#define XB_SPIN(cond, bar) do { unsigned _sp = 0; while (cond) { __builtin_amdgcn_s_sleep(1); \
    if ((++_sp & 255u) == 0u) { if (xb_ld(&(bar)[XB_TMO])) break; if (_sp > XB_SPIN_CAP) { atomicAdd(&(bar)[XB_TMO], 1u); break; } } } } while (0)

struct XcdBarrier {
    unsigned* bar; unsigned x;
    volatile LAS unsigned* st;
};

__device__ __forceinline__ XcdBarrier xcd_barrier_post(unsigned* bar, volatile LAS unsigned* st) {
    XcdBarrier b; b.bar = bar; b.x = xb_xcc_id(); b.st = st;
    if (threadIdx.x == 0) (void)xb_add(&bar[XB_XCNT(b.x)], 1u);
    return b;
}
__device__ __forceinline__ void xcd_barrier_complete(unsigned* bar, unsigned x, unsigned& nloc, unsigned& nx) {
    const unsigned G = gridDim.x * gridDim.y * gridDim.z;
    unsigned sum, cnt, mine, sp = 0u;
    for (;;) {
        sum = 0u; cnt = 0u; mine = 0u;
#pragma unroll
        for (unsigned j = 0; j < 16; ++j) { const unsigned c = xb_ld(&bar[XB_XCNT(j)]); sum += c; cnt += (c > 0u) ? 1u : 0u; mine = (j == x) ? c : mine; }
        if (sum == G) break;
        __builtin_amdgcn_s_sleep(1);
        if ((++sp & 255u) == 0u) { if (xb_ld(&bar[XB_TMO])) break; if (sp > XB_SPIN_CAP) { atomicAdd(&bar[XB_TMO], 1u); break; } }
    }
    nloc = mine > 0u ? mine : 1u; nx = cnt > 0u ? cnt : 1u;
}

__device__ __forceinline__ void xcd_barrier(const XcdBarrier& b) {
    asm volatile("s_waitcnt vmcnt(0)" ::: "memory");
    __syncthreads();
    if (threadIdx.x == 0) {
        unsigned* bar = b.bar;
        __builtin_amdgcn_s_waitcnt(0);
        unsigned nloc = b.st[0], nx = b.st[1];
        if (nloc == 0u) { xcd_barrier_complete(bar, b.x, nloc, nx); b.st[0] = nloc; b.st[1] = nx; }
        const unsigned old = xb_add(&bar[XB_XSUB(b.x)], 1u);
        const unsigned gen = old / nloc;
        if (old + 1u == (gen + 1u) * nloc) {
            __builtin_amdgcn_fence(__ATOMIC_RELEASE, "agent");
            asm volatile("s_waitcnt vmcnt(0)" ::: "memory");
            const unsigned og = xb_add(&bar[XB_TOP], 1u);
            const unsigned tg = og / nx;
            if (og + 1u == (tg + 1u) * nx) xb_add(&bar[XB_TOPGEN], 1u);
            else XB_SPIN(xb_ld(&bar[XB_TOPGEN]) == tg, bar);
            __builtin_amdgcn_fence(__ATOMIC_ACQUIRE, "agent");
            xb_add(&bar[XB_XGEN(b.x)], 1u);
            asm volatile("s_waitcnt vmcnt(0)" ::: "memory");
        } else {
            XB_SPIN(xb_ld(&bar[XB_XGEN(b.x)]) == gen, bar);
            __builtin_amdgcn_fence(__ATOMIC_ACQUIRE, "agent");
            asm volatile("s_waitcnt vmcnt(0)" ::: "memory");
        }
    }
    __syncthreads();
}

enum { PT_PREP = 0, PT_NORM1, PT_GEMM_IN, PT_MIX_A, PT_MIX_B, PT_MIXPREP, PT_GEMM_OUT, PT_NORM2, PT_MLP1, PT_MLP2, PT_FINAL };

__global__ void __launch_bounds__(512, 2) mega_fwd(Params Pk) {
    extern __shared__ __attribute__((aligned(16))) unsigned char smem[];
    LAS unsigned char* lds = (LAS unsigned char*)smem;
#ifdef DBG_ZLDS
    for (int i = otid(); i < LDS_BYTES / 16; i += 512) ((LAS u32x4*)lds)[i] = (u32x4){0u, 0u, 0u, 0u};
    __syncthreads();
#endif
    { volatile LAS unsigned* st0 = (volatile LAS unsigned*)(lds + LDS_BYTES - 64); if (otid() < 2) st0[otid()] = 0u; }
    __syncthreads();
    XcdBarrier gbar; gbar.bar = (unsigned*)(Pk.ws + OFF_BAR); gbar.x = 0; gbar.st = (volatile LAS unsigned*)(lds + LDS_BYTES - 64);
    if (Pk.ph_hi - Pk.ph_lo > 1) gbar = xcd_barrier_post((unsigned*)(Pk.ws + OFF_BAR), (volatile LAS unsigned*)(lds + LDS_BYTES - 64));
    if (Pk.ph_hi < 0) cg::this_grid().sync();
    for (int ph = Pk.ph_lo; ph < Pk.ph_hi; ++ph) {
        PP P = (PP)__builtin_amdgcn_kernarg_segment_ptr();
        asm volatile("" : "+s"(P));
        int pt, l = 0;
        if (ph == 0) pt = PT_PREP;
        else if (ph == NPH - 1) pt = PT_FINAL;
        else {
            const int qq = ph - 1; int s;
            if (qq < 9) { l = 0; s = qq; } else if (qq < 17) { l = 1; s = qq - 9; } else if (qq < 26) { l = 2; s = qq - 17; } else { l = 3; s = qq - 26; }
            pt = (l & 1) ? (s < 4 ? s + 1 : s + 2) : s + 1;
        }
        const int j = l >> 1, odd = l & 1;
        const int nrep = (pt == REP_PT && (REP_L < 0 || l == REP_L)) ? 1 + REP_N : 1;
        for (int rep = 0; rep < nrep; ++rep) {
        int ngemm = 0; GemmCfg g; g.G = gridDim.x; g.c = obid(); g.j = j; g.l = l; g.nM = 48; g.ld = 1024; g.nt = 16; g.type = 0; g.nN = 0;
        switch (pt) {
        case PT_PREP: if (EN & 1) prep_phase(P, lds); break;
        case PT_NORM1: if (EN & 2) norm_phase(P, l, 0); break;
        case PT_GEMM_IN: ngemm = 1; g.type = odd ? T_IN_ODD : T_IN_EVEN; g.nN = 10; break;
        case PT_MIX_A: if (odd) { ngemm = 2; g.type = T_DFT_S; g.nM = 8; g.nN = 32; g.ld = 4096; g.nt = 16; } else { if (EN & 4) gla_phase(P, lds, j, 0); if (EN & 8) pool_phase(P); } break;
        case PT_MIX_B: if (odd) { if (EN & 8) convert_phase(P); } else { if (EN & 4) gla_phase(P, lds, j, 1); } break;
        case PT_MIXPREP: if (EN & 8) mixprep_phase(P, j); break;
        case PT_GEMM_OUT: ngemm = 1; g.type = odd ? T_OUT_ODD : T_OUT_EVEN; g.nN = 4; break;
        case PT_NORM2: if (EN & 2) norm_phase(P, l, 1); break;
        case PT_MLP1: ngemm = 1; g.type = T_MLP1; g.nN = 16; break;
        case PT_MLP2: ngemm = 1; g.type = T_MLP2; g.nN = 4; g.ld = 4096; g.nt = 64; break;
        default: if (EN & 2) norm_phase(P, 0, 2); break;
        }
        for (int gi = 0; gi < ngemm; ++gi) {
            if (gi == 1) { g.type = T_DFT_P; g.nM = 1; g.nN = 32; g.ld = 512; g.nt = 8; g.c = (obid() + gridDim.x - 32) % gridDim.x; }
            if (EN & 16) gemm_phase(lds, g);
        }
        if (pt == PT_MIX_A && odd && (EN & 8)) conv_phase(P, j);
        if (pt == PT_MLP2 && l < 3) { const int G2 = gridDim.x, bq = obid(); if (G2 > 192) { if (bq >= 192) { convert_layer(P, lds, l + 1, bq - 192, G2 - 192); gemv_mod(P, lds, l + 1, bq - 192, G2 - 192); if (l == 0) tgen_part(P, bq - 192, G2 - 192); } } else { convert_layer(P, lds, l + 1, bq, G2); gemv_mod(P, lds, l + 1, bq, G2); if (l == 0) tgen_part(P, bq, G2); } }
        if (ph + 1 < Pk.ph_hi || rep + 1 < nrep) xcd_barrier(gbar);
        }

    }
}


#ifdef DBG_K
__device__ __forceinline__ float dgst(unsigned u) { return (float)(u & 0xffffu) + (float)(u >> 16); }
__global__ void dbg_dump(float* out, const unsigned char* ws) {
    const unsigned* Xu = (const unsigned*)(ws + OFF_X); const unsigned* Hu = (const unsigned*)(ws + OFF_H); const unsigned* Au = (const unsigned*)(ws + OFF_AMIX);
    const unsigned* Bu = (const unsigned*)(ws + OFF_BIG); const unsigned* Uu = (const unsigned*)(ws + OFF_U); const unsigned* Wu = (const unsigned*)(ws);
    for (size_t i = (size_t)blockIdx.x * blockDim.x + threadIdx.x; i < (size_t)NTOK * 1024; i += (size_t)gridDim.x * blockDim.x) {
        float v = 0.f;
        if (DBG_SEL & 1) v += dgst(Xu[i]);
        if (DBG_SEL & 2) v += dgst(Hu[i % 6291456]);
        if (DBG_SEL & 4) v += dgst(Au[i % 6291456]);
        if (DBG_SEL & 8) v += dgst(Bu[i]) + dgst(Bu[i + 12582912]) + dgst(Bu[(i + 25165824) % 34603008]);
        if (DBG_SEL & 16) v += dgst(Uu[i % 2113536]);
        if (DBG_SEL & 32) v += dgst(Wu[i]) + dgst(Wu[i + 12582912]) + dgst(Wu[(i + 25165824) % 28573696]);
        out[i] = v;
    }
}
#endif
extern "C" void kernel_launch(void* const* d_in, const int* in_sizes, int n_in, void* d_out, int out_size, void* d_ws, size_t ws_size, hipStream_t stream) {
    static int grid = 0;
    if (grid == 0) {
        if (n_in != 22 || ws_size < WS_NEED) { fprintf(stderr, "kernel_launch: unexpected n_in %d / ws_size %zu (need %zu)\n", n_in, ws_size, (size_t)WS_NEED); grid = -1; return; }
        int dev = 0, cus = 0, per_cu = 0;
        hipGetDevice(&dev);
        hipDeviceGetAttribute(&cus, hipDeviceAttributeMultiprocessorCount, dev);
        if (hipFuncSetAttribute((const void*)mega_fwd, hipFuncAttributeMaxDynamicSharedMemorySize, LDS_BYTES) != hipSuccess) { fprintf(stderr, "kernel_launch: hipFuncSetAttribute failed\n"); grid = -1; return; }
        hipOccupancyMaxActiveBlocksPerMultiprocessor(&per_cu, (const void*)mega_fwd, 512, LDS_BYTES);
        if (per_cu < 1) { fprintf(stderr, "kernel_launch: occupancy query says %d blocks/CU\n", per_cu); per_cu = 1; }
        (void)hipGetLastError();
        grid = cus;
    }
    if (grid < 0) return;
    Params p{};
    for (int i = 0; i < 22; ++i) p.in[i] = (const float*)d_in[i];
    p.out = (float*)d_out; p.ws = (unsigned char*)d_ws;
#if MULTI_LAUNCH
#ifdef DBG_K
    for (int ph = 0; ph < DBG_K; ++ph) {
        p.ph_lo = ph; p.ph_hi = ph + 1;
        hipLaunchKernelGGL(mega_fwd, dim3(grid), dim3(512), LDS_BYTES, stream, p);
    }
    hipLaunchKernelGGL(dbg_dump, dim3(2048), dim3(256), 0, stream, (float*)d_out, (const unsigned char*)d_ws);
#else
    for (int ph = 0; ph < NPH; ++ph) {
        p.ph_lo = ph; p.ph_hi = ph + 1;
        hipLaunchKernelGGL(mega_fwd, dim3(grid), dim3(512), LDS_BYTES, stream, p);
    }
#endif
#else
    p.ph_lo = 0; p.ph_hi = NPH;
    if (hipMemsetAsync((char*)d_ws + OFF_BAR, 0, 16384, stream) != hipSuccess) { fprintf(stderr, "kernel_launch: memset of barrier word failed\n"); return; }
    void* args[] = {&p};
    hipError_t e = hipLaunchCooperativeKernel((const void*)mega_fwd, dim3(grid), dim3(512), args, LDS_BYTES, stream);
    if (e != hipSuccess) fprintf(stderr, "cooperative launch failed: %s (grid %d)\n", hipGetErrorString(e), grid);
#endif
}
```

```cpp
#include <hip/hip_runtime.h>
#include <hip/hip_cooperative_groups.h>
#include <cstdio>
#include <cstdint>
namespace cg = cooperative_groups;

#ifndef DBG_SEL
#define DBG_SEL 63
#endif
#ifndef DBG_NP
#define DBG_NP(x) (x)
#endif
#ifndef REP_PT
#define REP_PT -1
#endif
#ifndef REP_L
#define REP_L -1
#endif
#ifndef REP_N
#define REP_N 1
#endif
#ifndef XSYNC
#define XSYNC 0
#endif
#ifndef DBG_SINIT
#define DBG_SINIT 1
#endif
#ifndef EN
#define EN 31
#endif
#ifndef MULTI_LAUNCH
#define MULTI_LAUNCH 0
#endif

#define LAS __attribute__((address_space(3)))
typedef unsigned short bf16_t;
typedef short bf16x8 __attribute__((ext_vector_type(8)));
typedef float f32x4 __attribute__((ext_vector_type(4)));
typedef unsigned u32x2 __attribute__((ext_vector_type(2)));
typedef unsigned u32x4 __attribute__((ext_vector_type(4)));

constexpr int DM = 1024, NTOK = 12288, NPROMPT = 4096, DFF = 4096;
constexpr int LDS_BYTES = 147456;
constexpr int NPH = 36;
constexpr size_t MBy = 1048576;
constexpr size_t OFF_W1T = 0, OFF_W2T = 32 * MBy, OFF_WIE = 64 * MBy, OFF_WOE = 74 * MBy, OFF_WIO = 78 * MBy, OFF_WOO = 88 * MBy;
constexpr size_t OFF_T2K = 92 * MBy, OFF_T256 = 108 * MBy, OFF_MOD = 108 * MBy + 262144, OFF_U = 109 * MBy, OFF_DTOT = 117 * MBy;
constexpr size_t OFF_X = 118 * MBy, OFF_H = 166 * MBy, OFF_AMIX = 190 * MBy, OFF_BIG = 214 * MBy, WS_NEED = 348 * MBy;
constexpr size_t OFF_HID = OFF_BIG;
constexpr size_t OFF_QB = OFF_BIG, OFF_KB = OFF_BIG + 6 * MBy, OFF_VT = OFF_BIG + 12 * MBy, OFF_GATE = OFF_BIG + 24 * MBy, OFF_LOGF = OFF_BIG + 36 * MBy;
constexpr size_t OFF_UB = OFF_BIG + 60 * MBy, OFF_ODIR = OFF_BIG + 72 * MBy;
constexpr size_t OFF_XTS = OFF_BIG, OFF_XTP = OFF_BIG + 16 * MBy, OFF_XIN = OFF_BIG + 24 * MBy, OFF_BG = OFF_BIG + 36 * MBy, OFF_CG = OFF_BIG + 48 * MBy;
constexpr size_t OFF_FACCP = OFF_BIG + 60 * MBy, OFF_FACCS = OFF_BIG + 68 * MBy;
constexpr size_t OFF_BAR = 117 * MBy + 524288;
constexpr size_t OUT_STATE = (size_t)NTOK * DM;

struct Params { const float* in[22]; float* out; unsigned char* ws; int ph_lo, ph_hi; };
typedef const __attribute__((address_space(4))) Params* PP;
enum { I_XP = 0, I_XS, I_STATE, I_C, I_CCTX, I_NORMG, I_FINALG, I_WADA, I_BADA, I_W1, I_W2, I_WINE, I_WA2, I_BA2, I_GLAG, I_POOLW, I_POOLS, I_WOUTE, I_WINO, I_CONVW, I_CONVB, I_WOUTO };

__device__ __forceinline__ int otid() { int t = __builtin_amdgcn_workitem_id_x(); asm volatile("" : "+v"(t)); return t; }
__device__ __forceinline__ int obid() { int b = __builtin_amdgcn_workgroup_id_x(); asm volatile("" : "+s"(b)); return b; }
typedef float f32x2 __attribute__((ext_vector_type(2)));
typedef __bf16 bf16x2v __attribute__((ext_vector_type(2)));
__device__ __forceinline__ unsigned pk2(float lo, float hi) { f32x2 v = {lo, hi}; bf16x2v b = __builtin_convertvector(v, bf16x2v); return __builtin_bit_cast(unsigned, b); }
__device__ __forceinline__ bf16_t f2bf(float x) { return (bf16_t)(pk2(x, 0.f) & 0xffffu); }
__device__ __forceinline__ float bf2f(bf16_t u) { return __uint_as_float(((unsigned)u) << 16); }
__device__ __forceinline__ float bflo(unsigned u) { return __uint_as_float(u << 16); }
__device__ __forceinline__ float bfhi(unsigned u) { return __uint_as_float(u & 0xffff0000u); }
__device__ __forceinline__ float wave_sum(float v) {
#pragma unroll
    for (int o = 1; o < 64; o <<= 1) v += __shfl_xor(v, o);
    return v;
}
__device__ __forceinline__ float siluf(float x) { return x * __builtin_amdgcn_rcpf(1.f + __expf(-x)); }
__device__ __forceinline__ float logsigmoidf(float x) { return fminf(x, 0.f) - __logf(1.f + __expf(-fabsf(x))); }
__device__ __forceinline__ int cond_of_seg(int pm) { return pm < 16 ? 0 : 1 + ((pm - 16) >> 3); }

namespace pg8 {
constexpr int BM = 256, BK = 64, HALF = 128, HTB = HALF * BK * 2, STAGE_BYTES = 8 * HTB, NXCD = 8, WGM = 8;
__host__ __device__ __forceinline__ int lds_byte(int r, int c) { const int st = (r >> 4) * 2 + (c >> 5), rr = r & 15, cc = c & 31, ob = rr * 64 + cc * 2; return st * 1024 + (ob ^ (((ob >> 9) & 1) << 5)); }
__host__ __device__ __forceinline__ int perm32(int rho) { const int n = rho >> 4, i = rho & 15; return 8 * (i >> 2) + 4 * n + (i & 3); }
__host__ __device__ __forceinline__ void stage_rc(int b, int& R, int& C) { const int st = b / 1024, sb = b % 1024, swz = sb ^ (((sb >> 9) & 1) << 5); R = (st >> 1) * 16 + swz / 64; C = (st & 1) * 32 + (swz % 64) / 2; }
}

enum { KD_BF16 = 0, KD_SILU, KD_RELU2, KD_LOGF, KD_RES, KD_ATOM };
enum { T_IN_EVEN = 0, T_IN_ODD, T_OUT_EVEN, T_OUT_ODD, T_MLP1, T_MLP2, T_DFT_S, T_DFT_P };
struct Unit { int pm, pn; };
struct UnitIO { const char* A; const char* B; char* out; const float* aux; int kind; int ld; };
struct GemmCfg { int type, j, l, nM, nN, ld, nt, G, c; };

__device__ __forceinline__ void make_unit(const GemmCfg& g, int pm, int pn, UnitIO& u) {
    PP Pq = (PP)__builtin_amdgcn_kernarg_segment_ptr();
    unsigned char* ws = Pq->ws;
    const size_t rowA = (size_t)pm * 256 * 1024 * 2;
    u.aux = nullptr; u.kind = KD_BF16; u.ld = 512;
    const float* modp = (const float*)(ws + OFF_MOD) + (size_t)(g.l * 5 + cond_of_seg(pm)) * 6144;
    switch (g.type) {
    case T_IN_EVEN: {
        const char* W = (const char*)(ws + OFF_WIE) + (size_t)g.j * 2560 * 1024 * 2 + (size_t)pn * 256 * 1024 * 2;
        const char* Hh = (const char*)(ws + OFF_H) + rowA;
        u.A = Hh; u.B = W;
        if (pn == 0) { u.out = (char*)(ws + OFF_QB) + (size_t)pm * 256 * 256 * 2; u.ld = 256; }
        else if (pn == 1) { u.out = (char*)(ws + OFF_KB) + (size_t)pm * 256 * 256 * 2; u.ld = 256; }
        else if (pn < 4) { u.A = W; u.B = Hh; u.out = (char*)(ws + OFF_VT) + ((size_t)(pn - 2) * 256 * NTOK + (size_t)pm * 256) * 2; u.ld = NTOK; }
        else if (pn < 6) { u.out = (char*)(ws + OFF_GATE) + ((size_t)pm * 256 * 512 + (pn - 4) * 256) * 2; u.kind = KD_SILU; }
        else if (pn < 8) { u.out = (char*)(ws + OFF_LOGF) + ((size_t)pm * 256 * 512 + (pn - 6) * 256) * 4; u.kind = KD_LOGF; u.aux = Pq->in[I_BA2] + g.j * 512 + (pn - 6) * 256; }
        else { u.out = (char*)(ws + OFF_UB) + ((size_t)pm * 256 * 512 + (pn - 8) * 256) * 2; }
    } break;
    case T_IN_ODD: {
        const char* W = (const char*)(ws + OFF_WIO) + (size_t)g.j * 2560 * 1024 * 2 + (size_t)pn * 256 * 1024 * 2;
        const char* Hh = (const char*)(ws + OFF_H) + rowA;
        u.A = Hh; u.B = W;
        if (pn < 4) {
            u.A = W; u.B = Hh;
            const int z = pn >> 1, ch0 = (pn & 1) * 256;
            if (pm < 16) { u.out = (char*)(ws + OFF_XTP) + ((size_t)(pm * 512 + ch0) * 512 + z * 256) * 2; u.ld = 512; }
            else { const int b = (pm - 16) >> 3, part = (pm - 16) & 7; u.out = (char*)(ws + OFF_XTS) + ((size_t)(b * 512 + ch0) * 4096 + z * 2048 + part * 256) * 2; u.ld = 4096; }
        } else {
            const size_t base = (pn < 6) ? OFF_XIN : (pn < 8 ? OFF_BG : OFF_CG);
            u.out = (char*)(ws + base) + ((size_t)pm * 256 * 512 + (pn & 1) * 256) * 2;
        }
    } break;
    case T_OUT_EVEN: case T_OUT_ODD: {
        u.A = (const char*)(ws + OFF_AMIX) + rowA;
        u.B = (const char*)(ws + (g.type == T_OUT_EVEN ? OFF_WOE : OFF_WOO)) + (size_t)g.j * 1024 * 1024 * 2 + (size_t)pn * 256 * 1024 * 2;
        u.out = (char*)(ws + OFF_X) + ((size_t)pm * 256 * 1024 + pn * 256) * 4; u.ld = 1024; u.kind = KD_RES; u.aux = modp + 2048 + pn * 256;
    } break;
    case T_MLP1: {
        u.A = (const char*)(ws + OFF_H) + rowA;
        u.B = (const char*)(ws + OFF_W1T) + (size_t)g.l * 4096 * 1024 * 2 + (size_t)pn * 256 * 1024 * 2;
        u.out = (char*)(ws + OFF_HID) + ((size_t)pm * 256 * 4096 + pn * 256) * 2; u.ld = 4096; u.kind = KD_RELU2;
    } break;
    case T_MLP2: {
        u.A = (const char*)(ws + OFF_HID) + (size_t)pm * 256 * 4096 * 2;
        u.B = (const char*)(ws + OFF_W2T) + (size_t)g.l * 4096 * 1024 * 2 + (size_t)pn * 256 * 4096 * 2;
        u.out = (char*)(ws + OFF_X) + ((size_t)pm * 256 * 1024 + pn * 256) * 4; u.ld = 1024; u.kind = KD_RES; u.aux = modp + 5120 + pn * 256;
    } break;
    case T_DFT_S: {
        const int pnb = pn >> 2, ks = pn & 3;
        u.A = (const char*)(ws + OFF_T2K) + ((size_t)pm * 256 * 4096 + ks * 1024) * 2;
        u.B = (const char*)(ws + OFF_XTS) + ((size_t)pnb * 256 * 4096 + ks * 1024) * 2;
        u.out = (char*)(ws + OFF_FACCS) + ((size_t)ks * 8192 * 512 + (size_t)((pnb >> 1) * 2048 + pm * 256) * 512 + (pnb & 1) * 256) * 4; u.kind = KD_ATOM;
    } break;
    default: {
        u.A = (const char*)(ws + OFF_T256);
        u.B = (const char*)(ws + OFF_XTP) + (size_t)pn * 256 * 512 * 2;
        u.out = (char*)(ws + OFF_FACCP) + ((size_t)((pn >> 1) * 256) * 512 + (pn & 1) * 256) * 4; u.kind = KD_ATOM;
    } break;
    }
}

__device__ __forceinline__ bool next_unit(const GemmCfg& g, int i, Unit& u) {
    const int nwg = g.nM * g.nN;
    const long L = (long)i * g.G + g.c; if (L >= nwg) return false;
    int wgid = (int)L; { const int q = nwg / pg8::NXCD, r = nwg % pg8::NXCD, xcd = wgid % pg8::NXCD, off = wgid / pg8::NXCD; wgid = (xcd < r ? xcd * (q + 1) : r * (q + 1) + (xcd - r) * q) + off; }
    const int nig = pg8::WGM * g.nN, gid = wgid / nig, fm = gid * pg8::WGM, gsz = (g.nM - fm) < pg8::WGM ? (g.nM - fm) : pg8::WGM;
    const int pm = fm + ((wgid % nig) % gsz), pn = (wgid % nig) / gsz;
    u.pm = pm; u.pn = pn; return true;
}

__device__ __forceinline__ void epilogue(const f32x4 (&acc)[2][2][4][2], const GemmCfg& g, const Unit& uu, int wr, int wc, int fr, int fq) {
    UnitIO u; make_unit(g, uu.pm, uu.pn, u);
    const int row0 = wr * 64 + fr, col0 = wc * 32 + 8 * fq;
    const int kind = u.kind, ld = u.ld;
    if (kind <= KD_RELU2) {
        bf16_t* O = (bf16_t*)u.out;
#pragma unroll
        for (int ai = 0; ai < 2; ++ai)
#pragma unroll
            for (int m = 0; m < 4; ++m) {
                bf16_t* rowp = O + (size_t)(row0 + ai * 128 + m * 16) * ld + col0;
#pragma unroll
                for (int bj = 0; bj < 2; ++bj) {
                    f32x4 v0 = acc[ai][bj][m][0], v1 = acc[ai][bj][m][1];
                    if (kind == KD_SILU) { v0[0] = siluf(v0[0]); v0[1] = siluf(v0[1]); v0[2] = siluf(v0[2]); v0[3] = siluf(v0[3]); v1[0] = siluf(v1[0]); v1[1] = siluf(v1[1]); v1[2] = siluf(v1[2]); v1[3] = siluf(v1[3]); }
                    else if (kind == KD_RELU2) {
                        v0[0] = fmaxf(v0[0], 0.f); v0[1] = fmaxf(v0[1], 0.f); v0[2] = fmaxf(v0[2], 0.f); v0[3] = fmaxf(v0[3], 0.f); v0 = v0 * v0;
                        v1[0] = fmaxf(v1[0], 0.f); v1[1] = fmaxf(v1[1], 0.f); v1[2] = fmaxf(v1[2], 0.f); v1[3] = fmaxf(v1[3], 0.f); v1 = v1 * v1; }
                    u32x4 o; o.x = pk2(v0[0], v0[1]); o.y = pk2(v0[2], v0[3]); o.z = pk2(v1[0], v1[1]); o.w = pk2(v1[2], v1[3]);
                    *(u32x4*)(rowp + bj * 128) = o;
                }
            }
    } else if (kind == KD_RES) {
        float* O = (float*)u.out;
        f32x4 gv[2][2];
#pragma unroll
        for (int bj = 0; bj < 2; ++bj)
#pragma unroll
            for (int n = 0; n < 2; ++n) gv[bj][n] = *(const f32x4*)(u.aux + col0 + bj * 128 + n * 4);
#pragma unroll
        for (int ai = 0; ai < 2; ++ai)
#pragma unroll
            for (int m = 0; m < 4; ++m) {
                float* rowp = O + (size_t)(row0 + ai * 128 + m * 16) * ld + col0;
#pragma unroll
                for (int bj = 0; bj < 2; ++bj)
#pragma unroll
                    for (int n = 0; n < 2; ++n) { f32x4* p = (f32x4*)(rowp + bj * 128 + n * 4); *p = *p + gv[bj][n] * acc[ai][bj][m][n]; }
            }
    } else if (kind == KD_LOGF) {
        float* O = (float*)u.out;
#pragma unroll
        for (int bj = 0; bj < 2; ++bj)
#pragma unroll
            for (int n = 0; n < 2; ++n) {
                const f32x4 bv = *(const f32x4*)(u.aux + col0 + bj * 128 + n * 4);
#pragma unroll
                for (int ai = 0; ai < 2; ++ai)
#pragma unroll
                    for (int m = 0; m < 4; ++m) {
                        f32x4 v = acc[ai][bj][m][n] + bv;
                        v[0] = logsigmoidf(v[0]) * 0.0625f; v[1] = logsigmoidf(v[1]) * 0.0625f; v[2] = logsigmoidf(v[2]) * 0.0625f; v[3] = logsigmoidf(v[3]) * 0.0625f;
                        *(f32x4*)(O + (size_t)(row0 + ai * 128 + m * 16) * ld + col0 + bj * 128 + n * 4) = v;
                    }
            }
    } else {
        float* O = (float*)u.out;
#pragma unroll
        for (int ai = 0; ai < 2; ++ai)
#pragma unroll
            for (int m = 0; m < 4; ++m) {
                float* rowp = O + (size_t)(row0 + ai * 128 + m * 16) * ld + col0;
#pragma unroll
                for (int bj = 0; bj < 2; ++bj)
#pragma unroll
                    for (int n = 0; n < 2; ++n) {
                        *(f32x4*)(rowp + bj * 128 + n * 4) = acc[ai][bj][m][n];
                    }
            }
    }
}

__device__ __forceinline__ void gemm_phase(LAS unsigned char* lds, const GemmCfg& g) {
    using namespace pg8;
    const int tid = otid(), wid = __builtin_amdgcn_readfirstlane(tid >> 6), lane = tid & 63, wr = wid >> 2, wc = wid & 3, fr = lane & 15, fq = lane >> 4;
    const int nt = g.nt;
    unsigned voffA[2], voffB[2];
#pragma unroll
    for (int i = 0; i < 2; ++i) { int R, C; stage_rc(tid * 16 + i * 8192, R, C); const int Rb = (R & ~31) + perm32(R & 31); voffA[i] = (unsigned)(R * g.ld + C) * 2u; voffB[i] = (unsigned)(Rb * g.ld + C) * 2u; }
    const size_t kstep = (size_t)(BK * 2);
    const size_t hstepA = (size_t)HALF * g.ld * 2;
#define hstepB hstepA
    const unsigned ldsw = (unsigned)wid * 1024u;
    const int aoff = lds_byte(wr * 64 + fr, fq * 8), boff = lds_byte(wc * 32 + fr, fq * 8);
#define PG8_SA(b, h) (((b) * 2 + (h)) * HTB)
#define PG8_SB(b, h) ((4 + (b) * 2 + (h)) * HTB)
#define PG8_STAGE(bufoff, gbase, voff) do { _Pragma("unroll") for (int _i = 0; _i < 2; ++_i) \
        __builtin_amdgcn_global_load_lds((const unsigned*)((const char*)(gbase) + (voff)[_i]), (LAS unsigned*)(lds + (bufoff) + ldsw + _i * 8192), 16, 0, 0); } while (0)
#define PG8_LDA(dst, b, h) do { _Pragma("unroll") for (int m = 0; m < 4; ++m) _Pragma("unroll") for (int k = 0; k < 2; ++k) dst[m][k] = *(const LAS bf16x8*)(lds + PG8_SA(b, h) + aoff + m * 2048 + k * 1024); } while (0)
#define PG8_LDB(dst, b, h) do { _Pragma("unroll") for (int n = 0; n < 2; ++n) _Pragma("unroll") for (int k = 0; k < 2; ++k) dst[n][k] = *(const LAS bf16x8*)(lds + PG8_SB(b, h) + boff + n * 2048 + k * 1024); } while (0)
#define PG8_MMA(ai, bj, At, Bt) do { __builtin_amdgcn_s_setprio(1); _Pragma("unroll") for (int m = 0; m < 4; ++m) _Pragma("unroll") for (int n = 0; n < 2; ++n) _Pragma("unroll") for (int k = 0; k < 2; ++k) \
        acc[ai][bj][m][n] = __builtin_amdgcn_mfma_f32_16x16x32_bf16(Bt[n][k], At[m][k], acc[ai][bj][m][n], 0, 0, 0); __builtin_amdgcn_s_setprio(0); } while (0)
#define PG8_WAIT_V(n) asm volatile("s_waitcnt vmcnt(" #n ")" ::: "memory")
#define PG8_WAIT_L(n) asm volatile("s_waitcnt lgkmcnt(" #n ")" ::: "memory")
#define PG8_BAR __builtin_amdgcn_s_barrier()
#define PG8_SCHED __builtin_amdgcn_sched_barrier(0)
    Unit cur, nxt; int ui = 0;
    if (!next_unit(g, 0, cur)) return;
    f32x4 acc[2][2][4][2];
#pragma unroll
    for (int a = 0; a < 2; ++a)
#pragma unroll
        for (int b = 0; b < 2; ++b)
#pragma unroll
            for (int m = 0; m < 4; ++m)
#pragma unroll
                for (int n = 0; n < 2; ++n) acc[a][b][m][n] = (f32x4){0.f, 0.f, 0.f, 0.f};
    bf16x8 At[4][2], B0[2][2], B1[2][2];
    const char* cA; const char* cB; { UnitIO io; make_unit(g, cur.pm, cur.pn, io); cA = io.A; cB = io.B; }
    PG8_STAGE(PG8_SB(0, 0), cB, voffB); PG8_STAGE(PG8_SA(0, 0), cA, voffA); PG8_STAGE(PG8_SB(0, 1), cB + hstepB, voffB); PG8_STAGE(PG8_SA(0, 1), cA + hstepA, voffA);
    if (wr == 1) PG8_BAR;
    PG8_WAIT_V(4); PG8_BAR;
    PG8_STAGE(PG8_SB(1, 0), cB + kstep, voffB); PG8_STAGE(PG8_SA(1, 0), cA + kstep, voffA); PG8_STAGE(PG8_SB(1, 1), cB + hstepB + kstep, voffB);
    PG8_WAIT_V(6); PG8_BAR;
    for (;;) {
        const bool has_next = next_unit(g, ui + 1, nxt);
        const char* nA = cA; const char* nB = cB; if (has_next) { UnitIO io; make_unit(g, nxt.pm, nxt.pn, io); nA = io.A; nB = io.B; }
        for (int t = 0; t < nt; t += 2) {
            const bool last = (t == nt - 2);
            const char* a1 = cA + (size_t)(t + 1) * kstep;
            const char* a2 = last ? nA : cA + (size_t)(t + 2) * kstep; const char* b2 = last ? nB : cB + (size_t)(t + 2) * kstep;
            const char* a3 = a2 + kstep; const char* b3 = b2 + kstep;
            PG8_LDB(B0, 0, 0); PG8_SCHED; PG8_LDA(At, 0, 0); PG8_STAGE(PG8_SA(1, 1), a1 + hstepA, voffA);
            PG8_WAIT_L(8); PG8_BAR; PG8_WAIT_L(0); PG8_MMA(0, 0, At, B0); PG8_BAR; PG8_SCHED;
            PG8_LDB(B1, 0, 1); PG8_STAGE(PG8_SB(0, 0), b2, voffB);
            PG8_BAR; PG8_WAIT_L(0); PG8_MMA(0, 1, At, B1); PG8_BAR;
            PG8_LDA(At, 0, 1); PG8_STAGE(PG8_SA(0, 0), a2, voffA);
            PG8_BAR; PG8_WAIT_L(0); PG8_MMA(1, 0, At, B0); PG8_BAR; PG8_SCHED;
            PG8_STAGE(PG8_SB(0, 1), b2 + hstepB, voffB);
            PG8_WAIT_V(6); PG8_BAR; PG8_MMA(1, 1, At, B1); PG8_BAR;
            PG8_LDB(B0, 1, 0); PG8_SCHED; PG8_LDA(At, 1, 0); PG8_STAGE(PG8_SA(0, 1), a2 + hstepA, voffA);
            PG8_WAIT_L(8); PG8_BAR; PG8_WAIT_L(0); PG8_MMA(0, 0, At, B0); PG8_BAR; PG8_SCHED;
            PG8_LDB(B1, 1, 1); PG8_STAGE(PG8_SB(1, 0), b3, voffB);
            PG8_BAR; PG8_WAIT_L(0); PG8_MMA(0, 1, At, B1); PG8_BAR;
            PG8_LDA(At, 1, 1); PG8_STAGE(PG8_SA(1, 0), a3, voffA);
            PG8_BAR; PG8_WAIT_L(0); PG8_MMA(1, 0, At, B0); PG8_BAR; PG8_SCHED;
            PG8_STAGE(PG8_SB(1, 1), b3 + hstepB, voffB);
            PG8_WAIT_V(6); PG8_BAR; PG8_MMA(1, 1, At, B1); PG8_BAR;
        }
        epilogue(acc, g, cur, wr, wc, fr, fq);
        if (!has_next) break;
#pragma unroll
        for (int a = 0; a < 2; ++a)
#pragma unroll
            for (int b = 0; b < 2; ++b)
#pragma unroll
                for (int m = 0; m < 4; ++m)
#pragma unroll
                    for (int n = 0; n < 2; ++n) acc[a][b][m][n] = (f32x4){0.f, 0.f, 0.f, 0.f};
        cur = nxt; cA = nA; cB = nB; ++ui;
    }
    PG8_WAIT_V(0);
    if (wr == 0) PG8_BAR;
    PG8_BAR;
#undef hstepB
#undef PG8_SA
#undef PG8_SB
#undef PG8_STAGE
#undef PG8_LDA
#undef PG8_LDB
#undef PG8_MMA
#undef PG8_WAIT_V
#undef PG8_WAIT_L
#undef PG8_BAR
#undef PG8_SCHED
}

__device__ __forceinline__ void transpose_item(const float* W, int ldn, int n0, int k0, bf16_t* WT, int drow0, int ldk, float scale, LAS float* scr, int lane) {
    float tv[32];
#pragma unroll
    for (int i = 0; i < 32; ++i) { const int kk = 2 * i + (lane >> 5); tv[i] = W[(size_t)(k0 + kk) * ldn + n0 + (lane & 31)]; }
#pragma unroll
    for (int i = 0; i < 32; ++i) { const int kk = 2 * i + (lane >> 5); scr[kk * 33 + (lane & 31)] = tv[i]; }
    asm volatile("s_waitcnt lgkmcnt(0)" ::: "memory");
    const int c = lane & 7;
#pragma unroll
    for (int jx = 0; jx < 4; ++jx) {
        const int n = (lane >> 3) + 8 * jx; const LAS float* s = scr + (8 * c) * 33 + n;
        u32x4 o; o.x = pk2(s[0] * scale, s[33] * scale); o.y = pk2(s[66] * scale, s[99] * scale); o.z = pk2(s[132] * scale, s[165] * scale); o.w = pk2(s[198] * scale, s[231] * scale);
        *(u32x4*)(WT + (size_t)(drow0 + n) * ldk + k0 + 8 * c) = o;
    }
    asm volatile("s_waitcnt lgkmcnt(0)" ::: "memory");
}

__device__ __forceinline__ void convert_layer(PP P, LAS unsigned char* lds, int l, int vb, int nb) {
    const int tid = otid(), lane = tid & 63, wave = tid >> 6;
    unsigned char* ws = P->ws;
    const int j = l >> 1, odd = l & 1;
    __syncthreads();
    {
        LAS float* scr = (LAS float*)(lds + wave * 8704);
        for (int it = vb * 8 + wave; it < 5376; it += nb * 8) {
            int r = it;
            if (r < 2048) { const int kb = r / 128, nbk = r % 128;
                transpose_item(P->in[I_W1] + (size_t)l * 1024 * 4096, 4096, nbk * 32, kb * 64, (bf16_t*)(ws + OFF_W1T) + (size_t)l * 4096 * 1024, nbk * 32, 1024, 1.f, scr, lane); continue; }
            r -= 2048;
            if (r < 2048) { const int kb = r / 32, nbk = r % 32;
                transpose_item(P->in[I_W2] + (size_t)l * 4096 * 1024, 1024, nbk * 32, kb * 64, (bf16_t*)(ws + OFF_W2T) + (size_t)l * 1024 * 4096, nbk * 32, 4096, 1.f, scr, lane); continue; }
            r -= 2048;
            if (!odd) {
                if (r < 1024) { const int kb = r / 64, nbk = r % 64; const int sb = nbk < 48 ? nbk : nbk + 1; const int n0 = sb * 32; const int drow = n0 < 1536 ? n0 : n0 + 480;
                    transpose_item(P->in[I_WINE] + (size_t)j * 1024 * 2080, 2080, n0, kb * 64, (bf16_t*)(ws + OFF_WIE) + (size_t)j * 2560 * 1024, drow, 1024, n0 < 256 ? 0.125f : 1.f, scr, lane); continue; }
                r -= 1024;
                { const int kb = r / 32, nbk = r % 32;
                    transpose_item(P->in[I_WOUTE] + (size_t)j * 1024 * 1024, 1024, nbk * 32, kb * 64, (bf16_t*)(ws + OFF_WOE) + (size_t)j * 1024 * 1024, nbk * 32, 1024, 1.f, scr, lane); }
            } else {
                if (r < 768) { const int kb = r / 48, nbk = r % 48; const int n0 = 512 + nbk * 32;
                    transpose_item(P->in[I_WINO] + (size_t)j * 1024 * 2048, 2048, n0, kb * 64, (bf16_t*)(ws + OFF_WIO) + (size_t)j * 2560 * 1024, n0 + 512, 1024, 1.f, scr, lane); continue; }
                r -= 768;
                { const int kb = r / 32, nbk = r % 32;
                    transpose_item(P->in[I_WOUTO] + (size_t)j * 1024 * 1024, 1024, nbk * 32, kb * 64, (bf16_t*)(ws + OFF_WOO) + (size_t)j * 1024 * 1024, nbk * 32, 1024, 1.f, scr, lane); }
            }
        }
    }
    __syncthreads();
    if (odd) {
    {
        LAS float* wt = (LAS float*)lds;
        LAS float* tab = (LAS float*)(lds + 64 * 129 * 4);
        for (int it = vb; it < 64; it += nb) {
            const int g = (it >> 4) & 3, kb = it & 15;
            for (int idx = tid; idx < 64 * 128; idx += 512) { const int kk = idx >> 7, c = idx & 127; wt[kk * 129 + c] = P->in[I_WINO][((size_t)j * 1024 + kb * 64 + kk) * 2048 + g * 128 + c]; }
            if (tid < 128) { tab[tid] = __builtin_amdgcn_cosf((float)tid * (1.f / 128.f)); tab[128 + tid] = __builtin_amdgcn_sinf((float)tid * (1.f / 128.f)); }
            __syncthreads();
            const int li = lane & 15, lq = lane >> 4;
            f32x4 acc[2][4];
#pragma unroll
            for (int ti = 0; ti < 2; ++ti)
#pragma unroll
                for (int u = 0; u < 4; ++u) acc[ti][u] = (f32x4){0.f, 0.f, 0.f, 0.f};
            const int zm0 = 16 * (2 * wave) + li, zm1 = zm0 + 16;
            for (int sx = 0; sx < 32; ++sx) {
                const int c = 4 * sx + lq;
                const float a0 = tab[(zm0 >> 7) * 128 + (((zm0 & 127) * c) & 127)], a1 = tab[(zm1 >> 7) * 128 + (((zm1 & 127) * c) & 127)];
#pragma unroll
                for (int u = 0; u < 4; ++u) {
                    const float b = wt[(16 * u + li) * 129 + c];
                    acc[0][u] = __builtin_amdgcn_mfma_f32_16x16x4f32(a0, b, acc[0][u], 0, 0, 0);
                    acc[1][u] = __builtin_amdgcn_mfma_f32_16x16x4f32(a1, b, acc[1][u], 0, 0, 0);
                }
            }
#pragma unroll
            for (int ti = 0; ti < 2; ++ti)
#pragma unroll
                for (int r = 0; r < 4; ++r) {
                    const int zm = 16 * (2 * wave + ti) + 4 * lq + r, z = zm >> 7, m = zm & 127;
                    bf16_t* O = (bf16_t*)(ws + OFF_WIO) + (size_t)j * 2560 * 1024 + (size_t)(z * 512 + g * 128 + m) * 1024 + kb * 64 + li;
#pragma unroll
                    for (int u = 0; u < 4; ++u) O[16 * u] = f2bf(acc[ti][u][r]);
                }
            __syncthreads();
        }
    }
    } else {
    {
        LAS float* Pt = (LAS float*)lds;
        LAS float* Wd = (LAS float*)(lds + 65536);
        for (int it = vb; it < 64; it += nb) {
            const int g = (it >> 4) & 3, nbk = it & 15;
            for (int idx = tid; idx < 128 * 128; idx += 512) { const int c = idx >> 7, d = idx & 127; Pt[d * 128 + c] = P->in[I_POOLW][((size_t)(j * 4 + g) * 128 + c) * 128 + d] * P->in[I_POOLS][j * 512 + g * 128 + d]; }
            for (int idx = tid; idx < 128 * 64; idx += 512) { const int d = idx >> 6, n = idx & 63; Wd[d * 64 + n] = P->in[I_WOUTE][((size_t)j * 1024 + 512 + g * 128 + d) * 1024 + nbk * 64 + n]; }
            __syncthreads();
            const int c = tid & 127, ng = tid >> 7;
            float acc[16];
#pragma unroll
            for (int nn = 0; nn < 16; ++nn) acc[nn] = 0.f;
            for (int d = 0; d < 128; ++d) {
                const float p = Pt[d * 128 + c];
#pragma unroll
                for (int nn = 0; nn < 16; ++nn) acc[nn] += p * Wd[d * 64 + ng * 16 + nn];
            }
            bf16_t* O = (bf16_t*)(ws + OFF_WOE) + (size_t)j * 1024 * 1024 + (size_t)(nbk * 64 + ng * 16) * 1024 + 512 + g * 128 + c;
#pragma unroll
            for (int nn = 0; nn < 16; ++nn) O[(size_t)nn * 1024] = f2bf(acc[nn]);
            __syncthreads();
        }
    }
    {
        LAS float* av = (LAS float*)lds;
        LAS float* w2 = (LAS float*)(lds + 16384);
        for (int it = (vb + nb - (nb > 16 ? 16 : 0)) % nb; it < 16; it += nb) {
            const int kb = it & 15;
            for (int idx = tid; idx < 64 * 32; idx += 512) { const int kk = idx >> 5, r = idx & 31; av[kk * 33 + r] = P->in[I_WINE][((size_t)j * 1024 + kb * 64 + kk) * 2080 + 1536 + r]; }
            for (int idx = tid; idx < 8192; idx += 512) w2[idx] = P->in[I_WA2][(size_t)j * 8192 + idx];
            __syncthreads();
            const int k = tid & 63, grp = tid >> 6, z = grp >> 2, n0 = (grp & 3) * 64;
            float a[16];
#pragma unroll
            for (int r = 0; r < 16; ++r) a[r] = av[k * 33 + z * 16 + r];
            bf16_t* O = (bf16_t*)(ws + OFF_WIE) + (size_t)j * 2560 * 1024 + (size_t)(1536 + z * 256 + n0) * 1024 + kb * 64 + k;
            for (int nn = 0; nn < 64; ++nn) {
                float s = 0.f;
#pragma unroll
                for (int r = 0; r < 16; ++r) s += a[r] * w2[(z * 16 + r) * 256 + n0 + nn];
                O[(size_t)nn * 1024] = f2bf(s);
            }
            __syncthreads();
        }
    }
    }
}

__device__ __forceinline__ void tgen_part(PP P, int vb, int nb) {
    const int tid = otid(); unsigned char* ws = P->ws;
    {
        const int gt = vb * 512 + tid, GT = nb * 512;
        for (int it = gt; it < 2048 * 512 + 256 * 64; it += GT) {
            int L, k, c0; bf16_t* T; float s;
            if (it < 2048 * 512) { L = 2048; k = it >> 9; c0 = (it & 511) * 8; T = (bf16_t*)(ws + OFF_T2K); s = 1.f / 512.f; }
            else { const int r = it - 2048 * 512; L = 256; k = r >> 6; c0 = (r & 63) * 8; T = (bf16_t*)(ws + OFF_T256); s = 0.00552427172801990f; }
            const int z = c0 >= L; const int l0 = c0 - z * L; const float invL = 1.f / (float)L;
            float v[8];
#pragma unroll
            for (int e = 0; e < 8; ++e) { const int ph = (k * (l0 + e)) & (L - 1); const float fr = (float)ph * invL; v[e] = z ? -__builtin_amdgcn_sinf(fr) * s : __builtin_amdgcn_cosf(fr) * s; }
            u32x4 o; o.x = pk2(v[0], v[1]); o.y = pk2(v[2], v[3]); o.z = pk2(v[4], v[5]); o.w = pk2(v[6], v[7]);
            *(u32x4*)(T + (size_t)k * (2 * L) + c0) = o;
        }
    }
}
__device__ __forceinline__ void gemv_mod(PP P, LAS unsigned char* lds, int l, int vb, int nb) {
    const int tid = otid(); unsigned char* ws = P->ws;
    __syncthreads();
    {
        LAS float* sc = (LAS float*)lds;
        LAS float* red = (LAS float*)(lds + 20480);
        bool staged = false;
        for (int it = vb; it < 48; it += nb) {
            if (!staged) {
                for (int idx = tid; idx < 5120; idx += 512) { const int cnd = idx >> 10, k = idx & 1023; const float c = cnd == 0 ? P->in[I_CCTX][k] : P->in[I_C][(cnd - 1) * 1024 + k]; sc[idx] = siluf(c); }
                staged = true; __syncthreads();
            }
            const int cb = it, quad = tid & 31, kc = tid >> 5;
            const float* wp = P->in[I_WADA] + ((size_t)l * 1024 + kc * 64) * 6144 + cb * 128 + quad * 4;
            f32x4 a[5];
#pragma unroll
            for (int cnd = 0; cnd < 5; ++cnd) a[cnd] = (f32x4){0.f, 0.f, 0.f, 0.f};
#pragma unroll 16
            for (int kk = 0; kk < 64; ++kk) {
                const f32x4 w = *(const f32x4*)(wp + (size_t)kk * 6144);
#pragma unroll
                for (int cnd = 0; cnd < 5; ++cnd) a[cnd] += w * sc[cnd * 1024 + kc * 64 + kk];
            }
#pragma unroll
            for (int cnd = 0; cnd < 5; ++cnd) *(LAS f32x4*)(red + (kc * 5 + cnd) * 128 + quad * 4) = a[cnd];
            __syncthreads();
            for (int idx = tid; idx < 640; idx += 512) {
                const int cnd = idx >> 7, cc = idx & 127; float s = 0.f;
#pragma unroll
                for (int k2 = 0; k2 < 16; ++k2) s += red[(k2 * 5 + cnd) * 128 + cc];
                ((float*)(ws + OFF_MOD))[(size_t)(l * 5 + cnd) * 6144 + cb * 128 + cc] = s + P->in[I_BADA][l * 6144 + cb * 128 + cc];
            }
            __syncthreads();
        }
    }
    __syncthreads();
}

__device__ __forceinline__ void prep_phase(PP P, LAS unsigned char* lds) {
    const int tid = otid(), lane = tid & 63, wave = tid >> 6, G = gridDim.x, bx = obid();
    unsigned char* ws = P->ws;
    convert_layer(P, lds, 0, (bx + 64) % G, G);
    {
        float* X = (float*)(ws + OFF_X);
        for (int r = bx * 8 + wave; r < NTOK; r += G * 8) {
            if (r < NPROMPT) {
#pragma unroll
                for (int jj = 0; jj < 4; ++jj) *(f32x4*)(X + (size_t)r * 1024 + jj * 256 + lane * 4) = *(const f32x4*)(P->in[I_XP] + (size_t)r * 1024 + jj * 256 + lane * 4);
            } else {
                const int s = r - NPROMPT, t = s & 2047; const float gr = (float)(t >> 6), gc = (float)(t & 63);
#pragma unroll
                for (int jj = 0; jj < 4; ++jj) {
                    f32x4 v = *(const f32x4*)(P->in[I_XS] + (size_t)s * 1024 + jj * 256 + lane * 4);
#pragma unroll
                    for (int e = 0; e < 4; ++e) {
                        const float fq = __builtin_amdgcn_exp2f(-(float)(lane * 4 + e) * (13.287712379549449f / 256.f));
                        const float ang = (jj < 2 ? gr : gc) * fq;
                        v[e] += (jj & 1) ? __cosf(ang) : __sinf(ang);
                    }
                    *(f32x4*)(X + (size_t)r * 1024 + jj * 256 + lane * 4) = v;
                }
            }
        }
    }
    __syncthreads();
    gemv_mod(P, lds, 0, (bx + 128) % G, G);
}

__device__ __forceinline__ void norm_phase(PP P, int l, int which) {
    const int tid = otid(), lane = tid & 63, wave = tid >> 6, G = gridDim.x, bx = obid();
    unsigned char* ws = P->ws;
    const float* X = (const float*)(ws + OFF_X);
    const float* gp = which == 2 ? P->in[I_FINALG] : P->in[I_NORMG] + (size_t)(l * 2 + which) * 1024;
    f32x4 gv[4];
#pragma unroll
    for (int jj = 0; jj < 4; ++jj) gv[jj] = *(const f32x4*)(gp + jj * 256 + lane * 4);
    for (int r0 = bx * 8 + wave; r0 < NTOK; r0 += G * 16) {
        f32x4 v[2][4]; float ss[2] = {0.f, 0.f};
#pragma unroll
        for (int u = 0; u < 2; ++u) { const int r = r0 + u * G * 8; if (r < NTOK) {
#pragma unroll
            for (int jj = 0; jj < 4; ++jj) v[u][jj] = *(const f32x4*)(X + (size_t)r * 1024 + jj * 256 + lane * 4); } }
#pragma unroll
        for (int u = 0; u < 2; ++u) {
            const int r = r0 + u * G * 8; if (r >= NTOK) continue;
#pragma unroll
            for (int jj = 0; jj < 4; ++jj) ss[u] += v[u][jj][0] * v[u][jj][0] + v[u][jj][1] * v[u][jj][1] + v[u][jj][2] * v[u][jj][2] + v[u][jj][3] * v[u][jj][3];
            const float rstd = rsqrtf(wave_sum(ss[u]) * (1.f / 1024.f) + 1e-6f);
            if (which == 2) {
#pragma unroll
                for (int jj = 0; jj < 4; ++jj) *(f32x4*)(P->out + (size_t)r * 1024 + jj * 256 + lane * 4) = v[u][jj] * rstd * gv[jj];
            } else {
                const int cnd = r < NPROMPT ? 0 : 1 + ((r - NPROMPT) >> 11);
                const float* mp = (const float*)(ws + OFF_MOD) + (size_t)(l * 5 + cnd) * 6144 + which * 3072;
                bf16_t* Hh = (bf16_t*)(ws + OFF_H) + (size_t)r * 1024;
#pragma unroll
                for (int jj = 0; jj < 4; ++jj) {
                    const f32x4 sh = *(const f32x4*)(mp + jj * 256 + lane * 4), sc = *(const f32x4*)(mp + 1024 + jj * 256 + lane * 4);
                    const f32x4 y = v[u][jj] * rstd * gv[jj] * (sc + 1.f) + sh;
                    u32x2 o; o.x = pk2(y[0], y[1]); o.y = pk2(y[2], y[3]);
                    *(u32x2*)(Hh + jj * 256 + lane * 4) = o;
                }
            }
        }
    }
}

template <int W> __device__ __forceinline__ void pool_item(const bf16_t* UB, bf16_t* AM, int t, int ch) {
    int s0, L; if (t < NPROMPT) { s0 = t & ~255; L = 256; } else { s0 = NPROMPT + ((t - NPROMPT) & ~2047); L = 2048; }
    const int tl = t - s0;
    u32x4 v[W];
#pragma unroll
    for (int jx = 0; jx < W; ++jx) { int tt = tl - W / 2 + jx; tt = tt < 0 ? 0 : (tt >= L ? L - 1 : tt); v[jx] = *(const u32x4*)(UB + (size_t)(s0 + tt) * 512 + ch); }
    const u32x4 c = *(const u32x4*)(UB + (size_t)t * 512 + ch);
    float s[8];
#pragma unroll
    for (int e = 0; e < 8; ++e) s[e] = 0.f;
#pragma unroll
    for (int jx = 0; jx < W; ++jx) {
        const int tt = tl - W / 2 + jx; const float m = (tt >= 0 && tt < L) ? 1.f : 0.f;
        s[0] += m * bflo(v[jx].x); s[1] += m * bfhi(v[jx].x); s[2] += m * bflo(v[jx].y); s[3] += m * bfhi(v[jx].y);
        s[4] += m * bflo(v[jx].z); s[5] += m * bfhi(v[jx].z); s[6] += m * bflo(v[jx].w); s[7] += m * bfhi(v[jx].w);
    }
    const int lo = max(tl - W / 2, 0), hi = min(tl + W - W / 2, L);
    const float ic = 1.f / (float)(hi - lo);
    u32x4 o;
    o.x = pk2(s[0] * ic - bflo(c.x), s[1] * ic - bfhi(c.x)); o.y = pk2(s[2] * ic - bflo(c.y), s[3] * ic - bfhi(c.y));
    o.z = pk2(s[4] * ic - bflo(c.z), s[5] * ic - bfhi(c.z)); o.w = pk2(s[6] * ic - bflo(c.w), s[7] * ic - bfhi(c.w));
    *(u32x4*)(AM + (size_t)t * 1024 + 512 + ch) = o;
}
__device__ __forceinline__ void pool_phase(PP P) {
    unsigned char* ws = P->ws;
    const bf16_t* UB = (const bf16_t*)(ws + OFF_UB);
    bf16_t* AM = (bf16_t*)(ws + OFF_AMIX);
    const int tid = otid(), lane = tid & 63, wave = tid >> 6;
    for (int wi = obid() * 8 + wave; wi < 4 * (NTOK / 4); wi += gridDim.x * 8) {
        const int g = wi & 3, t = (wi >> 2) * 4 + (lane >> 4), ch = (g * 16 + (lane & 15)) * 8;
        if (g == 0) pool_item<2>(UB, AM, t, ch);
        else if (g == 1) pool_item<4>(UB, AM, t, ch);
        else if (g == 2) pool_item<8>(UB, AM, t, ch);
        else pool_item<16>(UB, AM, t, ch);
    }
}

__device__ __forceinline__ void mixprep_phase(PP P, int j) {
    const int tid = otid(), lane = tid & 63, wave = tid >> 6;
    unsigned char* ws = P->ws;
    const float* O0 = (const float*)(ws + OFF_ODIR); const float* O1 = O0 + (size_t)NTOK * 512;
    const bf16_t* GT = (const bf16_t*)(ws + OFF_GATE);
    bf16_t* AM = (bf16_t*)(ws + OFF_AMIX);
    const int ch = lane * 8;
    const f32x4 g0 = *(const f32x4*)(P->in[I_GLAG] + j * 128 + (ch & 127)), g1 = *(const f32x4*)(P->in[I_GLAG] + j * 128 + (ch & 127) + 4);
    const int G8 = gridDim.x * 8;
    for (int r0 = obid() * 8 + wave; r0 < NTOK; r0 += 2 * G8) {
        f32x4 a[2], b[2]; u32x4 gt[2];
#pragma unroll
        for (int u = 0; u < 2; ++u) { const int r = r0 + u * G8; if (r < NTOK) {
            a[u] = *(const f32x4*)(O0 + (size_t)r * 512 + ch) + *(const f32x4*)(O1 + (size_t)r * 512 + ch);
            b[u] = *(const f32x4*)(O0 + (size_t)r * 512 + ch + 4) + *(const f32x4*)(O1 + (size_t)r * 512 + ch + 4);
            gt[u] = *(const u32x4*)(GT + (size_t)r * 512 + ch); } }
#pragma unroll
        for (int u = 0; u < 2; ++u) {
            const int r = r0 + u * G8; if (r >= NTOK) continue;
            float ss = a[u][0] * a[u][0] + a[u][1] * a[u][1] + a[u][2] * a[u][2] + a[u][3] * a[u][3] + b[u][0] * b[u][0] + b[u][1] * b[u][1] + b[u][2] * b[u][2] + b[u][3] * b[u][3];
            ss += __shfl_xor(ss, 1); ss += __shfl_xor(ss, 2); ss += __shfl_xor(ss, 4); ss += __shfl_xor(ss, 8);
            const float rstd = rsqrtf(ss * (1.f / 128.f) + 1e-6f);
            const f32x4 aa = a[u] * rstd * g0, bb = b[u] * rstd * g1;
            u32x4 o;
            o.x = pk2(aa[0] * bflo(gt[u].x), aa[1] * bfhi(gt[u].x)); o.y = pk2(aa[2] * bflo(gt[u].y), aa[3] * bfhi(gt[u].y));
            o.z = pk2(bb[0] * bflo(gt[u].z), bb[1] * bfhi(gt[u].z)); o.w = pk2(bb[2] * bflo(gt[u].w), bb[3] * bfhi(gt[u].w));
            *(u32x4*)(AM + (size_t)r * 1024 + ch) = o;
        }
    }
}

__device__ __forceinline__ void conv_phase(PP P, int j, int vb, int nb) {
    unsigned char* ws = P->ws;
    const bf16_t* XI = (const bf16_t*)(ws + OFF_XIN); const bf16_t* BGp = (const bf16_t*)(ws + OFF_BG); const bf16_t* CGp = (const bf16_t*)(ws + OFF_CG);
    bf16_t* AM = (bf16_t*)(ws + OFF_AMIX);
    for (int idx = vb * 512 + otid(); idx < NTOK * 64; idx += nb * 512) {
        const int t = idx >> 6, ch = (idx & 63) * 8;
        int s0, L; if (t < NPROMPT) { s0 = t & ~255; L = 256; } else { s0 = NPROMPT + ((t - NPROMPT) & ~2047); L = 2048; }
        const int tl = t - s0;
        float cv[8];
        { const f32x4 b0 = *(const f32x4*)(P->in[I_CONVB] + j * 512 + ch), b1 = *(const f32x4*)(P->in[I_CONVB] + j * 512 + ch + 4);
          cv[0] = b0[0]; cv[1] = b0[1]; cv[2] = b0[2]; cv[3] = b0[3]; cv[4] = b1[0]; cv[5] = b1[1]; cv[6] = b1[2]; cv[7] = b1[3]; }
#pragma unroll
        for (int jj = 0; jj < 3; ++jj) {
            const int tt = tl + jj - 1;
            if (tt < 0 || tt >= L) continue;
            const u32x4 xv = *(const u32x4*)(XI + (size_t)(s0 + tt) * 512 + ch), cg = *(const u32x4*)(CGp + (size_t)(s0 + tt) * 512 + ch);
            const f32x4 w0 = *(const f32x4*)(P->in[I_CONVW] + (size_t)(j * 3 + jj) * 512 + ch), w1 = *(const f32x4*)(P->in[I_CONVW] + (size_t)(j * 3 + jj) * 512 + ch + 4);
            cv[0] += bflo(xv.x) * bflo(cg.x) * w0[0]; cv[1] += bfhi(xv.x) * bfhi(cg.x) * w0[1]; cv[2] += bflo(xv.y) * bflo(cg.y) * w0[2]; cv[3] += bfhi(xv.y) * bfhi(cg.y) * w0[3];
            cv[4] += bflo(xv.z) * bflo(cg.z) * w1[0]; cv[5] += bfhi(xv.z) * bfhi(cg.z) * w1[1]; cv[6] += bflo(xv.w) * bflo(cg.w) * w1[2]; cv[7] += bfhi(xv.w) * bfhi(cg.w) * w1[3];
        }
        const u32x4 bg = *(const u32x4*)(BGp + (size_t)t * 512 + ch);
        u32x4 o;
        o.x = pk2(cv[0] * bflo(bg.x), cv[1] * bfhi(bg.x)); o.y = pk2(cv[2] * bflo(bg.y), cv[3] * bfhi(bg.y));
        o.z = pk2(cv[4] * bflo(bg.z), cv[5] * bfhi(bg.z)); o.w = pk2(cv[6] * bflo(bg.w), cv[7] * bfhi(bg.w));
        *(u32x4*)(AM + (size_t)t * 1024 + 512 + ch) = o;
    }
}

__device__ __forceinline__ void convert_phase(PP P) {
    unsigned char* ws = P->ws;
    bf16_t* AM = (bf16_t*)(ws + OFF_AMIX);
    for (int idx = obid() * 512 + otid(); idx < NTOK * 64; idx += gridDim.x * 512) {
        const int t = idx >> 6, ch = (idx & 63) * 8;
        f32x4 a, b;
        if (t < NPROMPT) { const float* F = (const float*)(ws + OFF_FACCP) + (size_t)t * 512 + ch; a = *(const f32x4*)F; b = *(const f32x4*)(F + 4); }
        else {
            const float* F = (const float*)(ws + OFF_FACCS) + (size_t)(t - NPROMPT) * 512 + ch;
            a = *(const f32x4*)F; b = *(const f32x4*)(F + 4);
#pragma unroll
            for (int ks = 1; ks < 4; ++ks) { a += *(const f32x4*)(F + (size_t)ks * 8192 * 512); b += *(const f32x4*)(F + (size_t)ks * 8192 * 512 + 4); }
        }
        u32x4 o; o.x = pk2(a[0], a[1]); o.y = pk2(a[2], a[3]); o.z = pk2(b[0], b[1]); o.w = pk2(b[2], b[3]);
        *(u32x4*)(AM + (size_t)t * 1024 + ch) = o;
    }
}

__device__ __forceinline__ int permd(int d) { return (d & 32) | ((d & 12) << 1) | ((d & 16) >> 2) | (d & 3); }
__device__ __forceinline__ bf16x8 pack8(const f32x4& a, const f32x4& b) {
    u32x4 o; o.x = pk2(a[0], a[1]); o.y = pk2(a[2], a[3]); o.z = pk2(b[0], b[1]); o.w = pk2(b[2], b[3]);
    return __builtin_bit_cast(bf16x8, o);
}
__device__ __forceinline__ void gla_item(PP P, LAS unsigned char* lds, int j, int seg, int head, int dir, bool full) {
    const int tid = otid(), lane = tid & 63, w = tid >> 6, r = lane & 15, q = lane >> 4;
    unsigned char* ws = P->ws;
    const bf16_t* QB = (const bf16_t*)(ws + OFF_QB); const bf16_t* KB = (const bf16_t*)(ws + OFF_KB); const bf16_t* VT = (const bf16_t*)(ws + OFF_VT);
    const float* LOGF = (const float*)(ws + OFF_LOGF);
    float* ODIR = (float*)(ws + OFF_ODIR);
    float* Ubuf = (float*)(ws + OFF_U); float* Dtot = (float*)(ws + OFF_DTOT);
    LAS bf16_t* QT = (LAS bf16_t*)(lds);
    LAS bf16_t* KT = (LAS bf16_t*)(lds + 36864);
    LAS bf16_t* KH = (LAS bf16_t*)(lds + 73728);
    LAS float* DL = (LAS float*)(lds + 114688);
    LAS bf16x8* ATT = (LAS bf16x8*)(lds + 116736);
    const int tok0 = seg * 256;
    __syncthreads();
    {
        const int d = tid & 63, c = w, pd = permd(d);
        float b = 0.f;
        const float* lf = LOGF + (size_t)(tok0 + 32 * c) * 512 + dir * 256 + head * 64 + d;
        const bf16_t* qp = QB + (size_t)(tok0 + 32 * c) * 256 + head * 64 + d;
        const bf16_t* kp = KB + (size_t)(tok0 + 32 * c) * 256 + head * 64 + d;
        float lfv[32]; bf16_t qv16[32], kv16[32];
#pragma unroll
        for (int ii = 0; ii < 32; ++ii) { const int il = dir ? 31 - ii : ii; lfv[ii] = lf[(size_t)il * 512]; qv16[ii] = qp[(size_t)il * 256]; kv16[ii] = kp[(size_t)il * 256]; }
#pragma unroll
        for (int ii = 0; ii < 32; ++ii) {
            const int il = dir ? 31 - ii : ii;
            b += lfv[ii];
            const float qv = bf2f(qv16[ii]), kv = bf2f(kv16[ii]);
            QT[(32 * c + il) * 72 + pd] = f2bf(qv * __expf(b));
            KT[(32 * c + il) * 72 + pd] = f2bf(kv * __expf(-b));
        }
        const float eT = __expf(b);
        DL[c * 64 + d] = eT;
#pragma unroll 8
        for (int il = 0; il < 32; ++il) KH[(c * 64 + d) * 40 + permd(il)] = f2bf(bf2f(KT[(32 * c + il) * 72 + pd]) * eT);
    }
    __syncthreads();
    if (full) {
        const int c = w;
        f32x4 at[2][2];
#pragma unroll
        for (int a = 0; a < 2; ++a)
#pragma unroll
            for (int b = 0; b < 2; ++b) at[a][b] = (f32x4){0.f, 0.f, 0.f, 0.f};
#pragma unroll
        for (int kk = 0; kk < 2; ++kk) {
            bf16x8 ka[2], qb[2];
#pragma unroll
            for (int t = 0; t < 2; ++t) { ka[t] = *(const LAS bf16x8*)(KT + (32 * c + 16 * t + r) * 72 + 32 * kk + 8 * q); qb[t] = *(const LAS bf16x8*)(QT + (32 * c + 16 * t + r) * 72 + 32 * kk + 8 * q); }
#pragma unroll
            for (int tj = 0; tj < 2; ++tj)
#pragma unroll
                for (int ti = 0; ti < 2; ++ti) at[tj][ti] = __builtin_amdgcn_mfma_f32_16x16x32_bf16(ka[tj], qb[ti], at[tj][ti], 0, 0, 0);
        }
#pragma unroll
        for (int ti = 0; ti < 2; ++ti) {
            const int i = 16 * ti + r;
#pragma unroll
            for (int tj = 0; tj < 2; ++tj)
#pragma unroll
                for (int jj = 0; jj < 4; ++jj) { const int jx = 16 * tj + 4 * q + jj; const bool keep = dir ? (jx >= i) : (jx <= i); if (!keep) at[tj][ti][jj] = 0.f; }
            ATT[(c * 2 + ti) * 64 + lane] = pack8(at[0][ti], at[1][ti]);
        }
    }
    __syncthreads();
    f32x4 S[4];
#pragma unroll
    for (int t = 0; t < 4; ++t) S[t] = (f32x4){0.f, 0.f, 0.f, 0.f};
    const int e = 16 * w + r;
    if (DBG_SINIT && full && seg >= 16) {
        const int sb = (seg - 16) >> 3, part = (seg - 16) & 7;
        const float* s0 = P->in[I_STATE] + ((size_t)(((sb * 2 + j) * 2 + dir) * 4 + head) * 64) * 128;
#pragma unroll
        for (int t = 0; t < 4; ++t)
#pragma unroll
            for (int jj = 0; jj < 4; ++jj) S[t][jj] = s0[(size_t)(16 * t + 4 * q + jj) * 128 + e];
        const int np = dir ? 7 - part : part;
#pragma unroll
        for (int xb = 0; xb < 8; xb += 4) {
            if (xb >= np) break;
            float dvv[4][16], uvv[4][16];
#pragma unroll
            for (int xi = 0; xi < 4; ++xi) {
                const int x = xb + xi; if (x >= 7) continue;
                const int pp = dir ? 7 - x : x;
                const size_t ib = (size_t)(((sb * 8 + pp) * 4 + head) * 2 + dir) * 64;
#pragma unroll
                for (int t = 0; t < 4; ++t)
#pragma unroll
                    for (int jj = 0; jj < 4; ++jj) { const int d = 16 * t + 4 * q + jj; dvv[xi][t * 4 + jj] = Dtot[ib + d]; uvv[xi][t * 4 + jj] = Ubuf[(ib + d) * 128 + e]; }
            }
#pragma unroll
            for (int xi = 0; xi < 4; ++xi) {
                const int x = xb + xi; if (x >= 7) continue;
                const bool on = x < np;
#pragma unroll
                for (int t = 0; t < 4; ++t)
#pragma unroll
                    for (int jj = 0; jj < 4; ++jj) S[t][jj] = on ? S[t][jj] * dvv[xi][t * 4 + jj] + uvv[xi][t * 4 + jj] : S[t][jj];
            }
        }
    }
    const bf16_t* vt = VT + (size_t)(head * 128 + e) * NTOK + tok0;
    u32x2 vpre0[8], vpre1[8];
#pragma unroll
    for (int cc = 0; cc < 8; ++cc) { const int c = dir ? 7 - cc : cc; vpre0[cc] = *(const u32x2*)(vt + 32 * c + 4 * q); vpre1[cc] = *(const u32x2*)(vt + 32 * c + 16 + 4 * q); }
#pragma unroll
    for (int cc = 0; cc < 8; ++cc) {
        const int c = dir ? 7 - cc : cc;
        const u32x2 v0 = vpre0[cc], v1 = vpre1[cc];
        u32x4 vv; vv.x = v0.x; vv.y = v0.y; vv.z = v1.x; vv.w = v1.y;
        const bf16x8 vb = __builtin_bit_cast(bf16x8, vv);
        if (full) {
            bf16x8 sb2[2];
            sb2[0] = pack8(S[0], S[1]); sb2[1] = pack8(S[2], S[3]);
#pragma unroll
            for (int mi = 0; mi < 2; ++mi) {
                f32x4 o = (f32x4){0.f, 0.f, 0.f, 0.f};
#pragma unroll
                for (int kk = 0; kk < 2; ++kk) {
                    const bf16x8 qa = *(const LAS bf16x8*)(QT + (32 * c + 16 * mi + r) * 72 + 32 * kk + 8 * q);
                    o = __builtin_amdgcn_mfma_f32_16x16x32_bf16(qa, sb2[kk], o, 0, 0, 0);
                }
                const bf16x8 aa = ATT[(c * 2 + mi) * 64 + lane];
                o = __builtin_amdgcn_mfma_f32_16x16x32_bf16(aa, vb, o, 0, 0, 0);
                float* op = ODIR + ((size_t)dir * NTOK + tok0 + 32 * c + 16 * mi + 4 * q) * 512 + head * 128 + e;
#pragma unroll
                for (int jj = 0; jj < 4; ++jj) op[(size_t)jj * 512] = o[jj];
            }
        }
#pragma unroll
        for (int t = 0; t < 4; ++t) {
            const f32x4 dv = *(const LAS f32x4*)(DL + c * 64 + 16 * t + 4 * q);
            S[t] = S[t] * dv;
            const bf16x8 ka = *(const LAS bf16x8*)(KH + (c * 64 + 16 * t + r) * 40 + 8 * q);
            S[t] = __builtin_amdgcn_mfma_f32_16x16x32_bf16(ka, vb, S[t], 0, 0, 0);
        }
    }
    if (full) {
        if (seg < 16) {
            float* so = P->out + OUT_STATE + ((size_t)(((seg * 2 + j) * 2 + dir) * 4 + head) * 64) * 128;
#pragma unroll
            for (int t = 0; t < 4; ++t)
#pragma unroll
                for (int jj = 0; jj < 4; ++jj) so[(size_t)(16 * t + 4 * q + jj) * 128 + e] = S[t][jj];
        }
    } else {
        const size_t ib = (size_t)(((seg - 16) * 4 + head) * 2 + dir) * 64;
#pragma unroll
        for (int t = 0; t < 4; ++t)
#pragma unroll
            for (int jj = 0; jj < 4; ++jj) Ubuf[(ib + 16 * t + 4 * q + jj) * 128 + e] = S[t][jj];
        if (tid < 64) { float p = 1.f;
#pragma unroll
            for (int c = 0; c < 8; ++c) p *= DL[c * 64 + tid];
            Dtot[ib + tid] = p; }
    }
}

__device__ __forceinline__ void gla_phase(PP P, LAS unsigned char* lds, int j, int sub) {
    const int G = gridDim.x;
    if (sub == 0) {
        for (int it = obid(); it < 384; it += G) {
            if (it >= 128 && it < 256) { const int pi = it - 128; gla_item(P, lds, j, pi >> 3, (pi >> 1) & 3, pi & 1, true); }
            else { const int li = it < 128 ? it : it - 128; gla_item(P, lds, j, 16 + (li >> 3), (li >> 1) & 3, li & 1, false); }
        }
    } else {
        for (int it = obid(); it < 256; it += G) gla_item(P, lds, j, 16 + (it >> 3), (it >> 1) & 3, it & 1, true);
    }
}


#define XB_TMO      128
#define XB_XCNT(j)  (256  + 64 * (j))
#define XB_XSUB(j)  (1280 + 64 * (j))
#define XB_XGEN(j)  (2304 + 64 * (j))
#define XB_TOP      3328
#define XB_TOPGEN   3392
#define XCD_BAR_WORDS 3456
#define XB_SPIN_CAP (1u << 18)

__device__ __forceinline__ unsigned xb_ld(unsigned* p)              { return __hip_atomic_load(p, __ATOMIC_RELAXED, __HIP_MEMORY_SCOPE_AGENT); }
__device__ __forceinline__ unsigned xb_add(unsigned* p, unsigned v) { return __hip_atomic_fetch_add(p, v, __ATOMIC_RELAXED, __HIP_MEMORY_SCOPE_AGENT); }
__device__ __forceinline__ unsigned xb_xcc_id() { return (unsigned)__builtin_amdgcn_s_getreg((3 << 11) | 20) & 0xFu; }
#define XB_SPIN(cond, bar) do { unsigned _sp = 0; while (cond) { __builtin_amdgcn_s_sleep(1); \
    if ((++_sp & 255u) == 0u) { if (xb_ld(&(bar)[XB_TMO])) break; if (_sp > XB_SPIN_CAP) { atomicAdd(&(bar)[XB_TMO], 1u); break; } } } } while (0)

struct XcdBarrier {
    unsigned* bar; unsigned x;
    volatile LAS unsigned* st;
};

__device__ __forceinline__ XcdBarrier xcd_barrier_post(unsigned* bar, volatile LAS unsigned* st) {
    XcdBarrier b; b.bar = bar; b.x = xb_xcc_id(); b.st = st;
    if (threadIdx.x == 0) (void)xb_add(&bar[XB_XCNT(b.x)], 1u);
    return b;
}
__device__ __forceinline__ void xcd_barrier_complete(unsigned* bar, unsigned x, unsigned& nloc, unsigned& nx) {
    const unsigned G = gridDim.x * gridDim.y * gridDim.z;
    unsigned sum, cnt, mine, sp = 0u;
    for (;;) {
        sum = 0u; cnt = 0u; mine = 0u;
#pragma unroll
        for (unsigned j = 0; j < 16; ++j) { const unsigned c = xb_ld(&bar[XB_XCNT(j)]); sum += c; cnt += (c > 0u) ? 1u : 0u; mine = (j == x) ? c : mine; }
        if (sum == G) break;
        __builtin_amdgcn_s_sleep(1);
        if ((++sp & 255u) == 0u) { if (xb_ld(&bar[XB_TMO])) break; if (sp > XB_SPIN_CAP) { atomicAdd(&bar[XB_TMO], 1u); break; } }
    }
    nloc = mine > 0u ? mine : 1u; nx = cnt > 0u ? cnt : 1u;
}

__device__ __forceinline__ void xcd_barrier(const XcdBarrier& b) {
    asm volatile("s_waitcnt vmcnt(0)" ::: "memory");
    __syncthreads();
    if (threadIdx.x == 0) {
        unsigned* bar = b.bar;
        __builtin_amdgcn_s_waitcnt(0);
        unsigned nloc = b.st[0], nx = b.st[1];
        if (nloc == 0u) { xcd_barrier_complete(bar, b.x, nloc, nx); b.st[0] = nloc; b.st[1] = nx; }
        const unsigned old = xb_add(&bar[XB_XSUB(b.x)], 1u);
        const unsigned gen = old / nloc;
        if (old + 1u == (gen + 1u) * nloc) {
            __builtin_amdgcn_fence(__ATOMIC_RELEASE, "agent");
            asm volatile("s_waitcnt vmcnt(0)" ::: "memory");
            const unsigned og = xb_add(&bar[XB_TOP], 1u);
            const unsigned tg = og / nx;
            if (og + 1u == (tg + 1u) * nx) xb_add(&bar[XB_TOPGEN], 1u);
            else XB_SPIN(xb_ld(&bar[XB_TOPGEN]) == tg, bar);
            __builtin_amdgcn_fence(__ATOMIC_ACQUIRE, "agent");
            xb_add(&bar[XB_XGEN(b.x)], 1u);
            asm volatile("s_waitcnt vmcnt(0)" ::: "memory");
        } else {
            XB_SPIN(xb_ld(&bar[XB_XGEN(b.x)]) == gen, bar);
            __builtin_amdgcn_fence(__ATOMIC_ACQUIRE, "agent");
            asm volatile("s_waitcnt vmcnt(0)" ::: "memory");
        }
    }
    __syncthreads();
}

enum { PT_PREP = 0, PT_NORM1, PT_GEMM_IN, PT_MIX_A, PT_MIX_B, PT_MIXPREP, PT_GEMM_OUT, PT_NORM2, PT_MLP1, PT_MLP2, PT_FINAL };

__global__ void __launch_bounds__(512, 2) mega_fwd(Params Pk) {
    extern __shared__ __attribute__((aligned(16))) unsigned char smem[];
    LAS unsigned char* lds = (LAS unsigned char*)smem;
#ifdef DBG_ZLDS
    for (int i = otid(); i < LDS_BYTES / 16; i += 512) ((LAS u32x4*)lds)[i] = (u32x4){0u, 0u, 0u, 0u};
    __syncthreads();
#endif
    { volatile LAS unsigned* st0 = (volatile LAS unsigned*)(lds + LDS_BYTES - 64); if (otid() < 2) st0[otid()] = 0u; }
    __syncthreads();
    XcdBarrier gbar; gbar.bar = (unsigned*)(Pk.ws + OFF_BAR); gbar.x = 0; gbar.st = (volatile LAS unsigned*)(lds + LDS_BYTES - 64);
    if (Pk.ph_hi - Pk.ph_lo > 1) gbar = xcd_barrier_post((unsigned*)(Pk.ws + OFF_BAR), (volatile LAS unsigned*)(lds + LDS_BYTES - 64));
    if (Pk.ph_hi < 0) cg::this_grid().sync();
    for (int ph = Pk.ph_lo; ph < Pk.ph_hi; ++ph) {
        PP P = (PP)__builtin_amdgcn_kernarg_segment_ptr();
        asm volatile("" : "+s"(P));
        int pt, l = 0;
        if (ph == 0) pt = PT_PREP;
        else if (ph == NPH - 1) pt = PT_FINAL;
        else {
            const int qq = ph - 1; int s;
            if (qq < 9) { l = 0; s = qq; } else if (qq < 17) { l = 1; s = qq - 9; } else if (qq < 26) { l = 2; s = qq - 17; } else { l = 3; s = qq - 26; }
            pt = (l & 1) ? (s < 4 ? s + 1 : s + 2) : s + 1;
        }
        const int j = l >> 1, odd = l & 1;
        const int nrep = (pt == REP_PT && (REP_L < 0 || l == REP_L)) ? 1 + REP_N : 1;
        for (int rep = 0; rep < nrep; ++rep) {
        int ngemm = 0; GemmCfg g; g.G = gridDim.x; g.c = obid(); g.j = j; g.l = l; g.nM = 48; g.ld = 1024; g.nt = 16; g.type = 0; g.nN = 0;
        switch (pt) {
        case PT_PREP: if (EN & 1) prep_phase(P, lds); break;
        case PT_NORM1: if (EN & 2) norm_phase(P, l, 0); break;
        case PT_GEMM_IN: ngemm = 1; g.type = odd ? T_IN_ODD : T_IN_EVEN; g.nN = 10; break;
        case PT_MIX_A: if (odd) { ngemm = 2; g.type = T_DFT_S; g.nM = 8; g.nN = 32; g.ld = 4096; g.nt = 16; } else { if (EN & 4) gla_phase(P, lds, j, 0); if (EN & 8) pool_phase(P); } break;
        case PT_MIX_B: if (odd) { if (EN & 8) convert_phase(P); } else { if (EN & 4) gla_phase(P, lds, j, 1); } break;
        case PT_MIXPREP: if (EN & 8) mixprep_phase(P, j); break;
        case PT_GEMM_OUT: ngemm = 1; g.type = odd ? T_OUT_ODD : T_OUT_EVEN; g.nN = 4; break;
        case PT_NORM2: if (EN & 2) norm_phase(P, l, 1); break;
        case PT_MLP1: ngemm = 1; g.type = T_MLP1; g.nN = 16; break;
        case PT_MLP2: ngemm = 1; g.type = T_MLP2; g.nN = 4; g.ld = 4096; g.nt = 64; break;
        default: if (EN & 2) norm_phase(P, 0, 2); break;
        }
        for (int gi = 0; gi < ngemm; ++gi) {
            if (gi == 1) { g.type = T_DFT_P; g.nM = 1; g.nN = 32; g.ld = 512; g.nt = 8; g.c = (obid() + gridDim.x - 32) % gridDim.x; }
            if (EN & 16) gemm_phase(lds, g);
        }
        if (pt == PT_MIX_A && odd && (EN & 8)) {
            const int G3 = gridDim.x, b3 = obid();
            if (G3 > 64) { if (b3 < 32) conv_phase(P, j, b3, G3 - 32); else if (b3 >= 64) conv_phase(P, j, b3 - 32, G3 - 32); }
            else conv_phase(P, j, b3, G3);
        }
        if (pt == PT_MLP2 && l < 3) { const int G2 = gridDim.x, bq = obid(); if (G2 > 192) { if (bq >= 192) { convert_layer(P, lds, l + 1, bq - 192, G2 - 192); gemv_mod(P, lds, l + 1, bq - 192, G2 - 192); if (l == 0) tgen_part(P, bq - 192, G2 - 192); } } else { convert_layer(P, lds, l + 1, bq, G2); gemv_mod(P, lds, l + 1, bq, G2); if (l == 0) tgen_part(P, bq, G2); } }
        if (ph + 1 < Pk.ph_hi || rep + 1 < nrep) xcd_barrier(gbar);
        }

    }
}


#ifdef DBG_K
__device__ __forceinline__ float dgst(unsigned u) { return (float)(u & 0xffffu) + (float)(u >> 16); }
__global__ void dbg_dump(float* out, const unsigned char* ws) {
    const unsigned* Xu = (const unsigned*)(ws + OFF_X); const unsigned* Hu = (const unsigned*)(ws + OFF_H); const unsigned* Au = (const unsigned*)(ws + OFF_AMIX);
    const unsigned* Bu = (const unsigned*)(ws + OFF_BIG); const unsigned* Uu = (const unsigned*)(ws + OFF_U); const unsigned* Wu = (const unsigned*)(ws);
    for (size_t i = (size_t)blockIdx.x * blockDim.x + threadIdx.x; i < (size_t)NTOK * 1024; i += (size_t)gridDim.x * blockDim.x) {
        float v = 0.f;
        if (DBG_SEL & 1) v += dgst(Xu[i]);
        if (DBG_SEL & 2) v += dgst(Hu[i % 6291456]);
        if (DBG_SEL & 4) v += dgst(Au[i % 6291456]);
        if (DBG_SEL & 8) v += dgst(Bu[i]) + dgst(Bu[i + 12582912]) + dgst(Bu[(i + 25165824) % 34603008]);
        if (DBG_SEL & 16) v += dgst(Uu[i % 2113536]);
        if (DBG_SEL & 32) v += dgst(Wu[i]) + dgst(Wu[i + 12582912]) + dgst(Wu[(i + 25165824) % 28573696]);
        out[i] = v;
    }
}
#endif
extern "C" void kernel_launch(void* const* d_in, const int* in_sizes, int n_in, void* d_out, int out_size, void* d_ws, size_t ws_size, hipStream_t stream) {
    static int grid = 0;
    if (grid == 0) {
        if (n_in != 22 || ws_size < WS_NEED) { fprintf(stderr, "kernel_launch: unexpected n_in %d / ws_size %zu (need %zu)\n", n_in, ws_size, (size_t)WS_NEED); grid = -1; return; }
        int dev = 0, cus = 0, per_cu = 0;
        hipGetDevice(&dev);
        hipDeviceGetAttribute(&cus, hipDeviceAttributeMultiprocessorCount, dev);
        if (hipFuncSetAttribute((const void*)mega_fwd, hipFuncAttributeMaxDynamicSharedMemorySize, LDS_BYTES) != hipSuccess) { fprintf(stderr, "kernel_launch: hipFuncSetAttribute failed\n"); grid = -1; return; }
        hipOccupancyMaxActiveBlocksPerMultiprocessor(&per_cu, (const void*)mega_fwd, 512, LDS_BYTES);
        if (per_cu < 1) { fprintf(stderr, "kernel_launch: occupancy query says %d blocks/CU\n", per_cu); per_cu = 1; }
        (void)hipGetLastError();
        grid = cus;
    }
    if (grid < 0) return;
    Params p{};
    for (int i = 0; i < 22; ++i) p.in[i] = (const float*)d_in[i];
    p.out = (float*)d_out; p.ws = (unsigned char*)d_ws;
#if MULTI_LAUNCH
#ifdef DBG_K
    for (int ph = 0; ph < DBG_K; ++ph) {
        p.ph_lo = ph; p.ph_hi = ph + 1;
        hipLaunchKernelGGL(mega_fwd, dim3(grid), dim3(512), LDS_BYTES, stream, p);
    }
    hipLaunchKernelGGL(dbg_dump, dim3(2048), dim3(256), 0, stream, (float*)d_out, (const unsigned char*)d_ws);
#else
    for (int ph = 0; ph < NPH; ++ph) {
        p.ph_lo = ph; p.ph_hi = ph + 1;
        hipLaunchKernelGGL(mega_fwd, dim3(grid), dim3(512), LDS_BYTES, stream, p);
    }
#endif
#else
    p.ph_lo = 0; p.ph_hi = NPH;
    if (hipMemsetAsync((char*)d_ws + OFF_BAR, 0, 16384, stream) != hipSuccess) { fprintf(stderr, "kernel_launch: memset of barrier word failed\n"); return; }
    void* args[] = {&p};
    hipError_t e = hipLaunchCooperativeKernel((const void*)mega_fwd, dim3(grid), dim3(512), args, LDS_BYTES, stream);
    if (e != hipSuccess) fprintf(stderr, "cooperative launch failed: %s (grid %d)\n", hipGetErrorString(e), grid);
#endif
}
```

```cpp
#include <hip/hip_runtime.h>
#include <hip/hip_cooperative_groups.h>
#include <cstdio>
#include <cstdint>
namespace cg = cooperative_groups;

#ifndef DBG_SEL
#define DBG_SEL 63
#endif
#ifndef DBG_NP
#define DBG_NP(x) (x)
#endif
#ifndef REP_PT
#define REP_PT -1
#endif
#ifndef REP_L
#define REP_L -1
#endif
#ifndef REP_N
#define REP_N 1
#endif
#ifndef XSYNC
#define XSYNC 0
#endif
#ifndef DBG_SINIT
#define DBG_SINIT 1
#endif
#ifndef EN
#define EN 31
#endif
#ifndef MULTI_LAUNCH
#define MULTI_LAUNCH 0
#endif

#define LAS __attribute__((address_space(3)))
typedef unsigned short bf16_t;
typedef short bf16x8 __attribute__((ext_vector_type(8)));
typedef float f32x4 __attribute__((ext_vector_type(4)));
typedef unsigned u32x2 __attribute__((ext_vector_type(2)));
typedef unsigned u32x4 __attribute__((ext_vector_type(4)));

constexpr int DM = 1024, NTOK = 12288, NPROMPT = 4096, DFF = 4096;
constexpr int LDS_BYTES = 147456;
constexpr int NPH = 36;
constexpr size_t MBy = 1048576;
constexpr size_t OFF_W1T = 0, OFF_W2T = 32 * MBy, OFF_WIE = 64 * MBy, OFF_WOE = 74 * MBy, OFF_WIO = 78 * MBy, OFF_WOO = 88 * MBy;
constexpr size_t OFF_T2K = 92 * MBy, OFF_T256 = 108 * MBy, OFF_MOD = 108 * MBy + 262144, OFF_U = 109 * MBy, OFF_DTOT = 117 * MBy;
constexpr size_t OFF_X = 118 * MBy, OFF_H = 166 * MBy, OFF_AMIX = 190 * MBy, OFF_BIG = 214 * MBy, WS_NEED = 348 * MBy;
constexpr size_t OFF_HID = OFF_BIG;
constexpr size_t OFF_QB = OFF_BIG, OFF_KB = OFF_BIG + 6 * MBy, OFF_VT = OFF_BIG + 12 * MBy, OFF_GATE = OFF_BIG + 24 * MBy, OFF_LOGF = OFF_BIG + 36 * MBy;
constexpr size_t OFF_UB = OFF_BIG + 60 * MBy, OFF_ODIR = OFF_BIG + 72 * MBy;
constexpr size_t OFF_XTS = OFF_BIG, OFF_XTP = OFF_BIG + 16 * MBy, OFF_XIN = OFF_BIG + 24 * MBy, OFF_BG = OFF_BIG + 36 * MBy, OFF_CG = OFF_BIG + 48 * MBy;
constexpr size_t OFF_FACCP = OFF_BIG + 60 * MBy, OFF_FACCS = OFF_BIG + 68 * MBy;
constexpr size_t OFF_BAR = 117 * MBy + 524288;
constexpr size_t OUT_STATE = (size_t)NTOK * DM;

struct Params { const float* in[22]; float* out; unsigned char* ws; int ph_lo, ph_hi; };
typedef const __attribute__((address_space(4))) Params* PP;
enum { I_XP = 0, I_XS, I_STATE, I_C, I_CCTX, I_NORMG, I_FINALG, I_WADA, I_BADA, I_W1, I_W2, I_WINE, I_WA2, I_BA2, I_GLAG, I_POOLW, I_POOLS, I_WOUTE, I_WINO, I_CONVW, I_CONVB, I_WOUTO };

__device__ __forceinline__ int otid() { int t = __builtin_amdgcn_workitem_id_x(); asm volatile("" : "+v"(t)); return t; }
__device__ __forceinline__ int obid() { int b = __builtin_amdgcn_workgroup_id_x(); asm volatile("" : "+s"(b)); return b; }
typedef float f32x2 __attribute__((ext_vector_type(2)));
typedef __bf16 bf16x2v __attribute__((ext_vector_type(2)));
__device__ __forceinline__ unsigned pk2(float lo, float hi) { f32x2 v = {lo, hi}; bf16x2v b = __builtin_convertvector(v, bf16x2v); return __builtin_bit_cast(unsigned, b); }
__device__ __forceinline__ bf16_t f2bf(float x) { return (bf16_t)(pk2(x, 0.f) & 0xffffu); }
__device__ __forceinline__ float bf2f(bf16_t u) { return __uint_as_float(((unsigned)u) << 16); }
__device__ __forceinline__ float bflo(unsigned u) { return __uint_as_float(u << 16); }
__device__ __forceinline__ float bfhi(unsigned u) { return __uint_as_float(u & 0xffff0000u); }
__device__ __forceinline__ float wave_sum(float v) {
#pragma unroll
    for (int o = 1; o < 64; o <<= 1) v += __shfl_xor(v, o);
    return v;
}
__device__ __forceinline__ float siluf(float x) { return x * __builtin_amdgcn_rcpf(1.f + __expf(-x)); }
__device__ __forceinline__ float logsigmoidf(float x) { return fminf(x, 0.f) - __logf(1.f + __expf(-fabsf(x))); }
__device__ __forceinline__ int cond_of_seg(int pm) { return pm < 16 ? 0 : 1 + ((pm - 16) >> 3); }

namespace pg8 {
constexpr int BM = 256, BK = 64, HALF = 128, HTB = HALF * BK * 2, STAGE_BYTES = 8 * HTB, NXCD = 8, WGM = 8;
__host__ __device__ __forceinline__ int lds_byte(int r, int c) { const int st = (r >> 4) * 2 + (c >> 5), rr = r & 15, cc = c & 31, ob = rr * 64 + cc * 2; return st * 1024 + (ob ^ (((ob >> 9) & 1) << 5)); }
__host__ __device__ __forceinline__ int perm32(int rho) { const int n = rho >> 4, i = rho & 15; return 8 * (i >> 2) + 4 * n + (i & 3); }
__host__ __device__ __forceinline__ void stage_rc(int b, int& R, int& C) { const int st = b / 1024, sb = b % 1024, swz = sb ^ (((sb >> 9) & 1) << 5); R = (st >> 1) * 16 + swz / 64; C = (st & 1) * 32 + (swz % 64) / 2; }
}

enum { KD_BF16 = 0, KD_SILU, KD_RELU2, KD_LOGF, KD_RES, KD_ATOM };
enum { T_IN_EVEN = 0, T_IN_ODD, T_OUT_EVEN, T_OUT_ODD, T_MLP1, T_MLP2, T_DFT_S, T_DFT_P };
struct Unit { int pm, pn; };
struct UnitIO { const char* A; const char* B; char* out; const float* aux; int kind; int ld; };
struct GemmCfg { int type, j, l, nM, nN, ld, nt, G, c; };

__device__ __forceinline__ void make_unit(const GemmCfg& g, int pm, int pn, UnitIO& u) {
    PP Pq = (PP)__builtin_amdgcn_kernarg_segment_ptr();
    unsigned char* ws = Pq->ws;
    const size_t rowA = (size_t)pm * 256 * 1024 * 2;
    u.aux = nullptr; u.kind = KD_BF16; u.ld = 512;
    const float* modp = (const float*)(ws + OFF_MOD) + (size_t)(g.l * 5 + cond_of_seg(pm)) * 6144;
    switch (g.type) {
    case T_IN_EVEN: {
        const char* W = (const char*)(ws + OFF_WIE) + (size_t)g.j * 2560 * 1024 * 2 + (size_t)pn * 256 * 1024 * 2;
        const char* Hh = (const char*)(ws + OFF_H) + rowA;
        u.A = Hh; u.B = W;
        if (pn == 0) { u.out = (char*)(ws + OFF_QB) + (size_t)pm * 256 * 256 * 2; u.ld = 256; }
        else if (pn == 1) { u.out = (char*)(ws + OFF_KB) + (size_t)pm * 256 * 256 * 2; u.ld = 256; }
        else if (pn < 4) { u.A = W; u.B = Hh; u.out = (char*)(ws + OFF_VT) + ((size_t)(pn - 2) * 256 * NTOK + (size_t)pm * 256) * 2; u.ld = NTOK; }
        else if (pn < 6) { u.out = (char*)(ws + OFF_GATE) + ((size_t)pm * 256 * 512 + (pn - 4) * 256) * 2; u.kind = KD_SILU; }
        else if (pn < 8) { u.out = (char*)(ws + OFF_LOGF) + ((size_t)pm * 256 * 512 + (pn - 6) * 256) * 4; u.kind = KD_LOGF; u.aux = Pq->in[I_BA2] + g.j * 512 + (pn - 6) * 256; }
        else { u.out = (char*)(ws + OFF_UB) + ((size_t)pm * 256 * 512 + (pn - 8) * 256) * 2; }
    } break;
    case T_IN_ODD: {
        const char* W = (const char*)(ws + OFF_WIO) + (size_t)g.j * 2560 * 1024 * 2 + (size_t)pn * 256 * 1024 * 2;
        const char* Hh = (const char*)(ws + OFF_H) + rowA;
        u.A = Hh; u.B = W;
        if (pn < 4) {
            u.A = W; u.B = Hh;
            const int z = pn >> 1, ch0 = (pn & 1) * 256;
            if (pm < 16) { u.out = (char*)(ws + OFF_XTP) + ((size_t)(pm * 512 + ch0) * 512 + z * 256) * 2; u.ld = 512; }
            else { const int b = (pm - 16) >> 3, part = (pm - 16) & 7; u.out = (char*)(ws + OFF_XTS) + ((size_t)(b * 512 + ch0) * 4096 + z * 2048 + part * 256) * 2; u.ld = 4096; }
        } else {
            const size_t base = (pn < 6) ? OFF_XIN : (pn < 8 ? OFF_BG : OFF_CG);
            u.out = (char*)(ws + base) + ((size_t)pm * 256 * 512 + (pn & 1) * 256) * 2;
        }
    } break;
    case T_OUT_EVEN: case T_OUT_ODD: {
        u.A = (const char*)(ws + OFF_AMIX) + rowA;
        u.B = (const char*)(ws + (g.type == T_OUT_EVEN ? OFF_WOE : OFF_WOO)) + (size_t)g.j * 1024 * 1024 * 2 + (size_t)pn * 256 * 1024 * 2;
        u.out = (char*)(ws + OFF_X) + ((size_t)pm * 256 * 1024 + pn * 256) * 4; u.ld = 1024; u.kind = KD_RES; u.aux = modp + 2048 + pn * 256;
    } break;
    case T_MLP1: {
        u.A = (const char*)(ws + OFF_H) + rowA;
        u.B = (const char*)(ws + OFF_W1T) + (size_t)g.l * 4096 * 1024 * 2 + (size_t)pn * 256 * 1024 * 2;
        u.out = (char*)(ws + OFF_HID) + ((size_t)pm * 256 * 4096 + pn * 256) * 2; u.ld = 4096; u.kind = KD_RELU2;
    } break;
    case T_MLP2: {
        u.A = (const char*)(ws + OFF_HID) + (size_t)pm * 256 * 4096 * 2;
        u.B = (const char*)(ws + OFF_W2T) + (size_t)g.l * 4096 * 1024 * 2 + (size_t)pn * 256 * 4096 * 2;
        u.out = (char*)(ws + OFF_X) + ((size_t)pm * 256 * 1024 + pn * 256) * 4; u.ld = 1024; u.kind = KD_RES; u.aux = modp + 5120 + pn * 256;
    } break;
    case T_DFT_S: {
        const int pnb = pn >> 2, ks = pn & 3;
        u.A = (const char*)(ws + OFF_T2K) + ((size_t)pm * 256 * 4096 + ks * 1024) * 2;
        u.B = (const char*)(ws + OFF_XTS) + ((size_t)pnb * 256 * 4096 + ks * 1024) * 2;
        u.out = (char*)(ws + OFF_FACCS) + ((size_t)ks * 8192 * 512 + (size_t)((pnb >> 1) * 2048 + pm * 256) * 512 + (pnb & 1) * 256) * 4; u.kind = KD_ATOM;
    } break;
    default: {
        u.A = (const char*)(ws + OFF_T256);
        u.B = (const char*)(ws + OFF_XTP) + (size_t)pn * 256 * 512 * 2;
        u.out = (char*)(ws + OFF_FACCP) + ((size_t)((pn >> 1) * 256) * 512 + (pn & 1) * 256) * 4; u.kind = KD_ATOM;
    } break;
    }
}

__device__ __forceinline__ bool next_unit(const GemmCfg& g, int i, Unit& u) {
    const int nwg = g.nM * g.nN;
    const long L = (long)i * g.G + g.c; if (L >= nwg) return false;
    int wgid = (int)L; { const int q = nwg / pg8::NXCD, r = nwg % pg8::NXCD, xcd = wgid % pg8::NXCD, off = wgid / pg8::NXCD; wgid = (xcd < r ? xcd * (q + 1) : r * (q + 1) + (xcd - r) * q) + off; }
    const int nig = pg8::WGM * g.nN, gid = wgid / nig, fm = gid * pg8::WGM, gsz = (g.nM - fm) < pg8::WGM ? (g.nM - fm) : pg8::WGM;
    const int pm = fm + ((wgid % nig) % gsz), pn = (wgid % nig) / gsz;
    u.pm = pm; u.pn = pn; return true;
}

__device__ __forceinline__ void epilogue(const f32x4 (&acc)[2][2][4][2], const GemmCfg& g, const Unit& uu, int wr, int wc, int fr, int fq) {
    UnitIO u; make_unit(g, uu.pm, uu.pn, u);
    const int row0 = wr * 64 + fr, col0 = wc * 32 + 8 * fq;
    const int kind = u.kind, ld = u.ld;
    if (kind <= KD_RELU2) {
        bf16_t* O = (bf16_t*)u.out;
#pragma unroll
        for (int ai = 0; ai < 2; ++ai)
#pragma unroll
            for (int m = 0; m < 4; ++m) {
                bf16_t* rowp = O + (size_t)(row0 + ai * 128 + m * 16) * ld + col0;
#pragma unroll
                for (int bj = 0; bj < 2; ++bj) {
                    f32x4 v0 = acc[ai][bj][m][0], v1 = acc[ai][bj][m][1];
                    if (kind == KD_SILU) { v0[0] = siluf(v0[0]); v0[1] = siluf(v0[1]); v0[2] = siluf(v0[2]); v0[3] = siluf(v0[3]); v1[0] = siluf(v1[0]); v1[1] = siluf(v1[1]); v1[2] = siluf(v1[2]); v1[3] = siluf(v1[3]); }
                    else if (kind == KD_RELU2) {
                        v0[0] = fmaxf(v0[0], 0.f); v0[1] = fmaxf(v0[1], 0.f); v0[2] = fmaxf(v0[2], 0.f); v0[3] = fmaxf(v0[3], 0.f); v0 = v0 * v0;
                        v1[0] = fmaxf(v1[0], 0.f); v1[1] = fmaxf(v1[1], 0.f); v1[2] = fmaxf(v1[2], 0.f); v1[3] = fmaxf(v1[3], 0.f); v1 = v1 * v1; }
                    u32x4 o; o.x = pk2(v0[0], v0[1]); o.y = pk2(v0[2], v0[3]); o.z = pk2(v1[0], v1[1]); o.w = pk2(v1[2], v1[3]);
                    *(u32x4*)(rowp + bj * 128) = o;
                }
            }
    } else if (kind == KD_RES) {
        float* O = (float*)u.out;
        f32x4 gv[2][2];
#pragma unroll
        for (int bj = 0; bj < 2; ++bj)
#pragma unroll
            for (int n = 0; n < 2; ++n) gv[bj][n] = *(const f32x4*)(u.aux + col0 + bj * 128 + n * 4);
#pragma unroll
        for (int ai = 0; ai < 2; ++ai)
#pragma unroll
            for (int m = 0; m < 4; ++m) {
                float* rowp = O + (size_t)(row0 + ai * 128 + m * 16) * ld + col0;
#pragma unroll
                for (int bj = 0; bj < 2; ++bj)
#pragma unroll
                    for (int n = 0; n < 2; ++n) { f32x4* p = (f32x4*)(rowp + bj * 128 + n * 4); *p = *p + gv[bj][n] * acc[ai][bj][m][n]; }
            }
    } else if (kind == KD_LOGF) {
        float* O = (float*)u.out;
#pragma unroll
        for (int bj = 0; bj < 2; ++bj)
#pragma unroll
            for (int n = 0; n < 2; ++n) {
                const f32x4 bv = *(const f32x4*)(u.aux + col0 + bj * 128 + n * 4);
#pragma unroll
                for (int ai = 0; ai < 2; ++ai)
#pragma unroll
                    for (int m = 0; m < 4; ++m) {
                        f32x4 v = acc[ai][bj][m][n] + bv;
                        v[0] = logsigmoidf(v[0]) * 0.0625f; v[1] = logsigmoidf(v[1]) * 0.0625f; v[2] = logsigmoidf(v[2]) * 0.0625f; v[3] = logsigmoidf(v[3]) * 0.0625f;
                        *(f32x4*)(O + (size_t)(row0 + ai * 128 + m * 16) * ld + col0 + bj * 128 + n * 4) = v;
                    }
            }
    } else {
        float* O = (float*)u.out;
#pragma unroll
        for (int ai = 0; ai < 2; ++ai)
#pragma unroll
            for (int m = 0; m < 4; ++m) {
                float* rowp = O + (size_t)(row0 + ai * 128 + m * 16) * ld + col0;
#pragma unroll
                for (int bj = 0; bj < 2; ++bj)
#pragma unroll
                    for (int n = 0; n < 2; ++n) {
                        *(f32x4*)(rowp + bj * 128 + n * 4) = acc[ai][bj][m][n];
                    }
            }
    }
}

__device__ __forceinline__ void gemm_phase(LAS unsigned char* lds, const GemmCfg& g) {
    using namespace pg8;
    const int tid = otid(), wid = __builtin_amdgcn_readfirstlane(tid >> 6), lane = tid & 63, wr = wid >> 2, wc = wid & 3, fr = lane & 15, fq = lane >> 4;
    const int nt = g.nt;
    unsigned voffA[2], voffB[2];
#pragma unroll
    for (int i = 0; i < 2; ++i) { int R, C; stage_rc(tid * 16 + i * 8192, R, C); const int Rb = (R & ~31) + perm32(R & 31); voffA[i] = (unsigned)(R * g.ld + C) * 2u; voffB[i] = (unsigned)(Rb * g.ld + C) * 2u; }
    const size_t kstep = (size_t)(BK * 2);
    const size_t hstepA = (size_t)HALF * g.ld * 2;
#define hstepB hstepA
    const unsigned ldsw = (unsigned)wid * 1024u;
    const int aoff = lds_byte(wr * 64 + fr, fq * 8), boff = lds_byte(wc * 32 + fr, fq * 8);
#define PG8_SA(b, h) (((b) * 2 + (h)) * HTB)
#define PG8_SB(b, h) ((4 + (b) * 2 + (h)) * HTB)
#define PG8_STAGE(bufoff, gbase, voff) do { _Pragma("unroll") for (int _i = 0; _i < 2; ++_i) \
        __builtin_amdgcn_global_load_lds((const unsigned*)((const char*)(gbase) + (voff)[_i]), (LAS unsigned*)(lds + (bufoff) + ldsw + _i * 8192), 16, 0, 0); } while (0)
#define PG8_LDA(dst, b, h) do { _Pragma("unroll") for (int m = 0; m < 4; ++m) _Pragma("unroll") for (int k = 0; k < 2; ++k) dst[m][k] = *(const LAS bf16x8*)(lds + PG8_SA(b, h) + aoff + m * 2048 + k * 1024); } while (0)
#define PG8_LDB(dst, b, h) do { _Pragma("unroll") for (int n = 0; n < 2; ++n) _Pragma("unroll") for (int k = 0; k < 2; ++k) dst[n][k] = *(const LAS bf16x8*)(lds + PG8_SB(b, h) + boff + n * 2048 + k * 1024); } while (0)
#define PG8_MMA(ai, bj, At, Bt) do { __builtin_amdgcn_s_setprio(1); _Pragma("unroll") for (int m = 0; m < 4; ++m) _Pragma("unroll") for (int n = 0; n < 2; ++n) _Pragma("unroll") for (int k = 0; k < 2; ++k) \
        acc[ai][bj][m][n] = __builtin_amdgcn_mfma_f32_16x16x32_bf16(Bt[n][k], At[m][k], acc[ai][bj][m][n], 0, 0, 0); __builtin_amdgcn_s_setprio(0); } while (0)
#define PG8_WAIT_V(n) asm volatile("s_waitcnt vmcnt(" #n ")" ::: "memory")
#define PG8_WAIT_L(n) asm volatile("s_waitcnt lgkmcnt(" #n ")" ::: "memory")
#define PG8_BAR __builtin_amdgcn_s_barrier()
#define PG8_SCHED __builtin_amdgcn_sched_barrier(0)
    Unit cur, nxt; int ui = 0;
    if (!next_unit(g, 0, cur)) return;
    f32x4 acc[2][2][4][2];
#pragma unroll
    for (int a = 0; a < 2; ++a)
#pragma unroll
        for (int b = 0; b < 2; ++b)
#pragma unroll
            for (int m = 0; m < 4; ++m)
#pragma unroll
                for (int n = 0; n < 2; ++n) acc[a][b][m][n] = (f32x4){0.f, 0.f, 0.f, 0.f};
    bf16x8 At[4][2], B0[2][2], B1[2][2];
    const char* cA; const char* cB; { UnitIO io; make_unit(g, cur.pm, cur.pn, io); cA = io.A; cB = io.B; }
    PG8_STAGE(PG8_SB(0, 0), cB, voffB); PG8_STAGE(PG8_SB(0, 1), cB + hstepB, voffB); PG8_STAGE(PG8_SA(0, 0), cA, voffA); PG8_STAGE(PG8_SA(0, 1), cA + hstepA, voffA);
    if (wr == 1) PG8_BAR;
    PG8_WAIT_V(2); PG8_BAR;
    PG8_STAGE(PG8_SB(1, 0), cB + kstep, voffB); PG8_STAGE(PG8_SA(1, 0), cA + kstep, voffA); PG8_STAGE(PG8_SB(1, 1), cB + hstepB + kstep, voffB);
    PG8_WAIT_V(6); PG8_BAR;
    for (;;) {
        const bool has_next = next_unit(g, ui + 1, nxt);
        const char* nA = cA; const char* nB = cB; if (has_next) { UnitIO io; make_unit(g, nxt.pm, nxt.pn, io); nA = io.A; nB = io.B; }
        for (int t = 0; t < nt; t += 2) {
            const bool last = (t == nt - 2);
            const char* a1 = cA + (size_t)(t + 1) * kstep;
            const char* a2 = last ? nA : cA + (size_t)(t + 2) * kstep; const char* b2 = last ? nB : cB + (size_t)(t + 2) * kstep;
            const char* a3 = a2 + kstep; const char* b3 = b2 + kstep;
            PG8_LDB(B0, 0, 0); PG8_LDB(B1, 0, 1); PG8_SCHED; PG8_LDA(At, 0, 0); PG8_STAGE(PG8_SA(1, 1), a1 + hstepA, voffA);
            PG8_WAIT_V(8); PG8_WAIT_L(0); PG8_BAR; PG8_MMA(0, 0, At, B0); PG8_MMA(0, 1, At, B1); PG8_BAR; PG8_SCHED;
            PG8_LDA(At, 0, 1); PG8_STAGE(PG8_SB(0, 0), b2, voffB); PG8_STAGE(PG8_SB(0, 1), b2 + hstepB, voffB); PG8_STAGE(PG8_SA(0, 0), a2, voffA);
            PG8_WAIT_V(8); PG8_WAIT_L(0); PG8_BAR; PG8_MMA(1, 0, At, B0); PG8_MMA(1, 1, At, B1); PG8_BAR; PG8_SCHED;
            PG8_LDB(B0, 1, 0); PG8_LDB(B1, 1, 1); PG8_SCHED; PG8_LDA(At, 1, 0); PG8_STAGE(PG8_SA(0, 1), a2 + hstepA, voffA);
            PG8_WAIT_V(8); PG8_WAIT_L(0); PG8_BAR; PG8_MMA(0, 0, At, B0); PG8_MMA(0, 1, At, B1); PG8_BAR; PG8_SCHED;
            PG8_LDA(At, 1, 1); PG8_STAGE(PG8_SB(1, 0), b3, voffB); PG8_STAGE(PG8_SB(1, 1), b3 + hstepB, voffB); PG8_STAGE(PG8_SA(1, 0), a3, voffA);
            PG8_WAIT_V(8); PG8_WAIT_L(0); PG8_BAR; PG8_MMA(1, 0, At, B0); PG8_MMA(1, 1, At, B1); PG8_BAR; PG8_SCHED;
        }
        if (wr == 0) PG8_BAR;
        epilogue(acc, g, cur, wr, wc, fr, fq);
        if (!has_next) break;
#pragma unroll
        for (int a = 0; a < 2; ++a)
#pragma unroll
            for (int b = 0; b < 2; ++b)
#pragma unroll
                for (int m = 0; m < 4; ++m)
#pragma unroll
                    for (int n = 0; n < 2; ++n) acc[a][b][m][n] = (f32x4){0.f, 0.f, 0.f, 0.f};
        cur = nxt; cA = nA; cB = nB; ++ui;
        if (wr == 1) PG8_BAR;
    }
    PG8_WAIT_V(0);
    PG8_BAR;
#undef hstepB
#undef PG8_SA
#undef PG8_SB
#undef PG8_STAGE
#undef PG8_LDA
#undef PG8_LDB
#undef PG8_MMA
#undef PG8_WAIT_V
#undef PG8_WAIT_L
#undef PG8_BAR
#undef PG8_SCHED
}

__device__ __forceinline__ void transpose_item(const float* W, int ldn, int n0, int k0, bf16_t* WT, int drow0, int ldk, float scale, LAS float* scr, int lane) {
    float tv[32];
#pragma unroll
    for (int i = 0; i < 32; ++i) { const int kk = 2 * i + (lane >> 5); tv[i] = W[(size_t)(k0 + kk) * ldn + n0 + (lane & 31)]; }
#pragma unroll
    for (int i = 0; i < 32; ++i) { const int kk = 2 * i + (lane >> 5); scr[kk * 33 + (lane & 31)] = tv[i]; }
    asm volatile("s_waitcnt lgkmcnt(0)" ::: "memory");
    const int c = lane & 7;
#pragma unroll
    for (int jx = 0; jx < 4; ++jx) {
        const int n = (lane >> 3) + 8 * jx; const LAS float* s = scr + (8 * c) * 33 + n;
        u32x4 o; o.x = pk2(s[0] * scale, s[33] * scale); o.y = pk2(s[66] * scale, s[99] * scale); o.z = pk2(s[132] * scale, s[165] * scale); o.w = pk2(s[198] * scale, s[231] * scale);
        *(u32x4*)(WT + (size_t)(drow0 + n) * ldk + k0 + 8 * c) = o;
    }
    asm volatile("s_waitcnt lgkmcnt(0)" ::: "memory");
}

__device__ __forceinline__ void convert_layer(PP P, LAS unsigned char* lds, int l, int vb, int nb) {
    const int tid = otid(), lane = tid & 63, wave = tid >> 6;
    unsigned char* ws = P->ws;
    const int j = l >> 1, odd = l & 1;
    __syncthreads();
    {
        LAS float* scr = (LAS float*)(lds + wave * 8704);
        for (int it = vb * 8 + wave; it < 5376; it += nb * 8) {
            int r = it;
            if (r < 2048) { const int kb = r / 128, nbk = r % 128;
                transpose_item(P->in[I_W1] + (size_t)l * 1024 * 4096, 4096, nbk * 32, kb * 64, (bf16_t*)(ws + OFF_W1T) + (size_t)l * 4096 * 1024, nbk * 32, 1024, 1.f, scr, lane); continue; }
            r -= 2048;
            if (r < 2048) { const int kb = r / 32, nbk = r % 32;
                transpose_item(P->in[I_W2] + (size_t)l * 4096 * 1024, 1024, nbk * 32, kb * 64, (bf16_t*)(ws + OFF_W2T) + (size_t)l * 1024 * 4096, nbk * 32, 4096, 1.f, scr, lane); continue; }
            r -= 2048;
            if (!odd) {
                if (r < 1024) { const int kb = r / 64, nbk = r % 64; const int sb = nbk < 48 ? nbk : nbk + 1; const int n0 = sb * 32; const int drow = n0 < 1536 ? n0 : n0 + 480;
                    transpose_item(P->in[I_WINE] + (size_t)j * 1024 * 2080, 2080, n0, kb * 64, (bf16_t*)(ws + OFF_WIE) + (size_t)j * 2560 * 1024, drow, 1024, n0 < 256 ? 0.125f : 1.f, scr, lane); continue; }
                r -= 1024;
                { const int kb = r / 32, nbk = r % 32;
                    transpose_item(P->in[I_WOUTE] + (size_t)j * 1024 * 1024, 1024, nbk * 32, kb * 64, (bf16_t*)(ws + OFF_WOE) + (size_t)j * 1024 * 1024, nbk * 32, 1024, 1.f, scr, lane); }
            } else {
                if (r < 768) { const int kb = r / 48, nbk = r % 48; const int n0 = 512 + nbk * 32;
                    transpose_item(P->in[I_WINO] + (size_t)j * 1024 * 2048, 2048, n0, kb * 64, (bf16_t*)(ws + OFF_WIO) + (size_t)j * 2560 * 1024, n0 + 512, 1024, 1.f, scr, lane); continue; }
                r -= 768;
                { const int kb = r / 32, nbk = r % 32;
                    transpose_item(P->in[I_WOUTO] + (size_t)j * 1024 * 1024, 1024, nbk * 32, kb * 64, (bf16_t*)(ws + OFF_WOO) + (size_t)j * 1024 * 1024, nbk * 32, 1024, 1.f, scr, lane); }
            }
        }
    }
    __syncthreads();
    if (odd) {
    {
        LAS float* wt = (LAS float*)lds;
        LAS float* tab = (LAS float*)(lds + 64 * 129 * 4);
        for (int it = vb; it < 64; it += nb) {
            const int g = (it >> 4) & 3, kb = it & 15;
            for (int idx = tid; idx < 64 * 128; idx += 512) { const int kk = idx >> 7, c = idx & 127; wt[kk * 129 + c] = P->in[I_WINO][((size_t)j * 1024 + kb * 64 + kk) * 2048 + g * 128 + c]; }
            if (tid < 128) { tab[tid] = __builtin_amdgcn_cosf((float)tid * (1.f / 128.f)); tab[128 + tid] = __builtin_amdgcn_sinf((float)tid * (1.f / 128.f)); }
            __syncthreads();
            const int li = lane & 15, lq = lane >> 4;
            f32x4 acc[2][4];
#pragma unroll
            for (int ti = 0; ti < 2; ++ti)
#pragma unroll
                for (int u = 0; u < 4; ++u) acc[ti][u] = (f32x4){0.f, 0.f, 0.f, 0.f};
            const int zm0 = 16 * (2 * wave) + li, zm1 = zm0 + 16;
            for (int sx = 0; sx < 32; ++sx) {
                const int c = 4 * sx + lq;
                const float a0 = tab[(zm0 >> 7) * 128 + (((zm0 & 127) * c) & 127)], a1 = tab[(zm1 >> 7) * 128 + (((zm1 & 127) * c) & 127)];
#pragma unroll
                for (int u = 0; u < 4; ++u) {
                    const float b = wt[(16 * u + li) * 129 + c];
                    acc[0][u] = __builtin_amdgcn_mfma_f32_16x16x4f32(a0, b, acc[0][u], 0, 0, 0);
                    acc[1][u] = __builtin_amdgcn_mfma_f32_16x16x4f32(a1, b, acc[1][u], 0, 0, 0);
                }
            }
#pragma unroll
            for (int ti = 0; ti < 2; ++ti)
#pragma unroll
                for (int r = 0; r < 4; ++r) {
                    const int zm = 16 * (2 * wave + ti) + 4 * lq + r, z = zm >> 7, m = zm & 127;
                    bf16_t* O = (bf16_t*)(ws + OFF_WIO) + (size_t)j * 2560 * 1024 + (size_t)(z * 512 + g * 128 + m) * 1024 + kb * 64 + li;
#pragma unroll
                    for (int u = 0; u < 4; ++u) O[16 * u] = f2bf(acc[ti][u][r]);
                }
            __syncthreads();
        }
    }
    } else {
    {
        LAS float* Pt = (LAS float*)lds;
        LAS float* Wd = (LAS float*)(lds + 65536);
        for (int it = vb; it < 64; it += nb) {
            const int g = (it >> 4) & 3, nbk = it & 15;
            for (int idx = tid; idx < 128 * 128; idx += 512) { const int c = idx >> 7, d = idx & 127; Pt[d * 128 + c] = P->in[I_POOLW][((size_t)(j * 4 + g) * 128 + c) * 128 + d] * P->in[I_POOLS][j * 512 + g * 128 + d]; }
            for (int idx = tid; idx < 128 * 64; idx += 512) { const int d = idx >> 6, n = idx & 63; Wd[d * 64 + n] = P->in[I_WOUTE][((size_t)j * 1024 + 512 + g * 128 + d) * 1024 + nbk * 64 + n]; }
            __syncthreads();
            const int c = tid & 127, ng = tid >> 7;
            float acc[16];
#pragma unroll
            for (int nn = 0; nn < 16; ++nn) acc[nn] = 0.f;
            for (int d = 0; d < 128; ++d) {
                const float p = Pt[d * 128 + c];
#pragma unroll
                for (int nn = 0; nn < 16; ++nn) acc[nn] += p * Wd[d * 64 + ng * 16 + nn];
            }
            bf16_t* O = (bf16_t*)(ws + OFF_WOE) + (size_t)j * 1024 * 1024 + (size_t)(nbk * 64 + ng * 16) * 1024 + 512 + g * 128 + c;
#pragma unroll
            for (int nn = 0; nn < 16; ++nn) O[(size_t)nn * 1024] = f2bf(acc[nn]);
            __syncthreads();
        }
    }
    {
        LAS float* av = (LAS float*)lds;
        LAS float* w2 = (LAS float*)(lds + 16384);
        for (int it = (vb + nb - (nb > 16 ? 16 : 0)) % nb; it < 16; it += nb) {
            const int kb = it & 15;
            for (int idx = tid; idx < 64 * 32; idx += 512) { const int kk = idx >> 5, r = idx & 31; av[kk * 33 + r] = P->in[I_WINE][((size_t)j * 1024 + kb * 64 + kk) * 2080 + 1536 + r]; }
            for (int idx = tid; idx < 8192; idx += 512) w2[idx] = P->in[I_WA2][(size_t)j * 8192 + idx];
            __syncthreads();
            const int k = tid & 63, grp = tid >> 6, z = grp >> 2, n0 = (grp & 3) * 64;
            float a[16];
#pragma unroll
            for (int r = 0; r < 16; ++r) a[r] = av[k * 33 + z * 16 + r];
            bf16_t* O = (bf16_t*)(ws + OFF_WIE) + (size_t)j * 2560 * 1024 + (size_t)(1536 + z * 256 + n0) * 1024 + kb * 64 + k;
            for (int nn = 0; nn < 64; ++nn) {
                float s = 0.f;
#pragma unroll
                for (int r = 0; r < 16; ++r) s += a[r] * w2[(z * 16 + r) * 256 + n0 + nn];
                O[(size_t)nn * 1024] = f2bf(s);
            }
            __syncthreads();
        }
    }
    }
}

__device__ __forceinline__ void tgen_part(PP P, int vb, int nb) {
    const int tid = otid(); unsigned char* ws = P->ws;
    {
        const int gt = vb * 512 + tid, GT = nb * 512;
        for (int it = gt; it < 2048 * 512 + 256 * 64; it += GT) {
            int L, k, c0; bf16_t* T; float s;
            if (it < 2048 * 512) { L = 2048; k = it >> 9; c0 = (it & 511) * 8; T = (bf16_t*)(ws + OFF_T2K); s = 1.f / 512.f; }
            else { const int r = it - 2048 * 512; L = 256; k = r >> 6; c0 = (r & 63) * 8; T = (bf16_t*)(ws + OFF_T256); s = 0.00552427172801990f; }
            const int z = c0 >= L; const int l0 = c0 - z * L; const float invL = 1.f / (float)L;
            float v[8];
#pragma unroll
            for (int e = 0; e < 8; ++e) { const int ph = (k * (l0 + e)) & (L - 1); const float fr = (float)ph * invL; v[e] = z ? -__builtin_amdgcn_sinf(fr) * s : __builtin_amdgcn_cosf(fr) * s; }
            u32x4 o; o.x = pk2(v[0], v[1]); o.y = pk2(v[2], v[3]); o.z = pk2(v[4], v[5]); o.w = pk2(v[6], v[7]);
            *(u32x4*)(T + (size_t)k * (2 * L) + c0) = o;
        }
    }
}
__device__ __forceinline__ void gemv_mod(PP P, LAS unsigned char* lds, int l, int vb, int nb) {
    const int tid = otid(); unsigned char* ws = P->ws;
    __syncthreads();
    {
        LAS float* sc = (LAS float*)lds;
        LAS float* red = (LAS float*)(lds + 20480);
        bool staged = false;
        for (int it = vb; it < 48; it += nb) {
            if (!staged) {
                for (int idx = tid; idx < 5120; idx += 512) { const int cnd = idx >> 10, k = idx & 1023; const float c = cnd == 0 ? P->in[I_CCTX][k] : P->in[I_C][(cnd - 1) * 1024 + k]; sc[idx] = siluf(c); }
                staged = true; __syncthreads();
            }
            const int cb = it, quad = tid & 31, kc = tid >> 5;
            const float* wp = P->in[I_WADA] + ((size_t)l * 1024 + kc * 64) * 6144 + cb * 128 + quad * 4;
            f32x4 a[5];
#pragma unroll
            for (int cnd = 0; cnd < 5; ++cnd) a[cnd] = (f32x4){0.f, 0.f, 0.f, 0.f};
#pragma unroll 16
            for (int kk = 0; kk < 64; ++kk) {
                const f32x4 w = *(const f32x4*)(wp + (size_t)kk * 6144);
#pragma unroll
                for (int cnd = 0; cnd < 5; ++cnd) a[cnd] += w * sc[cnd * 1024 + kc * 64 + kk];
            }
#pragma unroll
            for (int cnd = 0; cnd < 5; ++cnd) *(LAS f32x4*)(red + (kc * 5 + cnd) * 128 + quad * 4) = a[cnd];
            __syncthreads();
            for (int idx = tid; idx < 640; idx += 512) {
                const int cnd = idx >> 7, cc = idx & 127; float s = 0.f;
#pragma unroll
                for (int k2 = 0; k2 < 16; ++k2) s += red[(k2 * 5 + cnd) * 128 + cc];
                ((float*)(ws + OFF_MOD))[(size_t)(l * 5 + cnd) * 6144 + cb * 128 + cc] = s + P->in[I_BADA][l * 6144 + cb * 128 + cc];
            }
            __syncthreads();
        }
    }
    __syncthreads();
}

__device__ __forceinline__ void prep_phase(PP P, LAS unsigned char* lds) {
    const int tid = otid(), lane = tid & 63, wave = tid >> 6, G = gridDim.x, bx = obid();
    unsigned char* ws = P->ws;
    convert_layer(P, lds, 0, (bx + 64) % G, G);
    {
        float* X = (float*)(ws + OFF_X);
        for (int r = bx * 8 + wave; r < NTOK; r += G * 8) {
            if (r < NPROMPT) {
#pragma unroll
                for (int jj = 0; jj < 4; ++jj) *(f32x4*)(X + (size_t)r * 1024 + jj * 256 + lane * 4) = *(const f32x4*)(P->in[I_XP] + (size_t)r * 1024 + jj * 256 + lane * 4);
            } else {
                const int s = r - NPROMPT, t = s & 2047; const float gr = (float)(t >> 6), gc = (float)(t & 63);
#pragma unroll
                for (int jj = 0; jj < 4; ++jj) {
                    f32x4 v = *(const f32x4*)(P->in[I_XS] + (size_t)s * 1024 + jj * 256 + lane * 4);
#pragma unroll
                    for (int e = 0; e < 4; ++e) {
                        const float fq = __builtin_amdgcn_exp2f(-(float)(lane * 4 + e) * (13.287712379549449f / 256.f));
                        const float ang = (jj < 2 ? gr : gc) * fq;
                        v[e] += (jj & 1) ? __cosf(ang) : __sinf(ang);
                    }
                    *(f32x4*)(X + (size_t)r * 1024 + jj * 256 + lane * 4) = v;
                }
            }
        }
    }
    __syncthreads();
    gemv_mod(P, lds, 0, (bx + 128) % G, G);
}

__device__ __forceinline__ void norm_phase(PP P, int l, int which) {
    const int tid = otid(), lane = tid & 63, wave = tid >> 6, G = gridDim.x, bx = obid();
    unsigned char* ws = P->ws;
    const float* X = (const float*)(ws + OFF_X);
    const float* gp = which == 2 ? P->in[I_FINALG] : P->in[I_NORMG] + (size_t)(l * 2 + which) * 1024;
    f32x4 gv[4];
#pragma unroll
    for (int jj = 0; jj < 4; ++jj) gv[jj] = *(const f32x4*)(gp + jj * 256 + lane * 4);
    for (int r0 = bx * 8 + wave; r0 < NTOK; r0 += G * 16) {
        f32x4 v[2][4]; float ss[2] = {0.f, 0.f};
#pragma unroll
        for (int u = 0; u < 2; ++u) { const int r = r0 + u * G * 8; if (r < NTOK) {
#pragma unroll
            for (int jj = 0; jj < 4; ++jj) v[u][jj] = *(const f32x4*)(X + (size_t)r * 1024 + jj * 256 + lane * 4); } }
#pragma unroll
        for (int u = 0; u < 2; ++u) {
            const int r = r0 + u * G * 8; if (r >= NTOK) continue;
#pragma unroll
            for (int jj = 0; jj < 4; ++jj) ss[u] += v[u][jj][0] * v[u][jj][0] + v[u][jj][1] * v[u][jj][1] + v[u][jj][2] * v[u][jj][2] + v[u][jj][3] * v[u][jj][3];
            const float rstd = rsqrtf(wave_sum(ss[u]) * (1.f / 1024.f) + 1e-6f);
            if (which == 2) {
#pragma unroll
                for (int jj = 0; jj < 4; ++jj) *(f32x4*)(P->out + (size_t)r * 1024 + jj * 256 + lane * 4) = v[u][jj] * rstd * gv[jj];
            } else {
                const int cnd = r < NPROMPT ? 0 : 1 + ((r - NPROMPT) >> 11);
                const float* mp = (const float*)(ws + OFF_MOD) + (size_t)(l * 5 + cnd) * 6144 + which * 3072;
                bf16_t* Hh = (bf16_t*)(ws + OFF_H) + (size_t)r * 1024;
#pragma unroll
                for (int jj = 0; jj < 4; ++jj) {
                    const f32x4 sh = *(const f32x4*)(mp + jj * 256 + lane * 4), sc = *(const f32x4*)(mp + 1024 + jj * 256 + lane * 4);
                    const f32x4 y = v[u][jj] * rstd * gv[jj] * (sc + 1.f) + sh;
                    u32x2 o; o.x = pk2(y[0], y[1]); o.y = pk2(y[2], y[3]);
                    *(u32x2*)(Hh + jj * 256 + lane * 4) = o;
                }
            }
        }
    }
}

template <int W> __device__ __forceinline__ void pool_item(const bf16_t* UB, bf16_t* AM, int t, int ch) {
    int s0, L; if (t < NPROMPT) { s0 = t & ~255; L = 256; } else { s0 = NPROMPT + ((t - NPROMPT) & ~2047); L = 2048; }
    const int tl = t - s0;
    u32x4 v[W];
#pragma unroll
    for (int jx = 0; jx < W; ++jx) { int tt = tl - W / 2 + jx; tt = tt < 0 ? 0 : (tt >= L ? L - 1 : tt); v[jx] = *(const u32x4*)(UB + (size_t)(s0 + tt) * 512 + ch); }
    const u32x4 c = *(const u32x4*)(UB + (size_t)t * 512 + ch);
    float s[8];
#pragma unroll
    for (int e = 0; e < 8; ++e) s[e] = 0.f;
#pragma unroll
    for (int jx = 0; jx < W; ++jx) {
        const int tt = tl - W / 2 + jx; const float m = (tt >= 0 && tt < L) ? 1.f : 0.f;
        s[0] += m * bflo(v[jx].x); s[1] += m * bfhi(v[jx].x); s[2] += m * bflo(v[jx].y); s[3] += m * bfhi(v[jx].y);
        s[4] += m * bflo(v[jx].z); s[5] += m * bfhi(v[jx].z); s[6] += m * bflo(v[jx].w); s[7] += m * bfhi(v[jx].w);
    }
    const int lo = max(tl - W / 2, 0), hi = min(tl + W - W / 2, L);
    const float ic = 1.f / (float)(hi - lo);
    u32x4 o;
    o.x = pk2(s[0] * ic - bflo(c.x), s[1] * ic - bfhi(c.x)); o.y = pk2(s[2] * ic - bflo(c.y), s[3] * ic - bfhi(c.y));
    o.z = pk2(s[4] * ic - bflo(c.z), s[5] * ic - bfhi(c.z)); o.w = pk2(s[6] * ic - bflo(c.w), s[7] * ic - bfhi(c.w));
    *(u32x4*)(AM + (size_t)t * 1024 + 512 + ch) = o;
}
__device__ __forceinline__ void pool_phase(PP P) {
    unsigned char* ws = P->ws;
    const bf16_t* UB = (const bf16_t*)(ws + OFF_UB);
    bf16_t* AM = (bf16_t*)(ws + OFF_AMIX);
    const int tid = otid(), lane = tid & 63, wave = tid >> 6;
    for (int wi = obid() * 8 + wave; wi < 4 * (NTOK / 4); wi += gridDim.x * 8) {
        const int g = wi & 3, t = (wi >> 2) * 4 + (lane >> 4), ch = (g * 16 + (lane & 15)) * 8;
        if (g == 0) pool_item<2>(UB, AM, t, ch);
        else if (g == 1) pool_item<4>(UB, AM, t, ch);
        else if (g == 2) pool_item<8>(UB, AM, t, ch);
        else pool_item<16>(UB, AM, t, ch);
    }
}

__device__ __forceinline__ void mixprep_phase(PP P, int j) {
    const int tid = otid(), lane = tid & 63, wave = tid >> 6;
    unsigned char* ws = P->ws;
    const float* O0 = (const float*)(ws + OFF_ODIR); const float* O1 = O0 + (size_t)NTOK * 512;
    const bf16_t* GT = (const bf16_t*)(ws + OFF_GATE);
    bf16_t* AM = (bf16_t*)(ws + OFF_AMIX);
    const int ch = lane * 8;
    const f32x4 g0 = *(const f32x4*)(P->in[I_GLAG] + j * 128 + (ch & 127)), g1 = *(const f32x4*)(P->in[I_GLAG] + j * 128 + (ch & 127) + 4);
    const int G8 = gridDim.x * 8;
    for (int r0 = obid() * 8 + wave; r0 < NTOK; r0 += 2 * G8) {
        f32x4 a[2], b[2]; u32x4 gt[2];
#pragma unroll
        for (int u = 0; u < 2; ++u) { const int r = r0 + u * G8; if (r < NTOK) {
            a[u] = *(const f32x4*)(O0 + (size_t)r * 512 + ch) + *(const f32x4*)(O1 + (size_t)r * 512 + ch);
            b[u] = *(const f32x4*)(O0 + (size_t)r * 512 + ch + 4) + *(const f32x4*)(O1 + (size_t)r * 512 + ch + 4);
            gt[u] = *(const u32x4*)(GT + (size_t)r * 512 + ch); } }
#pragma unroll
        for (int u = 0; u < 2; ++u) {
            const int r = r0 + u * G8; if (r >= NTOK) continue;
            float ss = a[u][0] * a[u][0] + a[u][1] * a[u][1] + a[u][2] * a[u][2] + a[u][3] * a[u][3] + b[u][0] * b[u][0] + b[u][1] * b[u][1] + b[u][2] * b[u][2] + b[u][3] * b[u][3];
            ss += __shfl_xor(ss, 1); ss += __shfl_xor(ss, 2); ss += __shfl_xor(ss, 4); ss += __shfl_xor(ss, 8);
            const float rstd = rsqrtf(ss * (1.f / 128.f) + 1e-6f);
            const f32x4 aa = a[u] * rstd * g0, bb = b[u] * rstd * g1;
            u32x4 o;
            o.x = pk2(aa[0] * bflo(gt[u].x), aa[1] * bfhi(gt[u].x)); o.y = pk2(aa[2] * bflo(gt[u].y), aa[3] * bfhi(gt[u].y));
            o.z = pk2(bb[0] * bflo(gt[u].z), bb[1] * bfhi(gt[u].z)); o.w = pk2(bb[2] * bflo(gt[u].w), bb[3] * bfhi(gt[u].w));
            *(u32x4*)(AM + (size_t)r * 1024 + ch) = o;
        }
    }
}

__device__ __forceinline__ void conv_phase(PP P, int j, int vb, int nb) {
    unsigned char* ws = P->ws;
    const bf16_t* XI = (const bf16_t*)(ws + OFF_XIN); const bf16_t* BGp = (const bf16_t*)(ws + OFF_BG); const bf16_t* CGp = (const bf16_t*)(ws + OFF_CG);
    bf16_t* AM = (bf16_t*)(ws + OFF_AMIX);
    for (int idx = vb * 512 + otid(); idx < NTOK * 64; idx += nb * 512) {
        const int t = idx >> 6, ch = (idx & 63) * 8;
        int s0, L; if (t < NPROMPT) { s0 = t & ~255; L = 256; } else { s0 = NPROMPT + ((t - NPROMPT) & ~2047); L = 2048; }
        const int tl = t - s0;
        float cv[8];
        { const f32x4 b0 = *(const f32x4*)(P->in[I_CONVB] + j * 512 + ch), b1 = *(const f32x4*)(P->in[I_CONVB] + j * 512 + ch + 4);
          cv[0] = b0[0]; cv[1] = b0[1]; cv[2] = b0[2]; cv[3] = b0[3]; cv[4] = b1[0]; cv[5] = b1[1]; cv[6] = b1[2]; cv[7] = b1[3]; }
#pragma unroll
        for (int jj = 0; jj < 3; ++jj) {
            const int tt = tl + jj - 1;
            if (tt < 0 || tt >= L) continue;
            const u32x4 xv = *(const u32x4*)(XI + (size_t)(s0 + tt) * 512 + ch), cg = *(const u32x4*)(CGp + (size_t)(s0 + tt) * 512 + ch);
            const f32x4 w0 = *(const f32x4*)(P->in[I_CONVW] + (size_t)(j * 3 + jj) * 512 + ch), w1 = *(const f32x4*)(P->in[I_CONVW] + (size_t)(j * 3 + jj) * 512 + ch + 4);
            cv[0] += bflo(xv.x) * bflo(cg.x) * w0[0]; cv[1] += bfhi(xv.x) * bfhi(cg.x) * w0[1]; cv[2] += bflo(xv.y) * bflo(cg.y) * w0[2]; cv[3] += bfhi(xv.y) * bfhi(cg.y) * w0[3];
            cv[4] += bflo(xv.z) * bflo(cg.z) * w1[0]; cv[5] += bfhi(xv.z) * bfhi(cg.z) * w1[1]; cv[6] += bflo(xv.w) * bflo(cg.w) * w1[2]; cv[7] += bfhi(xv.w) * bfhi(cg.w) * w1[3];
        }
        const u32x4 bg = *(const u32x4*)(BGp + (size_t)t * 512 + ch);
        u32x4 o;
        o.x = pk2(cv[0] * bflo(bg.x), cv[1] * bfhi(bg.x)); o.y = pk2(cv[2] * bflo(bg.y), cv[3] * bfhi(bg.y));
        o.z = pk2(cv[4] * bflo(bg.z), cv[5] * bfhi(bg.z)); o.w = pk2(cv[6] * bflo(bg.w), cv[7] * bfhi(bg.w));
        *(u32x4*)(AM + (size_t)t * 1024 + 512 + ch) = o;
    }
}

__device__ __forceinline__ void convert_phase(PP P) {
    unsigned char* ws = P->ws;
    bf16_t* AM = (bf16_t*)(ws + OFF_AMIX);
    for (int idx = obid() * 512 + otid(); idx < NTOK * 64; idx += gridDim.x * 512) {
        const int t = idx >> 6, ch = (idx & 63) * 8;
        f32x4 a, b;
        if (t < NPROMPT) { const float* F = (const float*)(ws + OFF_FACCP) + (size_t)t * 512 + ch; a = *(const f32x4*)F; b = *(const f32x4*)(F + 4); }
        else {
            const float* F = (const float*)(ws + OFF_FACCS) + (size_t)(t - NPROMPT) * 512 + ch;
            a = *(const f32x4*)F; b = *(const f32x4*)(F + 4);
#pragma unroll
            for (int ks = 1; ks < 4; ++ks) { a += *(const f32x4*)(F + (size_t)ks * 8192 * 512); b += *(const f32x4*)(F + (size_t)ks * 8192 * 512 + 4); }
        }
        u32x4 o; o.x = pk2(a[0], a[1]); o.y = pk2(a[2], a[3]); o.z = pk2(b[0], b[1]); o.w = pk2(b[2], b[3]);
        *(u32x4*)(AM + (size_t)t * 1024 + ch) = o;
    }
}

__device__ __forceinline__ int permd(int d) { return (d & 32) | ((d & 12) << 1) | ((d & 16) >> 2) | (d & 3); }
__device__ __forceinline__ bf16x8 pack8(const f32x4& a, const f32x4& b) {
    u32x4 o; o.x = pk2(a[0], a[1]); o.y = pk2(a[2], a[3]); o.z = pk2(b[0], b[1]); o.w = pk2(b[2], b[3]);
    return __builtin_bit_cast(bf16x8, o);
}
__device__ __forceinline__ void gla_item(PP P, LAS unsigned char* lds, int j, int seg, int head, int dir, bool full) {
    const int tid = otid(), lane = tid & 63, w = tid >> 6, r = lane & 15, q = lane >> 4;
    unsigned char* ws = P->ws;
    const bf16_t* QB = (const bf16_t*)(ws + OFF_QB); const bf16_t* KB = (const bf16_t*)(ws + OFF_KB); const bf16_t* VT = (const bf16_t*)(ws + OFF_VT);
    const float* LOGF = (const float*)(ws + OFF_LOGF);
    float* ODIR = (float*)(ws + OFF_ODIR);
    float* Ubuf = (float*)(ws + OFF_U); float* Dtot = (float*)(ws + OFF_DTOT);
    LAS bf16_t* QT = (LAS bf16_t*)(lds);
    LAS bf16_t* KT = (LAS bf16_t*)(lds + 36864);
    LAS bf16_t* KH = (LAS bf16_t*)(lds + 73728);
    LAS float* DL = (LAS float*)(lds + 114688);
    LAS bf16x8* ATT = (LAS bf16x8*)(lds + 116736);
    const int tok0 = seg * 256;
    __syncthreads();
    {
        const int d = tid & 63, c = w, pd = permd(d);
        float b = 0.f;
        const float* lf = LOGF + (size_t)(tok0 + 32 * c) * 512 + dir * 256 + head * 64 + d;
        const bf16_t* qp = QB + (size_t)(tok0 + 32 * c) * 256 + head * 64 + d;
        const bf16_t* kp = KB + (size_t)(tok0 + 32 * c) * 256 + head * 64 + d;
        float lfv[32]; bf16_t qv16[32], kv16[32];
#pragma unroll
        for (int ii = 0; ii < 32; ++ii) { const int il = dir ? 31 - ii : ii; lfv[ii] = lf[(size_t)il * 512]; qv16[ii] = qp[(size_t)il * 256]; kv16[ii] = kp[(size_t)il * 256]; }
#pragma unroll
        for (int ii = 0; ii < 32; ++ii) {
            const int il = dir ? 31 - ii : ii;
            b += lfv[ii];
            const float qv = bf2f(qv16[ii]), kv = bf2f(kv16[ii]);
            QT[(32 * c + il) * 72 + pd] = f2bf(qv * __expf(b));
            KT[(32 * c + il) * 72 + pd] = f2bf(kv * __expf(-b));
        }
        const float eT = __expf(b);
        DL[c * 64 + d] = eT;
#pragma unroll 8
        for (int il = 0; il < 32; ++il) KH[(c * 64 + d) * 40 + permd(il)] = f2bf(bf2f(KT[(32 * c + il) * 72 + pd]) * eT);
    }
    __syncthreads();
    if (full) {
        const int c = w;
        f32x4 at[2][2];
#pragma unroll
        for (int a = 0; a < 2; ++a)
#pragma unroll
            for (int b = 0; b < 2; ++b) at[a][b] = (f32x4){0.f, 0.f, 0.f, 0.f};
#pragma unroll
        for (int kk = 0; kk < 2; ++kk) {
            bf16x8 ka[2], qb[2];
#pragma unroll
            for (int t = 0; t < 2; ++t) { ka[t] = *(const LAS bf16x8*)(KT + (32 * c + 16 * t + r) * 72 + 32 * kk + 8 * q); qb[t] = *(const LAS bf16x8*)(QT + (32 * c + 16 * t + r) * 72 + 32 * kk + 8 * q); }
#pragma unroll
            for (int tj = 0; tj < 2; ++tj)
#pragma unroll
                for (int ti = 0; ti < 2; ++ti) at[tj][ti] = __builtin_amdgcn_mfma_f32_16x16x32_bf16(ka[tj], qb[ti], at[tj][ti], 0, 0, 0);
        }
#pragma unroll
        for (int ti = 0; ti < 2; ++ti) {
            const int i = 16 * ti + r;
#pragma unroll
            for (int tj = 0; tj < 2; ++tj)
#pragma unroll
                for (int jj = 0; jj < 4; ++jj) { const int jx = 16 * tj + 4 * q + jj; const bool keep = dir ? (jx >= i) : (jx <= i); if (!keep) at[tj][ti][jj] = 0.f; }
            ATT[(c * 2 + ti) * 64 + lane] = pack8(at[0][ti], at[1][ti]);
        }
    }
    __syncthreads();
    f32x4 S[4];
#pragma unroll
    for (int t = 0; t < 4; ++t) S[t] = (f32x4){0.f, 0.f, 0.f, 0.f};
    const int e = 16 * w + r;
    if (DBG_SINIT && full && seg >= 16) {
        const int sb = (seg - 16) >> 3, part = (seg - 16) & 7;
        const float* s0 = P->in[I_STATE] + ((size_t)(((sb * 2 + j) * 2 + dir) * 4 + head) * 64) * 128;
#pragma unroll
        for (int t = 0; t < 4; ++t)
#pragma unroll
            for (int jj = 0; jj < 4; ++jj) S[t][jj] = s0[(size_t)(16 * t + 4 * q + jj) * 128 + e];
        const int np = dir ? 7 - part : part;
#pragma unroll
        for (int xb = 0; xb < 8; xb += 4) {
            if (xb >= np) break;
            float dvv[4][16], uvv[4][16];
#pragma unroll
            for (int xi = 0; xi < 4; ++xi) {
                const int x = xb + xi; if (x >= 7) continue;
                const int pp = dir ? 7 - x : x;
                const size_t ib = (size_t)(((sb * 8 + pp) * 4 + head) * 2 + dir) * 64;
#pragma unroll
                for (int t = 0; t < 4; ++t)
#pragma unroll
                    for (int jj = 0; jj < 4; ++jj) { const int d = 16 * t + 4 * q + jj; dvv[xi][t * 4 + jj] = Dtot[ib + d]; uvv[xi][t * 4 + jj] = Ubuf[(ib + d) * 128 + e]; }
            }
#pragma unroll
            for (int xi = 0; xi < 4; ++xi) {
                const int x = xb + xi; if (x >= 7) continue;
                const bool on = x < np;
#pragma unroll
                for (int t = 0; t < 4; ++t)
#pragma unroll
                    for (int jj = 0; jj < 4; ++jj) S[t][jj] = on ? S[t][jj] * dvv[xi][t * 4 + jj] + uvv[xi][t * 4 + jj] : S[t][jj];
            }
        }
    }
    const bf16_t* vt = VT + (size_t)(head * 128 + e) * NTOK + tok0;
    u32x2 vpre0[8], vpre1[8];
#pragma unroll
    for (int cc = 0; cc < 8; ++cc) { const int c = dir ? 7 - cc : cc; vpre0[cc] = *(const u32x2*)(vt + 32 * c + 4 * q); vpre1[cc] = *(const u32x2*)(vt + 32 * c + 16 + 4 * q); }
#pragma unroll
    for (int cc = 0; cc < 8; ++cc) {
        const int c = dir ? 7 - cc : cc;
        const u32x2 v0 = vpre0[cc], v1 = vpre1[cc];
        u32x4 vv; vv.x = v0.x; vv.y = v0.y; vv.z = v1.x; vv.w = v1.y;
        const bf16x8 vb = __builtin_bit_cast(bf16x8, vv);
        if (full) {
            bf16x8 sb2[2];
            sb2[0] = pack8(S[0], S[1]); sb2[1] = pack8(S[2], S[3]);
#pragma unroll
            for (int mi = 0; mi < 2; ++mi) {
                f32x4 o = (f32x4){0.f, 0.f, 0.f, 0.f};
#pragma unroll
                for (int kk = 0; kk < 2; ++kk) {
                    const bf16x8 qa = *(const LAS bf16x8*)(QT + (32 * c + 16 * mi + r) * 72 + 32 * kk + 8 * q);
                    o = __builtin_amdgcn_mfma_f32_16x16x32_bf16(qa, sb2[kk], o, 0, 0, 0);
                }
                const bf16x8 aa = ATT[(c * 2 + mi) * 64 + lane];
                o = __builtin_amdgcn_mfma_f32_16x16x32_bf16(aa, vb, o, 0, 0, 0);
                float* op = ODIR + ((size_t)dir * NTOK + tok0 + 32 * c + 16 * mi + 4 * q) * 512 + head * 128 + e;
#pragma unroll
                for (int jj = 0; jj < 4; ++jj) op[(size_t)jj * 512] = o[jj];
            }
        }
#pragma unroll
        for (int t = 0; t < 4; ++t) {
            const f32x4 dv = *(const LAS f32x4*)(DL + c * 64 + 16 * t + 4 * q);
            S[t] = S[t] * dv;
            const bf16x8 ka = *(const LAS bf16x8*)(KH + (c * 64 + 16 * t + r) * 40 + 8 * q);
            S[t] = __builtin_amdgcn_mfma_f32_16x16x32_bf16(ka, vb, S[t], 0, 0, 0);
        }
    }
    if (full) {
        if (seg < 16) {
            float* so = P->out + OUT_STATE + ((size_t)(((seg * 2 + j) * 2 + dir) * 4 + head) * 64) * 128;
#pragma unroll
            for (int t = 0; t < 4; ++t)
#pragma unroll
                for (int jj = 0; jj < 4; ++jj) so[(size_t)(16 * t + 4 * q + jj) * 128 + e] = S[t][jj];
        }
    } else {
        const size_t ib = (size_t)(((seg - 16) * 4 + head) * 2 + dir) * 64;
#pragma unroll
        for (int t = 0; t < 4; ++t)
#pragma unroll
            for (int jj = 0; jj < 4; ++jj) Ubuf[(ib + 16 * t + 4 * q + jj) * 128 + e] = S[t][jj];
        if (tid < 64) { float p = 1.f;
#pragma unroll
            for (int c = 0; c < 8; ++c) p *= DL[c * 64 + tid];
            Dtot[ib + tid] = p; }
    }
}

__device__ __forceinline__ void gla_phase(PP P, LAS unsigned char* lds, int j, int sub) {
    const int G = gridDim.x;
    if (sub == 0) {
        for (int it = obid(); it < 384; it += G) {
            if (it >= 128 && it < 256) { const int pi = it - 128; gla_item(P, lds, j, pi >> 3, (pi >> 1) & 3, pi & 1, true); }
            else { const int li = it < 128 ? it : it - 128; gla_item(P, lds, j, 16 + (li >> 3), (li >> 1) & 3, li & 1, false); }
        }
    } else {
        for (int it = obid(); it < 256; it += G) gla_item(P, lds, j, 16 + (it >> 3), (it >> 1) & 3, it & 1, true);
    }
}


#define XB_TMO      128
#define XB_XCNT(j)  (256  + 64 * (j))
#define XB_XSUB(j)  (1280 + 64 * (j))
#define XB_XGEN(j)  (2304 + 64 * (j))
#define XB_TOP      3328
#define XB_TOPGEN   3392
#define XCD_BAR_WORDS 3456
#define XB_SPIN_CAP (1u << 18)

__device__ __forceinline__ unsigned xb_ld(unsigned* p)              { return __hip_atomic_load(p, __ATOMIC_RELAXED, __HIP_MEMORY_SCOPE_AGENT); }
__device__ __forceinline__ unsigned xb_add(unsigned* p, unsigned v) { return __hip_atomic_fetch_add(p, v, __ATOMIC_RELAXED, __HIP_MEMORY_SCOPE_AGENT); }
__device__ __forceinline__ unsigned xb_xcc_id() { return (unsigned)__builtin_amdgcn_s_getreg((3 << 11) | 20) & 0xFu; }
#define XB_SPIN(cond, bar) do { unsigned _sp = 0; while (cond) { __builtin_amdgcn_s_sleep(1); \
    if ((++_sp & 255u) == 0u) { if (xb_ld(&(bar)[XB_TMO])) break; if (_sp > XB_SPIN_CAP) { atomicAdd(&(bar)[XB_TMO], 1u); break; } } } } while (0)

struct XcdBarrier {
    unsigned* bar; unsigned x;
    volatile LAS unsigned* st;
};

__device__ __forceinline__ XcdBarrier xcd_barrier_post(unsigned* bar, volatile LAS unsigned* st) {
    XcdBarrier b; b.bar = bar; b.x = xb_xcc_id(); b.st = st;
    if (threadIdx.x == 0) (void)xb_add(&bar[XB_XCNT(b.x)], 1u);
    return b;
}
__device__ __forceinline__ void xcd_barrier_complete(unsigned* bar, unsigned x, unsigned& nloc, unsigned& nx) {
    const unsigned G = gridDim.x * gridDim.y * gridDim.z;
    unsigned sum, cnt, mine, sp = 0u;
    for (;;) {
        sum = 0u; cnt = 0u; mine = 0u;
#pragma unroll
        for (unsigned j = 0; j < 16; ++j) { const unsigned c = xb_ld(&bar[XB_XCNT(j)]); sum += c; cnt += (c > 0u) ? 1u : 0u; mine = (j == x) ? c : mine; }
        if (sum == G) break;
        __builtin_amdgcn_s_sleep(1);
        if ((++sp & 255u) == 0u) { if (xb_ld(&bar[XB_TMO])) break; if (sp > XB_SPIN_CAP) { atomicAdd(&bar[XB_TMO], 1u); break; } }
    }
    nloc = mine > 0u ? mine : 1u; nx = cnt > 0u ? cnt : 1u;
}

__device__ __forceinline__ void xcd_barrier(const XcdBarrier& b) {
    asm volatile("s_waitcnt vmcnt(0)" ::: "memory");
    __syncthreads();
    if (threadIdx.x == 0) {
        unsigned* bar = b.bar;
        __builtin_amdgcn_s_waitcnt(0);
        unsigned nloc = b.st[0], nx = b.st[1];
        if (nloc == 0u) { xcd_barrier_complete(bar, b.x, nloc, nx); b.st[0] = nloc; b.st[1] = nx; }
        const unsigned old = xb_add(&bar[XB_XSUB(b.x)], 1u);
        const unsigned gen = old / nloc;
        if (old + 1u == (gen + 1u) * nloc) {
            __builtin_amdgcn_fence(__ATOMIC_RELEASE, "agent");
            asm volatile("s_waitcnt vmcnt(0)" ::: "memory");
            const unsigned og = xb_add(&bar[XB_TOP], 1u);
            const unsigned tg = og / nx;
            if (og + 1u == (tg + 1u) * nx) xb_add(&bar[XB_TOPGEN], 1u);
            else XB_SPIN(xb_ld(&bar[XB_TOPGEN]) == tg, bar);
            __builtin_amdgcn_fence(__ATOMIC_ACQUIRE, "agent");
            xb_add(&bar[XB_XGEN(b.x)], 1u);
            asm volatile("s_waitcnt vmcnt(0)" ::: "memory");
        } else {
            XB_SPIN(xb_ld(&bar[XB_XGEN(b.x)]) == gen, bar);
            __builtin_amdgcn_fence(__ATOMIC_ACQUIRE, "agent");
            asm volatile("s_waitcnt vmcnt(0)" ::: "memory");
        }
    }
    __syncthreads();
}

enum { PT_PREP = 0, PT_NORM1, PT_GEMM_IN, PT_MIX_A, PT_MIX_B, PT_MIXPREP, PT_GEMM_OUT, PT_NORM2, PT_MLP1, PT_MLP2, PT_FINAL };

__global__ void __launch_bounds__(512, 2) mega_fwd(Params Pk) {
    extern __shared__ __attribute__((aligned(16))) unsigned char smem[];
    LAS unsigned char* lds = (LAS unsigned char*)smem;
#ifdef DBG_ZLDS
    for (int i = otid(); i < LDS_BYTES / 16; i += 512) ((LAS u32x4*)lds)[i] = (u32x4){0u, 0u, 0u, 0u};
    __syncthreads();
#endif
    { volatile LAS unsigned* st0 = (volatile LAS unsigned*)(lds + LDS_BYTES - 64); if (otid() < 2) st0[otid()] = 0u; }
    __syncthreads();
    XcdBarrier gbar; gbar.bar = (unsigned*)(Pk.ws + OFF_BAR); gbar.x = 0; gbar.st = (volatile LAS unsigned*)(lds + LDS_BYTES - 64);
    if (Pk.ph_hi - Pk.ph_lo > 1) gbar = xcd_barrier_post((unsigned*)(Pk.ws + OFF_BAR), (volatile LAS unsigned*)(lds + LDS_BYTES - 64));
    if (Pk.ph_hi < 0) cg::this_grid().sync();
    for (int ph = Pk.ph_lo; ph < Pk.ph_hi; ++ph) {
        PP P = (PP)__builtin_amdgcn_kernarg_segment_ptr();
        asm volatile("" : "+s"(P));
        int pt, l = 0;
        if (ph == 0) pt = PT_PREP;
        else if (ph == NPH - 1) pt = PT_FINAL;
        else {
            const int qq = ph - 1; int s;
            if (qq < 9) { l = 0; s = qq; } else if (qq < 17) { l = 1; s = qq - 9; } else if (qq < 26) { l = 2; s = qq - 17; } else { l = 3; s = qq - 26; }
            pt = (l & 1) ? (s < 4 ? s + 1 : s + 2) : s + 1;
        }
        const int j = l >> 1, odd = l & 1;
        const int nrep = (pt == REP_PT && (REP_L < 0 || l == REP_L)) ? 1 + REP_N : 1;
        for (int rep = 0; rep < nrep; ++rep) {
        int ngemm = 0; GemmCfg g; g.G = gridDim.x; g.c = obid(); g.j = j; g.l = l; g.nM = 48; g.ld = 1024; g.nt = 16; g.type = 0; g.nN = 0;
        switch (pt) {
        case PT_PREP: if (EN & 1) prep_phase(P, lds); break;
        case PT_NORM1: if (EN & 2) norm_phase(P, l, 0); break;
        case PT_GEMM_IN: ngemm = 1; g.type = odd ? T_IN_ODD : T_IN_EVEN; g.nN = 10; break;
        case PT_MIX_A: if (odd) { ngemm = 2; g.type = T_DFT_S; g.nM = 8; g.nN = 32; g.ld = 4096; g.nt = 16; } else { if (EN & 4) gla_phase(P, lds, j, 0); if (EN & 8) pool_phase(P); } break;
        case PT_MIX_B: if (odd) { if (EN & 8) convert_phase(P); } else { if (EN & 4) gla_phase(P, lds, j, 1); } break;
        case PT_MIXPREP: if (EN & 8) mixprep_phase(P, j); break;
        case PT_GEMM_OUT: ngemm = 1; g.type = odd ? T_OUT_ODD : T_OUT_EVEN; g.nN = 4; break;
        case PT_NORM2: if (EN & 2) norm_phase(P, l, 1); break;
        case PT_MLP1: ngemm = 1; g.type = T_MLP1; g.nN = 16; break;
        case PT_MLP2: ngemm = 1; g.type = T_MLP2; g.nN = 4; g.ld = 4096; g.nt = 64; break;
        default: if (EN & 2) norm_phase(P, 0, 2); break;
        }
        for (int gi = 0; gi < ngemm; ++gi) {
            if (gi == 1) { g.type = T_DFT_P; g.nM = 1; g.nN = 32; g.ld = 512; g.nt = 8; g.c = (obid() + gridDim.x - 32) % gridDim.x; }
            if (EN & 16) gemm_phase(lds, g);
        }
        if (pt == PT_MIX_A && odd && (EN & 8)) {
            const int G3 = gridDim.x, b3 = obid();
            if (G3 > 64) { if (b3 < 32) conv_phase(P, j, b3, G3 - 32); else if (b3 >= 64) conv_phase(P, j, b3 - 32, G3 - 32); }
            else conv_phase(P, j, b3, G3);
        }
        if (pt == PT_MLP2 && l < 3) { const int G2 = gridDim.x, bq = obid(); if (G2 > 192) { if (bq >= 192) { convert_layer(P, lds, l + 1, bq - 192, G2 - 192); gemv_mod(P, lds, l + 1, bq - 192, G2 - 192); if (l == 0) tgen_part(P, bq - 192, G2 - 192); } } else { convert_layer(P, lds, l + 1, bq, G2); gemv_mod(P, lds, l + 1, bq, G2); if (l == 0) tgen_part(P, bq, G2); } }
        if (ph + 1 < Pk.ph_hi || rep + 1 < nrep) xcd_barrier(gbar);
        }

    }
}


#ifdef DBG_K
__device__ __forceinline__ float dgst(unsigned u) { return (float)(u & 0xffffu) + (float)(u >> 16); }
__global__ void dbg_dump(float* out, const unsigned char* ws) {
    const unsigned* Xu = (const unsigned*)(ws + OFF_X); const unsigned* Hu = (const unsigned*)(ws + OFF_H); const unsigned* Au = (const unsigned*)(ws + OFF_AMIX);
    const unsigned* Bu = (const unsigned*)(ws + OFF_BIG); const unsigned* Uu = (const unsigned*)(ws + OFF_U); const unsigned* Wu = (const unsigned*)(ws);
    for (size_t i = (size_t)blockIdx.x * blockDim.x + threadIdx.x; i < (size_t)NTOK * 1024; i += (size_t)gridDim.x * blockDim.x) {
        float v = 0.f;
        if (DBG_SEL & 1) v += dgst(Xu[i]);
        if (DBG_SEL & 2) v += dgst(Hu[i % 6291456]);
        if (DBG_SEL & 4) v += dgst(Au[i % 6291456]);
        if (DBG_SEL & 8) v += dgst(Bu[i]) + dgst(Bu[i + 12582912]) + dgst(Bu[(i + 25165824) % 34603008]);
        if (DBG_SEL & 16) v += dgst(Uu[i % 2113536]);
        if (DBG_SEL & 32) v += dgst(Wu[i]) + dgst(Wu[i + 12582912]) + dgst(Wu[(i + 25165824) % 28573696]);
        out[i] = v;
    }
}
#endif
extern "C" void kernel_launch(void* const* d_in, const int* in_sizes, int n_in, void* d_out, int out_size, void* d_ws, size_t ws_size, hipStream_t stream) {
    static int grid = 0;
    if (grid == 0) {
        if (n_in != 22 || ws_size < WS_NEED) { fprintf(stderr, "kernel_launch: unexpected n_in %d / ws_size %zu (need %zu)\n", n_in, ws_size, (size_t)WS_NEED); grid = -1; return; }
        int dev = 0, cus = 0, per_cu = 0;
        hipGetDevice(&dev);
        hipDeviceGetAttribute(&cus, hipDeviceAttributeMultiprocessorCount, dev);
        if (hipFuncSetAttribute((const void*)mega_fwd, hipFuncAttributeMaxDynamicSharedMemorySize, LDS_BYTES) != hipSuccess) { fprintf(stderr, "kernel_launch: hipFuncSetAttribute failed\n"); grid = -1; return; }
        hipOccupancyMaxActiveBlocksPerMultiprocessor(&per_cu, (const void*)mega_fwd, 512, LDS_BYTES);
        if (per_cu < 1) { fprintf(stderr, "kernel_launch: occupancy query says %d blocks/CU\n", per_cu); per_cu = 1; }
        (void)hipGetLastError();
        grid = cus;
    }
    if (grid < 0) return;
    Params p{};
    for (int i = 0; i < 22; ++i) p.in[i] = (const float*)d_in[i];
    p.out = (float*)d_out; p.ws = (unsigned char*)d_ws;
#if MULTI_LAUNCH
#ifdef DBG_K
    for (int ph = 0; ph < DBG_K; ++ph) {
        p.ph_lo = ph; p.ph_hi = ph + 1;
        hipLaunchKernelGGL(mega_fwd, dim3(grid), dim3(512), LDS_BYTES, stream, p);
    }
    hipLaunchKernelGGL(dbg_dump, dim3(2048), dim3(256), 0, stream, (float*)d_out, (const unsigned char*)d_ws);
#else
    for (int ph = 0; ph < NPH; ++ph) {
        p.ph_lo = ph; p.ph_hi = ph + 1;
        hipLaunchKernelGGL(mega_fwd, dim3(grid), dim3(512), LDS_BYTES, stream, p);
    }
#endif
#else
    p.ph_lo = 0; p.ph_hi = NPH;
    if (hipMemsetAsync((char*)d_ws + OFF_BAR, 0, 16384, stream) != hipSuccess) { fprintf(stderr, "kernel_launch: memset of barrier word failed\n"); return; }
    void* args[] = {&p};
    hipError_t e = hipLaunchCooperativeKernel((const void*)mega_fwd, dim3(grid), dim3(512), args, LDS_BYTES, stream);
    if (e != hipSuccess) fprintf(stderr, "cooperative launch failed: %s (grid %d)\n", hipGetErrorString(e), grid);
#endif
}
```

```cpp
#include <hip/hip_runtime.h>
#include <hip/hip_cooperative_groups.h>
#include <cstdio>
#include <cstdint>
namespace cg = cooperative_groups;

#ifndef DBG_SEL
#define DBG_SEL 63
#endif
#ifndef DBG_NP
#define DBG_NP(x) (x)
#endif
#ifndef DEFER
#define DEFER 1
#endif
#ifndef REP_PT
#define REP_PT -1
#endif
#ifndef REP_L
#define REP_L -1
#endif
#ifndef REP_N
#define REP_N 1
#endif
#ifndef XSYNC
#define XSYNC 0
#endif
#ifndef DBG_SINIT
#define DBG_SINIT 1
#endif
#ifndef EN
#define EN 31
#endif
#ifndef MULTI_LAUNCH
#define MULTI_LAUNCH 0
#endif

#define LAS __attribute__((address_space(3)))
typedef unsigned short bf16_t;
typedef short bf16x8 __attribute__((ext_vector_type(8)));
typedef float f32x4 __attribute__((ext_vector_type(4)));
typedef unsigned u32x2 __attribute__((ext_vector_type(2)));
typedef unsigned u32x4 __attribute__((ext_vector_type(4)));

constexpr int DM = 1024, NTOK = 12288, NPROMPT = 4096, DFF = 4096;
constexpr int LDS_BYTES = 147456;
constexpr int NPH = 36;
constexpr size_t MBy = 1048576;
constexpr size_t OFF_W1T = 0, OFF_W2T = 32 * MBy, OFF_WIE = 64 * MBy, OFF_WOE = 74 * MBy, OFF_WIO = 78 * MBy, OFF_WOO = 88 * MBy;
constexpr size_t OFF_T2K = 92 * MBy, OFF_T256 = 108 * MBy, OFF_MOD = 108 * MBy + 262144, OFF_U = 109 * MBy, OFF_DTOT = 117 * MBy;
constexpr size_t OFF_X = 118 * MBy, OFF_H = 166 * MBy, OFF_AMIX = 190 * MBy, OFF_BIG = 214 * MBy, WS_NEED = 348 * MBy;
constexpr size_t OFF_HID = OFF_BIG;
constexpr size_t OFF_QB = OFF_BIG, OFF_KB = OFF_BIG + 6 * MBy, OFF_VT = OFF_BIG + 12 * MBy, OFF_GATE = OFF_BIG + 24 * MBy, OFF_LOGF = OFF_BIG + 36 * MBy;
constexpr size_t OFF_UB = OFF_BIG + 60 * MBy, OFF_ODIR = OFF_BIG + 72 * MBy;
constexpr size_t OFF_XTS = OFF_BIG, OFF_XTP = OFF_BIG + 16 * MBy, OFF_XIN = OFF_BIG + 24 * MBy, OFF_BG = OFF_BIG + 36 * MBy, OFF_CG = OFF_BIG + 48 * MBy;
constexpr size_t OFF_FACCP = OFF_BIG + 60 * MBy, OFF_FACCS = OFF_BIG + 68 * MBy;
constexpr size_t OFF_BAR = 117 * MBy + 524288;
constexpr size_t OUT_STATE = (size_t)NTOK * DM;

struct Params { const float* in[22]; float* out; unsigned char* ws; int ph_lo, ph_hi; };
typedef const __attribute__((address_space(4))) Params* PP;
enum { I_XP = 0, I_XS, I_STATE, I_C, I_CCTX, I_NORMG, I_FINALG, I_WADA, I_BADA, I_W1, I_W2, I_WINE, I_WA2, I_BA2, I_GLAG, I_POOLW, I_POOLS, I_WOUTE, I_WINO, I_CONVW, I_CONVB, I_WOUTO };

__device__ __forceinline__ int otid() { int t = __builtin_amdgcn_workitem_id_x(); asm volatile("" : "+v"(t)); return t; }
__device__ __forceinline__ int obid() { int b = __builtin_amdgcn_workgroup_id_x(); asm volatile("" : "+s"(b)); return b; }
typedef float f32x2 __attribute__((ext_vector_type(2)));
typedef __bf16 bf16x2v __attribute__((ext_vector_type(2)));
__device__ __forceinline__ unsigned pk2(float lo, float hi) { f32x2 v = {lo, hi}; bf16x2v b = __builtin_convertvector(v, bf16x2v); return __builtin_bit_cast(unsigned, b); }
__device__ __forceinline__ bf16_t f2bf(float x) { return (bf16_t)(pk2(x, 0.f) & 0xffffu); }
__device__ __forceinline__ float bf2f(bf16_t u) { return __uint_as_float(((unsigned)u) << 16); }
__device__ __forceinline__ float bflo(unsigned u) { return __uint_as_float(u << 16); }
__device__ __forceinline__ float bfhi(unsigned u) { return __uint_as_float(u & 0xffff0000u); }
__device__ __forceinline__ float wave_sum(float v) {
#pragma unroll
    for (int o = 1; o < 64; o <<= 1) v += __shfl_xor(v, o);
    return v;
}
__device__ __forceinline__ float siluf(float x) { return x * __builtin_amdgcn_rcpf(1.f + __expf(-x)); }
__device__ __forceinline__ float logsigmoidf(float x) { return fminf(x, 0.f) - __logf(1.f + __expf(-fabsf(x))); }
__device__ __forceinline__ int cond_of_seg(int pm) { return pm < 16 ? 0 : 1 + ((pm - 16) >> 3); }

namespace pg8 {
constexpr int BM = 256, BK = 64, HALF = 128, HTB = HALF * BK * 2, STAGE_BYTES = 8 * HTB, NXCD = 8, WGM = 8;
__host__ __device__ __forceinline__ int lds_byte(int r, int c) { const int st = (r >> 4) * 2 + (c >> 5), rr = r & 15, cc = c & 31, ob = rr * 64 + cc * 2; return st * 1024 + (ob ^ (((ob >> 9) & 1) << 5)); }
__host__ __device__ __forceinline__ int perm32(int rho) { const int n = rho >> 4, i = rho & 15; return 8 * (i >> 2) + 4 * n + (i & 3); }
__host__ __device__ __forceinline__ void stage_rc(int b, int& R, int& C) { const int st = b / 1024, sb = b % 1024, swz = sb ^ (((sb >> 9) & 1) << 5); R = (st >> 1) * 16 + swz / 64; C = (st & 1) * 32 + (swz % 64) / 2; }
}

enum { KD_BF16 = 0, KD_SILU, KD_RELU2, KD_LOGF, KD_RES, KD_ATOM };
enum { T_IN_EVEN = 0, T_IN_ODD, T_OUT_EVEN, T_OUT_ODD, T_MLP1, T_MLP2, T_DFT_S, T_DFT_P };
struct Unit { int pm, pn; };
struct UnitIO { const char* A; const char* B; char* out; const float* aux; int kind; int ld; };
struct GemmCfg { int type, j, l, nM, nN, ld, nt, G, c; };

__device__ __forceinline__ void make_unit(const GemmCfg& g, int pm, int pn, UnitIO& u) {
    PP Pq = (PP)__builtin_amdgcn_kernarg_segment_ptr();
    unsigned char* ws = Pq->ws;
    const size_t rowA = (size_t)pm * 256 * 1024 * 2;
    u.aux = nullptr; u.kind = KD_BF16; u.ld = 512;
    const float* modp = (const float*)(ws + OFF_MOD) + (size_t)(g.l * 5 + cond_of_seg(pm)) * 6144;
    switch (g.type) {
    case T_IN_EVEN: {
        const char* W = (const char*)(ws + OFF_WIE) + (size_t)g.j * 2560 * 1024 * 2 + (size_t)pn * 256 * 1024 * 2;
        const char* Hh = (const char*)(ws + OFF_H) + rowA;
        u.A = Hh; u.B = W;
        if (pn == 0) { u.out = (char*)(ws + OFF_QB) + (size_t)pm * 256 * 256 * 2; u.ld = 256; }
        else if (pn == 1) { u.out = (char*)(ws + OFF_KB) + (size_t)pm * 256 * 256 * 2; u.ld = 256; }
        else if (pn < 4) { u.A = W; u.B = Hh; u.out = (char*)(ws + OFF_VT) + ((size_t)(pn - 2) * 256 * NTOK + (size_t)pm * 256) * 2; u.ld = NTOK; }
        else if (pn < 6) { u.out = (char*)(ws + OFF_GATE) + ((size_t)pm * 256 * 512 + (pn - 4) * 256) * 2; u.kind = KD_SILU; }
        else if (pn < 8) { u.out = (char*)(ws + OFF_LOGF) + ((size_t)pm * 256 * 512 + (pn - 6) * 256) * 4; u.kind = KD_LOGF; u.aux = Pq->in[I_BA2] + g.j * 512 + (pn - 6) * 256; }
        else { u.out = (char*)(ws + OFF_UB) + ((size_t)pm * 256 * 512 + (pn - 8) * 256) * 2; }
    } break;
    case T_IN_ODD: {
        const char* W = (const char*)(ws + OFF_WIO) + (size_t)g.j * 2560 * 1024 * 2 + (size_t)pn * 256 * 1024 * 2;
        const char* Hh = (const char*)(ws + OFF_H) + rowA;
        u.A = Hh; u.B = W;
        if (pn < 4) {
            u.A = W; u.B = Hh;
            const int z = pn >> 1, ch0 = (pn & 1) * 256;
            if (pm < 16) { u.out = (char*)(ws + OFF_XTP) + ((size_t)(pm * 512 + ch0) * 512 + z * 256) * 2; u.ld = 512; }
            else { const int b = (pm - 16) >> 3, part = (pm - 16) & 7; u.out = (char*)(ws + OFF_XTS) + ((size_t)(b * 512 + ch0) * 4096 + z * 2048 + part * 256) * 2; u.ld = 4096; }
        } else {
            const size_t base = (pn < 6) ? OFF_XIN : (pn < 8 ? OFF_BG : OFF_CG);
            u.out = (char*)(ws + base) + ((size_t)pm * 256 * 512 + (pn & 1) * 256) * 2;
        }
    } break;
    case T_OUT_EVEN: case T_OUT_ODD: {
        u.A = (const char*)(ws + OFF_AMIX) + rowA;
        u.B = (const char*)(ws + (g.type == T_OUT_EVEN ? OFF_WOE : OFF_WOO)) + (size_t)g.j * 1024 * 1024 * 2 + (size_t)pn * 256 * 1024 * 2;
        u.out = (char*)(ws + OFF_X) + ((size_t)pm * 256 * 1024 + pn * 256) * 4; u.ld = 1024; u.kind = KD_RES; u.aux = modp + 2048 + pn * 256;
    } break;
    case T_MLP1: {
        u.A = (const char*)(ws + OFF_H) + rowA;
        u.B = (const char*)(ws + OFF_W1T) + (size_t)g.l * 4096 * 1024 * 2 + (size_t)pn * 256 * 1024 * 2;
        u.out = (char*)(ws + OFF_HID) + ((size_t)pm * 256 * 4096 + pn * 256) * 2; u.ld = 4096; u.kind = KD_RELU2;
    } break;
    case T_MLP2: {
        u.A = (const char*)(ws + OFF_HID) + (size_t)pm * 256 * 4096 * 2;
        u.B = (const char*)(ws + OFF_W2T) + (size_t)g.l * 4096 * 1024 * 2 + (size_t)pn * 256 * 4096 * 2;
        u.out = (char*)(ws + OFF_X) + ((size_t)pm * 256 * 1024 + pn * 256) * 4; u.ld = 1024; u.kind = KD_RES; u.aux = modp + 5120 + pn * 256;
    } break;
    case T_DFT_S: {
        const int pnb = pn >> 2, ks = pn & 3;
        u.A = (const char*)(ws + OFF_T2K) + ((size_t)pm * 256 * 4096 + ks * 1024) * 2;
        u.B = (const char*)(ws + OFF_XTS) + ((size_t)pnb * 256 * 4096 + ks * 1024) * 2;
        u.out = (char*)(ws + OFF_FACCS) + ((size_t)ks * 8192 * 512 + (size_t)((pnb >> 1) * 2048 + pm * 256) * 512 + (pnb & 1) * 256) * 4; u.kind = KD_ATOM;
    } break;
    default: {
        u.A = (const char*)(ws + OFF_T256);
        u.B = (const char*)(ws + OFF_XTP) + (size_t)pn * 256 * 512 * 2;
        u.out = (char*)(ws + OFF_FACCP) + ((size_t)((pn >> 1) * 256) * 512 + (pn & 1) * 256) * 4; u.kind = KD_ATOM;
    } break;
    }
}

__device__ __forceinline__ bool next_unit(const GemmCfg& g, int i, Unit& u) {
    const int nwg = g.nM * g.nN;
    const long L = (long)i * g.G + g.c; if (L >= nwg) return false;
    int wgid = (int)L; { const int q = nwg / pg8::NXCD, r = nwg % pg8::NXCD, xcd = wgid % pg8::NXCD, off = wgid / pg8::NXCD; wgid = (xcd < r ? xcd * (q + 1) : r * (q + 1) + (xcd - r) * q) + off; }
    const int nig = pg8::WGM * g.nN, gid = wgid / nig, fm = gid * pg8::WGM, gsz = (g.nM - fm) < pg8::WGM ? (g.nM - fm) : pg8::WGM;
    const int pm = fm + ((wgid % nig) % gsz), pn = (wgid % nig) / gsz;
    u.pm = pm; u.pn = pn; return true;
}

__device__ __forceinline__ void epilogue(const f32x4 (&acc)[2][2][4][2], const GemmCfg& g, const Unit& uu, int wr, int wc, int fr, int fq) {
    UnitIO u; make_unit(g, uu.pm, uu.pn, u);
    const int row0 = wr * 64 + fr, col0 = wc * 32 + 8 * fq;
    const int kind = u.kind, ld = u.ld;
    if (kind <= KD_RELU2) {
        bf16_t* O = (bf16_t*)u.out;
#pragma unroll
        for (int ai = 0; ai < 2; ++ai)
#pragma unroll
            for (int m = 0; m < 4; ++m) {
                bf16_t* rowp = O + (size_t)(row0 + ai * 128 + m * 16) * ld + col0;
#pragma unroll
                for (int bj = 0; bj < 2; ++bj) {
                    f32x4 v0 = acc[ai][bj][m][0], v1 = acc[ai][bj][m][1];
                    if (kind == KD_SILU) { v0[0] = siluf(v0[0]); v0[1] = siluf(v0[1]); v0[2] = siluf(v0[2]); v0[3] = siluf(v0[3]); v1[0] = siluf(v1[0]); v1[1] = siluf(v1[1]); v1[2] = siluf(v1[2]); v1[3] = siluf(v1[3]); }
                    else if (kind == KD_RELU2) {
                        v0[0] = fmaxf(v0[0], 0.f); v0[1] = fmaxf(v0[1], 0.f); v0[2] = fmaxf(v0[2], 0.f); v0[3] = fmaxf(v0[3], 0.f); v0 = v0 * v0;
                        v1[0] = fmaxf(v1[0], 0.f); v1[1] = fmaxf(v1[1], 0.f); v1[2] = fmaxf(v1[2], 0.f); v1[3] = fmaxf(v1[3], 0.f); v1 = v1 * v1; }
                    u32x4 o; o.x = pk2(v0[0], v0[1]); o.y = pk2(v0[2], v0[3]); o.z = pk2(v1[0], v1[1]); o.w = pk2(v1[2], v1[3]);
                    *(u32x4*)(rowp + bj * 128) = o;
                }
            }
    } else if (kind == KD_RES) {
        float* O = (float*)u.out;
        f32x4 gv[2][2];
#pragma unroll
        for (int bj = 0; bj < 2; ++bj)
#pragma unroll
            for (int n = 0; n < 2; ++n) gv[bj][n] = *(const f32x4*)(u.aux + col0 + bj * 128 + n * 4);
#pragma unroll
        for (int ai = 0; ai < 2; ++ai)
#pragma unroll
            for (int m = 0; m < 4; ++m) {
                float* rowp = O + (size_t)(row0 + ai * 128 + m * 16) * ld + col0;
#pragma unroll
                for (int bj = 0; bj < 2; ++bj)
#pragma unroll
                    for (int n = 0; n < 2; ++n) { f32x4* p = (f32x4*)(rowp + bj * 128 + n * 4); *p = *p + gv[bj][n] * acc[ai][bj][m][n]; }
            }
    } else if (kind == KD_LOGF) {
        float* O = (float*)u.out;
#pragma unroll
        for (int bj = 0; bj < 2; ++bj)
#pragma unroll
            for (int n = 0; n < 2; ++n) {
                const f32x4 bv = *(const f32x4*)(u.aux + col0 + bj * 128 + n * 4);
#pragma unroll
                for (int ai = 0; ai < 2; ++ai)
#pragma unroll
                    for (int m = 0; m < 4; ++m) {
                        f32x4 v = acc[ai][bj][m][n] + bv;
                        v[0] = logsigmoidf(v[0]) * 0.0625f; v[1] = logsigmoidf(v[1]) * 0.0625f; v[2] = logsigmoidf(v[2]) * 0.0625f; v[3] = logsigmoidf(v[3]) * 0.0625f;
                        *(f32x4*)(O + (size_t)(row0 + ai * 128 + m * 16) * ld + col0 + bj * 128 + n * 4) = v;
                    }
            }
    } else {
        float* O = (float*)u.out;
#pragma unroll
        for (int ai = 0; ai < 2; ++ai)
#pragma unroll
            for (int m = 0; m < 4; ++m) {
                float* rowp = O + (size_t)(row0 + ai * 128 + m * 16) * ld + col0;
#pragma unroll
                for (int bj = 0; bj < 2; ++bj)
#pragma unroll
                    for (int n = 0; n < 2; ++n) {
                        *(f32x4*)(rowp + bj * 128 + n * 4) = acc[ai][bj][m][n];
                    }
            }
    }
}

__device__ __forceinline__ void gemm_phase(LAS unsigned char* lds, const GemmCfg& g) {
    using namespace pg8;
    const int tid = otid(), wid = __builtin_amdgcn_readfirstlane(tid >> 6), lane = tid & 63, wr = wid >> 2, wc = wid & 3, fr = lane & 15, fq = lane >> 4;
    const int nt = g.nt;
    unsigned voffA[2], voffB[2];
#pragma unroll
    for (int i = 0; i < 2; ++i) { int R, C; stage_rc(tid * 16 + i * 8192, R, C); const int Rb = (R & ~31) + perm32(R & 31); voffA[i] = (unsigned)(R * g.ld + C) * 2u; voffB[i] = (unsigned)(Rb * g.ld + C) * 2u; }
    const size_t kstep = (size_t)(BK * 2);
    const size_t hstepA = (size_t)HALF * g.ld * 2;
#define hstepB hstepA
    const unsigned ldsw = (unsigned)wid * 1024u;
    const int aoff = lds_byte(wr * 64 + fr, fq * 8), boff = lds_byte(wc * 32 + fr, fq * 8);
#define PG8_SA(b, h) (((b) * 2 + (h)) * HTB)
#define PG8_SB(b, h) ((4 + (b) * 2 + (h)) * HTB)
#define PG8_STAGE(bufoff, gbase, voff) do { _Pragma("unroll") for (int _i = 0; _i < 2; ++_i) \
        __builtin_amdgcn_global_load_lds((const unsigned*)((const char*)(gbase) + (voff)[_i]), (LAS unsigned*)(lds + (bufoff) + ldsw + _i * 8192), 16, 0, 0); } while (0)
#define PG8_LDA(dst, b, h) do { _Pragma("unroll") for (int m = 0; m < 4; ++m) _Pragma("unroll") for (int k = 0; k < 2; ++k) dst[m][k] = *(const LAS bf16x8*)(lds + PG8_SA(b, h) + aoff + m * 2048 + k * 1024); } while (0)
#define PG8_LDB(dst, b, h) do { _Pragma("unroll") for (int n = 0; n < 2; ++n) _Pragma("unroll") for (int k = 0; k < 2; ++k) dst[n][k] = *(const LAS bf16x8*)(lds + PG8_SB(b, h) + boff + n * 2048 + k * 1024); } while (0)
#define PG8_MMA(ai, bj, At, Bt) do { __builtin_amdgcn_s_setprio(1); _Pragma("unroll") for (int m = 0; m < 4; ++m) _Pragma("unroll") for (int n = 0; n < 2; ++n) _Pragma("unroll") for (int k = 0; k < 2; ++k) \
        acc[ai][bj][m][n] = __builtin_amdgcn_mfma_f32_16x16x32_bf16(Bt[n][k], At[m][k], acc[ai][bj][m][n], 0, 0, 0); __builtin_amdgcn_s_setprio(0); } while (0)
#define PG8_WAIT_V(n) asm volatile("s_waitcnt vmcnt(" #n ")" ::: "memory")
#define PG8_WAIT_L(n) asm volatile("s_waitcnt lgkmcnt(" #n ")" ::: "memory")
#define PG8_BAR __builtin_amdgcn_s_barrier()
#define PG8_SCHED __builtin_amdgcn_sched_barrier(0)
    Unit cur, nxt; int ui = 0;
    if (!next_unit(g, 0, cur)) return;
    f32x4 acc[2][2][4][2];
#pragma unroll
    for (int a = 0; a < 2; ++a)
#pragma unroll
        for (int b = 0; b < 2; ++b)
#pragma unroll
            for (int m = 0; m < 4; ++m)
#pragma unroll
                for (int n = 0; n < 2; ++n) acc[a][b][m][n] = (f32x4){0.f, 0.f, 0.f, 0.f};
    bf16x8 At[4][2], B0[2][2], B1[2][2];
    const char* cA; const char* cB; { UnitIO io; make_unit(g, cur.pm, cur.pn, io); cA = io.A; cB = io.B; }
    PG8_STAGE(PG8_SB(0, 0), cB, voffB); PG8_STAGE(PG8_SB(0, 1), cB + hstepB, voffB); PG8_STAGE(PG8_SA(0, 0), cA, voffA); PG8_STAGE(PG8_SA(0, 1), cA + hstepA, voffA);
    if (wr == 1) PG8_BAR;
    PG8_WAIT_V(2); PG8_BAR;
    PG8_STAGE(PG8_SB(1, 0), cB + kstep, voffB); PG8_STAGE(PG8_SA(1, 0), cA + kstep, voffA); PG8_STAGE(PG8_SB(1, 1), cB + hstepB + kstep, voffB);
    PG8_WAIT_V(6); PG8_BAR;
    for (;;) {
        const bool has_next = next_unit(g, ui + 1, nxt);
        const char* nA = cA; const char* nB = cB; if (has_next) { UnitIO io; make_unit(g, nxt.pm, nxt.pn, io); nA = io.A; nB = io.B; }
        for (int t = 0; t < nt; t += 2) {
            const bool last = (t == nt - 2);
            const char* a1 = cA + (size_t)(t + 1) * kstep;
            const char* a2 = last ? nA : cA + (size_t)(t + 2) * kstep; const char* b2 = last ? nB : cB + (size_t)(t + 2) * kstep;
            const char* a3 = a2 + kstep; const char* b3 = b2 + kstep;
            PG8_LDB(B0, 0, 0); PG8_LDB(B1, 0, 1); PG8_SCHED; PG8_LDA(At, 0, 0); PG8_STAGE(PG8_SA(1, 1), a1 + hstepA, voffA);
            PG8_WAIT_V(8); PG8_WAIT_L(0); PG8_BAR; PG8_MMA(0, 0, At, B0); PG8_MMA(0, 1, At, B1); PG8_BAR; PG8_SCHED;
            PG8_LDA(At, 0, 1); PG8_STAGE(PG8_SB(0, 0), b2, voffB); PG8_STAGE(PG8_SB(0, 1), b2 + hstepB, voffB); PG8_STAGE(PG8_SA(0, 0), a2, voffA);
            PG8_WAIT_V(8); PG8_WAIT_L(0); PG8_BAR; PG8_MMA(1, 0, At, B0); PG8_MMA(1, 1, At, B1); PG8_BAR; PG8_SCHED;
            PG8_LDB(B0, 1, 0); PG8_LDB(B1, 1, 1); PG8_SCHED; PG8_LDA(At, 1, 0); PG8_STAGE(PG8_SA(0, 1), a2 + hstepA, voffA);
            PG8_WAIT_V(8); PG8_WAIT_L(0); PG8_BAR; PG8_MMA(0, 0, At, B0); PG8_MMA(0, 1, At, B1); PG8_BAR; PG8_SCHED;
            PG8_LDA(At, 1, 1); PG8_STAGE(PG8_SB(1, 0), b3, voffB); PG8_STAGE(PG8_SB(1, 1), b3 + hstepB, voffB); PG8_STAGE(PG8_SA(1, 0), a3, voffA);
            PG8_WAIT_V(8); PG8_WAIT_L(0); PG8_BAR; PG8_MMA(1, 0, At, B0); PG8_MMA(1, 1, At, B1); PG8_BAR; PG8_SCHED;
        }
        if (wr == 0) PG8_BAR;
        epilogue(acc, g, cur, wr, wc, fr, fq);
        if (!has_next) break;
#pragma unroll
        for (int a = 0; a < 2; ++a)
#pragma unroll
            for (int b = 0; b < 2; ++b)
#pragma unroll
                for (int m = 0; m < 4; ++m)
#pragma unroll
                    for (int n = 0; n < 2; ++n) acc[a][b][m][n] = (f32x4){0.f, 0.f, 0.f, 0.f};
        cur = nxt; cA = nA; cB = nB; ++ui;
        if (wr == 1) PG8_BAR;
    }
    PG8_WAIT_V(0);
    PG8_BAR;
#undef hstepB
#undef PG8_SA
#undef PG8_SB
#undef PG8_STAGE
#undef PG8_LDA
#undef PG8_LDB
#undef PG8_MMA
#undef PG8_WAIT_V
#undef PG8_WAIT_L
#undef PG8_BAR
#undef PG8_SCHED
}

__device__ __forceinline__ void transpose_item(const float* W, int ldn, int n0, int k0, bf16_t* WT, int drow0, int ldk, float scale, LAS float* scr, int lane) {
    float tv[32];
#pragma unroll
    for (int i = 0; i < 32; ++i) { const int kk = 2 * i + (lane >> 5); tv[i] = W[(size_t)(k0 + kk) * ldn + n0 + (lane & 31)]; }
#pragma unroll
    for (int i = 0; i < 32; ++i) { const int kk = 2 * i + (lane >> 5); scr[kk * 33 + (lane & 31)] = tv[i]; }
    asm volatile("s_waitcnt lgkmcnt(0)" ::: "memory");
    const int c = lane & 7;
#pragma unroll
    for (int jx = 0; jx < 4; ++jx) {
        const int n = (lane >> 3) + 8 * jx; const LAS float* s = scr + (8 * c) * 33 + n;
        u32x4 o; o.x = pk2(s[0] * scale, s[33] * scale); o.y = pk2(s[66] * scale, s[99] * scale); o.z = pk2(s[132] * scale, s[165] * scale); o.w = pk2(s[198] * scale, s[231] * scale);
        *(u32x4*)(WT + (size_t)(drow0 + n) * ldk + k0 + 8 * c) = o;
    }
    asm volatile("s_waitcnt lgkmcnt(0)" ::: "memory");
}

__device__ __forceinline__ void convert_layer(PP P, LAS unsigned char* lds, int l, int vb, int nb, int part = 7) {
    const int tid = otid(), lane = tid & 63, wave = tid >> 6;
    unsigned char* ws = P->ws;
    const int j = l >> 1, odd = l & 1;
    __syncthreads();
    {
        LAS float* scr = (LAS float*)(lds + wave * 8704);
        const int it_lo = (part & 1) ? 0 : 4096, it_hi = (part & 2) ? 5376 : 4096;
        for (int it = it_lo + vb * 8 + wave; it < it_hi; it += nb * 8) {
            int r = it;
            if (r < 2048) { const int kb = r / 128, nbk = r % 128;
                transpose_item(P->in[I_W1] + (size_t)l * 1024 * 4096, 4096, nbk * 32, kb * 64, (bf16_t*)(ws + OFF_W1T) + (size_t)l * 4096 * 1024, nbk * 32, 1024, 1.f, scr, lane); continue; }
            r -= 2048;
            if (r < 2048) { const int kb = r / 32, nbk = r % 32;
                transpose_item(P->in[I_W2] + (size_t)l * 4096 * 1024, 1024, nbk * 32, kb * 64, (bf16_t*)(ws + OFF_W2T) + (size_t)l * 1024 * 4096, nbk * 32, 4096, 1.f, scr, lane); continue; }
            r -= 2048;
            if (!odd) {
                if (r < 1024) { const int kb = r / 64, nbk = r % 64; const int sb = nbk < 48 ? nbk : nbk + 1; const int n0 = sb * 32; const int drow = n0 < 1536 ? n0 : n0 + 480;
                    transpose_item(P->in[I_WINE] + (size_t)j * 1024 * 2080, 2080, n0, kb * 64, (bf16_t*)(ws + OFF_WIE) + (size_t)j * 2560 * 1024, drow, 1024, n0 < 256 ? 0.125f : 1.f, scr, lane); continue; }
                r -= 1024;
                { const int kb = r / 32, nbk = r % 32;
                    transpose_item(P->in[I_WOUTE] + (size_t)j * 1024 * 1024, 1024, nbk * 32, kb * 64, (bf16_t*)(ws + OFF_WOE) + (size_t)j * 1024 * 1024, nbk * 32, 1024, 1.f, scr, lane); }
            } else {
                if (r < 768) { const int kb = r / 48, nbk = r % 48; const int n0 = 512 + nbk * 32;
                    transpose_item(P->in[I_WINO] + (size_t)j * 1024 * 2048, 2048, n0, kb * 64, (bf16_t*)(ws + OFF_WIO) + (size_t)j * 2560 * 1024, n0 + 512, 1024, 1.f, scr, lane); continue; }
                r -= 768;
                { const int kb = r / 32, nbk = r % 32;
                    transpose_item(P->in[I_WOUTO] + (size_t)j * 1024 * 1024, 1024, nbk * 32, kb * 64, (bf16_t*)(ws + OFF_WOO) + (size_t)j * 1024 * 1024, nbk * 32, 1024, 1.f, scr, lane); }
            }
        }
    }
    __syncthreads();
    if (!(part & 4)) return;
    if (odd) {
    {
        LAS float* wt = (LAS float*)lds;
        LAS float* tab = (LAS float*)(lds + 64 * 129 * 4);
        for (int it = vb; it < 64; it += nb) {
            const int g = (it >> 4) & 3, kb = it & 15;
            for (int idx = tid; idx < 64 * 128; idx += 512) { const int kk = idx >> 7, c = idx & 127; wt[kk * 129 + c] = P->in[I_WINO][((size_t)j * 1024 + kb * 64 + kk) * 2048 + g * 128 + c]; }
            if (tid < 128) { tab[tid] = __builtin_amdgcn_cosf((float)tid * (1.f / 128.f)); tab[128 + tid] = __builtin_amdgcn_sinf((float)tid * (1.f / 128.f)); }
            __syncthreads();
            const int li = lane & 15, lq = lane >> 4;
            f32x4 acc[2][4];
#pragma unroll
            for (int ti = 0; ti < 2; ++ti)
#pragma unroll
                for (int u = 0; u < 4; ++u) acc[ti][u] = (f32x4){0.f, 0.f, 0.f, 0.f};
            const int zm0 = 16 * (2 * wave) + li, zm1 = zm0 + 16;
            for (int sx = 0; sx < 32; ++sx) {
                const int c = 4 * sx + lq;
                const float a0 = tab[(zm0 >> 7) * 128 + (((zm0 & 127) * c) & 127)], a1 = tab[(zm1 >> 7) * 128 + (((zm1 & 127) * c) & 127)];
#pragma unroll
                for (int u = 0; u < 4; ++u) {
                    const float b = wt[(16 * u + li) * 129 + c];
                    acc[0][u] = __builtin_amdgcn_mfma_f32_16x16x4f32(a0, b, acc[0][u], 0, 0, 0);
                    acc[1][u] = __builtin_amdgcn_mfma_f32_16x16x4f32(a1, b, acc[1][u], 0, 0, 0);
                }
            }
#pragma unroll
            for (int ti = 0; ti < 2; ++ti)
#pragma unroll
                for (int r = 0; r < 4; ++r) {
                    const int zm = 16 * (2 * wave + ti) + 4 * lq + r, z = zm >> 7, m = zm & 127;
                    bf16_t* O = (bf16_t*)(ws + OFF_WIO) + (size_t)j * 2560 * 1024 + (size_t)(z * 512 + g * 128 + m) * 1024 + kb * 64 + li;
#pragma unroll
                    for (int u = 0; u < 4; ++u) O[16 * u] = f2bf(acc[ti][u][r]);
                }
            __syncthreads();
        }
    }
    } else {
    {
        LAS float* Pt = (LAS float*)lds;
        LAS float* Wd = (LAS float*)(lds + 65536);
        for (int it = vb; it < 64; it += nb) {
            const int g = (it >> 4) & 3, nbk = it & 15;
            for (int idx = tid; idx < 128 * 128; idx += 512) { const int c = idx >> 7, d = idx & 127; Pt[d * 128 + c] = P->in[I_POOLW][((size_t)(j * 4 + g) * 128 + c) * 128 + d] * P->in[I_POOLS][j * 512 + g * 128 + d]; }
            for (int idx = tid; idx < 128 * 64; idx += 512) { const int d = idx >> 6, n = idx & 63; Wd[d * 64 + n] = P->in[I_WOUTE][((size_t)j * 1024 + 512 + g * 128 + d) * 1024 + nbk * 64 + n]; }
            __syncthreads();
            const int c = tid & 127, ng = tid >> 7;
            float acc[16];
#pragma unroll
            for (int nn = 0; nn < 16; ++nn) acc[nn] = 0.f;
            for (int d = 0; d < 128; ++d) {
                const float p = Pt[d * 128 + c];
#pragma unroll
                for (int nn = 0; nn < 16; ++nn) acc[nn] += p * Wd[d * 64 + ng * 16 + nn];
            }
            bf16_t* O = (bf16_t*)(ws + OFF_WOE) + (size_t)j * 1024 * 1024 + (size_t)(nbk * 64 + ng * 16) * 1024 + 512 + g * 128 + c;
#pragma unroll
            for (int nn = 0; nn < 16; ++nn) O[(size_t)nn * 1024] = f2bf(acc[nn]);
            __syncthreads();
        }
    }
    {
        LAS float* av = (LAS float*)lds;
        LAS float* w2 = (LAS float*)(lds + 16384);
        for (int it = (vb + nb - (nb > 16 ? 16 : 0)) % nb; it < 16; it += nb) {
            const int kb = it & 15;
            for (int idx = tid; idx < 64 * 32; idx += 512) { const int kk = idx >> 5, r = idx & 31; av[kk * 33 + r] = P->in[I_WINE][((size_t)j * 1024 + kb * 64 + kk) * 2080 + 1536 + r]; }
            for (int idx = tid; idx < 8192; idx += 512) w2[idx] = P->in[I_WA2][(size_t)j * 8192 + idx];
            __syncthreads();
            const int k = tid & 63, grp = tid >> 6, z = grp >> 2, n0 = (grp & 3) * 64;
            float a[16];
#pragma unroll
            for (int r = 0; r < 16; ++r) a[r] = av[k * 33 + z * 16 + r];
            bf16_t* O = (bf16_t*)(ws + OFF_WIE) + (size_t)j * 2560 * 1024 + (size_t)(1536 + z * 256 + n0) * 1024 + kb * 64 + k;
            for (int nn = 0; nn < 64; ++nn) {
                float s = 0.f;
#pragma unroll
                for (int r = 0; r < 16; ++r) s += a[r] * w2[(z * 16 + r) * 256 + n0 + nn];
                O[(size_t)nn * 1024] = f2bf(s);
            }
            __syncthreads();
        }
    }
    }
}

__device__ __forceinline__ void tgen_part(PP P, int vb, int nb) {
    const int tid = otid(); unsigned char* ws = P->ws;
    {
        const int gt = vb * 512 + tid, GT = nb * 512;
        for (int it = gt; it < 2048 * 512 + 256 * 64; it += GT) {
            int L, k, c0; bf16_t* T; float s;
            if (it < 2048 * 512) { L = 2048; k = it >> 9; c0 = (it & 511) * 8; T = (bf16_t*)(ws + OFF_T2K); s = 1.f / 512.f; }
            else { const int r = it - 2048 * 512; L = 256; k = r >> 6; c0 = (r & 63) * 8; T = (bf16_t*)(ws + OFF_T256); s = 0.00552427172801990f; }
            const int z = c0 >= L; const int l0 = c0 - z * L; const float invL = 1.f / (float)L;
            float v[8];
#pragma unroll
            for (int e = 0; e < 8; ++e) { const int ph = (k * (l0 + e)) & (L - 1); const float fr = (float)ph * invL; v[e] = z ? -__builtin_amdgcn_sinf(fr) * s : __builtin_amdgcn_cosf(fr) * s; }
            u32x4 o; o.x = pk2(v[0], v[1]); o.y = pk2(v[2], v[3]); o.z = pk2(v[4], v[5]); o.w = pk2(v[6], v[7]);
            *(u32x4*)(T + (size_t)k * (2 * L) + c0) = o;
        }
    }
}
__device__ __forceinline__ void gemv_mod(PP P, LAS unsigned char* lds, int l, int vb, int nb) {
    const int tid = otid(); unsigned char* ws = P->ws;
    __syncthreads();
    {
        LAS float* sc = (LAS float*)lds;
        LAS float* red = (LAS float*)(lds + 20480);
        bool staged = false;
        for (int it = vb; it < 48; it += nb) {
            if (!staged) {
                for (int idx = tid; idx < 5120; idx += 512) { const int cnd = idx >> 10, k = idx & 1023; const float c = cnd == 0 ? P->in[I_CCTX][k] : P->in[I_C][(cnd - 1) * 1024 + k]; sc[idx] = siluf(c); }
                staged = true; __syncthreads();
            }
            const int cb = it, quad = tid & 31, kc = tid >> 5;
            const float* wp = P->in[I_WADA] + ((size_t)l * 1024 + kc * 64) * 6144 + cb * 128 + quad * 4;
            f32x4 a[5];
#pragma unroll
            for (int cnd = 0; cnd < 5; ++cnd) a[cnd] = (f32x4){0.f, 0.f, 0.f, 0.f};
#pragma unroll 16
            for (int kk = 0; kk < 64; ++kk) {
                const f32x4 w = *(const f32x4*)(wp + (size_t)kk * 6144);
#pragma unroll
                for (int cnd = 0; cnd < 5; ++cnd) a[cnd] += w * sc[cnd * 1024 + kc * 64 + kk];
            }
#pragma unroll
            for (int cnd = 0; cnd < 5; ++cnd) *(LAS f32x4*)(red + (kc * 5 + cnd) * 128 + quad * 4) = a[cnd];
            __syncthreads();
            for (int idx = tid; idx < 640; idx += 512) {
                const int cnd = idx >> 7, cc = idx & 127; float s = 0.f;
#pragma unroll
                for (int k2 = 0; k2 < 16; ++k2) s += red[(k2 * 5 + cnd) * 128 + cc];
                ((float*)(ws + OFF_MOD))[(size_t)(l * 5 + cnd) * 6144 + cb * 128 + cc] = s + P->in[I_BADA][l * 6144 + cb * 128 + cc];
            }
            __syncthreads();
        }
    }
    __syncthreads();
}

__device__ __forceinline__ void prep_phase(PP P, LAS unsigned char* lds) {
    const int tid = otid(), lane = tid & 63, wave = tid >> 6, G = gridDim.x, bx = obid();
    unsigned char* ws = P->ws;
#if DEFER == 1
    convert_layer(P, lds, 0, (bx + 64) % G, G);
#elif DEFER == 2
    convert_layer(P, lds, 0, (bx + 64) % G, G, 7);
    for (int lx = 1; lx < 4; ++lx) convert_layer(P, lds, lx, (bx + 64 * (lx + 1)) % G, G, 6);
#else
    for (int lx = 0; lx < 4; ++lx) convert_layer(P, lds, lx, (bx + 64 * (lx + 1)) % G, G);
    tgen_part(P, bx, G);
#endif
    {
        float* X = (float*)(ws + OFF_X);
        for (int r = bx * 8 + wave; r < NTOK; r += G * 8) {
            if (r < NPROMPT) {
#pragma unroll
                for (int jj = 0; jj < 4; ++jj) *(f32x4*)(X + (size_t)r * 1024 + jj * 256 + lane * 4) = *(const f32x4*)(P->in[I_XP] + (size_t)r * 1024 + jj * 256 + lane * 4);
            } else {
                const int s = r - NPROMPT, t = s & 2047; const float gr = (float)(t >> 6), gc = (float)(t & 63);
#pragma unroll
                for (int jj = 0; jj < 4; ++jj) {
                    f32x4 v = *(const f32x4*)(P->in[I_XS] + (size_t)s * 1024 + jj * 256 + lane * 4);
#pragma unroll
                    for (int e = 0; e < 4; ++e) {
                        const float fq = __builtin_amdgcn_exp2f(-(float)(lane * 4 + e) * (13.287712379549449f / 256.f));
                        const float ang = (jj < 2 ? gr : gc) * fq;
                        v[e] += (jj & 1) ? __cosf(ang) : __sinf(ang);
                    }
                    *(f32x4*)(X + (size_t)r * 1024 + jj * 256 + lane * 4) = v;
                }
            }
        }
    }
    __syncthreads();
#if DEFER == 1
    gemv_mod(P, lds, 0, (bx + 128) % G, G);
#else
    for (int lx = 0; lx < 4; ++lx) gemv_mod(P, lds, lx, (bx + 48 * lx) % G, G);
#endif
}

__device__ __forceinline__ void norm_phase(PP P, int l, int which) {
    const int tid = otid(), lane = tid & 63, wave = tid >> 6, G = gridDim.x, bx = obid();
    unsigned char* ws = P->ws;
    const float* X = (const float*)(ws + OFF_X);
    const float* gp = which == 2 ? P->in[I_FINALG] : P->in[I_NORMG] + (size_t)(l * 2 + which) * 1024;
    f32x4 gv[4];
#pragma unroll
    for (int jj = 0; jj < 4; ++jj) gv[jj] = *(const f32x4*)(gp + jj * 256 + lane * 4);
    for (int r0 = bx * 8 + wave; r0 < NTOK; r0 += G * 16) {
        f32x4 v[2][4]; float ss[2] = {0.f, 0.f};
#pragma unroll
        for (int u = 0; u < 2; ++u) { const int r = r0 + u * G * 8; if (r < NTOK) {
#pragma unroll
            for (int jj = 0; jj < 4; ++jj) v[u][jj] = *(const f32x4*)(X + (size_t)r * 1024 + jj * 256 + lane * 4); } }
#pragma unroll
        for (int u = 0; u < 2; ++u) {
            const int r = r0 + u * G * 8; if (r >= NTOK) continue;
#pragma unroll
            for (int jj = 0; jj < 4; ++jj) ss[u] += v[u][jj][0] * v[u][jj][0] + v[u][jj][1] * v[u][jj][1] + v[u][jj][2] * v[u][jj][2] + v[u][jj][3] * v[u][jj][3];
            const float rstd = rsqrtf(wave_sum(ss[u]) * (1.f / 1024.f) + 1e-6f);
            if (which == 2) {
#pragma unroll
                for (int jj = 0; jj < 4; ++jj) *(f32x4*)(P->out + (size_t)r * 1024 + jj * 256 + lane * 4) = v[u][jj] * rstd * gv[jj];
            } else {
                const int cnd = r < NPROMPT ? 0 : 1 + ((r - NPROMPT) >> 11);
                const float* mp = (const float*)(ws + OFF_MOD) + (size_t)(l * 5 + cnd) * 6144 + which * 3072;
                bf16_t* Hh = (bf16_t*)(ws + OFF_H) + (size_t)r * 1024;
#pragma unroll
                for (int jj = 0; jj < 4; ++jj) {
                    const f32x4 sh = *(const f32x4*)(mp + jj * 256 + lane * 4), sc = *(const f32x4*)(mp + 1024 + jj * 256 + lane * 4);
                    const f32x4 y = v[u][jj] * rstd * gv[jj] * (sc + 1.f) + sh;
                    u32x2 o; o.x = pk2(y[0], y[1]); o.y = pk2(y[2], y[3]);
                    *(u32x2*)(Hh + jj * 256 + lane * 4) = o;
                }
            }
        }
    }
}

__device__ __forceinline__ void acc8(float (&s)[8], const u32x4& v, float m) {
    s[0] += m * bflo(v.x); s[1] += m * bfhi(v.x); s[2] += m * bflo(v.y); s[3] += m * bfhi(v.y); s[4] += m * bflo(v.z); s[5] += m * bfhi(v.z); s[6] += m * bflo(v.w); s[7] += m * bfhi(v.w);
}
template <int W> __device__ __forceinline__ void pool_run(const bf16_t* UB, bf16_t* AM, int t0, int ch) {
    int s0, L; if (t0 < NPROMPT) { s0 = t0 & ~255; L = 256; } else { s0 = NPROMPT + ((t0 - NPROMPT) & ~2047); L = 2048; }
    const int tl0 = t0 - s0, base = tl0 - W / 2;
    u32x4 v[W + 7];
#pragma unroll
    for (int i = 0; i < W + 7; ++i) { int tt = base + i; tt = tt < 0 ? 0 : (tt >= L ? L - 1 : tt); v[i] = *(const u32x4*)(UB + (size_t)(s0 + tt) * 512 + ch); }
    float s[8];
#pragma unroll
    for (int e = 0; e < 8; ++e) s[e] = 0.f;
#pragma unroll
    for (int i = 0; i < W; ++i) { const int tt = base + i; acc8(s, v[i], (tt >= 0 && tt < L) ? 1.f : 0.f); }
#pragma unroll
    for (int r = 0; r < 8; ++r) {
        const int tl = tl0 + r;
        const int lo = max(tl - W / 2, 0), hi = min(tl + W - W / 2, L);
        const float ic = 1.f / (float)(hi - lo);
        const u32x4 c = v[r + W / 2];
        u32x4 o;
        o.x = pk2(s[0] * ic - bflo(c.x), s[1] * ic - bfhi(c.x)); o.y = pk2(s[2] * ic - bflo(c.y), s[3] * ic - bfhi(c.y));
        o.z = pk2(s[4] * ic - bflo(c.z), s[5] * ic - bfhi(c.z)); o.w = pk2(s[6] * ic - bflo(c.w), s[7] * ic - bfhi(c.w));
        *(u32x4*)(AM + (size_t)(t0 + r) * 1024 + 512 + ch) = o;
        if (r < 7) {
            const int tout = base + r, tin = base + r + W;
            acc8(s, v[r], (tout >= 0 && tout < L) ? -1.f : 0.f);
            acc8(s, v[r + W], (tin >= 0 && tin < L) ? 1.f : 0.f);
        }
    }
}
__device__ __forceinline__ void pool_phase(PP P) {
    unsigned char* ws = P->ws;
    const bf16_t* UB = (const bf16_t*)(ws + OFF_UB);
    bf16_t* AM = (bf16_t*)(ws + OFF_AMIX);
    const int tid = otid(), lane = tid & 63, wave = tid >> 6;
    for (int wi = obid() * 8 + wave; wi < 4 * (NTOK / 32); wi += gridDim.x * 8) {
        const int g = wi & 3, t0 = (wi >> 2) * 32 + (lane >> 4) * 8, ch = (g * 16 + (lane & 15)) * 8;
        if (g == 0) pool_run<2>(UB, AM, t0, ch);
        else if (g == 1) pool_run<4>(UB, AM, t0, ch);
        else if (g == 2) pool_run<8>(UB, AM, t0, ch);
        else pool_run<16>(UB, AM, t0, ch);
    }
}

__device__ __forceinline__ void mixprep_phase(PP P, int j) {
    const int tid = otid(), lane = tid & 63, wave = tid >> 6;
    unsigned char* ws = P->ws;
    const float* O0 = (const float*)(ws + OFF_ODIR); const float* O1 = O0 + (size_t)NTOK * 512;
    const bf16_t* GT = (const bf16_t*)(ws + OFF_GATE);
    bf16_t* AM = (bf16_t*)(ws + OFF_AMIX);
    const int ch = lane * 8;
    const f32x4 g0 = *(const f32x4*)(P->in[I_GLAG] + j * 128 + (ch & 127)), g1 = *(const f32x4*)(P->in[I_GLAG] + j * 128 + (ch & 127) + 4);
    const int G8 = gridDim.x * 8;
    for (int r0 = obid() * 8 + wave; r0 < NTOK; r0 += 2 * G8) {
        f32x4 a[2], b[2]; u32x4 gt[2];
#pragma unroll
        for (int u = 0; u < 2; ++u) { const int r = r0 + u * G8; if (r < NTOK) {
            a[u] = *(const f32x4*)(O0 + (size_t)r * 512 + ch) + *(const f32x4*)(O1 + (size_t)r * 512 + ch);
            b[u] = *(const f32x4*)(O0 + (size_t)r * 512 + ch + 4) + *(const f32x4*)(O1 + (size_t)r * 512 + ch + 4);
            gt[u] = *(const u32x4*)(GT + (size_t)r * 512 + ch); } }
#pragma unroll
        for (int u = 0; u < 2; ++u) {
            const int r = r0 + u * G8; if (r >= NTOK) continue;
            float ss = a[u][0] * a[u][0] + a[u][1] * a[u][1] + a[u][2] * a[u][2] + a[u][3] * a[u][3] + b[u][0] * b[u][0] + b[u][1] * b[u][1] + b[u][2] * b[u][2] + b[u][3] * b[u][3];
            ss += __shfl_xor(ss, 1); ss += __shfl_xor(ss, 2); ss += __shfl_xor(ss, 4); ss += __shfl_xor(ss, 8);
            const float rstd = rsqrtf(ss * (1.f / 128.f) + 1e-6f);
            const f32x4 aa = a[u] * rstd * g0, bb = b[u] * rstd * g1;
            u32x4 o;
            o.x = pk2(aa[0] * bflo(gt[u].x), aa[1] * bfhi(gt[u].x)); o.y = pk2(aa[2] * bflo(gt[u].y), aa[3] * bfhi(gt[u].y));
            o.z = pk2(bb[0] * bflo(gt[u].z), bb[1] * bfhi(gt[u].z)); o.w = pk2(bb[2] * bflo(gt[u].w), bb[3] * bfhi(gt[u].w));
            *(u32x4*)(AM + (size_t)r * 1024 + ch) = o;
        }
    }
}

__device__ __forceinline__ void conv_phase(PP P, int j, int vb, int nb) {
    unsigned char* ws = P->ws;
    const bf16_t* XI = (const bf16_t*)(ws + OFF_XIN); const bf16_t* BGp = (const bf16_t*)(ws + OFF_BG); const bf16_t* CGp = (const bf16_t*)(ws + OFF_CG);
    bf16_t* AM = (bf16_t*)(ws + OFF_AMIX);
    for (int idx = vb * 512 + otid(); idx < NTOK * 64; idx += nb * 512) {
        const int t = idx >> 6, ch = (idx & 63) * 8;
        int s0, L; if (t < NPROMPT) { s0 = t & ~255; L = 256; } else { s0 = NPROMPT + ((t - NPROMPT) & ~2047); L = 2048; }
        const int tl = t - s0;
        float cv[8];
        { const f32x4 b0 = *(const f32x4*)(P->in[I_CONVB] + j * 512 + ch), b1 = *(const f32x4*)(P->in[I_CONVB] + j * 512 + ch + 4);
          cv[0] = b0[0]; cv[1] = b0[1]; cv[2] = b0[2]; cv[3] = b0[3]; cv[4] = b1[0]; cv[5] = b1[1]; cv[6] = b1[2]; cv[7] = b1[3]; }
#pragma unroll
        for (int jj = 0; jj < 3; ++jj) {
            const int tt = tl + jj - 1;
            if (tt < 0 || tt >= L) continue;
            const u32x4 xv = *(const u32x4*)(XI + (size_t)(s0 + tt) * 512 + ch), cg = *(const u32x4*)(CGp + (size_t)(s0 + tt) * 512 + ch);
            const f32x4 w0 = *(const f32x4*)(P->in[I_CONVW] + (size_t)(j * 3 + jj) * 512 + ch), w1 = *(const f32x4*)(P->in[I_CONVW] + (size_t)(j * 3 + jj) * 512 + ch + 4);
            cv[0] += bflo(xv.x) * bflo(cg.x) * w0[0]; cv[1] += bfhi(xv.x) * bfhi(cg.x) * w0[1]; cv[2] += bflo(xv.y) * bflo(cg.y) * w0[2]; cv[3] += bfhi(xv.y) * bfhi(cg.y) * w0[3];
            cv[4] += bflo(xv.z) * bflo(cg.z) * w1[0]; cv[5] += bfhi(xv.z) * bfhi(cg.z) * w1[1]; cv[6] += bflo(xv.w) * bflo(cg.w) * w1[2]; cv[7] += bfhi(xv.w) * bfhi(cg.w) * w1[3];
        }
        const u32x4 bg = *(const u32x4*)(BGp + (size_t)t * 512 + ch);
        u32x4 o;
        o.x = pk2(cv[0] * bflo(bg.x), cv[1] * bfhi(bg.x)); o.y = pk2(cv[2] * bflo(bg.y), cv[3] * bfhi(bg.y));
        o.z = pk2(cv[4] * bflo(bg.z), cv[5] * bfhi(bg.z)); o.w = pk2(cv[6] * bflo(bg.w), cv[7] * bfhi(bg.w));
        *(u32x4*)(AM + (size_t)t * 1024 + 512 + ch) = o;
    }
}

__device__ __forceinline__ void convert_phase(PP P) {
    unsigned char* ws = P->ws;
    bf16_t* AM = (bf16_t*)(ws + OFF_AMIX);
    for (int idx = obid() * 512 + otid(); idx < NTOK * 64; idx += gridDim.x * 512) {
        const int t = idx >> 6, ch = (idx & 63) * 8;
        f32x4 a, b;
        if (t < NPROMPT) { const float* F = (const float*)(ws + OFF_FACCP) + (size_t)t * 512 + ch; a = *(const f32x4*)F; b = *(const f32x4*)(F + 4); }
        else {
            const float* F = (const float*)(ws + OFF_FACCS) + (size_t)(t - NPROMPT) * 512 + ch;
            a = *(const f32x4*)F; b = *(const f32x4*)(F + 4);
#pragma unroll
            for (int ks = 1; ks < 4; ++ks) { a += *(const f32x4*)(F + (size_t)ks * 8192 * 512); b += *(const f32x4*)(F + (size_t)ks * 8192 * 512 + 4); }
        }
        u32x4 o; o.x = pk2(a[0], a[1]); o.y = pk2(a[2], a[3]); o.z = pk2(b[0], b[1]); o.w = pk2(b[2], b[3]);
        *(u32x4*)(AM + (size_t)t * 1024 + ch) = o;
    }
}

__device__ __forceinline__ int permd(int d) { return (d & 32) | ((d & 12) << 1) | ((d & 16) >> 2) | (d & 3); }
__device__ __forceinline__ bf16x8 pack8(const f32x4& a, const f32x4& b) {
    u32x4 o; o.x = pk2(a[0], a[1]); o.y = pk2(a[2], a[3]); o.z = pk2(b[0], b[1]); o.w = pk2(b[2], b[3]);
    return __builtin_bit_cast(bf16x8, o);
}
__device__ __forceinline__ void gla_item(PP P, LAS unsigned char* lds, int j, int seg, int head, int dir, bool full) {
    const int tid = otid(), lane = tid & 63, w = tid >> 6, r = lane & 15, q = lane >> 4;
    unsigned char* ws = P->ws;
    const bf16_t* QB = (const bf16_t*)(ws + OFF_QB); const bf16_t* KB = (const bf16_t*)(ws + OFF_KB); const bf16_t* VT = (const bf16_t*)(ws + OFF_VT);
    const float* LOGF = (const float*)(ws + OFF_LOGF);
    float* ODIR = (float*)(ws + OFF_ODIR);
    float* Ubuf = (float*)(ws + OFF_U); float* Dtot = (float*)(ws + OFF_DTOT);
    LAS bf16_t* QT = (LAS bf16_t*)(lds);
    LAS bf16_t* KT = (LAS bf16_t*)(lds + 36864);
    LAS bf16_t* KH = (LAS bf16_t*)(lds + 73728);
    LAS float* DL = (LAS float*)(lds + 114688);
    LAS bf16x8* ATT = (LAS bf16x8*)(lds + 116736);
    const int tok0 = seg * 256;
    __syncthreads();
    {
        const int d = tid & 63, c = w, pd = permd(d);
        float b = 0.f;
        const float* lf = LOGF + (size_t)(tok0 + 32 * c) * 512 + dir * 256 + head * 64 + d;
        const bf16_t* qp = QB + (size_t)(tok0 + 32 * c) * 256 + head * 64 + d;
        const bf16_t* kp = KB + (size_t)(tok0 + 32 * c) * 256 + head * 64 + d;
        float lfv[32]; bf16_t qv16[32], kv16[32];
#pragma unroll
        for (int ii = 0; ii < 32; ++ii) { const int il = dir ? 31 - ii : ii; lfv[ii] = lf[(size_t)il * 512]; qv16[ii] = qp[(size_t)il * 256]; kv16[ii] = kp[(size_t)il * 256]; }
#pragma unroll
        for (int ii = 0; ii < 32; ++ii) {
            const int il = dir ? 31 - ii : ii;
            b += lfv[ii];
            const float qv = bf2f(qv16[ii]), kv = bf2f(kv16[ii]);
            QT[(32 * c + il) * 72 + pd] = f2bf(qv * __expf(b));
            KT[(32 * c + il) * 72 + pd] = f2bf(kv * __expf(-b));
        }
        const float eT = __expf(b);
        DL[c * 64 + d] = eT;
#pragma unroll 8
        for (int il = 0; il < 32; ++il) KH[(c * 64 + d) * 40 + permd(il)] = f2bf(bf2f(KT[(32 * c + il) * 72 + pd]) * eT);
    }
    __syncthreads();
    if (full) {
        const int c = w;
        f32x4 at[2][2];
#pragma unroll
        for (int a = 0; a < 2; ++a)
#pragma unroll
            for (int b = 0; b < 2; ++b) at[a][b] = (f32x4){0.f, 0.f, 0.f, 0.f};
#pragma unroll
        for (int kk = 0; kk < 2; ++kk) {
            bf16x8 ka[2], qb[2];
#pragma unroll
            for (int t = 0; t < 2; ++t) { ka[t] = *(const LAS bf16x8*)(KT + (32 * c + 16 * t + r) * 72 + 32 * kk + 8 * q); qb[t] = *(const LAS bf16x8*)(QT + (32 * c + 16 * t + r) * 72 + 32 * kk + 8 * q); }
#pragma unroll
            for (int tj = 0; tj < 2; ++tj)
#pragma unroll
                for (int ti = 0; ti < 2; ++ti) at[tj][ti] = __builtin_amdgcn_mfma_f32_16x16x32_bf16(ka[tj], qb[ti], at[tj][ti], 0, 0, 0);
        }
#pragma unroll
        for (int ti = 0; ti < 2; ++ti) {
            const int i = 16 * ti + r;
#pragma unroll
            for (int tj = 0; tj < 2; ++tj)
#pragma unroll
                for (int jj = 0; jj < 4; ++jj) { const int jx = 16 * tj + 4 * q + jj; const bool keep = dir ? (jx >= i) : (jx <= i); if (!keep) at[tj][ti][jj] = 0.f; }
            ATT[(c * 2 + ti) * 64 + lane] = pack8(at[0][ti], at[1][ti]);
        }
    }
    __syncthreads();
    f32x4 S[4];
#pragma unroll
    for (int t = 0; t < 4; ++t) S[t] = (f32x4){0.f, 0.f, 0.f, 0.f};
    const int e = 16 * w + r;
    if (DBG_SINIT && full && seg >= 16) {
        const int sb = (seg - 16) >> 3, part = (seg - 16) & 7;
        const float* s0 = P->in[I_STATE] + ((size_t)(((sb * 2 + j) * 2 + dir) * 4 + head) * 64) * 128;
#pragma unroll
        for (int t = 0; t < 4; ++t)
#pragma unroll
            for (int jj = 0; jj < 4; ++jj) S[t][jj] = s0[(size_t)(16 * t + 4 * q + jj) * 128 + e];
        const int np = dir ? 7 - part : part;
#pragma unroll
        for (int xb = 0; xb < 8; xb += 4) {
            if (xb >= np) break;
            float dvv[4][16], uvv[4][16];
#pragma unroll
            for (int xi = 0; xi < 4; ++xi) {
                const int x = xb + xi; if (x >= 7) continue;
                const int pp = dir ? 7 - x : x;
                const size_t ib = (size_t)(((sb * 8 + pp) * 4 + head) * 2 + dir) * 64;
#pragma unroll
                for (int t = 0; t < 4; ++t)
#pragma unroll
                    for (int jj = 0; jj < 4; ++jj) { const int d = 16 * t + 4 * q + jj; dvv[xi][t * 4 + jj] = Dtot[ib + d]; uvv[xi][t * 4 + jj] = Ubuf[(ib + d) * 128 + e]; }
            }
#pragma unroll
            for (int xi = 0; xi < 4; ++xi) {
                const int x = xb + xi; if (x >= 7) continue;
                const bool on = x < np;
#pragma unroll
                for (int t = 0; t < 4; ++t)
#pragma unroll
                    for (int jj = 0; jj < 4; ++jj) S[t][jj] = on ? S[t][jj] * dvv[xi][t * 4 + jj] + uvv[xi][t * 4 + jj] : S[t][jj];
            }
        }
    }
    const bf16_t* vt = VT + (size_t)(head * 128 + e) * NTOK + tok0;
    u32x2 vpre0[8], vpre1[8];
#pragma unroll
    for (int cc = 0; cc < 8; ++cc) { const int c = dir ? 7 - cc : cc; vpre0[cc] = *(const u32x2*)(vt + 32 * c + 4 * q); vpre1[cc] = *(const u32x2*)(vt + 32 * c + 16 + 4 * q); }
#pragma unroll
    for (int cc = 0; cc < 8; ++cc) {
        const int c = dir ? 7 - cc : cc;
        const u32x2 v0 = vpre0[cc], v1 = vpre1[cc];
        u32x4 vv; vv.x = v0.x; vv.y = v0.y; vv.z = v1.x; vv.w = v1.y;
        const bf16x8 vb = __builtin_bit_cast(bf16x8, vv);
        if (full) {
            bf16x8 sb2[2];
            sb2[0] = pack8(S[0], S[1]); sb2[1] = pack8(S[2], S[3]);
#pragma unroll
            for (int mi = 0; mi < 2; ++mi) {
                f32x4 o = (f32x4){0.f, 0.f, 0.f, 0.f};
#pragma unroll
                for (int kk = 0; kk < 2; ++kk) {
                    const bf16x8 qa = *(const LAS bf16x8*)(QT + (32 * c + 16 * mi + r) * 72 + 32 * kk + 8 * q);
                    o = __builtin_amdgcn_mfma_f32_16x16x32_bf16(qa, sb2[kk], o, 0, 0, 0);
                }
                const bf16x8 aa = ATT[(c * 2 + mi) * 64 + lane];
                o = __builtin_amdgcn_mfma_f32_16x16x32_bf16(aa, vb, o, 0, 0, 0);
                float* op = ODIR + ((size_t)dir * NTOK + tok0 + 32 * c + 16 * mi + 4 * q) * 512 + head * 128 + e;
#pragma unroll
                for (int jj = 0; jj < 4; ++jj) op[(size_t)jj * 512] = o[jj];
            }
        }
#pragma unroll
        for (int t = 0; t < 4; ++t) {
            const f32x4 dv = *(const LAS f32x4*)(DL + c * 64 + 16 * t + 4 * q);
            S[t] = S[t] * dv;
            const bf16x8 ka = *(const LAS bf16x8*)(KH + (c * 64 + 16 * t + r) * 40 + 8 * q);
            S[t] = __builtin_amdgcn_mfma_f32_16x16x32_bf16(ka, vb, S[t], 0, 0, 0);
        }
    }
    if (full) {
        if (seg < 16) {
            float* so = P->out + OUT_STATE + ((size_t)(((seg * 2 + j) * 2 + dir) * 4 + head) * 64) * 128;
#pragma unroll
            for (int t = 0; t < 4; ++t)
#pragma unroll
                for (int jj = 0; jj < 4; ++jj) so[(size_t)(16 * t + 4 * q + jj) * 128 + e] = S[t][jj];
        }
    } else {
        const size_t ib = (size_t)(((seg - 16) * 4 + head) * 2 + dir) * 64;
#pragma unroll
        for (int t = 0; t < 4; ++t)
#pragma unroll
            for (int jj = 0; jj < 4; ++jj) Ubuf[(ib + 16 * t + 4 * q + jj) * 128 + e] = S[t][jj];
        if (tid < 64) { float p = 1.f;
#pragma unroll
            for (int c = 0; c < 8; ++c) p *= DL[c * 64 + tid];
            Dtot[ib + tid] = p; }
    }
}

__device__ __forceinline__ void gla_phase(PP P, LAS unsigned char* lds, int j, int sub) {
    const int G = gridDim.x;
    if (sub == 0) {
        for (int it = obid(); it < 384; it += G) {
            if (it >= 128 && it < 256) { const int pi = it - 128; gla_item(P, lds, j, pi >> 3, (pi >> 1) & 3, pi & 1, true); }
            else { const int li = it < 128 ? it : it - 128; gla_item(P, lds, j, 16 + (li >> 3), (li >> 1) & 3, li & 1, false); }
        }
    } else {
        for (int it = obid(); it < 256; it += G) gla_item(P, lds, j, 16 + (it >> 3), (it >> 1) & 3, it & 1, true);
    }
}


#define XB_TMO      128
#define XB_XCNT(j)  (256  + 64 * (j))
#define XB_XSUB(j)  (1280 + 64 * (j))
#define XB_XGEN(j)  (2304 + 64 * (j))
#define XB_TOP      3328
#define XB_TOPGEN   3392
#define XCD_BAR_WORDS 3456
#define XB_SPIN_CAP (1u << 18)

__device__ __forceinline__ unsigned xb_ld(unsigned* p)              { return __hip_atomic_load(p, __ATOMIC_RELAXED, __HIP_MEMORY_SCOPE_AGENT); }
__device__ __forceinline__ unsigned xb_add(unsigned* p, unsigned v) { return __hip_atomic_fetch_add(p, v, __ATOMIC_RELAXED, __HIP_MEMORY_SCOPE_AGENT); }
__device__ __forceinline__ unsigned xb_xcc_id() { return (unsigned)__builtin_amdgcn_s_getreg((3 << 11) | 20) & 0xFu; }
#define XB_SPIN(cond, bar) do { unsigned _sp = 0; while (cond) { __builtin_amdgcn_s_sleep(1); \
    if ((++_sp & 255u) == 0u) { if (xb_ld(&(bar)[XB_TMO])) break; if (_sp > XB_SPIN_CAP) { atomicAdd(&(bar)[XB_TMO], 1u); break; } } } } while (0)

struct XcdBarrier {
    unsigned* bar; unsigned x;
    volatile LAS unsigned* st;
};

__device__ __forceinline__ XcdBarrier xcd_barrier_post(unsigned* bar, volatile LAS unsigned* st) {
    XcdBarrier b; b.bar = bar; b.x = xb_xcc_id(); b.st = st;
    if (threadIdx.x == 0) (void)xb_add(&bar[XB_XCNT(b.x)], 1u);
    return b;
}
__device__ __forceinline__ void xcd_barrier_complete(unsigned* bar, unsigned x, unsigned& nloc, unsigned& nx) {
    const unsigned G = gridDim.x * gridDim.y * gridDim.z;
    unsigned sum, cnt, mine, sp = 0u;
    for (;;) {
        sum = 0u; cnt = 0u; mine = 0u;
#pragma unroll
        for (unsigned j = 0; j < 16; ++j) { const unsigned c = xb_ld(&bar[XB_XCNT(j)]); sum += c; cnt += (c > 0u) ? 1u : 0u; mine = (j == x) ? c : mine; }
        if (sum == G) break;
        __builtin_amdgcn_s_sleep(1);
        if ((++sp & 255u) == 0u) { if (xb_ld(&bar[XB_TMO])) break; if (sp > XB_SPIN_CAP) { atomicAdd(&bar[XB_TMO], 1u); break; } }
    }
    nloc = mine > 0u ? mine : 1u; nx = cnt > 0u ? cnt : 1u;
}

__device__ __forceinline__ void xcd_barrier(const XcdBarrier& b) {
    asm volatile("s_waitcnt vmcnt(0)" ::: "memory");
    __syncthreads();
    if (threadIdx.x == 0) {
        unsigned* bar = b.bar;
        __builtin_amdgcn_s_waitcnt(0);
        unsigned nloc = b.st[0], nx = b.st[1];
        if (nloc == 0u) { xcd_barrier_complete(bar, b.x, nloc, nx); b.st[0] = nloc; b.st[1] = nx; }
        const unsigned old = xb_add(&bar[XB_XSUB(b.x)], 1u);
        const unsigned gen = old / nloc;
        if (old + 1u == (gen + 1u) * nloc) {
            __builtin_amdgcn_fence(__ATOMIC_RELEASE, "agent");
            asm volatile("s_waitcnt vmcnt(0)" ::: "memory");
            const unsigned og = xb_add(&bar[XB_TOP], 1u);
            const unsigned tg = og / nx;
            if (og + 1u == (tg + 1u) * nx) xb_add(&bar[XB_TOPGEN], 1u);
            else XB_SPIN(xb_ld(&bar[XB_TOPGEN]) == tg, bar);
            __builtin_amdgcn_fence(__ATOMIC_ACQUIRE, "agent");
            xb_add(&bar[XB_XGEN(b.x)], 1u);
            asm volatile("s_waitcnt vmcnt(0)" ::: "memory");
        } else {
            XB_SPIN(xb_ld(&bar[XB_XGEN(b.x)]) == gen, bar);
            __builtin_amdgcn_fence(__ATOMIC_ACQUIRE, "agent");
            asm volatile("s_waitcnt vmcnt(0)" ::: "memory");
        }
    }
    __syncthreads();
}

enum { PT_PREP = 0, PT_NORM1, PT_GEMM_IN, PT_MIX_A, PT_MIX_B, PT_MIXPREP, PT_GEMM_OUT, PT_NORM2, PT_MLP1, PT_MLP2, PT_FINAL };

__global__ void __launch_bounds__(512, 2) mega_fwd(Params Pk) {
    extern __shared__ __attribute__((aligned(16))) unsigned char smem[];
    LAS unsigned char* lds = (LAS unsigned char*)smem;
#ifdef DBG_ZLDS
    for (int i = otid(); i < LDS_BYTES / 16; i += 512) ((LAS u32x4*)lds)[i] = (u32x4){0u, 0u, 0u, 0u};
    __syncthreads();
#endif
    { volatile LAS unsigned* st0 = (volatile LAS unsigned*)(lds + LDS_BYTES - 64); if (otid() < 2) st0[otid()] = 0u; }
    __syncthreads();
    XcdBarrier gbar; gbar.bar = (unsigned*)(Pk.ws + OFF_BAR); gbar.x = 0; gbar.st = (volatile LAS unsigned*)(lds + LDS_BYTES - 64);
    if (Pk.ph_hi - Pk.ph_lo > 1) gbar = xcd_barrier_post((unsigned*)(Pk.ws + OFF_BAR), (volatile LAS unsigned*)(lds + LDS_BYTES - 64));
    if (Pk.ph_hi < 0) cg::this_grid().sync();
    for (int ph = Pk.ph_lo; ph < Pk.ph_hi; ++ph) {
        PP P = (PP)__builtin_amdgcn_kernarg_segment_ptr();
        asm volatile("" : "+s"(P));
        int pt, l = 0;
        if (ph == 0) pt = PT_PREP;
        else if (ph == NPH - 1) pt = PT_FINAL;
        else {
            const int qq = ph - 1; int s;
            if (qq < 9) { l = 0; s = qq; } else if (qq < 17) { l = 1; s = qq - 9; } else if (qq < 26) { l = 2; s = qq - 17; } else { l = 3; s = qq - 26; }
            pt = (l & 1) ? (s < 4 ? s + 1 : s + 2) : s + 1;
        }
        const int j = l >> 1, odd = l & 1;
        const int nrep = (pt == REP_PT && (REP_L < 0 || l == REP_L)) ? 1 + REP_N : 1;
        for (int rep = 0; rep < nrep; ++rep) {
        int ngemm = 0; GemmCfg g; g.G = gridDim.x; g.c = obid(); g.j = j; g.l = l; g.nM = 48; g.ld = 1024; g.nt = 16; g.type = 0; g.nN = 0;
        switch (pt) {
        case PT_PREP: if (EN & 1) prep_phase(P, lds); break;
        case PT_NORM1: if (EN & 2) norm_phase(P, l, 0); break;
        case PT_GEMM_IN: ngemm = 1; g.type = odd ? T_IN_ODD : T_IN_EVEN; g.nN = 10; break;
        case PT_MIX_A: if (odd) { ngemm = 2; g.type = T_DFT_S; g.nM = 8; g.nN = 32; g.ld = 4096; g.nt = 16; } else { if (EN & 4) gla_phase(P, lds, j, 0); if (EN & 8) pool_phase(P); } break;
        case PT_MIX_B: if (odd) { if (EN & 8) convert_phase(P); } else { if (EN & 4) gla_phase(P, lds, j, 1); } break;
        case PT_MIXPREP: if (EN & 8) mixprep_phase(P, j); break;
        case PT_GEMM_OUT: ngemm = 1; g.type = odd ? T_OUT_ODD : T_OUT_EVEN; g.nN = 4; break;
        case PT_NORM2: if (EN & 2) norm_phase(P, l, 1); break;
        case PT_MLP1: ngemm = 1; g.type = T_MLP1; g.nN = 16; break;
        case PT_MLP2: ngemm = 1; g.type = T_MLP2; g.nN = 4; g.ld = 4096; g.nt = 64; break;
        default: if (EN & 2) norm_phase(P, 0, 2); break;
        }
        for (int gi = 0; gi < ngemm; ++gi) {
            if (gi == 1) { g.type = T_DFT_P; g.nM = 1; g.nN = 32; g.ld = 512; g.nt = 8; g.c = (obid() + gridDim.x - 32) % gridDim.x; }
            if (EN & 16) gemm_phase(lds, g);
        }
        if (pt == PT_MIX_A && odd && (EN & 8)) {
            const int G3 = gridDim.x, b3 = obid();
            if (G3 > 64) { if (b3 < 32) conv_phase(P, j, b3, G3 - 32); else if (b3 >= 64) conv_phase(P, j, b3 - 32, G3 - 32); }
            else conv_phase(P, j, b3, G3);
        }
        if (DEFER && pt == PT_MLP2 && l < 3) {
            const int G2 = gridDim.x, bq = obid(); const bool idle = G2 > 192; const int vb2 = idle ? bq - 192 : bq, nb2 = idle ? G2 - 192 : G2;
            if (!idle || bq >= 192) {
                if (DEFER == 1) { convert_layer(P, lds, l + 1, vb2, nb2, 7); gemv_mod(P, lds, l + 1, vb2, nb2); if (l == 0) tgen_part(P, vb2, nb2); }
                else { convert_layer(P, lds, l + 1, vb2, nb2, 1); if (l == 0) tgen_part(P, vb2, nb2); }
            }
        }
        if (ph + 1 < Pk.ph_hi || rep + 1 < nrep) xcd_barrier(gbar);
        }

    }
}


#ifdef DBG_K
__device__ __forceinline__ float dgst(unsigned u) { return (float)(u & 0xffffu) + (float)(u >> 16); }
__global__ void dbg_dump(float* out, const unsigned char* ws) {
    const unsigned* Xu = (const unsigned*)(ws + OFF_X); const unsigned* Hu = (const unsigned*)(ws + OFF_H); const unsigned* Au = (const unsigned*)(ws + OFF_AMIX);
    const unsigned* Bu = (const unsigned*)(ws + OFF_BIG); const unsigned* Uu = (const unsigned*)(ws + OFF_U); const unsigned* Wu = (const unsigned*)(ws);
    for (size_t i = (size_t)blockIdx.x * blockDim.x + threadIdx.x; i < (size_t)NTOK * 1024; i += (size_t)gridDim.x * blockDim.x) {
        float v = 0.f;
        if (DBG_SEL & 1) v += dgst(Xu[i]);
        if (DBG_SEL & 2) v += dgst(Hu[i % 6291456]);
        if (DBG_SEL & 4) v += dgst(Au[i % 6291456]);
        if (DBG_SEL & 8) v += dgst(Bu[i]) + dgst(Bu[i + 12582912]) + dgst(Bu[(i + 25165824) % 34603008]);
        if (DBG_SEL & 16) v += dgst(Uu[i % 2113536]);
        if (DBG_SEL & 32) v += dgst(Wu[i]) + dgst(Wu[i + 12582912]) + dgst(Wu[(i + 25165824) % 28573696]);
        out[i] = v;
    }
}
#endif
extern "C" void kernel_launch(void* const* d_in, const int* in_sizes, int n_in, void* d_out, int out_size, void* d_ws, size_t ws_size, hipStream_t stream) {
    static int grid = 0;
    if (grid == 0) {
        if (n_in != 22 || ws_size < WS_NEED) { fprintf(stderr, "kernel_launch: unexpected n_in %d / ws_size %zu (need %zu)\n", n_in, ws_size, (size_t)WS_NEED); grid = -1; return; }
        int dev = 0, cus = 0, per_cu = 0;
        hipGetDevice(&dev);
        hipDeviceGetAttribute(&cus, hipDeviceAttributeMultiprocessorCount, dev);
        if (hipFuncSetAttribute((const void*)mega_fwd, hipFuncAttributeMaxDynamicSharedMemorySize, LDS_BYTES) != hipSuccess) { fprintf(stderr, "kernel_launch: hipFuncSetAttribute failed\n"); grid = -1; return; }
        hipOccupancyMaxActiveBlocksPerMultiprocessor(&per_cu, (const void*)mega_fwd, 512, LDS_BYTES);
        if (per_cu < 1) { fprintf(stderr, "kernel_launch: occupancy query says %d blocks/CU\n", per_cu); per_cu = 1; }
        (void)hipGetLastError();
        grid = cus;
    }
    if (grid < 0) return;
    Params p{};
    for (int i = 0; i < 22; ++i) p.in[i] = (const float*)d_in[i];
    p.out = (float*)d_out; p.ws = (unsigned char*)d_ws;
#if MULTI_LAUNCH
#ifdef DBG_K
    for (int ph = 0; ph < DBG_K; ++ph) {
        p.ph_lo = ph; p.ph_hi = ph + 1;
        hipLaunchKernelGGL(mega_fwd, dim3(grid), dim3(512), LDS_BYTES, stream, p);
    }
    hipLaunchKernelGGL(dbg_dump, dim3(2048), dim3(256), 0, stream, (float*)d_out, (const unsigned char*)d_ws);
#else
    for (int ph = 0; ph < NPH; ++ph) {
        p.ph_lo = ph; p.ph_hi = ph + 1;
        hipLaunchKernelGGL(mega_fwd, dim3(grid), dim3(512), LDS_BYTES, stream, p);
    }
#endif
#else
    p.ph_lo = 0; p.ph_hi = NPH;
    if (hipMemsetAsync((char*)d_ws + OFF_BAR, 0, 16384, stream) != hipSuccess) { fprintf(stderr, "kernel_launch: memset of barrier word failed\n"); return; }
    void* args[] = {&p};
    hipError_t e = hipLaunchCooperativeKernel((const void*)mega_fwd, dim3(grid), dim3(512), args, LDS_BYTES, stream);
    if (e != hipSuccess) fprintf(stderr, "cooperative launch failed: %s (grid %d)\n", hipGetErrorString(e), grid);
#endif
}
```

```cpp
#include <hip/hip_runtime.h>
#include <hip/hip_cooperative_groups.h>
#include <cstdio>
#include <cstdint>
namespace cg = cooperative_groups;

#ifndef DBG_SEL
#define DBG_SEL 63
#endif
#ifndef DBG_NP
#define DBG_NP(x) (x)
#endif
#ifndef DEFER
#define DEFER 1
#endif
#ifndef REP_PT
#define REP_PT -1
#endif
#ifndef REP_L
#define REP_L -1
#endif
#ifndef REP_N
#define REP_N 1
#endif
#ifndef XSYNC
#define XSYNC 0
#endif
#ifndef DBG_SINIT
#define DBG_SINIT 1
#endif
#ifndef EN
#define EN 31
#endif
#ifndef MULTI_LAUNCH
#define MULTI_LAUNCH 0
#endif

#define LAS __attribute__((address_space(3)))
typedef unsigned short bf16_t;
typedef short bf16x8 __attribute__((ext_vector_type(8)));
typedef float f32x4 __attribute__((ext_vector_type(4)));
typedef unsigned u32x2 __attribute__((ext_vector_type(2)));
typedef unsigned u32x4 __attribute__((ext_vector_type(4)));

constexpr int DM = 1024, NTOK = 12288, NPROMPT = 4096, DFF = 4096;
constexpr int LDS_BYTES = 147456;
constexpr int NPH = 36;
constexpr size_t MBy = 1048576;
constexpr size_t OFF_W1T = 0, OFF_W2T = 32 * MBy, OFF_WIE = 64 * MBy, OFF_WOE = 74 * MBy, OFF_WIO = 78 * MBy, OFF_WOO = 88 * MBy;
constexpr size_t OFF_T2K = 92 * MBy, OFF_T256 = 108 * MBy, OFF_MOD = 108 * MBy + 262144, OFF_U = 109 * MBy, OFF_DTOT = 117 * MBy;
constexpr size_t OFF_X = 118 * MBy, OFF_H = 166 * MBy, OFF_AMIX = 190 * MBy, OFF_BIG = 214 * MBy, WS_NEED = 348 * MBy;
constexpr size_t OFF_HID = OFF_BIG;
constexpr size_t OFF_QB = OFF_BIG, OFF_KB = OFF_BIG + 6 * MBy, OFF_VT = OFF_BIG + 12 * MBy, OFF_GATE = OFF_BIG + 24 * MBy, OFF_LOGF = OFF_BIG + 36 * MBy;
constexpr size_t OFF_UB = OFF_BIG + 60 * MBy, OFF_ODIR = OFF_BIG + 72 * MBy;
constexpr size_t OFF_XTS = OFF_BIG, OFF_XTP = OFF_BIG + 16 * MBy, OFF_XIN = OFF_BIG + 24 * MBy, OFF_BG = OFF_BIG + 36 * MBy, OFF_CG = OFF_BIG + 48 * MBy;
constexpr size_t OFF_FACCP = OFF_BIG + 60 * MBy, OFF_FACCS = OFF_BIG + 68 * MBy;
constexpr size_t OFF_BAR = 117 * MBy + 524288;
constexpr size_t OUT_STATE = (size_t)NTOK * DM;

struct Params { const float* in[22]; float* out; unsigned char* ws; int ph_lo, ph_hi; };
typedef const __attribute__((address_space(4))) Params* PP;
enum { I_XP = 0, I_XS, I_STATE, I_C, I_CCTX, I_NORMG, I_FINALG, I_WADA, I_BADA, I_W1, I_W2, I_WINE, I_WA2, I_BA2, I_GLAG, I_POOLW, I_POOLS, I_WOUTE, I_WINO, I_CONVW, I_CONVB, I_WOUTO };

__device__ __forceinline__ int otid() { int t = __builtin_amdgcn_workitem_id_x(); asm volatile("" : "+v"(t)); return t; }
__device__ __forceinline__ int obid() { int b = __builtin_amdgcn_workgroup_id_x(); asm volatile("" : "+s"(b)); return b; }
typedef float f32x2 __attribute__((ext_vector_type(2)));
typedef __bf16 bf16x2v __attribute__((ext_vector_type(2)));
__device__ __forceinline__ unsigned pk2(float lo, float hi) { f32x2 v = {lo, hi}; bf16x2v b = __builtin_convertvector(v, bf16x2v); return __builtin_bit_cast(unsigned, b); }
__device__ __forceinline__ bf16_t f2bf(float x) { return (bf16_t)(pk2(x, 0.f) & 0xffffu); }
__device__ __forceinline__ float bf2f(bf16_t u) { return __uint_as_float(((unsigned)u) << 16); }
__device__ __forceinline__ float bflo(unsigned u) { return __uint_as_float(u << 16); }
__device__ __forceinline__ float bfhi(unsigned u) { return __uint_as_float(u & 0xffff0000u); }
__device__ __forceinline__ float wave_sum(float v) {
#pragma unroll
    for (int o = 1; o < 64; o <<= 1) v += __shfl_xor(v, o);
    return v;
}
__device__ __forceinline__ float siluf(float x) { return x * __builtin_amdgcn_rcpf(1.f + __expf(-x)); }
__device__ __forceinline__ float logsigmoidf(float x) { return fminf(x, 0.f) - __logf(1.f + __expf(-fabsf(x))); }
__device__ __forceinline__ int cond_of_seg(int pm) { return pm < 16 ? 0 : 1 + ((pm - 16) >> 3); }

namespace pg8 {
constexpr int BM = 256, BK = 64, HALF = 128, HTB = HALF * BK * 2, STAGE_BYTES = 8 * HTB, NXCD = 8, WGM = 8;
__host__ __device__ __forceinline__ int lds_byte(int r, int c) { const int st = (r >> 4) * 2 + (c >> 5), rr = r & 15, cc = c & 31, ob = rr * 64 + cc * 2; return st * 1024 + (ob ^ (((ob >> 9) & 1) << 5)); }
__host__ __device__ __forceinline__ int perm32(int rho) { const int n = rho >> 4, i = rho & 15; return 8 * (i >> 2) + 4 * n + (i & 3); }
__host__ __device__ __forceinline__ void stage_rc(int b, int& R, int& C) { const int st = b / 1024, sb = b % 1024, swz = sb ^ (((sb >> 9) & 1) << 5); R = (st >> 1) * 16 + swz / 64; C = (st & 1) * 32 + (swz % 64) / 2; }
}

enum { KD_BF16 = 0, KD_SILU, KD_RELU2, KD_LOGF, KD_RES, KD_ATOM };
enum { T_IN_EVEN = 0, T_IN_ODD, T_OUT_EVEN, T_OUT_ODD, T_MLP1, T_MLP2, T_DFT_S, T_DFT_P };
struct Unit { int pm, pn; };
struct UnitIO { const char* A; const char* B; char* out; const float* aux; int kind; int ld; };
struct GemmCfg { int type, j, l, nM, nN, ld, nt, G, c; };

__device__ __forceinline__ void make_unit(const GemmCfg& g, int pm, int pn, UnitIO& u) {
    PP Pq = (PP)__builtin_amdgcn_kernarg_segment_ptr();
    unsigned char* ws = Pq->ws;
    const size_t rowA = (size_t)pm * 256 * 1024 * 2;
    u.aux = nullptr; u.kind = KD_BF16; u.ld = 512;
    const float* modp = (const float*)(ws + OFF_MOD) + (size_t)(g.l * 5 + cond_of_seg(pm)) * 6144;
    switch (g.type) {
    case T_IN_EVEN: {
        const char* W = (const char*)(ws + OFF_WIE) + (size_t)g.j * 2560 * 1024 * 2 + (size_t)pn * 256 * 1024 * 2;
        const char* Hh = (const char*)(ws + OFF_H) + rowA;
        u.A = Hh; u.B = W;
        if (pn == 0) { u.out = (char*)(ws + OFF_QB) + (size_t)pm * 256 * 256 * 2; u.ld = 256; }
        else if (pn == 1) { u.out = (char*)(ws + OFF_KB) + (size_t)pm * 256 * 256 * 2; u.ld = 256; }
        else if (pn < 4) { u.A = W; u.B = Hh; u.out = (char*)(ws + OFF_VT) + ((size_t)(pn - 2) * 256 * NTOK + (size_t)pm * 256) * 2; u.ld = NTOK; }
        else if (pn < 6) { u.out = (char*)(ws + OFF_GATE) + ((size_t)pm * 256 * 512 + (pn - 4) * 256) * 2; u.kind = KD_SILU; }
        else if (pn < 8) { u.out = (char*)(ws + OFF_LOGF) + ((size_t)pm * 256 * 512 + (pn - 6) * 256) * 4; u.kind = KD_LOGF; u.aux = Pq->in[I_BA2] + g.j * 512 + (pn - 6) * 256; }
        else { u.out = (char*)(ws + OFF_UB) + ((size_t)pm * 256 * 512 + (pn - 8) * 256) * 2; }
    } break;
    case T_IN_ODD: {
        const char* W = (const char*)(ws + OFF_WIO) + (size_t)g.j * 2560 * 1024 * 2 + (size_t)pn * 256 * 1024 * 2;
        const char* Hh = (const char*)(ws + OFF_H) + rowA;
        u.A = Hh; u.B = W;
        if (pn < 4) {
            u.A = W; u.B = Hh;
            const int z = pn >> 1, ch0 = (pn & 1) * 256;
            if (pm < 16) { u.out = (char*)(ws + OFF_XTP) + ((size_t)(pm * 512 + ch0) * 512 + z * 256) * 2; u.ld = 512; }
            else { const int b = (pm - 16) >> 3, part = (pm - 16) & 7; u.out = (char*)(ws + OFF_XTS) + ((size_t)(b * 512 + ch0) * 4096 + z * 2048 + part * 256) * 2; u.ld = 4096; }
        } else {
            const size_t base = (pn < 6) ? OFF_XIN : (pn < 8 ? OFF_BG : OFF_CG);
            u.out = (char*)(ws + base) + ((size_t)pm * 256 * 512 + (pn & 1) * 256) * 2;
        }
    } break;
    case T_OUT_EVEN: case T_OUT_ODD: {
        u.A = (const char*)(ws + OFF_AMIX) + rowA;
        u.B = (const char*)(ws + (g.type == T_OUT_EVEN ? OFF_WOE : OFF_WOO)) + (size_t)g.j * 1024 * 1024 * 2 + (size_t)pn * 256 * 1024 * 2;
        u.out = (char*)(ws + OFF_X) + ((size_t)pm * 256 * 1024 + pn * 256) * 4; u.ld = 1024; u.kind = KD_RES; u.aux = modp + 2048 + pn * 256;
    } break;
    case T_MLP1: {
        u.A = (const char*)(ws + OFF_H) + rowA;
        u.B = (const char*)(ws + OFF_W1T) + (size_t)g.l * 4096 * 1024 * 2 + (size_t)pn * 256 * 1024 * 2;
        u.out = (char*)(ws + OFF_HID) + ((size_t)pm * 256 * 4096 + pn * 256) * 2; u.ld = 4096; u.kind = KD_RELU2;
    } break;
    case T_MLP2: {
        u.A = (const char*)(ws + OFF_HID) + (size_t)pm * 256 * 4096 * 2;
        u.B = (const char*)(ws + OFF_W2T) + (size_t)g.l * 4096 * 1024 * 2 + (size_t)pn * 256 * 4096 * 2;
        u.out = (char*)(ws + OFF_X) + ((size_t)pm * 256 * 1024 + pn * 256) * 4; u.ld = 1024; u.kind = KD_RES; u.aux = modp + 5120 + pn * 256;
    } break;
    case T_DFT_S: {
        const int pnb = pn >> 2, ks = pn & 3;
        u.A = (const char*)(ws + OFF_T2K) + ((size_t)pm * 256 * 4096 + ks * 1024) * 2;
        u.B = (const char*)(ws + OFF_XTS) + ((size_t)pnb * 256 * 4096 + ks * 1024) * 2;
        u.out = (char*)(ws + OFF_FACCS) + ((size_t)ks * 8192 * 512 + (size_t)((pnb >> 1) * 2048 + pm * 256) * 512 + (pnb & 1) * 256) * 2; u.kind = KD_BF16;
    } break;
    default: {
        u.A = (const char*)(ws + OFF_T256);
        u.B = (const char*)(ws + OFF_XTP) + (size_t)pn * 256 * 512 * 2;
        u.out = (char*)(ws + OFF_AMIX) + ((size_t)((pn >> 1) * 256) * 1024 + (pn & 1) * 256) * 2; u.ld = 1024; u.kind = KD_BF16;
    } break;
    }
}

__device__ __forceinline__ bool next_unit(const GemmCfg& g, int i, Unit& u) {
    const int nwg = g.nM * g.nN;
    const long L = (long)i * g.G + g.c; if (L >= nwg) return false;
    int wgid = (int)L; { const int q = nwg / pg8::NXCD, r = nwg % pg8::NXCD, xcd = wgid % pg8::NXCD, off = wgid / pg8::NXCD; wgid = (xcd < r ? xcd * (q + 1) : r * (q + 1) + (xcd - r) * q) + off; }
    const int nig = pg8::WGM * g.nN, gid = wgid / nig, fm = gid * pg8::WGM, gsz = (g.nM - fm) < pg8::WGM ? (g.nM - fm) : pg8::WGM;
    const int pm = fm + ((wgid % nig) % gsz), pn = (wgid % nig) / gsz;
    u.pm = pm; u.pn = pn; return true;
}

__device__ __forceinline__ void epilogue(const f32x4 (&acc)[2][2][4][2], const GemmCfg& g, const Unit& uu, int wr, int wc, int fr, int fq) {
    UnitIO u; make_unit(g, uu.pm, uu.pn, u);
    const int row0 = wr * 64 + fr, col0 = wc * 32 + 8 * fq;
    const int kind = u.kind, ld = u.ld;
    if (kind <= KD_RELU2) {
        bf16_t* O = (bf16_t*)u.out;
#pragma unroll
        for (int ai = 0; ai < 2; ++ai)
#pragma unroll
            for (int m = 0; m < 4; ++m) {
                bf16_t* rowp = O + (size_t)(row0 + ai * 128 + m * 16) * ld + col0;
#pragma unroll
                for (int bj = 0; bj < 2; ++bj) {
                    f32x4 v0 = acc[ai][bj][m][0], v1 = acc[ai][bj][m][1];
                    if (kind == KD_SILU) { v0[0] = siluf(v0[0]); v0[1] = siluf(v0[1]); v0[2] = siluf(v0[2]); v0[3] = siluf(v0[3]); v1[0] = siluf(v1[0]); v1[1] = siluf(v1[1]); v1[2] = siluf(v1[2]); v1[3] = siluf(v1[3]); }
                    else if (kind == KD_RELU2) {
                        v0[0] = fmaxf(v0[0], 0.f); v0[1] = fmaxf(v0[1], 0.f); v0[2] = fmaxf(v0[2], 0.f); v0[3] = fmaxf(v0[3], 0.f); v0 = v0 * v0;
                        v1[0] = fmaxf(v1[0], 0.f); v1[1] = fmaxf(v1[1], 0.f); v1[2] = fmaxf(v1[2], 0.f); v1[3] = fmaxf(v1[3], 0.f); v1 = v1 * v1; }
                    u32x4 o; o.x = pk2(v0[0], v0[1]); o.y = pk2(v0[2], v0[3]); o.z = pk2(v1[0], v1[1]); o.w = pk2(v1[2], v1[3]);
                    *(u32x4*)(rowp + bj * 128) = o;
                }
            }
    } else if (kind == KD_RES) {
        float* O = (float*)u.out;
        f32x4 gv[2][2];
#pragma unroll
        for (int bj = 0; bj < 2; ++bj)
#pragma unroll
            for (int n = 0; n < 2; ++n) gv[bj][n] = *(const f32x4*)(u.aux + col0 + bj * 128 + n * 4);
#pragma unroll
        for (int ai = 0; ai < 2; ++ai)
#pragma unroll
            for (int m = 0; m < 4; ++m) {
                float* rowp = O + (size_t)(row0 + ai * 128 + m * 16) * ld + col0;
#pragma unroll
                for (int bj = 0; bj < 2; ++bj)
#pragma unroll
                    for (int n = 0; n < 2; ++n) { f32x4* p = (f32x4*)(rowp + bj * 128 + n * 4); *p = *p + gv[bj][n] * acc[ai][bj][m][n]; }
            }
    } else if (kind == KD_LOGF) {
        float* O = (float*)u.out;
#pragma unroll
        for (int bj = 0; bj < 2; ++bj)
#pragma unroll
            for (int n = 0; n < 2; ++n) {
                const f32x4 bv = *(const f32x4*)(u.aux + col0 + bj * 128 + n * 4);
#pragma unroll
                for (int ai = 0; ai < 2; ++ai)
#pragma unroll
                    for (int m = 0; m < 4; ++m) {
                        f32x4 v = acc[ai][bj][m][n] + bv;
                        v[0] = logsigmoidf(v[0]) * 0.0625f; v[1] = logsigmoidf(v[1]) * 0.0625f; v[2] = logsigmoidf(v[2]) * 0.0625f; v[3] = logsigmoidf(v[3]) * 0.0625f;
                        *(f32x4*)(O + (size_t)(row0 + ai * 128 + m * 16) * ld + col0 + bj * 128 + n * 4) = v;
                    }
            }
    } else {
        float* O = (float*)u.out;
#pragma unroll
        for (int ai = 0; ai < 2; ++ai)
#pragma unroll
            for (int m = 0; m < 4; ++m) {
                float* rowp = O + (size_t)(row0 + ai * 128 + m * 16) * ld + col0;
#pragma unroll
                for (int bj = 0; bj < 2; ++bj)
#pragma unroll
                    for (int n = 0; n < 2; ++n) {
                        *(f32x4*)(rowp + bj * 128 + n * 4) = acc[ai][bj][m][n];
                    }
            }
    }
}

__device__ __forceinline__ void gemm_phase(LAS unsigned char* lds, const GemmCfg& g) {
    using namespace pg8;
    const int tid = otid(), wid = __builtin_amdgcn_readfirstlane(tid >> 6), lane = tid & 63, wr = wid >> 2, wc = wid & 3, fr = lane & 15, fq = lane >> 4;
    const int nt = g.nt;
    unsigned voffA[2], voffB[2];
#pragma unroll
    for (int i = 0; i < 2; ++i) { int R, C; stage_rc(tid * 16 + i * 8192, R, C); const int Rb = (R & ~31) + perm32(R & 31); voffA[i] = (unsigned)(R * g.ld + C) * 2u; voffB[i] = (unsigned)(Rb * g.ld + C) * 2u; }
    const size_t kstep = (size_t)(BK * 2);
    const size_t hstepA = (size_t)HALF * g.ld * 2;
#define hstepB hstepA
    const unsigned ldsw = (unsigned)wid * 1024u;
    const int aoff = lds_byte(wr * 64 + fr, fq * 8), boff = lds_byte(wc * 32 + fr, fq * 8);
#define PG8_SA(b, h) (((b) * 2 + (h)) * HTB)
#define PG8_SB(b, h) ((4 + (b) * 2 + (h)) * HTB)
#define PG8_STAGE(bufoff, gbase, voff) do { _Pragma("unroll") for (int _i = 0; _i < 2; ++_i) \
        __builtin_amdgcn_global_load_lds((const unsigned*)((const char*)(gbase) + (voff)[_i]), (LAS unsigned*)(lds + (bufoff) + ldsw + _i * 8192), 16, 0, 0); } while (0)
#define PG8_LDA(dst, b, h) do { _Pragma("unroll") for (int m = 0; m < 4; ++m) _Pragma("unroll") for (int k = 0; k < 2; ++k) dst[m][k] = *(const LAS bf16x8*)(lds + PG8_SA(b, h) + aoff + m * 2048 + k * 1024); } while (0)
#define PG8_LDB(dst, b, h) do { _Pragma("unroll") for (int n = 0; n < 2; ++n) _Pragma("unroll") for (int k = 0; k < 2; ++k) dst[n][k] = *(const LAS bf16x8*)(lds + PG8_SB(b, h) + boff + n * 2048 + k * 1024); } while (0)
#define PG8_MMA(ai, bj, At, Bt) do { __builtin_amdgcn_s_setprio(1); _Pragma("unroll") for (int m = 0; m < 4; ++m) _Pragma("unroll") for (int n = 0; n < 2; ++n) _Pragma("unroll") for (int k = 0; k < 2; ++k) \
        acc[ai][bj][m][n] = __builtin_amdgcn_mfma_f32_16x16x32_bf16(Bt[n][k], At[m][k], acc[ai][bj][m][n], 0, 0, 0); __builtin_amdgcn_s_setprio(0); } while (0)
#define PG8_WAIT_V(n) asm volatile("s_waitcnt vmcnt(" #n ")" ::: "memory")
#define PG8_WAIT_L(n) asm volatile("s_waitcnt lgkmcnt(" #n ")" ::: "memory")
#define PG8_BAR __builtin_amdgcn_s_barrier()
#define PG8_SCHED __builtin_amdgcn_sched_barrier(0)
    Unit cur, nxt; int ui = 0;
    if (!next_unit(g, 0, cur)) return;
    f32x4 acc[2][2][4][2];
#pragma unroll
    for (int a = 0; a < 2; ++a)
#pragma unroll
        for (int b = 0; b < 2; ++b)
#pragma unroll
            for (int m = 0; m < 4; ++m)
#pragma unroll
                for (int n = 0; n < 2; ++n) acc[a][b][m][n] = (f32x4){0.f, 0.f, 0.f, 0.f};
    bf16x8 At[4][2], B0[2][2], B1[2][2];
    const char* cA; const char* cB; { UnitIO io; make_unit(g, cur.pm, cur.pn, io); cA = io.A; cB = io.B; }
    PG8_STAGE(PG8_SB(0, 0), cB, voffB); PG8_STAGE(PG8_SB(0, 1), cB + hstepB, voffB); PG8_STAGE(PG8_SA(0, 0), cA, voffA); PG8_STAGE(PG8_SA(0, 1), cA + hstepA, voffA);
    if (wr == 1) PG8_BAR;
    PG8_WAIT_V(2); PG8_BAR;
    PG8_STAGE(PG8_SB(1, 0), cB + kstep, voffB); PG8_STAGE(PG8_SA(1, 0), cA + kstep, voffA); PG8_STAGE(PG8_SB(1, 1), cB + hstepB + kstep, voffB);
    PG8_WAIT_V(6); PG8_BAR;
    for (;;) {
        const bool has_next = next_unit(g, ui + 1, nxt);
        const char* nA = cA; const char* nB = cB; if (has_next) { UnitIO io; make_unit(g, nxt.pm, nxt.pn, io); nA = io.A; nB = io.B; }
        for (int t = 0; t < nt; t += 2) {
            const bool last = (t == nt - 2);
            const char* a1 = cA + (size_t)(t + 1) * kstep;
            const char* a2 = last ? nA : cA + (size_t)(t + 2) * kstep; const char* b2 = last ? nB : cB + (size_t)(t + 2) * kstep;
            const char* a3 = a2 + kstep; const char* b3 = b2 + kstep;
            PG8_LDB(B0, 0, 0); PG8_LDB(B1, 0, 1); PG8_SCHED; PG8_LDA(At, 0, 0); PG8_STAGE(PG8_SA(1, 1), a1 + hstepA, voffA);
            PG8_WAIT_V(8); PG8_WAIT_L(0); PG8_BAR; PG8_MMA(0, 0, At, B0); PG8_MMA(0, 1, At, B1); PG8_BAR; PG8_SCHED;
            PG8_LDA(At, 0, 1); PG8_STAGE(PG8_SB(0, 0), b2, voffB); PG8_STAGE(PG8_SB(0, 1), b2 + hstepB, voffB); PG8_STAGE(PG8_SA(0, 0), a2, voffA);
            PG8_WAIT_V(8); PG8_WAIT_L(0); PG8_BAR; PG8_MMA(1, 0, At, B0); PG8_MMA(1, 1, At, B1); PG8_BAR; PG8_SCHED;
            PG8_LDB(B0, 1, 0); PG8_LDB(B1, 1, 1); PG8_SCHED; PG8_LDA(At, 1, 0); PG8_STAGE(PG8_SA(0, 1), a2 + hstepA, voffA);
            PG8_WAIT_V(8); PG8_WAIT_L(0); PG8_BAR; PG8_MMA(0, 0, At, B0); PG8_MMA(0, 1, At, B1); PG8_BAR; PG8_SCHED;
            PG8_LDA(At, 1, 1); PG8_STAGE(PG8_SB(1, 0), b3, voffB); PG8_STAGE(PG8_SB(1, 1), b3 + hstepB, voffB); PG8_STAGE(PG8_SA(1, 0), a3, voffA);
            PG8_WAIT_V(8); PG8_WAIT_L(0); PG8_BAR; PG8_MMA(1, 0, At, B0); PG8_MMA(1, 1, At, B1); PG8_BAR; PG8_SCHED;
        }
        if (wr == 0) PG8_BAR;
        epilogue(acc, g, cur, wr, wc, fr, fq);
        if (!has_next) break;
#pragma unroll
        for (int a = 0; a < 2; ++a)
#pragma unroll
            for (int b = 0; b < 2; ++b)
#pragma unroll
                for (int m = 0; m < 4; ++m)
#pragma unroll
                    for (int n = 0; n < 2; ++n) acc[a][b][m][n] = (f32x4){0.f, 0.f, 0.f, 0.f};
        cur = nxt; cA = nA; cB = nB; ++ui;
        if (wr == 1) PG8_BAR;
    }
    PG8_WAIT_V(0);
    PG8_BAR;
#undef hstepB
#undef PG8_SA
#undef PG8_SB
#undef PG8_STAGE
#undef PG8_LDA
#undef PG8_LDB
#undef PG8_MMA
#undef PG8_WAIT_V
#undef PG8_WAIT_L
#undef PG8_BAR
#undef PG8_SCHED
}

__device__ __forceinline__ void transpose_item(const float* W, int ldn, int n0, int k0, bf16_t* WT, int drow0, int ldk, float scale, LAS float* scr, int lane) {
    float tv[32];
#pragma unroll
    for (int i = 0; i < 32; ++i) { const int kk = 2 * i + (lane >> 5); tv[i] = W[(size_t)(k0 + kk) * ldn + n0 + (lane & 31)]; }
#pragma unroll
    for (int i = 0; i < 32; ++i) { const int kk = 2 * i + (lane >> 5); scr[kk * 33 + (lane & 31)] = tv[i]; }
    asm volatile("s_waitcnt lgkmcnt(0)" ::: "memory");
    const int c = lane & 7;
#pragma unroll
    for (int jx = 0; jx < 4; ++jx) {
        const int n = (lane >> 3) + 8 * jx; const LAS float* s = scr + (8 * c) * 33 + n;
        u32x4 o; o.x = pk2(s[0] * scale, s[33] * scale); o.y = pk2(s[66] * scale, s[99] * scale); o.z = pk2(s[132] * scale, s[165] * scale); o.w = pk2(s[198] * scale, s[231] * scale);
        *(u32x4*)(WT + (size_t)(drow0 + n) * ldk + k0 + 8 * c) = o;
    }
    asm volatile("s_waitcnt lgkmcnt(0)" ::: "memory");
}

__device__ __forceinline__ void convert_layer(PP P, LAS unsigned char* lds, int l, int vb, int nb, int part = 7) {
    const int tid = otid(), lane = tid & 63, wave = tid >> 6;
    unsigned char* ws = P->ws;
    const int j = l >> 1, odd = l & 1;
    __syncthreads();
    {
        LAS float* scr = (LAS float*)(lds + wave * 8704);
        const int it_lo = (part & 1) ? 0 : 4096, it_hi = (part & 2) ? 5376 : 4096;
        for (int it = it_lo + vb * 8 + wave; it < it_hi; it += nb * 8) {
            int r = it;
            if (r < 2048) { const int kb = r / 128, nbk = r % 128;
                transpose_item(P->in[I_W1] + (size_t)l * 1024 * 4096, 4096, nbk * 32, kb * 64, (bf16_t*)(ws + OFF_W1T) + (size_t)l * 4096 * 1024, nbk * 32, 1024, 1.f, scr, lane); continue; }
            r -= 2048;
            if (r < 2048) { const int kb = r / 32, nbk = r % 32;
                transpose_item(P->in[I_W2] + (size_t)l * 4096 * 1024, 1024, nbk * 32, kb * 64, (bf16_t*)(ws + OFF_W2T) + (size_t)l * 1024 * 4096, nbk * 32, 4096, 1.f, scr, lane); continue; }
            r -= 2048;
            if (!odd) {
                if (r < 1024) { const int kb = r / 64, nbk = r % 64; const int sb = nbk < 48 ? nbk : nbk + 1; const int n0 = sb * 32; const int drow = n0 < 1536 ? n0 : n0 + 480;
                    transpose_item(P->in[I_WINE] + (size_t)j * 1024 * 2080, 2080, n0, kb * 64, (bf16_t*)(ws + OFF_WIE) + (size_t)j * 2560 * 1024, drow, 1024, n0 < 256 ? 0.125f : 1.f, scr, lane); continue; }
                r -= 1024;
                { const int kb = r / 32, nbk = r % 32;
                    transpose_item(P->in[I_WOUTE] + (size_t)j * 1024 * 1024, 1024, nbk * 32, kb * 64, (bf16_t*)(ws + OFF_WOE) + (size_t)j * 1024 * 1024, nbk * 32, 1024, 1.f, scr, lane); }
            } else {
                if (r < 768) { const int kb = r / 48, nbk = r % 48; const int n0 = 512 + nbk * 32;
                    transpose_item(P->in[I_WINO] + (size_t)j * 1024 * 2048, 2048, n0, kb * 64, (bf16_t*)(ws + OFF_WIO) + (size_t)j * 2560 * 1024, n0 + 512, 1024, 1.f, scr, lane); continue; }
                r -= 768;
                { const int kb = r / 32, nbk = r % 32;
                    transpose_item(P->in[I_WOUTO] + (size_t)j * 1024 * 1024, 1024, nbk * 32, kb * 64, (bf16_t*)(ws + OFF_WOO) + (size_t)j * 1024 * 1024, nbk * 32, 1024, 1.f, scr, lane); }
            }
        }
    }
    __syncthreads();
    if (!(part & 4)) return;
    if (odd) {
    {
        LAS float* wt = (LAS float*)lds;
        LAS float* tab = (LAS float*)(lds + 64 * 129 * 4);
        for (int it = vb; it < 64; it += nb) {
            const int g = (it >> 4) & 3, kb = it & 15;
            for (int idx = tid; idx < 64 * 128; idx += 512) { const int kk = idx >> 7, c = idx & 127; wt[kk * 129 + c] = P->in[I_WINO][((size_t)j * 1024 + kb * 64 + kk) * 2048 + g * 128 + c]; }
            if (tid < 128) { tab[tid] = __builtin_amdgcn_cosf((float)tid * (1.f / 128.f)); tab[128 + tid] = __builtin_amdgcn_sinf((float)tid * (1.f / 128.f)); }
            __syncthreads();
            const int li = lane & 15, lq = lane >> 4;
            f32x4 acc[2][4];
#pragma unroll
            for (int ti = 0; ti < 2; ++ti)
#pragma unroll
                for (int u = 0; u < 4; ++u) acc[ti][u] = (f32x4){0.f, 0.f, 0.f, 0.f};
            const int zm0 = 16 * (2 * wave) + li, zm1 = zm0 + 16;
            for (int sx = 0; sx < 32; ++sx) {
                const int c = 4 * sx + lq;
                const float a0 = tab[(zm0 >> 7) * 128 + (((zm0 & 127) * c) & 127)], a1 = tab[(zm1 >> 7) * 128 + (((zm1 & 127) * c) & 127)];
#pragma unroll
                for (int u = 0; u < 4; ++u) {
                    const float b = wt[(16 * u + li) * 129 + c];
                    acc[0][u] = __builtin_amdgcn_mfma_f32_16x16x4f32(a0, b, acc[0][u], 0, 0, 0);
                    acc[1][u] = __builtin_amdgcn_mfma_f32_16x16x4f32(a1, b, acc[1][u], 0, 0, 0);
                }
            }
#pragma unroll
            for (int ti = 0; ti < 2; ++ti)
#pragma unroll
                for (int r = 0; r < 4; ++r) {
                    const int zm = 16 * (2 * wave + ti) + 4 * lq + r, z = zm >> 7, m = zm & 127;
                    bf16_t* O = (bf16_t*)(ws + OFF_WIO) + (size_t)j * 2560 * 1024 + (size_t)(z * 512 + g * 128 + m) * 1024 + kb * 64 + li;
#pragma unroll
                    for (int u = 0; u < 4; ++u) O[16 * u] = f2bf(acc[ti][u][r]);
                }
            __syncthreads();
        }
    }
    } else {
    {
        LAS float* Pt = (LAS float*)lds;
        LAS float* Wd = (LAS float*)(lds + 65536);
        for (int it = vb; it < 64; it += nb) {
            const int g = (it >> 4) & 3, nbk = it & 15;
            for (int idx = tid; idx < 128 * 128; idx += 512) { const int c = idx >> 7, d = idx & 127; Pt[d * 128 + c] = P->in[I_POOLW][((size_t)(j * 4 + g) * 128 + c) * 128 + d] * P->in[I_POOLS][j * 512 + g * 128 + d]; }
            for (int idx = tid; idx < 128 * 64; idx += 512) { const int d = idx >> 6, n = idx & 63; Wd[d * 64 + n] = P->in[I_WOUTE][((size_t)j * 1024 + 512 + g * 128 + d) * 1024 + nbk * 64 + n]; }
            __syncthreads();
            const int c = tid & 127, ng = tid >> 7;
            float acc[16];
#pragma unroll
            for (int nn = 0; nn < 16; ++nn) acc[nn] = 0.f;
            for (int d = 0; d < 128; ++d) {
                const float p = Pt[d * 128 + c];
#pragma unroll
                for (int nn = 0; nn < 16; ++nn) acc[nn] += p * Wd[d * 64 + ng * 16 + nn];
            }
            bf16_t* O = (bf16_t*)(ws + OFF_WOE) + (size_t)j * 1024 * 1024 + (size_t)(nbk * 64 + ng * 16) * 1024 + 512 + g * 128 + c;
#pragma unroll
            for (int nn = 0; nn < 16; ++nn) O[(size_t)nn * 1024] = f2bf(acc[nn]);
            __syncthreads();
        }
    }
    {
        LAS float* av = (LAS float*)lds;
        LAS float* w2 = (LAS float*)(lds + 16384);
        for (int it = (vb + nb - (nb > 16 ? 16 : 0)) % nb; it < 16; it += nb) {
            const int kb = it & 15;
            for (int idx = tid; idx < 64 * 32; idx += 512) { const int kk = idx >> 5, r = idx & 31; av[kk * 33 + r] = P->in[I_WINE][((size_t)j * 1024 + kb * 64 + kk) * 2080 + 1536 + r]; }
            for (int idx = tid; idx < 8192; idx += 512) w2[idx] = P->in[I_WA2][(size_t)j * 8192 + idx];
            __syncthreads();
            const int k = tid & 63, grp = tid >> 6, z = grp >> 2, n0 = (grp & 3) * 64;
            float a[16];
#pragma unroll
            for (int r = 0; r < 16; ++r) a[r] = av[k * 33 + z * 16 + r];
            bf16_t* O = (bf16_t*)(ws + OFF_WIE) + (size_t)j * 2560 * 1024 + (size_t)(1536 + z * 256 + n0) * 1024 + kb * 64 + k;
            for (int nn = 0; nn < 64; ++nn) {
                float s = 0.f;
#pragma unroll
                for (int r = 0; r < 16; ++r) s += a[r] * w2[(z * 16 + r) * 256 + n0 + nn];
                O[(size_t)nn * 1024] = f2bf(s);
            }
            __syncthreads();
        }
    }
    }
}

__device__ __forceinline__ void tgen_part(PP P, int vb, int nb) {
    const int tid = otid(); unsigned char* ws = P->ws;
    {
        const int gt = vb * 512 + tid, GT = nb * 512;
        for (int it = gt; it < 2048 * 512 + 256 * 64; it += GT) {
            int L, k, c0; bf16_t* T; float s;
            if (it < 2048 * 512) { L = 2048; k = it >> 9; c0 = (it & 511) * 8; T = (bf16_t*)(ws + OFF_T2K); s = 1.f / 512.f; }
            else { const int r = it - 2048 * 512; L = 256; k = r >> 6; c0 = (r & 63) * 8; T = (bf16_t*)(ws + OFF_T256); s = 0.00552427172801990f; }
            const int z = c0 >= L; const int l0 = c0 - z * L; const float invL = 1.f / (float)L;
            float v[8];
#pragma unroll
            for (int e = 0; e < 8; ++e) { const int ph = (k * (l0 + e)) & (L - 1); const float fr = (float)ph * invL; v[e] = z ? -__builtin_amdgcn_sinf(fr) * s : __builtin_amdgcn_cosf(fr) * s; }
            u32x4 o; o.x = pk2(v[0], v[1]); o.y = pk2(v[2], v[3]); o.z = pk2(v[4], v[5]); o.w = pk2(v[6], v[7]);
            *(u32x4*)(T + (size_t)k * (2 * L) + c0) = o;
        }
    }
}
__device__ __forceinline__ void gemv_mod(PP P, LAS unsigned char* lds, int l, int vb, int nb) {
    const int tid = otid(); unsigned char* ws = P->ws;
    __syncthreads();
    {
        LAS float* sc = (LAS float*)lds;
        LAS float* red = (LAS float*)(lds + 20480);
        bool staged = false;
        for (int it = vb; it < 48; it += nb) {
            if (!staged) {
                for (int idx = tid; idx < 5120; idx += 512) { const int cnd = idx >> 10, k = idx & 1023; const float c = cnd == 0 ? P->in[I_CCTX][k] : P->in[I_C][(cnd - 1) * 1024 + k]; sc[idx] = siluf(c); }
                staged = true; __syncthreads();
            }
            const int cb = it, quad = tid & 31, kc = tid >> 5;
            const float* wp = P->in[I_WADA] + ((size_t)l * 1024 + kc * 64) * 6144 + cb * 128 + quad * 4;
            f32x4 a[5];
#pragma unroll
            for (int cnd = 0; cnd < 5; ++cnd) a[cnd] = (f32x4){0.f, 0.f, 0.f, 0.f};
#pragma unroll 16
            for (int kk = 0; kk < 64; ++kk) {
                const f32x4 w = *(const f32x4*)(wp + (size_t)kk * 6144);
#pragma unroll
                for (int cnd = 0; cnd < 5; ++cnd) a[cnd] += w * sc[cnd * 1024 + kc * 64 + kk];
            }
#pragma unroll
            for (int cnd = 0; cnd < 5; ++cnd) *(LAS f32x4*)(red + (kc * 5 + cnd) * 128 + quad * 4) = a[cnd];
            __syncthreads();
            for (int idx = tid; idx < 640; idx += 512) {
                const int cnd = idx >> 7, cc = idx & 127; float s = 0.f;
#pragma unroll
                for (int k2 = 0; k2 < 16; ++k2) s += red[(k2 * 5 + cnd) * 128 + cc];
                ((float*)(ws + OFF_MOD))[(size_t)(l * 5 + cnd) * 6144 + cb * 128 + cc] = s + P->in[I_BADA][l * 6144 + cb * 128 + cc];
            }
            __syncthreads();
        }
    }
    __syncthreads();
}

__device__ __forceinline__ void prep_phase(PP P, LAS unsigned char* lds) {
    const int tid = otid(), lane = tid & 63, wave = tid >> 6, G = gridDim.x, bx = obid();
    unsigned char* ws = P->ws;
#if DEFER == 1
    convert_layer(P, lds, 0, (bx + 64) % G, G);
#elif DEFER == 2
    convert_layer(P, lds, 0, (bx + 64) % G, G, 7);
    for (int lx = 1; lx < 4; ++lx) convert_layer(P, lds, lx, (bx + 64 * (lx + 1)) % G, G, 6);
#else
    for (int lx = 0; lx < 4; ++lx) convert_layer(P, lds, lx, (bx + 64 * (lx + 1)) % G, G);
    tgen_part(P, bx, G);
#endif
    {
        float* X = (float*)(ws + OFF_X);
        for (int r = bx * 8 + wave; r < NTOK; r += G * 8) {
            if (r < NPROMPT) {
#pragma unroll
                for (int jj = 0; jj < 4; ++jj) *(f32x4*)(X + (size_t)r * 1024 + jj * 256 + lane * 4) = *(const f32x4*)(P->in[I_XP] + (size_t)r * 1024 + jj * 256 + lane * 4);
            } else {
                const int s = r - NPROMPT, t = s & 2047; const float gr = (float)(t >> 6), gc = (float)(t & 63);
#pragma unroll
                for (int jj = 0; jj < 4; ++jj) {
                    f32x4 v = *(const f32x4*)(P->in[I_XS] + (size_t)s * 1024 + jj * 256 + lane * 4);
#pragma unroll
                    for (int e = 0; e < 4; ++e) {
                        const float fq = __builtin_amdgcn_exp2f(-(float)(lane * 4 + e) * (13.287712379549449f / 256.f));
                        const float ang = (jj < 2 ? gr : gc) * fq;
                        v[e] += (jj & 1) ? __cosf(ang) : __sinf(ang);
                    }
                    *(f32x4*)(X + (size_t)r * 1024 + jj * 256 + lane * 4) = v;
                }
            }
        }
    }
    __syncthreads();
#if DEFER == 1
    gemv_mod(P, lds, 0, (bx + 128) % G, G);
#else
    for (int lx = 0; lx < 4; ++lx) gemv_mod(P, lds, lx, (bx + 48 * lx) % G, G);
#endif
}

__device__ __forceinline__ void norm_phase(PP P, int l, int which) {
    const int tid = otid(), lane = tid & 63, wave = tid >> 6, G = gridDim.x, bx = obid();
    unsigned char* ws = P->ws;
    const float* X = (const float*)(ws + OFF_X);
    const float* gp = which == 2 ? P->in[I_FINALG] : P->in[I_NORMG] + (size_t)(l * 2 + which) * 1024;
    f32x4 gv[4];
#pragma unroll
    for (int jj = 0; jj < 4; ++jj) gv[jj] = *(const f32x4*)(gp + jj * 256 + lane * 4);
    for (int r0 = bx * 8 + wave; r0 < NTOK; r0 += G * 16) {
        f32x4 v[2][4]; float ss[2] = {0.f, 0.f};
#pragma unroll
        for (int u = 0; u < 2; ++u) { const int r = r0 + u * G * 8; if (r < NTOK) {
#pragma unroll
            for (int jj = 0; jj < 4; ++jj) v[u][jj] = *(const f32x4*)(X + (size_t)r * 1024 + jj * 256 + lane * 4); } }
#pragma unroll
        for (int u = 0; u < 2; ++u) {
            const int r = r0 + u * G * 8; if (r >= NTOK) continue;
#pragma unroll
            for (int jj = 0; jj < 4; ++jj) ss[u] += v[u][jj][0] * v[u][jj][0] + v[u][jj][1] * v[u][jj][1] + v[u][jj][2] * v[u][jj][2] + v[u][jj][3] * v[u][jj][3];
            const float rstd = rsqrtf(wave_sum(ss[u]) * (1.f / 1024.f) + 1e-6f);
            if (which == 2) {
#pragma unroll
                for (int jj = 0; jj < 4; ++jj) *(f32x4*)(P->out + (size_t)r * 1024 + jj * 256 + lane * 4) = v[u][jj] * rstd * gv[jj];
            } else {
                const int cnd = r < NPROMPT ? 0 : 1 + ((r - NPROMPT) >> 11);
                const float* mp = (const float*)(ws + OFF_MOD) + (size_t)(l * 5 + cnd) * 6144 + which * 3072;
                bf16_t* Hh = (bf16_t*)(ws + OFF_H) + (size_t)r * 1024;
#pragma unroll
                for (int jj = 0; jj < 4; ++jj) {
                    const f32x4 sh = *(const f32x4*)(mp + jj * 256 + lane * 4), sc = *(const f32x4*)(mp + 1024 + jj * 256 + lane * 4);
                    const f32x4 y = v[u][jj] * rstd * gv[jj] * (sc + 1.f) + sh;
                    u32x2 o; o.x = pk2(y[0], y[1]); o.y = pk2(y[2], y[3]);
                    *(u32x2*)(Hh + jj * 256 + lane * 4) = o;
                }
            }
        }
    }
}

__device__ __forceinline__ void acc8(float (&s)[8], const u32x4& v, float m) {
    s[0] += m * bflo(v.x); s[1] += m * bfhi(v.x); s[2] += m * bflo(v.y); s[3] += m * bfhi(v.y); s[4] += m * bflo(v.z); s[5] += m * bfhi(v.z); s[6] += m * bflo(v.w); s[7] += m * bfhi(v.w);
}
template <int W> __device__ __forceinline__ void pool_run(const bf16_t* UB, bf16_t* AM, int t0, int ch) {
    int s0, L; if (t0 < NPROMPT) { s0 = t0 & ~255; L = 256; } else { s0 = NPROMPT + ((t0 - NPROMPT) & ~2047); L = 2048; }
    const int tl0 = t0 - s0, base = tl0 - W / 2;
    u32x4 v[W + 7];
#pragma unroll
    for (int i = 0; i < W + 7; ++i) { int tt = base + i; tt = tt < 0 ? 0 : (tt >= L ? L - 1 : tt); v[i] = *(const u32x4*)(UB + (size_t)(s0 + tt) * 512 + ch); }
    float s[8];
#pragma unroll
    for (int e = 0; e < 8; ++e) s[e] = 0.f;
#pragma unroll
    for (int i = 0; i < W; ++i) { const int tt = base + i; acc8(s, v[i], (tt >= 0 && tt < L) ? 1.f : 0.f); }
#pragma unroll
    for (int r = 0; r < 8; ++r) {
        const int tl = tl0 + r;
        const int lo = max(tl - W / 2, 0), hi = min(tl + W - W / 2, L);
        const float ic = 1.f / (float)(hi - lo);
        const u32x4 c = v[r + W / 2];
        u32x4 o;
        o.x = pk2(s[0] * ic - bflo(c.x), s[1] * ic - bfhi(c.x)); o.y = pk2(s[2] * ic - bflo(c.y), s[3] * ic - bfhi(c.y));
        o.z = pk2(s[4] * ic - bflo(c.z), s[5] * ic - bfhi(c.z)); o.w = pk2(s[6] * ic - bflo(c.w), s[7] * ic - bfhi(c.w));
        *(u32x4*)(AM + (size_t)(t0 + r) * 1024 + 512 + ch) = o;
        if (r < 7) {
            const int tout = base + r, tin = base + r + W;
            acc8(s, v[r], (tout >= 0 && tout < L) ? -1.f : 0.f);
            acc8(s, v[r + W], (tin >= 0 && tin < L) ? 1.f : 0.f);
        }
    }
}
__device__ __forceinline__ void pool_phase(PP P) {
    unsigned char* ws = P->ws;
    const bf16_t* UB = (const bf16_t*)(ws + OFF_UB);
    bf16_t* AM = (bf16_t*)(ws + OFF_AMIX);
    const int tid = otid(), lane = tid & 63, wave = tid >> 6;
    for (int wi = obid() * 8 + wave; wi < 4 * (NTOK / 32); wi += gridDim.x * 8) {
        const int g = wi & 3, t0 = (wi >> 2) * 32 + (lane >> 4) * 8, ch = (g * 16 + (lane & 15)) * 8;
        if (g == 0) pool_run<2>(UB, AM, t0, ch);
        else if (g == 1) pool_run<4>(UB, AM, t0, ch);
        else if (g == 2) pool_run<8>(UB, AM, t0, ch);
        else pool_run<16>(UB, AM, t0, ch);
    }
}

__device__ __forceinline__ void mixprep_phase(PP P, int j) {
    const int tid = otid(), lane = tid & 63, wave = tid >> 6;
    unsigned char* ws = P->ws;
    const float* O0 = (const float*)(ws + OFF_ODIR); const float* O1 = O0 + (size_t)NTOK * 512;
    const bf16_t* GT = (const bf16_t*)(ws + OFF_GATE);
    bf16_t* AM = (bf16_t*)(ws + OFF_AMIX);
    const int ch = lane * 8;
    const f32x4 g0 = *(const f32x4*)(P->in[I_GLAG] + j * 128 + (ch & 127)), g1 = *(const f32x4*)(P->in[I_GLAG] + j * 128 + (ch & 127) + 4);
    const int G8 = gridDim.x * 8;
    for (int r0 = obid() * 8 + wave; r0 < NTOK; r0 += 2 * G8) {
        f32x4 a[2], b[2]; u32x4 gt[2];
#pragma unroll
        for (int u = 0; u < 2; ++u) { const int r = r0 + u * G8; if (r < NTOK) {
            a[u] = *(const f32x4*)(O0 + (size_t)r * 512 + ch) + *(const f32x4*)(O1 + (size_t)r * 512 + ch);
            b[u] = *(const f32x4*)(O0 + (size_t)r * 512 + ch + 4) + *(const f32x4*)(O1 + (size_t)r * 512 + ch + 4);
            gt[u] = *(const u32x4*)(GT + (size_t)r * 512 + ch); } }
#pragma unroll
        for (int u = 0; u < 2; ++u) {
            const int r = r0 + u * G8; if (r >= NTOK) continue;
            float ss = a[u][0] * a[u][0] + a[u][1] * a[u][1] + a[u][2] * a[u][2] + a[u][3] * a[u][3] + b[u][0] * b[u][0] + b[u][1] * b[u][1] + b[u][2] * b[u][2] + b[u][3] * b[u][3];
            ss += __shfl_xor(ss, 1); ss += __shfl_xor(ss, 2); ss += __shfl_xor(ss, 4); ss += __shfl_xor(ss, 8);
            const float rstd = rsqrtf(ss * (1.f / 128.f) + 1e-6f);
            const f32x4 aa = a[u] * rstd * g0, bb = b[u] * rstd * g1;
            u32x4 o;
            o.x = pk2(aa[0] * bflo(gt[u].x), aa[1] * bfhi(gt[u].x)); o.y = pk2(aa[2] * bflo(gt[u].y), aa[3] * bfhi(gt[u].y));
            o.z = pk2(bb[0] * bflo(gt[u].z), bb[1] * bfhi(gt[u].z)); o.w = pk2(bb[2] * bflo(gt[u].w), bb[3] * bfhi(gt[u].w));
            *(u32x4*)(AM + (size_t)r * 1024 + ch) = o;
        }
    }
}

__device__ __forceinline__ void conv_phase(PP P, int j, int vb, int nb) {
    unsigned char* ws = P->ws;
    const bf16_t* XI = (const bf16_t*)(ws + OFF_XIN); const bf16_t* BGp = (const bf16_t*)(ws + OFF_BG); const bf16_t* CGp = (const bf16_t*)(ws + OFF_CG);
    bf16_t* AM = (bf16_t*)(ws + OFF_AMIX);
    for (int idx = vb * 512 + otid(); idx < NTOK * 64; idx += nb * 512) {
        const int t = idx >> 6, ch = (idx & 63) * 8;
        int s0, L; if (t < NPROMPT) { s0 = t & ~255; L = 256; } else { s0 = NPROMPT + ((t - NPROMPT) & ~2047); L = 2048; }
        const int tl = t - s0;
        float cv[8];
        { const f32x4 b0 = *(const f32x4*)(P->in[I_CONVB] + j * 512 + ch), b1 = *(const f32x4*)(P->in[I_CONVB] + j * 512 + ch + 4);
          cv[0] = b0[0]; cv[1] = b0[1]; cv[2] = b0[2]; cv[3] = b0[3]; cv[4] = b1[0]; cv[5] = b1[1]; cv[6] = b1[2]; cv[7] = b1[3]; }
#pragma unroll
        for (int jj = 0; jj < 3; ++jj) {
            const int tt = tl + jj - 1;
            if (tt < 0 || tt >= L) continue;
            const u32x4 xv = *(const u32x4*)(XI + (size_t)(s0 + tt) * 512 + ch), cg = *(const u32x4*)(CGp + (size_t)(s0 + tt) * 512 + ch);
            const f32x4 w0 = *(const f32x4*)(P->in[I_CONVW] + (size_t)(j * 3 + jj) * 512 + ch), w1 = *(const f32x4*)(P->in[I_CONVW] + (size_t)(j * 3 + jj) * 512 + ch + 4);
            cv[0] += bflo(xv.x) * bflo(cg.x) * w0[0]; cv[1] += bfhi(xv.x) * bfhi(cg.x) * w0[1]; cv[2] += bflo(xv.y) * bflo(cg.y) * w0[2]; cv[3] += bfhi(xv.y) * bfhi(cg.y) * w0[3];
            cv[4] += bflo(xv.z) * bflo(cg.z) * w1[0]; cv[5] += bfhi(xv.z) * bfhi(cg.z) * w1[1]; cv[6] += bflo(xv.w) * bflo(cg.w) * w1[2]; cv[7] += bfhi(xv.w) * bfhi(cg.w) * w1[3];
        }
        const u32x4 bg = *(const u32x4*)(BGp + (size_t)t * 512 + ch);
        u32x4 o;
        o.x = pk2(cv[0] * bflo(bg.x), cv[1] * bfhi(bg.x)); o.y = pk2(cv[2] * bflo(bg.y), cv[3] * bfhi(bg.y));
        o.z = pk2(cv[4] * bflo(bg.z), cv[5] * bfhi(bg.z)); o.w = pk2(cv[6] * bflo(bg.w), cv[7] * bfhi(bg.w));
        *(u32x4*)(AM + (size_t)t * 1024 + 512 + ch) = o;
    }
}

__device__ __forceinline__ void convert_phase(PP P) {
    unsigned char* ws = P->ws;
    bf16_t* AM = (bf16_t*)(ws + OFF_AMIX);
    const bf16_t* F0 = (const bf16_t*)(ws + OFF_FACCS);
    for (int idx = obid() * 512 + otid(); idx < 8192 * 64; idx += gridDim.x * 512) {
        const int ts = idx >> 6, ch = (idx & 63) * 8;
        const bf16_t* F = F0 + (size_t)ts * 512 + ch;
        u32x4 p[4];
#pragma unroll
        for (int ks = 0; ks < 4; ++ks) p[ks] = *(const u32x4*)(F + (size_t)ks * 8192 * 512);
        u32x4 o;
        o.x = pk2((bflo(p[0].x) + bflo(p[1].x)) + (bflo(p[2].x) + bflo(p[3].x)), (bfhi(p[0].x) + bfhi(p[1].x)) + (bfhi(p[2].x) + bfhi(p[3].x)));
        o.y = pk2((bflo(p[0].y) + bflo(p[1].y)) + (bflo(p[2].y) + bflo(p[3].y)), (bfhi(p[0].y) + bfhi(p[1].y)) + (bfhi(p[2].y) + bfhi(p[3].y)));
        o.z = pk2((bflo(p[0].z) + bflo(p[1].z)) + (bflo(p[2].z) + bflo(p[3].z)), (bfhi(p[0].z) + bfhi(p[1].z)) + (bfhi(p[2].z) + bfhi(p[3].z)));
        o.w = pk2((bflo(p[0].w) + bflo(p[1].w)) + (bflo(p[2].w) + bflo(p[3].w)), (bfhi(p[0].w) + bfhi(p[1].w)) + (bfhi(p[2].w) + bfhi(p[3].w)));
        *(u32x4*)(AM + (size_t)(NPROMPT + ts) * 1024 + ch) = o;
    }
}

__device__ __forceinline__ int permd(int d) { return (d & 32) | ((d & 12) << 1) | ((d & 16) >> 2) | (d & 3); }
__device__ __forceinline__ bf16x8 pack8(const f32x4& a, const f32x4& b) {
    u32x4 o; o.x = pk2(a[0], a[1]); o.y = pk2(a[2], a[3]); o.z = pk2(b[0], b[1]); o.w = pk2(b[2], b[3]);
    return __builtin_bit_cast(bf16x8, o);
}
__device__ __forceinline__ void gla_item(PP P, LAS unsigned char* lds, int j, int seg, int head, int dir, bool full) {
    const int tid = otid(), lane = tid & 63, w = tid >> 6, r = lane & 15, q = lane >> 4;
    unsigned char* ws = P->ws;
    const bf16_t* QB = (const bf16_t*)(ws + OFF_QB); const bf16_t* KB = (const bf16_t*)(ws + OFF_KB); const bf16_t* VT = (const bf16_t*)(ws + OFF_VT);
    const float* LOGF = (const float*)(ws + OFF_LOGF);
    float* ODIR = (float*)(ws + OFF_ODIR);
    float* Ubuf = (float*)(ws + OFF_U); float* Dtot = (float*)(ws + OFF_DTOT);
    LAS bf16_t* QT = (LAS bf16_t*)(lds);
    LAS bf16_t* KT = (LAS bf16_t*)(lds + 36864);
    LAS bf16_t* KH = (LAS bf16_t*)(lds + 73728);
    LAS float* DL = (LAS float*)(lds + 114688);
    LAS bf16x8* ATT = (LAS bf16x8*)(lds + 116736);
    const int tok0 = seg * 256;
    __syncthreads();
    {
        const int d = tid & 63, c = w, pd = permd(d);
        float b = 0.f;
        const float* lf = LOGF + (size_t)(tok0 + 32 * c) * 512 + dir * 256 + head * 64 + d;
        const bf16_t* qp = QB + (size_t)(tok0 + 32 * c) * 256 + head * 64 + d;
        const bf16_t* kp = KB + (size_t)(tok0 + 32 * c) * 256 + head * 64 + d;
        float lfv[32]; bf16_t qv16[32], kv16[32];
#pragma unroll
        for (int ii = 0; ii < 32; ++ii) { const int il = dir ? 31 - ii : ii; lfv[ii] = lf[(size_t)il * 512]; qv16[ii] = qp[(size_t)il * 256]; kv16[ii] = kp[(size_t)il * 256]; }
#pragma unroll
        for (int ii = 0; ii < 32; ++ii) {
            const int il = dir ? 31 - ii : ii;
            b += lfv[ii];
            const float qv = bf2f(qv16[ii]), kv = bf2f(kv16[ii]);
            QT[(32 * c + il) * 72 + pd] = f2bf(qv * __expf(b));
            KT[(32 * c + il) * 72 + pd] = f2bf(kv * __expf(-b));
        }
        const float eT = __expf(b);
        DL[c * 64 + d] = eT;
#pragma unroll 8
        for (int il = 0; il < 32; ++il) KH[(c * 64 + d) * 40 + permd(il)] = f2bf(bf2f(KT[(32 * c + il) * 72 + pd]) * eT);
    }
    __syncthreads();
    if (full) {
        const int c = w;
        f32x4 at[2][2];
#pragma unroll
        for (int a = 0; a < 2; ++a)
#pragma unroll
            for (int b = 0; b < 2; ++b) at[a][b] = (f32x4){0.f, 0.f, 0.f, 0.f};
#pragma unroll
        for (int kk = 0; kk < 2; ++kk) {
            bf16x8 ka[2], qb[2];
#pragma unroll
            for (int t = 0; t < 2; ++t) { ka[t] = *(const LAS bf16x8*)(KT + (32 * c + 16 * t + r) * 72 + 32 * kk + 8 * q); qb[t] = *(const LAS bf16x8*)(QT + (32 * c + 16 * t + r) * 72 + 32 * kk + 8 * q); }
#pragma unroll
            for (int tj = 0; tj < 2; ++tj)
#pragma unroll
                for (int ti = 0; ti < 2; ++ti) at[tj][ti] = __builtin_amdgcn_mfma_f32_16x16x32_bf16(ka[tj], qb[ti], at[tj][ti], 0, 0, 0);
        }
#pragma unroll
        for (int ti = 0; ti < 2; ++ti) {
            const int i = 16 * ti + r;
#pragma unroll
            for (int tj = 0; tj < 2; ++tj)
#pragma unroll
                for (int jj = 0; jj < 4; ++jj) { const int jx = 16 * tj + 4 * q + jj; const bool keep = dir ? (jx >= i) : (jx <= i); if (!keep) at[tj][ti][jj] = 0.f; }
            ATT[(c * 2 + ti) * 64 + lane] = pack8(at[0][ti], at[1][ti]);
        }
    }
    __syncthreads();
    f32x4 S[4];
#pragma unroll
    for (int t = 0; t < 4; ++t) S[t] = (f32x4){0.f, 0.f, 0.f, 0.f};
    const int e = 16 * w + r;
    if (DBG_SINIT && full && seg >= 16) {
        const int sb = (seg - 16) >> 3, part = (seg - 16) & 7;
        const float* s0 = P->in[I_STATE] + ((size_t)(((sb * 2 + j) * 2 + dir) * 4 + head) * 64) * 128;
#pragma unroll
        for (int t = 0; t < 4; ++t)
#pragma unroll
            for (int jj = 0; jj < 4; ++jj) S[t][jj] = s0[(size_t)(16 * t + 4 * q + jj) * 128 + e];
        const int np = dir ? 7 - part : part;
#pragma unroll
        for (int xb = 0; xb < 8; xb += 4) {
            if (xb >= np) break;
            float dvv[4][16], uvv[4][16];
#pragma unroll
            for (int xi = 0; xi < 4; ++xi) {
                const int x = xb + xi; if (x >= 7) continue;
                const int pp = dir ? 7 - x : x;
                const size_t ib = (size_t)(((sb * 8 + pp) * 4 + head) * 2 + dir) * 64;
#pragma unroll
                for (int t = 0; t < 4; ++t)
#pragma unroll
                    for (int jj = 0; jj < 4; ++jj) { const int d = 16 * t + 4 * q + jj; dvv[xi][t * 4 + jj] = Dtot[ib + d]; uvv[xi][t * 4 + jj] = Ubuf[(ib + d) * 128 + e]; }
            }
#pragma unroll
            for (int xi = 0; xi < 4; ++xi) {
                const int x = xb + xi; if (x >= 7) continue;
                const bool on = x < np;
#pragma unroll
                for (int t = 0; t < 4; ++t)
#pragma unroll
                    for (int jj = 0; jj < 4; ++jj) S[t][jj] = on ? S[t][jj] * dvv[xi][t * 4 + jj] + uvv[xi][t * 4 + jj] : S[t][jj];
            }
        }
    }
    const bf16_t* vt = VT + (size_t)(head * 128 + e) * NTOK + tok0;
    u32x2 vpre0[8], vpre1[8];
#pragma unroll
    for (int cc = 0; cc < 8; ++cc) { const int c = dir ? 7 - cc : cc; vpre0[cc] = *(const u32x2*)(vt + 32 * c + 4 * q); vpre1[cc] = *(const u32x2*)(vt + 32 * c + 16 + 4 * q); }
#pragma unroll
    for (int cc = 0; cc < 8; ++cc) {
        const int c = dir ? 7 - cc : cc;
        const u32x2 v0 = vpre0[cc], v1 = vpre1[cc];
        u32x4 vv; vv.x = v0.x; vv.y = v0.y; vv.z = v1.x; vv.w = v1.y;
        const bf16x8 vb = __builtin_bit_cast(bf16x8, vv);
        if (full) {
            bf16x8 sb2[2];
            sb2[0] = pack8(S[0], S[1]); sb2[1] = pack8(S[2], S[3]);
#pragma unroll
            for (int mi = 0; mi < 2; ++mi) {
                f32x4 o = (f32x4){0.f, 0.f, 0.f, 0.f};
#pragma unroll
                for (int kk = 0; kk < 2; ++kk) {
                    const bf16x8 qa = *(const LAS bf16x8*)(QT + (32 * c + 16 * mi + r) * 72 + 32 * kk + 8 * q);
                    o = __builtin_amdgcn_mfma_f32_16x16x32_bf16(qa, sb2[kk], o, 0, 0, 0);
                }
                const bf16x8 aa = ATT[(c * 2 + mi) * 64 + lane];
                o = __builtin_amdgcn_mfma_f32_16x16x32_bf16(aa, vb, o, 0, 0, 0);
                float* op = ODIR + ((size_t)dir * NTOK + tok0 + 32 * c + 16 * mi + 4 * q) * 512 + head * 128 + e;
#pragma unroll
                for (int jj = 0; jj < 4; ++jj) op[(size_t)jj * 512] = o[jj];
            }
        }
#pragma unroll
        for (int t = 0; t < 4; ++t) {
            const f32x4 dv = *(const LAS f32x4*)(DL + c * 64 + 16 * t + 4 * q);
            S[t] = S[t] * dv;
            const bf16x8 ka = *(const LAS bf16x8*)(KH + (c * 64 + 16 * t + r) * 40 + 8 * q);
            S[t] = __builtin_amdgcn_mfma_f32_16x16x32_bf16(ka, vb, S[t], 0, 0, 0);
        }
    }
    if (full) {
        if (seg < 16) {
            float* so = P->out + OUT_STATE + ((size_t)(((seg * 2 + j) * 2 + dir) * 4 + head) * 64) * 128;
#pragma unroll
            for (int t = 0; t < 4; ++t)
#pragma unroll
                for (int jj = 0; jj < 4; ++jj) so[(size_t)(16 * t + 4 * q + jj) * 128 + e] = S[t][jj];
        }
    } else {
        const size_t ib = (size_t)(((seg - 16) * 4 + head) * 2 + dir) * 64;
#pragma unroll
        for (int t = 0; t < 4; ++t)
#pragma unroll
            for (int jj = 0; jj < 4; ++jj) Ubuf[(ib + 16 * t + 4 * q + jj) * 128 + e] = S[t][jj];
        if (tid < 64) { float p = 1.f;
#pragma unroll
            for (int c = 0; c < 8; ++c) p *= DL[c * 64 + tid];
            Dtot[ib + tid] = p; }
    }
}

__device__ __forceinline__ void gla_phase(PP P, LAS unsigned char* lds, int j, int sub) {
    const int G = gridDim.x;
    if (sub == 0) {
        for (int it = obid(); it < 384; it += G) {
            if (it >= 128 && it < 256) { const int pi = it - 128; gla_item(P, lds, j, pi >> 3, (pi >> 1) & 3, pi & 1, true); }
            else { const int li = it < 128 ? it : it - 128; gla_item(P, lds, j, 16 + (li >> 3), (li >> 1) & 3, li & 1, false); }
        }
    } else {
        for (int it = obid(); it < 256; it += G) gla_item(P, lds, j, 16 + (it >> 3), (it >> 1) & 3, it & 1, true);
    }
}


#define XB_TMO      128
#define XB_XCNT(j)  (256  + 64 * (j))
#define XB_XSUB(j)  (1280 + 64 * (j))
#define XB_XGEN(j)  (2304 + 64 * (j))
#define XB_TOP      3328
#define XB_TOPGEN   3392
#define XCD_BAR_WORDS 3456
#define XB_SPIN_CAP (1u << 18)

__device__ __forceinline__ unsigned xb_ld(unsigned* p)              { return __hip_atomic_load(p, __ATOMIC_RELAXED, __HIP_MEMORY_SCOPE_AGENT); }
__device__ __forceinline__ unsigned xb_add(unsigned* p, unsigned v) { return __hip_atomic_fetch_add(p, v, __ATOMIC_RELAXED, __HIP_MEMORY_SCOPE_AGENT); }
__device__ __forceinline__ unsigned xb_xcc_id() { return (unsigned)__builtin_amdgcn_s_getreg((3 << 11) | 20) & 0xFu; }
#define XB_SPIN(cond, bar) do { unsigned _sp = 0; while (cond) { __builtin_amdgcn_s_sleep(1); \
    if ((++_sp & 255u) == 0u) { if (xb_ld(&(bar)[XB_TMO])) break; if (_sp > XB_SPIN_CAP) { atomicAdd(&(bar)[XB_TMO], 1u); break; } } } } while (0)

struct XcdBarrier {
    unsigned* bar; unsigned x;
    volatile LAS unsigned* st;
};

__device__ __forceinline__ XcdBarrier xcd_barrier_post(unsigned* bar, volatile LAS unsigned* st) {
    XcdBarrier b; b.bar = bar; b.x = xb_xcc_id(); b.st = st;
    if (threadIdx.x == 0) (void)xb_add(&bar[XB_XCNT(b.x)], 1u);
    return b;
}
__device__ __forceinline__ void xcd_barrier_complete(unsigned* bar, unsigned x, unsigned& nloc, unsigned& nx) {
    const unsigned G = gridDim.x * gridDim.y * gridDim.z;
    unsigned sum, cnt, mine, sp = 0u;
    for (;;) {
        sum = 0u; cnt = 0u; mine = 0u;
#pragma unroll
        for (unsigned j = 0; j < 16; ++j) { const unsigned c = xb_ld(&bar[XB_XCNT(j)]); sum += c; cnt += (c > 0u) ? 1u : 0u; mine = (j == x) ? c : mine; }
        if (sum == G) break;
        __builtin_amdgcn_s_sleep(1);
        if ((++sp & 255u) == 0u) { if (xb_ld(&bar[XB_TMO])) break; if (sp > XB_SPIN_CAP) { atomicAdd(&bar[XB_TMO], 1u); break; } }
    }
    nloc = mine > 0u ? mine : 1u; nx = cnt > 0u ? cnt : 1u;
}

__device__ __forceinline__ void xcd_barrier(const XcdBarrier& b) {
    asm volatile("s_waitcnt vmcnt(0)" ::: "memory");
    __syncthreads();
    if (threadIdx.x == 0) {
        unsigned* bar = b.bar;
        __builtin_amdgcn_s_waitcnt(0);
        unsigned nloc = b.st[0], nx = b.st[1];
        if (nloc == 0u) { xcd_barrier_complete(bar, b.x, nloc, nx); b.st[0] = nloc; b.st[1] = nx; }
        const unsigned old = xb_add(&bar[XB_XSUB(b.x)], 1u);
        const unsigned gen = old / nloc;
        if (old + 1u == (gen + 1u) * nloc) {
            __builtin_amdgcn_fence(__ATOMIC_RELEASE, "agent");
            asm volatile("s_waitcnt vmcnt(0)" ::: "memory");
            const unsigned og = xb_add(&bar[XB_TOP], 1u);
            const unsigned tg = og / nx;
            if (og + 1u == (tg + 1u) * nx) xb_add(&bar[XB_TOPGEN], 1u);
            else XB_SPIN(xb_ld(&bar[XB_TOPGEN]) == tg, bar);
            __builtin_amdgcn_fence(__ATOMIC_ACQUIRE, "agent");
            xb_add(&bar[XB_XGEN(b.x)], 1u);
            asm volatile("s_waitcnt vmcnt(0)" ::: "memory");
        } else {
            XB_SPIN(xb_ld(&bar[XB_XGEN(b.x)]) == gen, bar);
            __builtin_amdgcn_fence(__ATOMIC_ACQUIRE, "agent");
            asm volatile("s_waitcnt vmcnt(0)" ::: "memory");
        }
    }
    __syncthreads();
}

enum { PT_PREP = 0, PT_NORM1, PT_GEMM_IN, PT_MIX_A, PT_MIX_B, PT_MIXPREP, PT_GEMM_OUT, PT_NORM2, PT_MLP1, PT_MLP2, PT_FINAL };

__global__ void __launch_bounds__(512, 2) mega_fwd(Params Pk) {
    extern __shared__ __attribute__((aligned(16))) unsigned char smem[];
    LAS unsigned char* lds = (LAS unsigned char*)smem;
#ifdef DBG_ZLDS
    for (int i = otid(); i < LDS_BYTES / 16; i += 512) ((LAS u32x4*)lds)[i] = (u32x4){0u, 0u, 0u, 0u};
    __syncthreads();
#endif
    { volatile LAS unsigned* st0 = (volatile LAS unsigned*)(lds + LDS_BYTES - 64); if (otid() < 2) st0[otid()] = 0u; }
    __syncthreads();
    XcdBarrier gbar; gbar.bar = (unsigned*)(Pk.ws + OFF_BAR); gbar.x = 0; gbar.st = (volatile LAS unsigned*)(lds + LDS_BYTES - 64);
    if (Pk.ph_hi - Pk.ph_lo > 1) gbar = xcd_barrier_post((unsigned*)(Pk.ws + OFF_BAR), (volatile LAS unsigned*)(lds + LDS_BYTES - 64));
    if (Pk.ph_hi < 0) cg::this_grid().sync();
    for (int ph = Pk.ph_lo; ph < Pk.ph_hi; ++ph) {
        PP P = (PP)__builtin_amdgcn_kernarg_segment_ptr();
        asm volatile("" : "+s"(P));
        int pt, l = 0;
        if (ph == 0) pt = PT_PREP;
        else if (ph == NPH - 1) pt = PT_FINAL;
        else {
            const int qq = ph - 1; int s;
            if (qq < 9) { l = 0; s = qq; } else if (qq < 17) { l = 1; s = qq - 9; } else if (qq < 26) { l = 2; s = qq - 17; } else { l = 3; s = qq - 26; }
            pt = (l & 1) ? (s < 4 ? s + 1 : s + 2) : s + 1;
        }
        const int j = l >> 1, odd = l & 1;
        const int nrep = (pt == REP_PT && (REP_L < 0 || l == REP_L)) ? 1 + REP_N : 1;
        for (int rep = 0; rep < nrep; ++rep) {
        int ngemm = 0; GemmCfg g; g.G = gridDim.x; g.c = obid(); g.j = j; g.l = l; g.nM = 48; g.ld = 1024; g.nt = 16; g.type = 0; g.nN = 0;
        switch (pt) {
        case PT_PREP: if (EN & 1) prep_phase(P, lds); break;
        case PT_NORM1: if (EN & 2) norm_phase(P, l, 0); break;
        case PT_GEMM_IN: ngemm = 1; g.type = odd ? T_IN_ODD : T_IN_EVEN; g.nN = 10; break;
        case PT_MIX_A: if (odd) { ngemm = 2; g.type = T_DFT_S; g.nM = 8; g.nN = 32; g.ld = 4096; g.nt = 16; } else { if (EN & 4) gla_phase(P, lds, j, 0); if (EN & 8) pool_phase(P); } break;
        case PT_MIX_B: if (odd) { if (EN & 8) convert_phase(P); } else { if (EN & 4) gla_phase(P, lds, j, 1); } break;
        case PT_MIXPREP: if (EN & 8) mixprep_phase(P, j); break;
        case PT_GEMM_OUT: ngemm = 1; g.type = odd ? T_OUT_ODD : T_OUT_EVEN; g.nN = 4; break;
        case PT_NORM2: if (EN & 2) norm_phase(P, l, 1); break;
        case PT_MLP1: ngemm = 1; g.type = T_MLP1; g.nN = 16; break;
        case PT_MLP2: ngemm = 1; g.type = T_MLP2; g.nN = 4; g.ld = 4096; g.nt = 64; break;
        default: if (EN & 2) norm_phase(P, 0, 2); break;
        }
        for (int gi = 0; gi < ngemm; ++gi) {
            if (gi == 1) { g.type = T_DFT_P; g.nM = 1; g.nN = 32; g.ld = 512; g.nt = 8; g.c = (obid() + gridDim.x - 32) % gridDim.x; }
            if (EN & 16) gemm_phase(lds, g);
        }
        if (pt == PT_MIX_A && odd && (EN & 8)) {
            const int G3 = gridDim.x, b3 = obid();
            if (G3 > 64) { if (b3 < 32) conv_phase(P, j, b3, G3 - 32); else if (b3 >= 64) conv_phase(P, j, b3 - 32, G3 - 32); }
            else conv_phase(P, j, b3, G3);
        }
        if (DEFER && pt == PT_MLP2 && l < 3) {
            const int G2 = gridDim.x, bq = obid(); const bool idle = G2 > 192; const int vb2 = idle ? bq - 192 : bq, nb2 = idle ? G2 - 192 : G2;
            if (!idle || bq >= 192) {
                if (DEFER == 1) { convert_layer(P, lds, l + 1, vb2, nb2, 7); gemv_mod(P, lds, l + 1, vb2, nb2); if (l == 0) tgen_part(P, vb2, nb2); }
                else { convert_layer(P, lds, l + 1, vb2, nb2, 1); if (l == 0) tgen_part(P, vb2, nb2); }
            }
        }
        if (ph + 1 < Pk.ph_hi || rep + 1 < nrep) xcd_barrier(gbar);
        }

    }
}


#ifdef DBG_K
__device__ __forceinline__ float dgst(unsigned u) { return (float)(u & 0xffffu) + (float)(u >> 16); }
__global__ void dbg_dump(float* out, const unsigned char* ws) {
    const unsigned* Xu = (const unsigned*)(ws + OFF_X); const unsigned* Hu = (const unsigned*)(ws + OFF_H); const unsigned* Au = (const unsigned*)(ws + OFF_AMIX);
    const unsigned* Bu = (const unsigned*)(ws + OFF_BIG); const unsigned* Uu = (const unsigned*)(ws + OFF_U); const unsigned* Wu = (const unsigned*)(ws);
    for (size_t i = (size_t)blockIdx.x * blockDim.x + threadIdx.x; i < (size_t)NTOK * 1024; i += (size_t)gridDim.x * blockDim.x) {
        float v = 0.f;
        if (DBG_SEL & 1) v += dgst(Xu[i]);
        if (DBG_SEL & 2) v += dgst(Hu[i % 6291456]);
        if (DBG_SEL & 4) v += dgst(Au[i % 6291456]);
        if (DBG_SEL & 8) v += dgst(Bu[i]) + dgst(Bu[i + 12582912]) + dgst(Bu[(i + 25165824) % 34603008]);
        if (DBG_SEL & 16) v += dgst(Uu[i % 2113536]);
        if (DBG_SEL & 32) v += dgst(Wu[i]) + dgst(Wu[i + 12582912]) + dgst(Wu[(i + 25165824) % 28573696]);
        out[i] = v;
    }
}
#endif
extern "C" void kernel_launch(void* const* d_in, const int* in_sizes, int n_in, void* d_out, int out_size, void* d_ws, size_t ws_size, hipStream_t stream) {
    static int grid = 0;
    if (grid == 0) {
        if (n_in != 22 || ws_size < WS_NEED) { fprintf(stderr, "kernel_launch: unexpected n_in %d / ws_size %zu (need %zu)\n", n_in, ws_size, (size_t)WS_NEED); grid = -1; return; }
        int dev = 0, cus = 0, per_cu = 0;
        hipGetDevice(&dev);
        hipDeviceGetAttribute(&cus, hipDeviceAttributeMultiprocessorCount, dev);
        if (hipFuncSetAttribute((const void*)mega_fwd, hipFuncAttributeMaxDynamicSharedMemorySize, LDS_BYTES) != hipSuccess) { fprintf(stderr, "kernel_launch: hipFuncSetAttribute failed\n"); grid = -1; return; }
        hipOccupancyMaxActiveBlocksPerMultiprocessor(&per_cu, (const void*)mega_fwd, 512, LDS_BYTES);
        if (per_cu < 1) { fprintf(stderr, "kernel_launch: occupancy query says %d blocks/CU\n", per_cu); per_cu = 1; }
        (void)hipGetLastError();
        grid = cus;
    }
    if (grid < 0) return;
    Params p{};
    for (int i = 0; i < 22; ++i) p.in[i] = (const float*)d_in[i];
    p.out = (float*)d_out; p.ws = (unsigned char*)d_ws;
#if MULTI_LAUNCH
#ifdef DBG_K
    for (int ph = 0; ph < DBG_K; ++ph) {
        p.ph_lo = ph; p.ph_hi = ph + 1;
        hipLaunchKernelGGL(mega_fwd, dim3(grid), dim3(512), LDS_BYTES, stream, p);
    }
    hipLaunchKernelGGL(dbg_dump, dim3(2048), dim3(256), 0, stream, (float*)d_out, (const unsigned char*)d_ws);
#else
    for (int ph = 0; ph < NPH; ++ph) {
        p.ph_lo = ph; p.ph_hi = ph + 1;
        hipLaunchKernelGGL(mega_fwd, dim3(grid), dim3(512), LDS_BYTES, stream, p);
    }
#endif
#else
    p.ph_lo = 0; p.ph_hi = NPH;
    if (hipMemsetAsync((char*)d_ws + OFF_BAR, 0, 16384, stream) != hipSuccess) { fprintf(stderr, "kernel_launch: memset of barrier word failed\n"); return; }
    void* args[] = {&p};
    hipError_t e = hipLaunchCooperativeKernel((const void*)mega_fwd, dim3(grid), dim3(512), args, LDS_BYTES, stream);
    if (e != hipSuccess) fprintf(stderr, "cooperative launch failed: %s (grid %d)\n", hipGetErrorString(e), grid);
#endif
}
```

```cpp
#include <hip/hip_runtime.h>
#include <hip/hip_cooperative_groups.h>
#include <cstdio>
#include <cstdint>
namespace cg = cooperative_groups;

#ifndef DBG_SEL
#define DBG_SEL 63
#endif
#ifndef DBG_NP
#define DBG_NP(x) (x)
#endif
#ifndef DEFER
#define DEFER 1
#endif
#ifndef REP_PT
#define REP_PT -1
#endif
#ifndef REP_L
#define REP_L -1
#endif
#ifndef REP_N
#define REP_N 1
#endif
#ifndef XSYNC
#define XSYNC 0
#endif
#ifndef DBG_SINIT
#define DBG_SINIT 1
#endif
#ifndef EN
#define EN 31
#endif
#ifndef MULTI_LAUNCH
#define MULTI_LAUNCH 0
#endif

#define LAS __attribute__((address_space(3)))
typedef unsigned short bf16_t;
typedef short bf16x8 __attribute__((ext_vector_type(8)));
typedef float f32x4 __attribute__((ext_vector_type(4)));
typedef unsigned u32x2 __attribute__((ext_vector_type(2)));
typedef unsigned u32x4 __attribute__((ext_vector_type(4)));

constexpr int DM = 1024, NTOK = 12288, NPROMPT = 4096, DFF = 4096;
constexpr int LDS_BYTES = 147456;
constexpr int NPH = 36;
constexpr size_t MBy = 1048576;
constexpr size_t OFF_W1T = 0, OFF_W2T = 32 * MBy, OFF_WIE = 64 * MBy, OFF_WOE = 74 * MBy, OFF_WIO = 78 * MBy, OFF_WOO = 88 * MBy;
constexpr size_t OFF_T2K = 92 * MBy, OFF_T256 = 108 * MBy, OFF_MOD = 108 * MBy + 262144, OFF_U = 109 * MBy, OFF_DTOT = 117 * MBy;
constexpr size_t OFF_X = 118 * MBy, OFF_H = 166 * MBy, OFF_AMIX = 190 * MBy, OFF_BIG = 214 * MBy, WS_NEED = 348 * MBy;
constexpr size_t OFF_HID = OFF_BIG;
constexpr size_t OFF_QB = OFF_BIG, OFF_KB = OFF_BIG + 6 * MBy, OFF_VT = OFF_BIG + 12 * MBy, OFF_GATE = OFF_BIG + 24 * MBy, OFF_LOGF = OFF_BIG + 36 * MBy;
constexpr size_t OFF_UB = OFF_BIG + 60 * MBy, OFF_ODIR = OFF_BIG + 72 * MBy;
constexpr size_t OFF_XTS = OFF_BIG, OFF_XTP = OFF_BIG + 16 * MBy, OFF_XIN = OFF_BIG + 24 * MBy, OFF_BG = OFF_BIG + 36 * MBy, OFF_CG = OFF_BIG + 48 * MBy;
constexpr size_t OFF_FACCP = OFF_BIG + 60 * MBy, OFF_FACCS = OFF_BIG + 68 * MBy;
constexpr size_t OFF_BAR = 117 * MBy + 524288;
constexpr size_t OUT_STATE = (size_t)NTOK * DM;

struct Params { const float* in[22]; float* out; unsigned char* ws; int ph_lo, ph_hi; };
typedef const __attribute__((address_space(4))) Params* PP;
enum { I_XP = 0, I_XS, I_STATE, I_C, I_CCTX, I_NORMG, I_FINALG, I_WADA, I_BADA, I_W1, I_W2, I_WINE, I_WA2, I_BA2, I_GLAG, I_POOLW, I_POOLS, I_WOUTE, I_WINO, I_CONVW, I_CONVB, I_WOUTO };

__device__ __forceinline__ int otid() { int t = __builtin_amdgcn_workitem_id_x(); asm volatile("" : "+v"(t)); return t; }
__device__ __forceinline__ int obid() { int b = __builtin_amdgcn_workgroup_id_x(); asm volatile("" : "+s"(b)); return b; }
typedef float f32x2 __attribute__((ext_vector_type(2)));
typedef __bf16 bf16x2v __attribute__((ext_vector_type(2)));
__device__ __forceinline__ unsigned pk2(float lo, float hi) { f32x2 v = {lo, hi}; bf16x2v b = __builtin_convertvector(v, bf16x2v); return __builtin_bit_cast(unsigned, b); }
__device__ __forceinline__ bf16_t f2bf(float x) { return (bf16_t)(pk2(x, 0.f) & 0xffffu); }
__device__ __forceinline__ float bf2f(bf16_t u) { return __uint_as_float(((unsigned)u) << 16); }
__device__ __forceinline__ float bflo(unsigned u) { return __uint_as_float(u << 16); }
__device__ __forceinline__ float bfhi(unsigned u) { return __uint_as_float(u & 0xffff0000u); }
__device__ __forceinline__ float wave_sum(float v) {
#pragma unroll
    for (int o = 1; o < 64; o <<= 1) v += __shfl_xor(v, o);
    return v;
}
__device__ __forceinline__ float siluf(float x) { return x * __builtin_amdgcn_rcpf(1.f + __expf(-x)); }
__device__ __forceinline__ float logsigmoidf(float x) { return fminf(x, 0.f) - __logf(1.f + __expf(-fabsf(x))); }
__device__ __forceinline__ int cond_of_seg(int pm) { return pm < 16 ? 0 : 1 + ((pm - 16) >> 3); }

namespace pg8 {
constexpr int BM = 256, BK = 64, HALF = 128, HTB = HALF * BK * 2, STAGE_BYTES = 8 * HTB, NXCD = 8, WGM = 8;
__host__ __device__ __forceinline__ int lds_byte(int r, int c) { const int st = (r >> 4) * 2 + (c >> 5), rr = r & 15, cc = c & 31, ob = rr * 64 + cc * 2; return st * 1024 + (ob ^ (((ob >> 9) & 1) << 5)); }
__host__ __device__ __forceinline__ int perm32(int rho) { const int n = rho >> 4, i = rho & 15; return 8 * (i >> 2) + 4 * n + (i & 3); }
__host__ __device__ __forceinline__ void stage_rc(int b, int& R, int& C) { const int st = b / 1024, sb = b % 1024, swz = sb ^ (((sb >> 9) & 1) << 5); R = (st >> 1) * 16 + swz / 64; C = (st & 1) * 32 + (swz % 64) / 2; }
}

enum { KD_BF16 = 0, KD_SILU, KD_RELU2, KD_LOGF, KD_RES, KD_ATOM };
enum { T_IN_EVEN = 0, T_IN_ODD, T_OUT_EVEN, T_OUT_ODD, T_MLP1, T_MLP2, T_DFT_S, T_DFT_P };
struct Unit { int pm, pn; };
struct UnitIO { const char* A; const char* B; char* out; const float* aux; int kind; int ld; };
struct GemmCfg { int type, j, l, nM, nN, ld, nt, G, c; };

__device__ __forceinline__ void make_unit(const GemmCfg& g, int pm, int pn, UnitIO& u) {
    PP Pq = (PP)__builtin_amdgcn_kernarg_segment_ptr();
    unsigned char* ws = Pq->ws;
    const size_t rowA = (size_t)pm * 256 * 1024 * 2;
    u.aux = nullptr; u.kind = KD_BF16; u.ld = 512;
    const float* modp = (const float*)(ws + OFF_MOD) + (size_t)(g.l * 5 + cond_of_seg(pm)) * 6144;
    switch (g.type) {
    case T_IN_EVEN: {
        const char* W = (const char*)(ws + OFF_WIE) + (size_t)g.j * 2560 * 1024 * 2 + (size_t)pn * 256 * 1024 * 2;
        const char* Hh = (const char*)(ws + OFF_H) + rowA;
        u.A = Hh; u.B = W;
        if (pn == 0) { u.out = (char*)(ws + OFF_QB) + (size_t)pm * 256 * 256 * 2; u.ld = 256; }
        else if (pn == 1) { u.out = (char*)(ws + OFF_KB) + (size_t)pm * 256 * 256 * 2; u.ld = 256; }
        else if (pn < 4) { u.A = W; u.B = Hh; u.out = (char*)(ws + OFF_VT) + ((size_t)(pn - 2) * 256 * NTOK + (size_t)pm * 256) * 2; u.ld = NTOK; }
        else if (pn < 6) { u.out = (char*)(ws + OFF_GATE) + ((size_t)pm * 256 * 512 + (pn - 4) * 256) * 2; u.kind = KD_SILU; }
        else if (pn < 8) { u.out = (char*)(ws + OFF_LOGF) + ((size_t)pm * 256 * 512 + (pn - 6) * 256) * 4; u.kind = KD_LOGF; u.aux = Pq->in[I_BA2] + g.j * 512 + (pn - 6) * 256; }
        else { u.out = (char*)(ws + OFF_UB) + ((size_t)pm * 256 * 512 + (pn - 8) * 256) * 2; }
    } break;
    case T_IN_ODD: {
        const char* W = (const char*)(ws + OFF_WIO) + (size_t)g.j * 2560 * 1024 * 2 + (size_t)pn * 256 * 1024 * 2;
        const char* Hh = (const char*)(ws + OFF_H) + rowA;
        u.A = Hh; u.B = W;
        if (pn < 4) {
            u.A = W; u.B = Hh;
            const int z = pn >> 1, ch0 = (pn & 1) * 256;
            if (pm < 16) { u.out = (char*)(ws + OFF_XTP) + ((size_t)(pm * 512 + ch0) * 512 + z * 256) * 2; u.ld = 512; }
            else { const int b = (pm - 16) >> 3, part = (pm - 16) & 7; u.out = (char*)(ws + OFF_XTS) + ((size_t)(b * 512 + ch0) * 4096 + z * 2048 + part * 256) * 2; u.ld = 4096; }
        } else {
            const size_t base = (pn < 6) ? OFF_XIN : (pn < 8 ? OFF_BG : OFF_CG);
            u.out = (char*)(ws + base) + ((size_t)pm * 256 * 512 + (pn & 1) * 256) * 2;
        }
    } break;
    case T_OUT_EVEN: case T_OUT_ODD: {
        u.A = (const char*)(ws + OFF_AMIX) + rowA;
        u.B = (const char*)(ws + (g.type == T_OUT_EVEN ? OFF_WOE : OFF_WOO)) + (size_t)g.j * 1024 * 1024 * 2 + (size_t)pn * 256 * 1024 * 2;
        u.out = (char*)(ws + OFF_X) + ((size_t)pm * 256 * 1024 + pn * 256) * 2; u.ld = 1024; u.kind = KD_RES; u.aux = modp + 2048 + pn * 256;
    } break;
    case T_MLP1: {
        u.A = (const char*)(ws + OFF_H) + rowA;
        u.B = (const char*)(ws + OFF_W1T) + (size_t)g.l * 4096 * 1024 * 2 + (size_t)pn * 256 * 1024 * 2;
        u.out = (char*)(ws + OFF_HID) + ((size_t)pm * 256 * 4096 + pn * 256) * 2; u.ld = 4096; u.kind = KD_RELU2;
    } break;
    case T_MLP2: {
        u.A = (const char*)(ws + OFF_HID) + (size_t)pm * 256 * 4096 * 2;
        u.B = (const char*)(ws + OFF_W2T) + (size_t)g.l * 4096 * 1024 * 2 + (size_t)pn * 256 * 4096 * 2;
        u.out = (char*)(ws + OFF_X) + ((size_t)pm * 256 * 1024 + pn * 256) * 2; u.ld = 1024; u.kind = KD_RES; u.aux = modp + 5120 + pn * 256;
    } break;
    case T_DFT_S: {
        const int pnb = pn >> 2, ks = pn & 3;
        u.A = (const char*)(ws + OFF_T2K) + ((size_t)pm * 256 * 4096 + ks * 1024) * 2;
        u.B = (const char*)(ws + OFF_XTS) + ((size_t)pnb * 256 * 4096 + ks * 1024) * 2;
        u.out = (char*)(ws + OFF_FACCS) + ((size_t)ks * 8192 * 512 + (size_t)((pnb >> 1) * 2048 + pm * 256) * 512 + (pnb & 1) * 256) * 2; u.kind = KD_BF16;
    } break;
    default: {
        u.A = (const char*)(ws + OFF_T256);
        u.B = (const char*)(ws + OFF_XTP) + (size_t)pn * 256 * 512 * 2;
        u.out = (char*)(ws + OFF_AMIX) + ((size_t)((pn >> 1) * 256) * 1024 + (pn & 1) * 256) * 2; u.ld = 1024; u.kind = KD_BF16;
    } break;
    }
}

__device__ __forceinline__ bool next_unit(const GemmCfg& g, int i, Unit& u) {
    const int nwg = g.nM * g.nN;
    const long L = (long)i * g.G + g.c; if (L >= nwg) return false;
    int wgid = (int)L; { const int q = nwg / pg8::NXCD, r = nwg % pg8::NXCD, xcd = wgid % pg8::NXCD, off = wgid / pg8::NXCD; wgid = (xcd < r ? xcd * (q + 1) : r * (q + 1) + (xcd - r) * q) + off; }
    const int nig = pg8::WGM * g.nN, gid = wgid / nig, fm = gid * pg8::WGM, gsz = (g.nM - fm) < pg8::WGM ? (g.nM - fm) : pg8::WGM;
    const int pm = fm + ((wgid % nig) % gsz), pn = (wgid % nig) / gsz;
    u.pm = pm; u.pn = pn; return true;
}

__device__ __forceinline__ void epilogue(const f32x4 (&acc)[2][2][4][2], const GemmCfg& g, const Unit& uu, int wr, int wc, int fr, int fq) {
    UnitIO u; make_unit(g, uu.pm, uu.pn, u);
    const int row0 = wr * 64 + fr, col0 = wc * 32 + 8 * fq;
    const int kind = u.kind, ld = u.ld;
    if (kind <= KD_RELU2) {
        bf16_t* O = (bf16_t*)u.out;
#pragma unroll
        for (int ai = 0; ai < 2; ++ai)
#pragma unroll
            for (int m = 0; m < 4; ++m) {
                bf16_t* rowp = O + (size_t)(row0 + ai * 128 + m * 16) * ld + col0;
#pragma unroll
                for (int bj = 0; bj < 2; ++bj) {
                    f32x4 v0 = acc[ai][bj][m][0], v1 = acc[ai][bj][m][1];
                    if (kind == KD_SILU) { v0[0] = siluf(v0[0]); v0[1] = siluf(v0[1]); v0[2] = siluf(v0[2]); v0[3] = siluf(v0[3]); v1[0] = siluf(v1[0]); v1[1] = siluf(v1[1]); v1[2] = siluf(v1[2]); v1[3] = siluf(v1[3]); }
                    else if (kind == KD_RELU2) {
                        v0[0] = fmaxf(v0[0], 0.f); v0[1] = fmaxf(v0[1], 0.f); v0[2] = fmaxf(v0[2], 0.f); v0[3] = fmaxf(v0[3], 0.f); v0 = v0 * v0;
                        v1[0] = fmaxf(v1[0], 0.f); v1[1] = fmaxf(v1[1], 0.f); v1[2] = fmaxf(v1[2], 0.f); v1[3] = fmaxf(v1[3], 0.f); v1 = v1 * v1; }
                    u32x4 o; o.x = pk2(v0[0], v0[1]); o.y = pk2(v0[2], v0[3]); o.z = pk2(v1[0], v1[1]); o.w = pk2(v1[2], v1[3]);
                    *(u32x4*)(rowp + bj * 128) = o;
                }
            }
    } else if (kind == KD_RES) {
        bf16_t* O = (bf16_t*)u.out;
        f32x4 gv[2][2];
#pragma unroll
        for (int bj = 0; bj < 2; ++bj)
#pragma unroll
            for (int n = 0; n < 2; ++n) gv[bj][n] = *(const f32x4*)(u.aux + col0 + bj * 128 + n * 4);
#pragma unroll
        for (int ai = 0; ai < 2; ++ai)
#pragma unroll
            for (int m = 0; m < 4; ++m) {
                bf16_t* rowp = O + (size_t)(row0 + ai * 128 + m * 16) * ld + col0;
#pragma unroll
                for (int bj = 0; bj < 2; ++bj) {
                    u32x4* p = (u32x4*)(rowp + bj * 128);
                    const u32x4 xo = *p;
                    const f32x4 a0 = gv[bj][0] * acc[ai][bj][m][0], a1 = gv[bj][1] * acc[ai][bj][m][1];
                    u32x4 o;
                    o.x = pk2(bflo(xo.x) + a0[0], bfhi(xo.x) + a0[1]); o.y = pk2(bflo(xo.y) + a0[2], bfhi(xo.y) + a0[3]);
                    o.z = pk2(bflo(xo.z) + a1[0], bfhi(xo.z) + a1[1]); o.w = pk2(bflo(xo.w) + a1[2], bfhi(xo.w) + a1[3]);
                    *p = o;
                }
            }
    } else if (kind == KD_LOGF) {
        float* O = (float*)u.out;
#pragma unroll
        for (int bj = 0; bj < 2; ++bj)
#pragma unroll
            for (int n = 0; n < 2; ++n) {
                const f32x4 bv = *(const f32x4*)(u.aux + col0 + bj * 128 + n * 4);
#pragma unroll
                for (int ai = 0; ai < 2; ++ai)
#pragma unroll
                    for (int m = 0; m < 4; ++m) {
                        f32x4 v = acc[ai][bj][m][n] + bv;
                        v[0] = logsigmoidf(v[0]) * 0.0625f; v[1] = logsigmoidf(v[1]) * 0.0625f; v[2] = logsigmoidf(v[2]) * 0.0625f; v[3] = logsigmoidf(v[3]) * 0.0625f;
                        *(f32x4*)(O + (size_t)(row0 + ai * 128 + m * 16) * ld + col0 + bj * 128 + n * 4) = v;
                    }
            }
    } else {
        float* O = (float*)u.out;
#pragma unroll
        for (int ai = 0; ai < 2; ++ai)
#pragma unroll
            for (int m = 0; m < 4; ++m) {
                float* rowp = O + (size_t)(row0 + ai * 128 + m * 16) * ld + col0;
#pragma unroll
                for (int bj = 0; bj < 2; ++bj)
#pragma unroll
                    for (int n = 0; n < 2; ++n) {
                        *(f32x4*)(rowp + bj * 128 + n * 4) = acc[ai][bj][m][n];
                    }
            }
    }
}

__device__ __forceinline__ void gemm_phase(LAS unsigned char* lds, const GemmCfg& g) {
    using namespace pg8;
    const int tid = otid(), wid = __builtin_amdgcn_readfirstlane(tid >> 6), lane = tid & 63, wr = wid >> 2, wc = wid & 3, fr = lane & 15, fq = lane >> 4;
    const int nt = g.nt;
    unsigned voffA[2], voffB[2];
#pragma unroll
    for (int i = 0; i < 2; ++i) { int R, C; stage_rc(tid * 16 + i * 8192, R, C); const int Rb = (R & ~31) + perm32(R & 31); voffA[i] = (unsigned)(R * g.ld + C) * 2u; voffB[i] = (unsigned)(Rb * g.ld + C) * 2u; }
    const size_t kstep = (size_t)(BK * 2);
    const size_t hstepA = (size_t)HALF * g.ld * 2;
#define hstepB hstepA
    const unsigned ldsw = (unsigned)wid * 1024u;
    const int aoff = lds_byte(wr * 64 + fr, fq * 8), boff = lds_byte(wc * 32 + fr, fq * 8);
#define PG8_SA(b, h) (((b) * 2 + (h)) * HTB)
#define PG8_SB(b, h) ((4 + (b) * 2 + (h)) * HTB)
#define PG8_STAGE(bufoff, gbase, voff) do { _Pragma("unroll") for (int _i = 0; _i < 2; ++_i) \
        __builtin_amdgcn_global_load_lds((const unsigned*)((const char*)(gbase) + (voff)[_i]), (LAS unsigned*)(lds + (bufoff) + ldsw + _i * 8192), 16, 0, 0); } while (0)
#define PG8_LDA(dst, b, h) do { _Pragma("unroll") for (int m = 0; m < 4; ++m) _Pragma("unroll") for (int k = 0; k < 2; ++k) dst[m][k] = *(const LAS bf16x8*)(lds + PG8_SA(b, h) + aoff + m * 2048 + k * 1024); } while (0)
#define PG8_LDB(dst, b, h) do { _Pragma("unroll") for (int n = 0; n < 2; ++n) _Pragma("unroll") for (int k = 0; k < 2; ++k) dst[n][k] = *(const LAS bf16x8*)(lds + PG8_SB(b, h) + boff + n * 2048 + k * 1024); } while (0)
#define PG8_MMA(ai, bj, At, Bt) do { __builtin_amdgcn_s_setprio(1); _Pragma("unroll") for (int m = 0; m < 4; ++m) _Pragma("unroll") for (int n = 0; n < 2; ++n) _Pragma("unroll") for (int k = 0; k < 2; ++k) \
        acc[ai][bj][m][n] = __builtin_amdgcn_mfma_f32_16x16x32_bf16(Bt[n][k], At[m][k], acc[ai][bj][m][n], 0, 0, 0); __builtin_amdgcn_s_setprio(0); } while (0)
#define PG8_WAIT_V(n) asm volatile("s_waitcnt vmcnt(" #n ")" ::: "memory")
#define PG8_WAIT_L(n) asm volatile("s_waitcnt lgkmcnt(" #n ")" ::: "memory")
#define PG8_BAR __builtin_amdgcn_s_barrier()
#define PG8_SCHED __builtin_amdgcn_sched_barrier(0)
    Unit cur, nxt; int ui = 0;
    if (!next_unit(g, 0, cur)) return;
    f32x4 acc[2][2][4][2];
#pragma unroll
    for (int a = 0; a < 2; ++a)
#pragma unroll
        for (int b = 0; b < 2; ++b)
#pragma unroll
            for (int m = 0; m < 4; ++m)
#pragma unroll
                for (int n = 0; n < 2; ++n) acc[a][b][m][n] = (f32x4){0.f, 0.f, 0.f, 0.f};
    bf16x8 At[4][2], B0[2][2], B1[2][2];
    const char* cA; const char* cB; { UnitIO io; make_unit(g, cur.pm, cur.pn, io); cA = io.A; cB = io.B; }
    PG8_STAGE(PG8_SB(0, 0), cB, voffB); PG8_STAGE(PG8_SB(0, 1), cB + hstepB, voffB); PG8_STAGE(PG8_SA(0, 0), cA, voffA); PG8_STAGE(PG8_SA(0, 1), cA + hstepA, voffA);
    if (wr == 1) PG8_BAR;
    PG8_WAIT_V(2); PG8_BAR;
    PG8_STAGE(PG8_SB(1, 0), cB + kstep, voffB); PG8_STAGE(PG8_SA(1, 0), cA + kstep, voffA); PG8_STAGE(PG8_SB(1, 1), cB + hstepB + kstep, voffB);
    PG8_WAIT_V(6); PG8_BAR;
    for (;;) {
        const bool has_next = next_unit(g, ui + 1, nxt);
        const char* nA = cA; const char* nB = cB; if (has_next) { UnitIO io; make_unit(g, nxt.pm, nxt.pn, io); nA = io.A; nB = io.B; }
        for (int t = 0; t < nt; t += 2) {
            const bool last = (t == nt - 2);
            const char* a1 = cA + (size_t)(t + 1) * kstep;
            const char* a2 = last ? nA : cA + (size_t)(t + 2) * kstep; const char* b2 = last ? nB : cB + (size_t)(t + 2) * kstep;
            const char* a3 = a2 + kstep; const char* b3 = b2 + kstep;
            PG8_LDB(B0, 0, 0); PG8_LDB(B1, 0, 1); PG8_SCHED; PG8_LDA(At, 0, 0); PG8_STAGE(PG8_SA(1, 1), a1 + hstepA, voffA);
            PG8_WAIT_V(8); PG8_WAIT_L(0); PG8_BAR; PG8_MMA(0, 0, At, B0); PG8_MMA(0, 1, At, B1); PG8_BAR; PG8_SCHED;
            PG8_LDA(At, 0, 1); PG8_STAGE(PG8_SB(0, 0), b2, voffB); PG8_STAGE(PG8_SB(0, 1), b2 + hstepB, voffB); PG8_STAGE(PG8_SA(0, 0), a2, voffA);
            PG8_WAIT_V(8); PG8_WAIT_L(0); PG8_BAR; PG8_MMA(1, 0, At, B0); PG8_MMA(1, 1, At, B1); PG8_BAR; PG8_SCHED;
            PG8_LDB(B0, 1, 0); PG8_LDB(B1, 1, 1); PG8_SCHED; PG8_LDA(At, 1, 0); PG8_STAGE(PG8_SA(0, 1), a2 + hstepA, voffA);
            PG8_WAIT_V(8); PG8_WAIT_L(0); PG8_BAR; PG8_MMA(0, 0, At, B0); PG8_MMA(0, 1, At, B1); PG8_BAR; PG8_SCHED;
            PG8_LDA(At, 1, 1); PG8_STAGE(PG8_SB(1, 0), b3, voffB); PG8_STAGE(PG8_SB(1, 1), b3 + hstepB, voffB); PG8_STAGE(PG8_SA(1, 0), a3, voffA);
            PG8_WAIT_V(8); PG8_WAIT_L(0); PG8_BAR; PG8_MMA(1, 0, At, B0); PG8_MMA(1, 1, At, B1); PG8_BAR; PG8_SCHED;
        }
        if (wr == 0) PG8_BAR;
        epilogue(acc, g, cur, wr, wc, fr, fq);
        if (!has_next) break;
#pragma unroll
        for (int a = 0; a < 2; ++a)
#pragma unroll
            for (int b = 0; b < 2; ++b)
#pragma unroll
                for (int m = 0; m < 4; ++m)
#pragma unroll
                    for (int n = 0; n < 2; ++n) acc[a][b][m][n] = (f32x4){0.f, 0.f, 0.f, 0.f};
        cur = nxt; cA = nA; cB = nB; ++ui;
        if (wr == 1) PG8_BAR;
    }
    PG8_WAIT_V(0);
    PG8_BAR;
#undef hstepB
#undef PG8_SA
#undef PG8_SB
#undef PG8_STAGE
#undef PG8_LDA
#undef PG8_LDB
#undef PG8_MMA
#undef PG8_WAIT_V
#undef PG8_WAIT_L
#undef PG8_BAR
#undef PG8_SCHED
}

__device__ __forceinline__ void transpose_item(const float* W, int ldn, int n0, int k0, bf16_t* WT, int drow0, int ldk, float scale, LAS float* scr, int lane) {
    float tv[32];
#pragma unroll
    for (int i = 0; i < 32; ++i) { const int kk = 2 * i + (lane >> 5); tv[i] = W[(size_t)(k0 + kk) * ldn + n0 + (lane & 31)]; }
#pragma unroll
    for (int i = 0; i < 32; ++i) { const int kk = 2 * i + (lane >> 5); scr[kk * 33 + (lane & 31)] = tv[i]; }
    asm volatile("s_waitcnt lgkmcnt(0)" ::: "memory");
    const int c = lane & 7;
#pragma unroll
    for (int jx = 0; jx < 4; ++jx) {
        const int n = (lane >> 3) + 8 * jx; const LAS float* s = scr + (8 * c) * 33 + n;
        u32x4 o; o.x = pk2(s[0] * scale, s[33] * scale); o.y = pk2(s[66] * scale, s[99] * scale); o.z = pk2(s[132] * scale, s[165] * scale); o.w = pk2(s[198] * scale, s[231] * scale);
        *(u32x4*)(WT + (size_t)(drow0 + n) * ldk + k0 + 8 * c) = o;
    }
    asm volatile("s_waitcnt lgkmcnt(0)" ::: "memory");
}

__device__ __forceinline__ void convert_layer(PP P, LAS unsigned char* lds, int l, int vb, int nb, int part = 7) {
    const int tid = otid(), lane = tid & 63, wave = tid >> 6;
    unsigned char* ws = P->ws;
    const int j = l >> 1, odd = l & 1;
    __syncthreads();
    {
        LAS float* scr = (LAS float*)(lds + wave * 8704);
        const int it_lo = (part & 1) ? 0 : 4096, it_hi = (part & 2) ? 5376 : 4096;
        for (int it = it_lo + vb * 8 + wave; it < it_hi; it += nb * 8) {
            int r = it;
            if (r < 2048) { const int kb = r / 128, nbk = r % 128;
                transpose_item(P->in[I_W1] + (size_t)l * 1024 * 4096, 4096, nbk * 32, kb * 64, (bf16_t*)(ws + OFF_W1T) + (size_t)l * 4096 * 1024, nbk * 32, 1024, 1.f, scr, lane); continue; }
            r -= 2048;
            if (r < 2048) { const int kb = r / 32, nbk = r % 32;
                transpose_item(P->in[I_W2] + (size_t)l * 4096 * 1024, 1024, nbk * 32, kb * 64, (bf16_t*)(ws + OFF_W2T) + (size_t)l * 1024 * 4096, nbk * 32, 4096, 1.f, scr, lane); continue; }
            r -= 2048;
            if (!odd) {
                if (r < 1024) { const int kb = r / 64, nbk = r % 64; const int sb = nbk < 48 ? nbk : nbk + 1; const int n0 = sb * 32; const int drow = n0 < 1536 ? n0 : n0 + 480;
                    transpose_item(P->in[I_WINE] + (size_t)j * 1024 * 2080, 2080, n0, kb * 64, (bf16_t*)(ws + OFF_WIE) + (size_t)j * 2560 * 1024, drow, 1024, n0 < 256 ? 0.125f : 1.f, scr, lane); continue; }
                r -= 1024;
                { const int kb = r / 32, nbk = r % 32;
                    transpose_item(P->in[I_WOUTE] + (size_t)j * 1024 * 1024, 1024, nbk * 32, kb * 64, (bf16_t*)(ws + OFF_WOE) + (size_t)j * 1024 * 1024, nbk * 32, 1024, 1.f, scr, lane); }
            } else {
                if (r < 768) { const int kb = r / 48, nbk = r % 48; const int n0 = 512 + nbk * 32;
                    transpose_item(P->in[I_WINO] + (size_t)j * 1024 * 2048, 2048, n0, kb * 64, (bf16_t*)(ws + OFF_WIO) + (size_t)j * 2560 * 1024, n0 + 512, 1024, 1.f, scr, lane); continue; }
                r -= 768;
                { const int kb = r / 32, nbk = r % 32;
                    transpose_item(P->in[I_WOUTO] + (size_t)j * 1024 * 1024, 1024, nbk * 32, kb * 64, (bf16_t*)(ws + OFF_WOO) + (size_t)j * 1024 * 1024, nbk * 32, 1024, 1.f, scr, lane); }
            }
        }
    }
    __syncthreads();
    if (!(part & 4)) return;
    if (odd) {
    {
        LAS float* wt = (LAS float*)lds;
        LAS float* tab = (LAS float*)(lds + 64 * 129 * 4);
        for (int it = vb; it < 64; it += nb) {
            const int g = (it >> 4) & 3, kb = it & 15;
            for (int idx = tid; idx < 64 * 128; idx += 512) { const int kk = idx >> 7, c = idx & 127; wt[kk * 129 + c] = P->in[I_WINO][((size_t)j * 1024 + kb * 64 + kk) * 2048 + g * 128 + c]; }
            if (tid < 128) { tab[tid] = __builtin_amdgcn_cosf((float)tid * (1.f / 128.f)); tab[128 + tid] = __builtin_amdgcn_sinf((float)tid * (1.f / 128.f)); }
            __syncthreads();
            const int li = lane & 15, lq = lane >> 4;
            f32x4 acc[2][4];
#pragma unroll
            for (int ti = 0; ti < 2; ++ti)
#pragma unroll
                for (int u = 0; u < 4; ++u) acc[ti][u] = (f32x4){0.f, 0.f, 0.f, 0.f};
            const int zm0 = 16 * (2 * wave) + li, zm1 = zm0 + 16;
            for (int sx = 0; sx < 32; ++sx) {
                const int c = 4 * sx + lq;
                const float a0 = tab[(zm0 >> 7) * 128 + (((zm0 & 127) * c) & 127)], a1 = tab[(zm1 >> 7) * 128 + (((zm1 & 127) * c) & 127)];
#pragma unroll
                for (int u = 0; u < 4; ++u) {
                    const float b = wt[(16 * u + li) * 129 + c];
                    acc[0][u] = __builtin_amdgcn_mfma_f32_16x16x4f32(a0, b, acc[0][u], 0, 0, 0);
                    acc[1][u] = __builtin_amdgcn_mfma_f32_16x16x4f32(a1, b, acc[1][u], 0, 0, 0);
                }
            }
#pragma unroll
            for (int ti = 0; ti < 2; ++ti)
#pragma unroll
                for (int r = 0; r < 4; ++r) {
                    const int zm = 16 * (2 * wave + ti) + 4 * lq + r, z = zm >> 7, m = zm & 127;
                    bf16_t* O = (bf16_t*)(ws + OFF_WIO) + (size_t)j * 2560 * 1024 + (size_t)(z * 512 + g * 128 + m) * 1024 + kb * 64 + li;
#pragma unroll
                    for (int u = 0; u < 4; ++u) O[16 * u] = f2bf(acc[ti][u][r]);
                }
            __syncthreads();
        }
    }
    } else {
    {
        LAS float* Pt = (LAS float*)lds;
        LAS float* Wd = (LAS float*)(lds + 65536);
        for (int it = vb; it < 64; it += nb) {
            const int g = (it >> 4) & 3, nbk = it & 15;
            for (int idx = tid; idx < 128 * 128; idx += 512) { const int c = idx >> 7, d = idx & 127; Pt[d * 128 + c] = P->in[I_POOLW][((size_t)(j * 4 + g) * 128 + c) * 128 + d] * P->in[I_POOLS][j * 512 + g * 128 + d]; }
            for (int idx = tid; idx < 128 * 64; idx += 512) { const int d = idx >> 6, n = idx & 63; Wd[d * 64 + n] = P->in[I_WOUTE][((size_t)j * 1024 + 512 + g * 128 + d) * 1024 + nbk * 64 + n]; }
            __syncthreads();
            const int c = tid & 127, ng = tid >> 7;
            float acc[16];
#pragma unroll
            for (int nn = 0; nn < 16; ++nn) acc[nn] = 0.f;
            for (int d = 0; d < 128; ++d) {
                const float p = Pt[d * 128 + c];
#pragma unroll
                for (int nn = 0; nn < 16; ++nn) acc[nn] += p * Wd[d * 64 + ng * 16 + nn];
            }
            bf16_t* O = (bf16_t*)(ws + OFF_WOE) + (size_t)j * 1024 * 1024 + (size_t)(nbk * 64 + ng * 16) * 1024 + 512 + g * 128 + c;
#pragma unroll
            for (int nn = 0; nn < 16; ++nn) O[(size_t)nn * 1024] = f2bf(acc[nn]);
            __syncthreads();
        }
    }
    {
        LAS float* av = (LAS float*)lds;
        LAS float* w2 = (LAS float*)(lds + 16384);
        for (int it = (vb + nb - (nb > 16 ? 16 : 0)) % nb; it < 16; it += nb) {
            const int kb = it & 15;
            for (int idx = tid; idx < 64 * 32; idx += 512) { const int kk = idx >> 5, r = idx & 31; av[kk * 33 + r] = P->in[I_WINE][((size_t)j * 1024 + kb * 64 + kk) * 2080 + 1536 + r]; }
            for (int idx = tid; idx < 8192; idx += 512) w2[idx] = P->in[I_WA2][(size_t)j * 8192 + idx];
            __syncthreads();
            const int k = tid & 63, grp = tid >> 6, z = grp >> 2, n0 = (grp & 3) * 64;
            float a[16];
#pragma unroll
            for (int r = 0; r < 16; ++r) a[r] = av[k * 33 + z * 16 + r];
            bf16_t* O = (bf16_t*)(ws + OFF_WIE) + (size_t)j * 2560 * 1024 + (size_t)(1536 + z * 256 + n0) * 1024 + kb * 64 + k;
            for (int nn = 0; nn < 64; ++nn) {
                float s = 0.f;
#pragma unroll
                for (int r = 0; r < 16; ++r) s += a[r] * w2[(z * 16 + r) * 256 + n0 + nn];
                O[(size_t)nn * 1024] = f2bf(s);
            }
            __syncthreads();
        }
    }
    }
}

__device__ __forceinline__ void tgen_part(PP P, int vb, int nb) {
    const int tid = otid(); unsigned char* ws = P->ws;
    {
        const int gt = vb * 512 + tid, GT = nb * 512;
        for (int it = gt; it < 2048 * 512 + 256 * 64; it += GT) {
            int L, k, c0; bf16_t* T; float s;
            if (it < 2048 * 512) { L = 2048; k = it >> 9; c0 = (it & 511) * 8; T = (bf16_t*)(ws + OFF_T2K); s = 1.f / 512.f; }
            else { const int r = it - 2048 * 512; L = 256; k = r >> 6; c0 = (r & 63) * 8; T = (bf16_t*)(ws + OFF_T256); s = 0.00552427172801990f; }
            const int z = c0 >= L; const int l0 = c0 - z * L; const float invL = 1.f / (float)L;
            float v[8];
#pragma unroll
            for (int e = 0; e < 8; ++e) { const int ph = (k * (l0 + e)) & (L - 1); const float fr = (float)ph * invL; v[e] = z ? -__builtin_amdgcn_sinf(fr) * s : __builtin_amdgcn_cosf(fr) * s; }
            u32x4 o; o.x = pk2(v[0], v[1]); o.y = pk2(v[2], v[3]); o.z = pk2(v[4], v[5]); o.w = pk2(v[6], v[7]);
            *(u32x4*)(T + (size_t)k * (2 * L) + c0) = o;
        }
    }
}
__device__ __forceinline__ void gemv_mod(PP P, LAS unsigned char* lds, int l, int vb, int nb) {
    const int tid = otid(); unsigned char* ws = P->ws;
    __syncthreads();
    {
        LAS float* sc = (LAS float*)lds;
        LAS float* red = (LAS float*)(lds + 20480);
        bool staged = false;
        for (int it = vb; it < 48; it += nb) {
            if (!staged) {
                for (int idx = tid; idx < 5120; idx += 512) { const int cnd = idx >> 10, k = idx & 1023; const float c = cnd == 0 ? P->in[I_CCTX][k] : P->in[I_C][(cnd - 1) * 1024 + k]; sc[idx] = siluf(c); }
                staged = true; __syncthreads();
            }
            const int cb = it, quad = tid & 31, kc = tid >> 5;
            const float* wp = P->in[I_WADA] + ((size_t)l * 1024 + kc * 64) * 6144 + cb * 128 + quad * 4;
            f32x4 a[5];
#pragma unroll
            for (int cnd = 0; cnd < 5; ++cnd) a[cnd] = (f32x4){0.f, 0.f, 0.f, 0.f};
#pragma unroll 16
            for (int kk = 0; kk < 64; ++kk) {
                const f32x4 w = *(const f32x4*)(wp + (size_t)kk * 6144);
#pragma unroll
                for (int cnd = 0; cnd < 5; ++cnd) a[cnd] += w * sc[cnd * 1024 + kc * 64 + kk];
            }
#pragma unroll
            for (int cnd = 0; cnd < 5; ++cnd) *(LAS f32x4*)(red + (kc * 5 + cnd) * 128 + quad * 4) = a[cnd];
            __syncthreads();
            for (int idx = tid; idx < 640; idx += 512) {
                const int cnd = idx >> 7, cc = idx & 127; float s = 0.f;
#pragma unroll
                for (int k2 = 0; k2 < 16; ++k2) s += red[(k2 * 5 + cnd) * 128 + cc];
                ((float*)(ws + OFF_MOD))[(size_t)(l * 5 + cnd) * 6144 + cb * 128 + cc] = s + P->in[I_BADA][l * 6144 + cb * 128 + cc];
            }
            __syncthreads();
        }
    }
    __syncthreads();
}

__device__ __forceinline__ void prep_phase(PP P, LAS unsigned char* lds) {
    const int tid = otid(), lane = tid & 63, wave = tid >> 6, G = gridDim.x, bx = obid();
    unsigned char* ws = P->ws;
#if DEFER == 1
    convert_layer(P, lds, 0, (bx + 64) % G, G);
#elif DEFER == 2
    convert_layer(P, lds, 0, (bx + 64) % G, G, 7);
    for (int lx = 1; lx < 4; ++lx) convert_layer(P, lds, lx, (bx + 64 * (lx + 1)) % G, G, 6);
#else
    for (int lx = 0; lx < 4; ++lx) convert_layer(P, lds, lx, (bx + 64 * (lx + 1)) % G, G);
    tgen_part(P, bx, G);
#endif
    {
        bf16_t* X = (bf16_t*)(ws + OFF_X);
        for (int r = bx * 8 + wave; r < NTOK; r += G * 8) {
            if (r < NPROMPT) {
#pragma unroll
                for (int jj = 0; jj < 4; ++jj) { const f32x4 v = *(const f32x4*)(P->in[I_XP] + (size_t)r * 1024 + jj * 256 + lane * 4); u32x2 o; o.x = pk2(v[0], v[1]); o.y = pk2(v[2], v[3]); *(u32x2*)(X + (size_t)r * 1024 + jj * 256 + lane * 4) = o; }
            } else {
                const int s = r - NPROMPT, t = s & 2047; const float gr = (float)(t >> 6), gc = (float)(t & 63);
#pragma unroll
                for (int jj = 0; jj < 4; ++jj) {
                    f32x4 v = *(const f32x4*)(P->in[I_XS] + (size_t)s * 1024 + jj * 256 + lane * 4);
#pragma unroll
                    for (int e = 0; e < 4; ++e) {
                        const float fq = __builtin_amdgcn_exp2f(-(float)(lane * 4 + e) * (13.287712379549449f / 256.f));
                        const float ang = (jj < 2 ? gr : gc) * fq;
                        v[e] += (jj & 1) ? __cosf(ang) : __sinf(ang);
                    }
                    { u32x2 o; o.x = pk2(v[0], v[1]); o.y = pk2(v[2], v[3]); *(u32x2*)(X + (size_t)r * 1024 + jj * 256 + lane * 4) = o; }
                }
            }
        }
    }
    __syncthreads();
#if DEFER == 1
    gemv_mod(P, lds, 0, (bx + 128) % G, G);
#else
    for (int lx = 0; lx < 4; ++lx) gemv_mod(P, lds, lx, (bx + 48 * lx) % G, G);
#endif
}

__device__ __forceinline__ void norm_phase(PP P, int l, int which) {
    const int tid = otid(), lane = tid & 63, wave = tid >> 6, G = gridDim.x, bx = obid();
    unsigned char* ws = P->ws;
    const bf16_t* X = (const bf16_t*)(ws + OFF_X);
    const float* gp = which == 2 ? P->in[I_FINALG] : P->in[I_NORMG] + (size_t)(l * 2 + which) * 1024;
    f32x4 gv[4];
#pragma unroll
    for (int jj = 0; jj < 4; ++jj) gv[jj] = *(const f32x4*)(gp + jj * 256 + lane * 4);
    for (int r0 = bx * 8 + wave; r0 < NTOK; r0 += G * 16) {
        f32x4 v[2][4]; float ss[2] = {0.f, 0.f};
#pragma unroll
        for (int u = 0; u < 2; ++u) { const int r = r0 + u * G * 8; if (r < NTOK) {
#pragma unroll
            for (int jj = 0; jj < 4; ++jj) { const u32x2 tb = *(const u32x2*)(X + (size_t)r * 1024 + jj * 256 + lane * 4); v[u][jj] = (f32x4){bflo(tb.x), bfhi(tb.x), bflo(tb.y), bfhi(tb.y)}; } } }
#pragma unroll
        for (int u = 0; u < 2; ++u) {
            const int r = r0 + u * G * 8; if (r >= NTOK) continue;
#pragma unroll
            for (int jj = 0; jj < 4; ++jj) ss[u] += v[u][jj][0] * v[u][jj][0] + v[u][jj][1] * v[u][jj][1] + v[u][jj][2] * v[u][jj][2] + v[u][jj][3] * v[u][jj][3];
            const float rstd = rsqrtf(wave_sum(ss[u]) * (1.f / 1024.f) + 1e-6f);
            if (which == 2) {
#pragma unroll
                for (int jj = 0; jj < 4; ++jj) *(f32x4*)(P->out + (size_t)r * 1024 + jj * 256 + lane * 4) = v[u][jj] * rstd * gv[jj];
            } else {
                const int cnd = r < NPROMPT ? 0 : 1 + ((r - NPROMPT) >> 11);
                const float* mp = (const float*)(ws + OFF_MOD) + (size_t)(l * 5 + cnd) * 6144 + which * 3072;
                bf16_t* Hh = (bf16_t*)(ws + OFF_H) + (size_t)r * 1024;
#pragma unroll
                for (int jj = 0; jj < 4; ++jj) {
                    const f32x4 sh = *(const f32x4*)(mp + jj * 256 + lane * 4), sc = *(const f32x4*)(mp + 1024 + jj * 256 + lane * 4);
                    const f32x4 y = v[u][jj] * rstd * gv[jj] * (sc + 1.f) + sh;
                    u32x2 o; o.x = pk2(y[0], y[1]); o.y = pk2(y[2], y[3]);
                    *(u32x2*)(Hh + jj * 256 + lane * 4) = o;
                }
            }
        }
    }
}

__device__ __forceinline__ void acc8(float (&s)[8], const u32x4& v, float m) {
    s[0] += m * bflo(v.x); s[1] += m * bfhi(v.x); s[2] += m * bflo(v.y); s[3] += m * bfhi(v.y); s[4] += m * bflo(v.z); s[5] += m * bfhi(v.z); s[6] += m * bflo(v.w); s[7] += m * bfhi(v.w);
}
template <int W> __device__ __forceinline__ void pool_run(const bf16_t* UB, bf16_t* AM, int t0, int ch) {
    int s0, L; if (t0 < NPROMPT) { s0 = t0 & ~255; L = 256; } else { s0 = NPROMPT + ((t0 - NPROMPT) & ~2047); L = 2048; }
    const int tl0 = t0 - s0, base = tl0 - W / 2;
    u32x4 v[W + 7];
#pragma unroll
    for (int i = 0; i < W + 7; ++i) { int tt = base + i; tt = tt < 0 ? 0 : (tt >= L ? L - 1 : tt); v[i] = *(const u32x4*)(UB + (size_t)(s0 + tt) * 512 + ch); }
    float s[8];
#pragma unroll
    for (int e = 0; e < 8; ++e) s[e] = 0.f;
#pragma unroll
    for (int i = 0; i < W; ++i) { const int tt = base + i; acc8(s, v[i], (tt >= 0 && tt < L) ? 1.f : 0.f); }
#pragma unroll
    for (int r = 0; r < 8; ++r) {
        const int tl = tl0 + r;
        const int lo = max(tl - W / 2, 0), hi = min(tl + W - W / 2, L);
        const float ic = 1.f / (float)(hi - lo);
        const u32x4 c = v[r + W / 2];
        u32x4 o;
        o.x = pk2(s[0] * ic - bflo(c.x), s[1] * ic - bfhi(c.x)); o.y = pk2(s[2] * ic - bflo(c.y), s[3] * ic - bfhi(c.y));
        o.z = pk2(s[4] * ic - bflo(c.z), s[5] * ic - bfhi(c.z)); o.w = pk2(s[6] * ic - bflo(c.w), s[7] * ic - bfhi(c.w));
        *(u32x4*)(AM + (size_t)(t0 + r) * 1024 + 512 + ch) = o;
        if (r < 7) {
            const int tout = base + r, tin = base + r + W;
            acc8(s, v[r], (tout >= 0 && tout < L) ? -1.f : 0.f);
            acc8(s, v[r + W], (tin >= 0 && tin < L) ? 1.f : 0.f);
        }
    }
}
__device__ __forceinline__ void pool_phase(PP P) {
    unsigned char* ws = P->ws;
    const bf16_t* UB = (const bf16_t*)(ws + OFF_UB);
    bf16_t* AM = (bf16_t*)(ws + OFF_AMIX);
    const int tid = otid(), lane = tid & 63, wave = tid >> 6;
    for (int wi = obid() * 8 + wave; wi < 4 * (NTOK / 32); wi += gridDim.x * 8) {
        const int g = wi & 3, t0 = (wi >> 2) * 32 + (lane >> 4) * 8, ch = (g * 16 + (lane & 15)) * 8;
        if (g == 0) pool_run<2>(UB, AM, t0, ch);
        else if (g == 1) pool_run<4>(UB, AM, t0, ch);
        else if (g == 2) pool_run<8>(UB, AM, t0, ch);
        else pool_run<16>(UB, AM, t0, ch);
    }
}

__device__ __forceinline__ void mixprep_phase(PP P, int j) {
    const int tid = otid(), lane = tid & 63, wave = tid >> 6;
    unsigned char* ws = P->ws;
    const float* O0 = (const float*)(ws + OFF_ODIR); const float* O1 = O0 + (size_t)NTOK * 512;
    const bf16_t* GT = (const bf16_t*)(ws + OFF_GATE);
    bf16_t* AM = (bf16_t*)(ws + OFF_AMIX);
    const int ch = lane * 8;
    const f32x4 g0 = *(const f32x4*)(P->in[I_GLAG] + j * 128 + (ch & 127)), g1 = *(const f32x4*)(P->in[I_GLAG] + j * 128 + (ch & 127) + 4);
    const int G8 = gridDim.x * 8;
    for (int r0 = obid() * 8 + wave; r0 < NTOK; r0 += 2 * G8) {
        f32x4 a[2], b[2]; u32x4 gt[2];
#pragma unroll
        for (int u = 0; u < 2; ++u) { const int r = r0 + u * G8; if (r < NTOK) {
            a[u] = *(const f32x4*)(O0 + (size_t)r * 512 + ch) + *(const f32x4*)(O1 + (size_t)r * 512 + ch);
            b[u] = *(const f32x4*)(O0 + (size_t)r * 512 + ch + 4) + *(const f32x4*)(O1 + (size_t)r * 512 + ch + 4);
            gt[u] = *(const u32x4*)(GT + (size_t)r * 512 + ch); } }
#pragma unroll
        for (int u = 0; u < 2; ++u) {
            const int r = r0 + u * G8; if (r >= NTOK) continue;
            float ss = a[u][0] * a[u][0] + a[u][1] * a[u][1] + a[u][2] * a[u][2] + a[u][3] * a[u][3] + b[u][0] * b[u][0] + b[u][1] * b[u][1] + b[u][2] * b[u][2] + b[u][3] * b[u][3];
            ss += __shfl_xor(ss, 1); ss += __shfl_xor(ss, 2); ss += __shfl_xor(ss, 4); ss += __shfl_xor(ss, 8);
            const float rstd = rsqrtf(ss * (1.f / 128.f) + 1e-6f);
            const f32x4 aa = a[u] * rstd * g0, bb = b[u] * rstd * g1;
            u32x4 o;
            o.x = pk2(aa[0] * bflo(gt[u].x), aa[1] * bfhi(gt[u].x)); o.y = pk2(aa[2] * bflo(gt[u].y), aa[3] * bfhi(gt[u].y));
            o.z = pk2(bb[0] * bflo(gt[u].z), bb[1] * bfhi(gt[u].z)); o.w = pk2(bb[2] * bflo(gt[u].w), bb[3] * bfhi(gt[u].w));
            *(u32x4*)(AM + (size_t)r * 1024 + ch) = o;
        }
    }
}

__device__ __forceinline__ void conv_phase(PP P, int j, int vb, int nb) {
    unsigned char* ws = P->ws;
    const bf16_t* XI = (const bf16_t*)(ws + OFF_XIN); const bf16_t* BGp = (const bf16_t*)(ws + OFF_BG); const bf16_t* CGp = (const bf16_t*)(ws + OFF_CG);
    bf16_t* AM = (bf16_t*)(ws + OFF_AMIX);
    for (int idx = vb * 512 + otid(); idx < NTOK * 64; idx += nb * 512) {
        const int t = idx >> 6, ch = (idx & 63) * 8;
        int s0, L; if (t < NPROMPT) { s0 = t & ~255; L = 256; } else { s0 = NPROMPT + ((t - NPROMPT) & ~2047); L = 2048; }
        const int tl = t - s0;
        float cv[8];
        { const f32x4 b0 = *(const f32x4*)(P->in[I_CONVB] + j * 512 + ch), b1 = *(const f32x4*)(P->in[I_CONVB] + j * 512 + ch + 4);
          cv[0] = b0[0]; cv[1] = b0[1]; cv[2] = b0[2]; cv[3] = b0[3]; cv[4] = b1[0]; cv[5] = b1[1]; cv[6] = b1[2]; cv[7] = b1[3]; }
#pragma unroll
        for (int jj = 0; jj < 3; ++jj) {
            const int tt = tl + jj - 1;
            if (tt < 0 || tt >= L) continue;
            const u32x4 xv = *(const u32x4*)(XI + (size_t)(s0 + tt) * 512 + ch), cg = *(const u32x4*)(CGp + (size_t)(s0 + tt) * 512 + ch);
            const f32x4 w0 = *(const f32x4*)(P->in[I_CONVW] + (size_t)(j * 3 + jj) * 512 + ch), w1 = *(const f32x4*)(P->in[I_CONVW] + (size_t)(j * 3 + jj) * 512 + ch + 4);
            cv[0] += bflo(xv.x) * bflo(cg.x) * w0[0]; cv[1] += bfhi(xv.x) * bfhi(cg.x) * w0[1]; cv[2] += bflo(xv.y) * bflo(cg.y) * w0[2]; cv[3] += bfhi(xv.y) * bfhi(cg.y) * w0[3];
            cv[4] += bflo(xv.z) * bflo(cg.z) * w1[0]; cv[5] += bfhi(xv.z) * bfhi(cg.z) * w1[1]; cv[6] += bflo(xv.w) * bflo(cg.w) * w1[2]; cv[7] += bfhi(xv.w) * bfhi(cg.w) * w1[3];
        }
        const u32x4 bg = *(const u32x4*)(BGp + (size_t)t * 512 + ch);
        u32x4 o;
        o.x = pk2(cv[0] * bflo(bg.x), cv[1] * bfhi(bg.x)); o.y = pk2(cv[2] * bflo(bg.y), cv[3] * bfhi(bg.y));
        o.z = pk2(cv[4] * bflo(bg.z), cv[5] * bfhi(bg.z)); o.w = pk2(cv[6] * bflo(bg.w), cv[7] * bfhi(bg.w));
        *(u32x4*)(AM + (size_t)t * 1024 + 512 + ch) = o;
    }
}

__device__ __forceinline__ void convert_phase(PP P) {
    unsigned char* ws = P->ws;
    bf16_t* AM = (bf16_t*)(ws + OFF_AMIX);
    const bf16_t* F0 = (const bf16_t*)(ws + OFF_FACCS);
    for (int idx = obid() * 512 + otid(); idx < 8192 * 64; idx += gridDim.x * 512) {
        const int ts = idx >> 6, ch = (idx & 63) * 8;
        const bf16_t* F = F0 + (size_t)ts * 512 + ch;
        u32x4 p[4];
#pragma unroll
        for (int ks = 0; ks < 4; ++ks) p[ks] = *(const u32x4*)(F + (size_t)ks * 8192 * 512);
        u32x4 o;
        o.x = pk2((bflo(p[0].x) + bflo(p[1].x)) + (bflo(p[2].x) + bflo(p[3].x)), (bfhi(p[0].x) + bfhi(p[1].x)) + (bfhi(p[2].x) + bfhi(p[3].x)));
        o.y = pk2((bflo(p[0].y) + bflo(p[1].y)) + (bflo(p[2].y) + bflo(p[3].y)), (bfhi(p[0].y) + bfhi(p[1].y)) + (bfhi(p[2].y) + bfhi(p[3].y)));
        o.z = pk2((bflo(p[0].z) + bflo(p[1].z)) + (bflo(p[2].z) + bflo(p[3].z)), (bfhi(p[0].z) + bfhi(p[1].z)) + (bfhi(p[2].z) + bfhi(p[3].z)));
        o.w = pk2((bflo(p[0].w) + bflo(p[1].w)) + (bflo(p[2].w) + bflo(p[3].w)), (bfhi(p[0].w) + bfhi(p[1].w)) + (bfhi(p[2].w) + bfhi(p[3].w)));
        *(u32x4*)(AM + (size_t)(NPROMPT + ts) * 1024 + ch) = o;
    }
}

__device__ __forceinline__ int permd(int d) { return (d & 32) | ((d & 12) << 1) | ((d & 16) >> 2) | (d & 3); }
__device__ __forceinline__ bf16x8 pack8(const f32x4& a, const f32x4& b) {
    u32x4 o; o.x = pk2(a[0], a[1]); o.y = pk2(a[2], a[3]); o.z = pk2(b[0], b[1]); o.w = pk2(b[2], b[3]);
    return __builtin_bit_cast(bf16x8, o);
}
__device__ __forceinline__ void gla_item(PP P, LAS unsigned char* lds, int j, int seg, int head, int dir, bool full) {
    const int tid = otid(), lane = tid & 63, w = tid >> 6, r = lane & 15, q = lane >> 4;
    unsigned char* ws = P->ws;
    const bf16_t* QB = (const bf16_t*)(ws + OFF_QB); const bf16_t* KB = (const bf16_t*)(ws + OFF_KB); const bf16_t* VT = (const bf16_t*)(ws + OFF_VT);
    const float* LOGF = (const float*)(ws + OFF_LOGF);
    float* ODIR = (float*)(ws + OFF_ODIR);
    float* Ubuf = (float*)(ws + OFF_U); float* Dtot = (float*)(ws + OFF_DTOT);
    LAS bf16_t* QT = (LAS bf16_t*)(lds);
    LAS bf16_t* KT = (LAS bf16_t*)(lds + 36864);
    LAS bf16_t* KH = (LAS bf16_t*)(lds + 73728);
    LAS float* DL = (LAS float*)(lds + 114688);
    LAS bf16x8* ATT = (LAS bf16x8*)(lds + 116736);
    const int tok0 = seg * 256;
    __syncthreads();
    {
        const int d = tid & 63, c = w, pd = permd(d);
        float b = 0.f;
        const float* lf = LOGF + (size_t)(tok0 + 32 * c) * 512 + dir * 256 + head * 64 + d;
        const bf16_t* qp = QB + (size_t)(tok0 + 32 * c) * 256 + head * 64 + d;
        const bf16_t* kp = KB + (size_t)(tok0 + 32 * c) * 256 + head * 64 + d;
        float lfv[32]; bf16_t qv16[32], kv16[32];
#pragma unroll
        for (int ii = 0; ii < 32; ++ii) { const int il = dir ? 31 - ii : ii; lfv[ii] = lf[(size_t)il * 512]; qv16[ii] = qp[(size_t)il * 256]; kv16[ii] = kp[(size_t)il * 256]; }
#pragma unroll
        for (int ii = 0; ii < 32; ++ii) {
            const int il = dir ? 31 - ii : ii;
            b += lfv[ii];
            const float qv = bf2f(qv16[ii]), kv = bf2f(kv16[ii]);
            QT[(32 * c + il) * 72 + pd] = f2bf(qv * __expf(b));
            KT[(32 * c + il) * 72 + pd] = f2bf(kv * __expf(-b));
        }
        const float eT = __expf(b);
        DL[c * 64 + d] = eT;
#pragma unroll 8
        for (int il = 0; il < 32; ++il) KH[(c * 64 + d) * 40 + permd(il)] = f2bf(bf2f(KT[(32 * c + il) * 72 + pd]) * eT);
    }
    __syncthreads();
    if (full) {
        const int c = w;
        f32x4 at[2][2];
#pragma unroll
        for (int a = 0; a < 2; ++a)
#pragma unroll
            for (int b = 0; b < 2; ++b) at[a][b] = (f32x4){0.f, 0.f, 0.f, 0.f};
#pragma unroll
        for (int kk = 0; kk < 2; ++kk) {
            bf16x8 ka[2], qb[2];
#pragma unroll
            for (int t = 0; t < 2; ++t) { ka[t] = *(const LAS bf16x8*)(KT + (32 * c + 16 * t + r) * 72 + 32 * kk + 8 * q); qb[t] = *(const LAS bf16x8*)(QT + (32 * c + 16 * t + r) * 72 + 32 * kk + 8 * q); }
#pragma unroll
            for (int tj = 0; tj < 2; ++tj)
#pragma unroll
                for (int ti = 0; ti < 2; ++ti) at[tj][ti] = __builtin_amdgcn_mfma_f32_16x16x32_bf16(ka[tj], qb[ti], at[tj][ti], 0, 0, 0);
        }
#pragma unroll
        for (int ti = 0; ti < 2; ++ti) {
            const int i = 16 * ti + r;
#pragma unroll
            for (int tj = 0; tj < 2; ++tj)
#pragma unroll
                for (int jj = 0; jj < 4; ++jj) { const int jx = 16 * tj + 4 * q + jj; const bool keep = dir ? (jx >= i) : (jx <= i); if (!keep) at[tj][ti][jj] = 0.f; }
            ATT[(c * 2 + ti) * 64 + lane] = pack8(at[0][ti], at[1][ti]);
        }
    }
    __syncthreads();
    f32x4 S[4];
#pragma unroll
    for (int t = 0; t < 4; ++t) S[t] = (f32x4){0.f, 0.f, 0.f, 0.f};
    const int e = 16 * w + r;
    if (DBG_SINIT && full && seg >= 16) {
        const int sb = (seg - 16) >> 3, part = (seg - 16) & 7;
        const float* s0 = P->in[I_STATE] + ((size_t)(((sb * 2 + j) * 2 + dir) * 4 + head) * 64) * 128;
#pragma unroll
        for (int t = 0; t < 4; ++t)
#pragma unroll
            for (int jj = 0; jj < 4; ++jj) S[t][jj] = s0[(size_t)(16 * t + 4 * q + jj) * 128 + e];
        const int np = dir ? 7 - part : part;
#pragma unroll
        for (int xb = 0; xb < 8; xb += 4) {
            if (xb >= np) break;
            float dvv[4][16], uvv[4][16];
#pragma unroll
            for (int xi = 0; xi < 4; ++xi) {
                const int x = xb + xi; if (x >= 7) continue;
                const int pp = dir ? 7 - x : x;
                const size_t ib = (size_t)(((sb * 8 + pp) * 4 + head) * 2 + dir) * 64;
#pragma unroll
                for (int t = 0; t < 4; ++t)
#pragma unroll
                    for (int jj = 0; jj < 4; ++jj) { const int d = 16 * t + 4 * q + jj; dvv[xi][t * 4 + jj] = Dtot[ib + d]; uvv[xi][t * 4 + jj] = Ubuf[(ib + d) * 128 + e]; }
            }
#pragma unroll
            for (int xi = 0; xi < 4; ++xi) {
                const int x = xb + xi; if (x >= 7) continue;
                const bool on = x < np;
#pragma unroll
                for (int t = 0; t < 4; ++t)
#pragma unroll
                    for (int jj = 0; jj < 4; ++jj) S[t][jj] = on ? S[t][jj] * dvv[xi][t * 4 + jj] + uvv[xi][t * 4 + jj] : S[t][jj];
            }
        }
    }
    const bf16_t* vt = VT + (size_t)(head * 128 + e) * NTOK + tok0;
    u32x2 vpre0[8], vpre1[8];
#pragma unroll
    for (int cc = 0; cc < 8; ++cc) { const int c = dir ? 7 - cc : cc; vpre0[cc] = *(const u32x2*)(vt + 32 * c + 4 * q); vpre1[cc] = *(const u32x2*)(vt + 32 * c + 16 + 4 * q); }
#pragma unroll
    for (int cc = 0; cc < 8; ++cc) {
        const int c = dir ? 7 - cc : cc;
        const u32x2 v0 = vpre0[cc], v1 = vpre1[cc];
        u32x4 vv; vv.x = v0.x; vv.y = v0.y; vv.z = v1.x; vv.w = v1.y;
        const bf16x8 vb = __builtin_bit_cast(bf16x8, vv);
        if (full) {
            bf16x8 sb2[2];
            sb2[0] = pack8(S[0], S[1]); sb2[1] = pack8(S[2], S[3]);
#pragma unroll
            for (int mi = 0; mi < 2; ++mi) {
                f32x4 o = (f32x4){0.f, 0.f, 0.f, 0.f};
#pragma unroll
                for (int kk = 0; kk < 2; ++kk) {
                    const bf16x8 qa = *(const LAS bf16x8*)(QT + (32 * c + 16 * mi + r) * 72 + 32 * kk + 8 * q);
                    o = __builtin_amdgcn_mfma_f32_16x16x32_bf16(qa, sb2[kk], o, 0, 0, 0);
                }
                const bf16x8 aa = ATT[(c * 2 + mi) * 64 + lane];
                o = __builtin_amdgcn_mfma_f32_16x16x32_bf16(aa, vb, o, 0, 0, 0);
                float* op = ODIR + ((size_t)dir * NTOK + tok0 + 32 * c + 16 * mi + 4 * q) * 512 + head * 128 + e;
#pragma unroll
                for (int jj = 0; jj < 4; ++jj) op[(size_t)jj * 512] = o[jj];
            }
        }
#pragma unroll
        for (int t = 0; t < 4; ++t) {
            const f32x4 dv = *(const LAS f32x4*)(DL + c * 64 + 16 * t + 4 * q);
            S[t] = S[t] * dv;
            const bf16x8 ka = *(const LAS bf16x8*)(KH + (c * 64 + 16 * t + r) * 40 + 8 * q);
            S[t] = __builtin_amdgcn_mfma_f32_16x16x32_bf16(ka, vb, S[t], 0, 0, 0);
        }
    }
    if (full) {
        if (seg < 16) {
            float* so = P->out + OUT_STATE + ((size_t)(((seg * 2 + j) * 2 + dir) * 4 + head) * 64) * 128;
#pragma unroll
            for (int t = 0; t < 4; ++t)
#pragma unroll
                for (int jj = 0; jj < 4; ++jj) so[(size_t)(16 * t + 4 * q + jj) * 128 + e] = S[t][jj];
        }
    } else {
        const size_t ib = (size_t)(((seg - 16) * 4 + head) * 2 + dir) * 64;
#pragma unroll
        for (int t = 0; t < 4; ++t)
#pragma unroll
            for (int jj = 0; jj < 4; ++jj) Ubuf[(ib + 16 * t + 4 * q + jj) * 128 + e] = S[t][jj];
        if (tid < 64) { float p = 1.f;
#pragma unroll
            for (int c = 0; c < 8; ++c) p *= DL[c * 64 + tid];
            Dtot[ib + tid] = p; }
    }
}

__device__ __forceinline__ void gla_phase(PP P, LAS unsigned char* lds, int j, int sub) {
    const int G = gridDim.x;
    if (sub == 0) {
        for (int it = obid(); it < 384; it += G) {
            if (it >= 128 && it < 256) { const int pi = it - 128; gla_item(P, lds, j, pi >> 3, (pi >> 1) & 3, pi & 1, true); }
            else { const int li = it < 128 ? it : it - 128; gla_item(P, lds, j, 16 + (li >> 3), (li >> 1) & 3, li & 1, false); }
        }
    } else {
        for (int it = obid(); it < 256; it += G) gla_item(P, lds, j, 16 + (it >> 3), (it >> 1) & 3, it & 1, true);
    }
}


#define XB_TMO      128
#define XB_XCNT(j)  (256  + 64 * (j))
#define XB_XSUB(j)  (1280 + 64 * (j))
#define XB_XGEN(j)  (2304 + 64 * (j))
#define XB_TOP      3328
#define XB_TOPGEN   3392
#define XCD_BAR_WORDS 3456
#define XB_SPIN_CAP (1u << 18)

__device__ __forceinline__ unsigned xb_ld(unsigned* p)              { return __hip_atomic_load(p, __ATOMIC_RELAXED, __HIP_MEMORY_SCOPE_AGENT); }
__device__ __forceinline__ unsigned xb_add(unsigned* p, unsigned v) { return __hip_atomic_fetch_add(p, v, __ATOMIC_RELAXED, __HIP_MEMORY_SCOPE_AGENT); }
__device__ __forceinline__ unsigned xb_xcc_id() { return (unsigned)__builtin_amdgcn_s_getreg((3 << 11) | 20) & 0xFu; }
#define XB_SPIN(cond, bar) do { unsigned _sp = 0; while (cond) { __builtin_amdgcn_s_sleep(1); \
    if ((++_sp & 255u) == 0u) { if (xb_ld(&(bar)[XB_TMO])) break; if (_sp > XB_SPIN_CAP) { atomicAdd(&(bar)[XB_TMO], 1u); break; } } } } while (0)

struct XcdBarrier {
    unsigned* bar; unsigned x;
    volatile LAS unsigned* st;
};

__device__ __forceinline__ XcdBarrier xcd_barrier_post(unsigned* bar, volatile LAS unsigned* st) {
    XcdBarrier b; b.bar = bar; b.x = xb_xcc_id(); b.st = st;
    if (threadIdx.x == 0) (void)xb_add(&bar[XB_XCNT(b.x)], 1u);
    return b;
}
__device__ __forceinline__ void xcd_barrier_complete(unsigned* bar, unsigned x, unsigned& nloc, unsigned& nx) {
    const unsigned G = gridDim.x * gridDim.y * gridDim.z;
    unsigned sum, cnt, mine, sp = 0u;
    for (;;) {
        sum = 0u; cnt = 0u; mine = 0u;
#pragma unroll
        for (unsigned j = 0; j < 16; ++j) { const unsigned c = xb_ld(&bar[XB_XCNT(j)]); sum += c; cnt += (c > 0u) ? 1u : 0u; mine = (j == x) ? c : mine; }
        if (sum == G) break;
        __builtin_amdgcn_s_sleep(1);
        if ((++sp & 255u) == 0u) { if (xb_ld(&bar[XB_TMO])) break; if (sp > XB_SPIN_CAP) { atomicAdd(&bar[XB_TMO], 1u); break; } }
    }
    nloc = mine > 0u ? mine : 1u; nx = cnt > 0u ? cnt : 1u;
}

__device__ __forceinline__ void xcd_barrier(const XcdBarrier& b) {
    asm volatile("s_waitcnt vmcnt(0)" ::: "memory");
    __syncthreads();
    if (threadIdx.x == 0) {
        unsigned* bar = b.bar;
        __builtin_amdgcn_s_waitcnt(0);
        unsigned nloc = b.st[0], nx = b.st[1];
        if (nloc == 0u) { xcd_barrier_complete(bar, b.x, nloc, nx); b.st[0] = nloc; b.st[1] = nx; }
        const unsigned old = xb_add(&bar[XB_XSUB(b.x)], 1u);
        const unsigned gen = old / nloc;
        if (old + 1u == (gen + 1u) * nloc) {
            __builtin_amdgcn_fence(__ATOMIC_RELEASE, "agent");
            asm volatile("s_waitcnt vmcnt(0)" ::: "memory");
            const unsigned og = xb_add(&bar[XB_TOP], 1u);
            const unsigned tg = og / nx;
            if (og + 1u == (tg + 1u) * nx) xb_add(&bar[XB_TOPGEN], 1u);
            else XB_SPIN(xb_ld(&bar[XB_TOPGEN]) == tg, bar);
            __builtin_amdgcn_fence(__ATOMIC_ACQUIRE, "agent");
            xb_add(&bar[XB_XGEN(b.x)], 1u);
            asm volatile("s_waitcnt vmcnt(0)" ::: "memory");
        } else {
            XB_SPIN(xb_ld(&bar[XB_XGEN(b.x)]) == gen, bar);
            __builtin_amdgcn_fence(__ATOMIC_ACQUIRE, "agent");
            asm volatile("s_waitcnt vmcnt(0)" ::: "memory");
        }
    }
    __syncthreads();
}

enum { PT_PREP = 0, PT_NORM1, PT_GEMM_IN, PT_MIX_A, PT_MIX_B, PT_MIXPREP, PT_GEMM_OUT, PT_NORM2, PT_MLP1, PT_MLP2, PT_FINAL };

__global__ void __launch_bounds__(512, 2) mega_fwd(Params Pk) {
    extern __shared__ __attribute__((aligned(16))) unsigned char smem[];
    LAS unsigned char* lds = (LAS unsigned char*)smem;
#ifdef DBG_ZLDS
    for (int i = otid(); i < LDS_BYTES / 16; i += 512) ((LAS u32x4*)lds)[i] = (u32x4){0u, 0u, 0u, 0u};
    __syncthreads();
#endif
    { volatile LAS unsigned* st0 = (volatile LAS unsigned*)(lds + LDS_BYTES - 64); if (otid() < 2) st0[otid()] = 0u; }
    __syncthreads();
    XcdBarrier gbar; gbar.bar = (unsigned*)(Pk.ws + OFF_BAR); gbar.x = 0; gbar.st = (volatile LAS unsigned*)(lds + LDS_BYTES - 64);
    if (Pk.ph_hi - Pk.ph_lo > 1) gbar = xcd_barrier_post((unsigned*)(Pk.ws + OFF_BAR), (volatile LAS unsigned*)(lds + LDS_BYTES - 64));
    if (Pk.ph_hi < 0) cg::this_grid().sync();
    for (int ph = Pk.ph_lo; ph < Pk.ph_hi; ++ph) {
        PP P = (PP)__builtin_amdgcn_kernarg_segment_ptr();
        asm volatile("" : "+s"(P));
        int pt, l = 0;
        if (ph == 0) pt = PT_PREP;
        else if (ph == NPH - 1) pt = PT_FINAL;
        else {
            const int qq = ph - 1; int s;
            if (qq < 9) { l = 0; s = qq; } else if (qq < 17) { l = 1; s = qq - 9; } else if (qq < 26) { l = 2; s = qq - 17; } else { l = 3; s = qq - 26; }
            pt = (l & 1) ? (s < 4 ? s + 1 : s + 2) : s + 1;
        }
        const int j = l >> 1, odd = l & 1;
        const int nrep = (pt == REP_PT && (REP_L < 0 || l == REP_L)) ? 1 + REP_N : 1;
        for (int rep = 0; rep < nrep; ++rep) {
        int ngemm = 0; GemmCfg g; g.G = gridDim.x; g.c = obid(); g.j = j; g.l = l; g.nM = 48; g.ld = 1024; g.nt = 16; g.type = 0; g.nN = 0;
        switch (pt) {
        case PT_PREP: if (EN & 1) prep_phase(P, lds); break;
        case PT_NORM1: if (EN & 2) norm_phase(P, l, 0); break;
        case PT_GEMM_IN: ngemm = 1; g.type = odd ? T_IN_ODD : T_IN_EVEN; g.nN = 10; break;
        case PT_MIX_A: if (odd) { ngemm = 2; g.type = T_DFT_S; g.nM = 8; g.nN = 32; g.ld = 4096; g.nt = 16; } else { if (EN & 4) gla_phase(P, lds, j, 0); if (EN & 8) pool_phase(P); } break;
        case PT_MIX_B: if (odd) { if (EN & 8) convert_phase(P); } else { if (EN & 4) gla_phase(P, lds, j, 1); } break;
        case PT_MIXPREP: if (EN & 8) mixprep_phase(P, j); break;
        case PT_GEMM_OUT: ngemm = 1; g.type = odd ? T_OUT_ODD : T_OUT_EVEN; g.nN = 4; break;
        case PT_NORM2: if (EN & 2) norm_phase(P, l, 1); break;
        case PT_MLP1: ngemm = 1; g.type = T_MLP1; g.nN = 16; break;
        case PT_MLP2: ngemm = 1; g.type = T_MLP2; g.nN = 4; g.ld = 4096; g.nt = 64; break;
        default: if (EN & 2) norm_phase(P, 0, 2); break;
        }
        for (int gi = 0; gi < ngemm; ++gi) {
            if (gi == 1) { g.type = T_DFT_P; g.nM = 1; g.nN = 32; g.ld = 512; g.nt = 8; g.c = (obid() + gridDim.x - 32) % gridDim.x; }
            if (EN & 16) gemm_phase(lds, g);
        }
        if (pt == PT_MIX_A && odd && (EN & 8)) {
            const int G3 = gridDim.x, b3 = obid();
            if (G3 > 64) { if (b3 < 32) conv_phase(P, j, b3, G3 - 32); else if (b3 >= 64) conv_phase(P, j, b3 - 32, G3 - 32); }
            else conv_phase(P, j, b3, G3);
        }
        if (DEFER && pt == PT_MLP2 && l < 3) {
            const int G2 = gridDim.x, bq = obid(); const bool idle = G2 > 192; const int vb2 = idle ? bq - 192 : bq, nb2 = idle ? G2 - 192 : G2;
            if (!idle || bq >= 192) {
                if (DEFER == 1) { convert_layer(P, lds, l + 1, vb2, nb2, 7); gemv_mod(P, lds, l + 1, vb2, nb2); if (l == 0) tgen_part(P, vb2, nb2); }
                else { convert_layer(P, lds, l + 1, vb2, nb2, 1); if (l == 0) tgen_part(P, vb2, nb2); }
            }
        }
        if (ph + 1 < Pk.ph_hi || rep + 1 < nrep) xcd_barrier(gbar);
        }

    }
}


#ifdef DBG_K
__device__ __forceinline__ float dgst(unsigned u) { return (float)(u & 0xffffu) + (float)(u >> 16); }
__global__ void dbg_dump(float* out, const unsigned char* ws) {
    const unsigned* Xu = (const unsigned*)(ws + OFF_X); const unsigned* Hu = (const unsigned*)(ws + OFF_H); const unsigned* Au = (const unsigned*)(ws + OFF_AMIX);
    const unsigned* Bu = (const unsigned*)(ws + OFF_BIG); const unsigned* Uu = (const unsigned*)(ws + OFF_U); const unsigned* Wu = (const unsigned*)(ws);
    for (size_t i = (size_t)blockIdx.x * blockDim.x + threadIdx.x; i < (size_t)NTOK * 1024; i += (size_t)gridDim.x * blockDim.x) {
        float v = 0.f;
        if (DBG_SEL & 1) v += dgst(Xu[i]);
        if (DBG_SEL & 2) v += dgst(Hu[i % 6291456]);
        if (DBG_SEL & 4) v += dgst(Au[i % 6291456]);
        if (DBG_SEL & 8) v += dgst(Bu[i]) + dgst(Bu[i + 12582912]) + dgst(Bu[(i + 25165824) % 34603008]);
        if (DBG_SEL & 16) v += dgst(Uu[i % 2113536]);
        if (DBG_SEL & 32) v += dgst(Wu[i]) + dgst(Wu[i + 12582912]) + dgst(Wu[(i + 25165824) % 28573696]);
        out[i] = v;
    }
}
#endif
extern "C" void kernel_launch(void* const* d_in, const int* in_sizes, int n_in, void* d_out, int out_size, void* d_ws, size_t ws_size, hipStream_t stream) {
    static int grid = 0;
    if (grid == 0) {
        if (n_in != 22 || ws_size < WS_NEED) { fprintf(stderr, "kernel_launch: unexpected n_in %d / ws_size %zu (need %zu)\n", n_in, ws_size, (size_t)WS_NEED); grid = -1; return; }
        int dev = 0, cus = 0, per_cu = 0;
        hipGetDevice(&dev);
        hipDeviceGetAttribute(&cus, hipDeviceAttributeMultiprocessorCount, dev);
        if (hipFuncSetAttribute((const void*)mega_fwd, hipFuncAttributeMaxDynamicSharedMemorySize, LDS_BYTES) != hipSuccess) { fprintf(stderr, "kernel_launch: hipFuncSetAttribute failed\n"); grid = -1; return; }
        hipOccupancyMaxActiveBlocksPerMultiprocessor(&per_cu, (const void*)mega_fwd, 512, LDS_BYTES);
        if (per_cu < 1) { fprintf(stderr, "kernel_launch: occupancy query says %d blocks/CU\n", per_cu); per_cu = 1; }
        (void)hipGetLastError();
        grid = cus;
    }
    if (grid < 0) return;
    Params p{};
    for (int i = 0; i < 22; ++i) p.in[i] = (const float*)d_in[i];
    p.out = (float*)d_out; p.ws = (unsigned char*)d_ws;
#if MULTI_LAUNCH
#ifdef DBG_K
    for (int ph = 0; ph < DBG_K; ++ph) {
        p.ph_lo = ph; p.ph_hi = ph + 1;
        hipLaunchKernelGGL(mega_fwd, dim3(grid), dim3(512), LDS_BYTES, stream, p);
    }
    hipLaunchKernelGGL(dbg_dump, dim3(2048), dim3(256), 0, stream, (float*)d_out, (const unsigned char*)d_ws);
#else
    for (int ph = 0; ph < NPH; ++ph) {
        p.ph_lo = ph; p.ph_hi = ph + 1;
        hipLaunchKernelGGL(mega_fwd, dim3(grid), dim3(512), LDS_BYTES, stream, p);
    }
#endif
#else
    p.ph_lo = 0; p.ph_hi = NPH;
    if (hipMemsetAsync((char*)d_ws + OFF_BAR, 0, 16384, stream) != hipSuccess) { fprintf(stderr, "kernel_launch: memset of barrier word failed\n"); return; }
    void* args[] = {&p};
    hipError_t e = hipLaunchCooperativeKernel((const void*)mega_fwd, dim3(grid), dim3(512), args, LDS_BYTES, stream);
    if (e != hipSuccess) fprintf(stderr, "cooperative launch failed: %s (grid %d)\n", hipGetErrorString(e), grid);
#endif
}
```
